# Optimizing an MI355X kernel written in HIP

```python
import math
import jax
import jax.numpy as jnp
from jax import lax
import numpy as np

D_MODEL = 1024
BATCH = 8
SEQ = 2048
DEPTH = 2

GRID_W = 64
CTX_LEN = 256

NORM_EPS = 1e-6
N_BRANCH = 3
N_MOD = 6

DA_HEADS = 4
DA_HEAD_DIM = 64
DA_V_DIM = 2 * DA_HEAD_DIM
DA_QK_COLS = DA_HEADS * 2 * DA_HEAD_DIM
DA_WIDTH = DA_HEADS * DA_V_DIM
DA_SUBLN_EPS = 1e-5
Q_BLOCK = 128
ROPE_BASE = 10000.0

SC_WIDTH = 512
SC_KSIZE = 3

RW_HEADS = 8
RW_HEAD_DIM = 64
RW_WIDTH = RW_HEADS * RW_HEAD_DIM
RW_DECAY_LORA = 64
RW_AAA_LORA = 64
RW_GATE_LORA = 160
RW_DECAY_SCALE = 0.606531
RW_GN_EPS = 64e-5
N_DIR = 2

N_EXPERTS = 32
TOP_K = 4
D_FF = 1024
SWIGLU_LIMIT = 7.0
SWIGLU_ALPHA = 1.702
MOE_BLOCK = 256

BRANCH_WIDTH = DA_WIDTH
IN_SPLITS = (DA_QK_COLS, DA_QK_COLS, DA_WIDTH, SC_WIDTH, SC_WIDTH, SC_WIDTH, RW_WIDTH, RW_WIDTH, RW_WIDTH, N_BRANCH * D_MODEL)
IN_COLS = sum(IN_SPLITS)

kernel_name = 'hybrid_diffattn_conv_rwkv7_moe_dit'


def rms_norm(x, g, eps=NORM_EPS):
    xf = x.astype(jnp.float32)
    y = xf * lax.rsqrt(jnp.mean(xf * xf, axis=-1, keepdims=True) + eps)
    return (y * g.astype(jnp.float32)).astype(x.dtype)


def modulate(x, g, shift, scale):
    return rms_norm(x, g) * (1 + scale) + shift


def split_cols(t):
    offsets = np.cumsum(IN_SPLITS)[:-1].tolist()
    return jnp.split(t, offsets, axis=-1)


def to_heads(t, n_heads):
    return t.reshape(t.shape[:-1] + (n_heads, t.shape[-1] // n_heads))


def rope_1d(t, pos):
    half = t.shape[-1] // 2
    inv = jnp.power(ROPE_BASE, -jnp.arange(half, dtype=jnp.float32) / half)
    ang = pos.astype(jnp.float32)[:, None] * inv[None, :]
    cos = jnp.cos(ang)[None, :, None, :]
    sin = jnp.sin(ang)[None, :, None, :]
    t1 = t[..., :half].astype(jnp.float32)
    t2 = t[..., half:].astype(jnp.float32)
    return jnp.concatenate([t1 * cos - t2 * sin, t1 * sin + t2 * cos], axis=-1).astype(t.dtype)


def rope_2d(t, rows, cols):
    d = t.shape[-1] // 2
    return jnp.concatenate([rope_1d(t[..., :d], rows), rope_1d(t[..., d:], cols)], axis=-1)


def qk_pair(t):
    t = t.reshape(t.shape[:-1] + (DA_HEADS, 2, DA_HEAD_DIM))
    return t[..., 0, :], t[..., 1, :]


def diff_attend(q1, q2, k1, k2, v, lam):
    scale = DA_HEAD_DIM ** -0.5
    s1 = jnp.einsum('bqhd,bkhd->bhqk', q1, k1).astype(jnp.float32) * scale
    s2 = jnp.einsum('bqhd,bkhd->bhqk', q2, k2).astype(jnp.float32) * scale
    p = jax.nn.softmax(s1, axis=-1) - lam * jax.nn.softmax(s2, axis=-1)
    return jnp.einsum('bhqk,bkhe->bqhe', p.astype(v.dtype), v)


def blocked_diff_attend(q1, q2, k1, k2, v, lam):
    b, s, h, d = q1.shape
    nb = s // Q_BLOCK

    def to_blocks(t):
        return t.reshape(b, nb, Q_BLOCK, h, d).swapaxes(0, 1)

    def one_block(qs):
        return diff_attend(qs[0], qs[1], k1, k2, v, lam)

    out = lax.map(one_block, (to_blocks(q1), to_blocks(q2)))
    return out.swapaxes(0, 1).reshape(b, s, h, v.shape[-1])


def diff_attention_branch(q, k, v, qc, kc, vc, rows, cols, lam, lam_init, subln_g, need_ctx_out):
    q1, q2 = qk_pair(q)
    k1, k2 = qk_pair(k)
    q1, q2, k1, k2 = [rope_2d(t, rows, cols) for t in (q1, q2, k1, k2)]
    k1c, k2c = qk_pair(kc)
    vh = to_heads(v, DA_HEADS)
    vhc = to_heads(vc, DA_HEADS)
    o = blocked_diff_attend(q1, q2, jnp.concatenate([k1, k1c], axis=1), jnp.concatenate([k2, k2c], axis=1),
                            jnp.concatenate([vh, vhc], axis=1), lam)
    out = (rms_norm(o, subln_g, DA_SUBLN_EPS) * (1 - lam_init)).reshape(o.shape[:2] + (DA_WIDTH,))
    out_c = None
    if need_ctx_out:
        q1c, q2c = qk_pair(qc)
        oc = diff_attend(q1c, q2c, k1c, k2c, vhc, lam)
        out_c = (rms_norm(oc, subln_g, DA_SUBLN_EPS) * (1 - lam_init)).reshape(oc.shape[:2] + (DA_WIDTH,))
    return out, out_c


def depthwise_conv3(u, w):
    return lax.conv_general_dilated(u, w[:, None, :].astype(u.dtype), window_strides=(1,), padding=((1, 1),),
                                    dimension_numbers=('NWC', 'WIO', 'NWC'), feature_group_count=u.shape[-1])


def short_conv_branch(b_gate, c_gate, xin, w):
    return b_gate * depthwise_conv3(c_gate * xin, w)


def l2_normalize(t):
    tf = t.astype(jnp.float32)
    return (tf * lax.rsqrt(jnp.maximum(jnp.sum(tf * tf, axis=-1, keepdims=True), 1e-24))).astype(t.dtype)


def rwkv_direction_terms(h, k, p, d):
    decay = jnp.exp(-RW_DECAY_SCALE * jax.nn.sigmoid(p['rw_w0'][d] + jnp.tanh(h @ p['rw_w1'][d]) @ p['rw_w2'][d]))
    a = jax.nn.sigmoid(p['rw_a0'][d] + (h @ p['rw_a1'][d]) @ p['rw_a2'][d])
    k_eff = k * (1 + (a - 1) * p['rw_k_a'])
    return to_heads(decay, RW_HEADS), to_heads(a, RW_HEADS), to_heads(k_eff, RW_HEADS)


def rwkv_scan(state0, r, decay, k, v, kk, a, reverse, emit):
    xs = tuple(t.swapaxes(0, 1) for t in (r, decay, k, v, kk, a))

    def step(s, inp):
        r_t, w_t, k_t, v_t, kk_t, a_t = inp
        s = (s * w_t[:, :, None, :]
             - jnp.einsum('bhij,bhj->bhi', s, kk_t)[..., None] * (kk_t * a_t)[:, :, None, :]
             + v_t[..., None] * k_t[:, :, None, :])
        y = jnp.einsum('bhij,bhj->bhi', s, r_t) if emit else None
        return s, y

    s_final, ys = lax.scan(step, state0, xs, reverse=reverse)
    return s_final, (ys.swapaxes(0, 1) if emit else None)


def bonus_term(r, k, v, r_k):
    return jnp.sum(r * k * r_k, axis=-1, keepdims=True) * v


def rwkv_output(y, bonus, g, p):
    yf = y.astype(jnp.float32)
    mu = jnp.mean(yf, axis=-1, keepdims=True)
    var = jnp.mean(jnp.square(yf - mu), axis=-1, keepdims=True)
    yn = ((yf - mu) * lax.rsqrt(var + RW_GN_EPS)).reshape(y.shape[:2] + (RW_WIDTH,))
    yn = (yn * p['rw_lnx_g'].astype(jnp.float32) + p['rw_lnx_b'].astype(jnp.float32)).astype(y.dtype)
    return (yn + bonus.reshape(y.shape[:2] + (RW_WIDTH,))) * g


def rwkv_branch(h, r, k, v, hc, rc, kc, vc, p, need_ctx_out):
    b = h.shape[0]
    state0 = jnp.zeros((b, RW_HEADS, RW_HEAD_DIM, RW_HEAD_DIM), h.dtype)
    rh, vh = to_heads(r, RW_HEADS), to_heads(v, RW_HEADS)
    rch, vch = to_heads(rc, RW_HEADS), to_heads(vc, RW_HEADS)
    kk = l2_normalize(to_heads(k * p['rw_k_k'], RW_HEADS))
    kkc = l2_normalize(to_heads(kc * p['rw_k_k'], RW_HEADS))
    ys, bon, ycs, bonc = [], [], [], []
    for d in range(N_DIR):
        rev = d == 1
        dc, ac, kec = rwkv_direction_terms(hc, kc, p, d)
        s_ctx, yc_d = rwkv_scan(state0, rch, dc, kec, vch, kkc, ac, rev, need_ctx_out)
        dl, al, kel = rwkv_direction_terms(h, k, p, d)
        _, y_d = rwkv_scan(s_ctx, rh, dl, kel, vh, kk, al, rev, True)
        ys.append(y_d)
        bon.append(bonus_term(rh, kel, vh, p['rw_r_k']))
        if need_ctx_out:
            ycs.append(yc_d)
            bonc.append(bonus_term(rch, kec, vch, p['rw_r_k']))
    g = jax.nn.sigmoid(h @ p['rw_g1']) @ p['rw_g2']
    out = rwkv_output(ys[0] + ys[1], bon[0] + bon[1], g, p)
    out_c = None
    if need_ctx_out:
        gc = jax.nn.sigmoid(hc @ p['rw_g1']) @ p['rw_g2']
        out_c = rwkv_output(ycs[0] + ycs[1], bonc[0] + bonc[1], gc, p)
    return out, out_c


def merge_branches(branches, gate_logits, w_branch, w_out):
    stacked = jnp.stack(branches, axis=-2)
    proj = jnp.einsum('btne,ned->btnd', stacked, w_branch)
    gates = jax.nn.sigmoid(gate_logits.reshape(gate_logits.shape[:-1] + (N_BRANCH, D_MODEL)))
    return jnp.sum(gates * proj, axis=-2) @ w_out


def token_mixer(h, hc, rows, cols, lam, lam_init, p, need_ctx_out):
    q, k, v, sb, sg, sx, rr, rk, rv, gl = split_cols(h @ p['w_in'])
    qc, kc, vc, sbc, sgc, sxc, rrc, rkc, rvc, glc = split_cols(hc @ p['w_in'])
    o_da, o_da_c = diff_attention_branch(q, k, v, qc, kc, vc, rows, cols, lam, lam_init, p['da_subln_g'], need_ctx_out)
    o_rw, o_rw_c = rwkv_branch(h, rr, rk, rv, hc, rrc, rkc, rvc, p, need_ctx_out)
    o_sc = short_conv_branch(sb, sg, sx, p['conv_w'])
    y = merge_branches((o_da, o_sc, o_rw), gl, p['w_branch'], p['w_out'])
    yc = None
    if need_ctx_out:
        o_sc_c = short_conv_branch(sbc, sgc, sxc, p['conv_w'])
        yc = merge_branches((o_da_c, o_sc_c, o_rw_c), glc, p['w_branch'], p['w_out'])
    return y, yc


def moe_ffn(tokens, router_w, router_b, w1, b1, w2, b2):
    n_tok, d_model = tokens.shape
    logits = (tokens @ router_w + router_b).astype(jnp.float32)
    top_val, top_idx = lax.top_k(logits, TOP_K)
    gates = jax.nn.softmax(top_val, axis=-1)
    n_assign = n_tok * TOP_K
    expert_of = top_idx.reshape(-1).astype(jnp.int32)
    token_of = jnp.arange(n_assign, dtype=jnp.int32) // TOP_K
    order = jnp.argsort(expert_of)
    e_sorted = expert_of[order]
    counts = jnp.bincount(expert_of, length=N_EXPERTS)
    padded = (counts + MOE_BLOCK - 1) // MOE_BLOCK * MOE_BLOCK
    start = jnp.cumsum(counts) - counts
    end_padded = jnp.cumsum(padded)
    start_padded = end_padded - padded
    dest = start_padded[e_sorted] + jnp.arange(n_assign, dtype=jnp.int32) - start[e_sorted]
    n_rows = -(-n_assign // MOE_BLOCK) * MOE_BLOCK + N_EXPERTS * MOE_BLOCK
    n_blocks = n_rows // MOE_BLOCK
    row_token = jnp.full((n_rows,), n_tok, jnp.int32).at[dest].set(token_of[order])
    row_gate = jnp.zeros((n_rows,), jnp.float32).at[dest].set(gates.reshape(-1)[order])
    block_expert = jnp.minimum(jnp.searchsorted(end_padded, jnp.arange(n_blocks) * MOE_BLOCK, side='right'), N_EXPERTS - 1)
    tokens_pad = jnp.concatenate([tokens, jnp.zeros((1, d_model), tokens.dtype)], axis=0)
    xb = tokens_pad[row_token].reshape(n_blocks, MOE_BLOCK, d_model)

    def expert_block(args):
        xblk, e = args
        hid = xblk @ w1[e] + b1[e]
        glu = jnp.minimum(hid[:, :D_FF], SWIGLU_LIMIT)
        lin = jnp.clip(hid[:, D_FF:], -SWIGLU_LIMIT, SWIGLU_LIMIT)
        return (glu * jax.nn.sigmoid(SWIGLU_ALPHA * glu) * (lin + 1)) @ w2[e] + b2[e]

    yb = lax.map(expert_block, (xb, block_expert)).reshape(n_rows, d_model)
    yb = yb * row_gate[:, None].astype(yb.dtype)
    return jax.ops.segment_sum(yb, row_token, num_segments=n_tok + 1)[:n_tok]


def layer(x, xc, silu_c, silu_cc, rows, cols, li, need_ctx_out, p):
    b, s, _ = x.shape
    mod = (silu_c @ p['w_mod'] + p['b_mod']).reshape(b, 1, N_MOD, D_MODEL)
    modc = (silu_cc @ p['w_mod'] + p['b_mod']).reshape(N_MOD, D_MODEL)
    sh_a, sc_a, g_a, sh_f, sc_f, g_f = [mod[:, :, i] for i in range(N_MOD)]
    sh_ac, sc_ac, g_ac, sh_fc, sc_fc, g_fc = [modc[i] for i in range(N_MOD)]
    lam_init = 0.8 - 0.6 * math.exp(-0.3 * li)
    lv = p['da_lambda'].astype(jnp.float32)
    lam = jnp.exp(jnp.sum(lv[0] * lv[1])) - jnp.exp(jnp.sum(lv[2] * lv[3])) + lam_init
    h = modulate(x, p['norm1_g'], sh_a, sc_a)
    hc = modulate(xc, p['norm1_g'], sh_ac, sc_ac)
    y, yc = token_mixer(h, hc, rows, cols, lam, lam_init, p, need_ctx_out)
    x = x + g_a * y
    h2 = modulate(x, p['norm2_g'], sh_f, sc_f)
    moe_w = (p['router_w'], p['router_b'], p['exp_w1'], p['exp_b1'], p['exp_w2'], p['exp_b2'])
    if need_ctx_out:
        xc = xc + g_ac * yc
        h2c = modulate(xc, p['norm2_g'], sh_fc, sc_fc)
        f = moe_ffn(jnp.concatenate([h2.reshape(-1, D_MODEL), h2c.reshape(-1, D_MODEL)], axis=0), *moe_w)
        x = x + g_f * f[:b * s].reshape(b, s, D_MODEL)
        xc = xc + g_fc * f[b * s:].reshape(xc.shape)
    else:
        x = x + g_f * moe_ffn(h2.reshape(-1, D_MODEL), *moe_w).reshape(b, s, D_MODEL)
    return x, xc


def setup_inputs(seed: int = 0) -> dict:
    key = jax.random.key(seed)
    keys = jax.random.split(key, 40)
    D = D_MODEL

    def nrm(i, shape, scale):
        return scale * jax.random.normal(keys[i], shape, jnp.float32)

    return {
        'x': nrm(0, (BATCH, SEQ, D), 1.0),
        'c': nrm(1, (BATCH, D), 1.0),
        'ctx': nrm(2, (BATCH, CTX_LEN, D), 1.0),
        'c_ctx': nrm(3, (D,), 1.0),
        'w_mod': nrm(4, (DEPTH, D, N_MOD * D), 0.5 * D ** -0.5),
        'b_mod': nrm(5, (DEPTH, N_MOD * D), 0.02),
        'norm1_g': 1.0 + nrm(6, (DEPTH, D), 0.02),
        'norm2_g': 1.0 + nrm(7, (DEPTH, D), 0.02),
        'w_in': nrm(8, (DEPTH, D, IN_COLS), D ** -0.5),
        'da_lambda': nrm(9, (DEPTH, 4, DA_HEAD_DIM), 0.1),
        'da_subln_g': 1.0 + nrm(10, (DEPTH, DA_V_DIM), 0.02),
        'conv_w': nrm(11, (DEPTH, SC_KSIZE, SC_WIDTH), SC_KSIZE ** -0.5),
        'rw_w0': nrm(12, (DEPTH, N_DIR, RW_WIDTH), 0.5),
        'rw_w1': nrm(13, (DEPTH, N_DIR, D, RW_DECAY_LORA), D ** -0.5),
        'rw_w2': nrm(14, (DEPTH, N_DIR, RW_DECAY_LORA, RW_WIDTH), 0.5 * RW_DECAY_LORA ** -0.5),
        'rw_a0': nrm(15, (DEPTH, N_DIR, RW_WIDTH), 0.5),
        'rw_a1': nrm(16, (DEPTH, N_DIR, D, RW_AAA_LORA), D ** -0.5),
        'rw_a2': nrm(17, (DEPTH, N_DIR, RW_AAA_LORA, RW_WIDTH), 0.5 * RW_AAA_LORA ** -0.5),
        'rw_g1': nrm(18, (DEPTH, D, RW_GATE_LORA), D ** -0.5),
        'rw_g2': nrm(19, (DEPTH, RW_GATE_LORA, RW_WIDTH), RW_GATE_LORA ** -0.5),
        'rw_k_k': 0.85 + nrm(20, (DEPTH, RW_WIDTH), 0.05),
        'rw_k_a': 1.0 + nrm(21, (DEPTH, RW_WIDTH), 0.05),
        'rw_r_k': nrm(22, (DEPTH, RW_HEADS, RW_HEAD_DIM), 0.1),
        'rw_lnx_g': 1.0 + nrm(23, (DEPTH, RW_WIDTH), 0.02),
        'rw_lnx_b': nrm(24, (DEPTH, RW_WIDTH), 0.02),
        'w_branch': nrm(25, (DEPTH, N_BRANCH, BRANCH_WIDTH, D), BRANCH_WIDTH ** -0.5),
        'w_out': nrm(26, (DEPTH, D, D), D ** -0.5),
        'router_w': nrm(27, (DEPTH, D, N_EXPERTS), D ** -0.5),
        'router_b': nrm(28, (DEPTH, N_EXPERTS), 0.01),
        'exp_w1': nrm(29, (DEPTH, N_EXPERTS, D, 2 * D_FF), D ** -0.5),
        'exp_b1': nrm(30, (DEPTH, N_EXPERTS, 2 * D_FF), 0.01),
        'exp_w2': nrm(31, (DEPTH, N_EXPERTS, D_FF, D), D_FF ** -0.5),
        'exp_b2': nrm(32, (DEPTH, N_EXPERTS, D), 0.01),
        'final_g': 1.0 + nrm(33, (D,), 0.02),
    }


def reference(x, c, ctx, c_ctx, w_mod, b_mod, norm1_g, norm2_g, w_in, da_lambda, da_subln_g, conv_w,
              rw_w0, rw_w1, rw_w2, rw_a0, rw_a1, rw_a2, rw_g1, rw_g2, rw_k_k, rw_k_a, rw_r_k, rw_lnx_g, rw_lnx_b,
              w_branch, w_out, router_w, router_b, exp_w1, exp_b1, exp_w2, exp_b2, final_g):
    n_tokens = x.shape[1]
    grid_rows = n_tokens // GRID_W
    rows = jnp.repeat(jnp.arange(grid_rows, dtype=jnp.int32), GRID_W)
    cols = jnp.tile(jnp.arange(GRID_W, dtype=jnp.int32), grid_rows)
    silu_c = jax.nn.silu(c)
    silu_cc = jax.nn.silu(c_ctx)
    xc = ctx
    for li in range(DEPTH):
        p = {
            'w_mod': w_mod[li], 'b_mod': b_mod[li], 'norm1_g': norm1_g[li], 'norm2_g': norm2_g[li],
            'w_in': w_in[li], 'da_lambda': da_lambda[li], 'da_subln_g': da_subln_g[li], 'conv_w': conv_w[li],
            'rw_w0': rw_w0[li], 'rw_w1': rw_w1[li], 'rw_w2': rw_w2[li],
            'rw_a0': rw_a0[li], 'rw_a1': rw_a1[li], 'rw_a2': rw_a2[li],
            'rw_g1': rw_g1[li], 'rw_g2': rw_g2[li], 'rw_k_k': rw_k_k[li], 'rw_k_a': rw_k_a[li],
            'rw_r_k': rw_r_k[li], 'rw_lnx_g': rw_lnx_g[li], 'rw_lnx_b': rw_lnx_b[li],
            'w_branch': w_branch[li], 'w_out': w_out[li],
            'router_w': router_w[li], 'router_b': router_b[li],
            'exp_w1': exp_w1[li], 'exp_b1': exp_b1[li], 'exp_w2': exp_w2[li], 'exp_b2': exp_b2[li],
        }
        x, xc = layer(x, xc, silu_c, silu_cc, rows, cols, li, li < DEPTH - 1, p)
    return rms_norm(x, final_g)
```

```cpp
#include <hip/hip_runtime.h>
#include <stdint.h>
#include <stdio.h>

typedef unsigned short bfu;
using bf16x8 = __attribute__((ext_vector_type(8))) short;
using f32x4  = __attribute__((ext_vector_type(4))) float;

constexpr int NB = 8, SEQ = 2048, CTX = 256, TB = 2304, NT = NB * TB, DM = 1024, NL = 2;
constexpr int NEXP = 32;
constexpr int NTHREADS = 256;
constexpr int LDS_MAIN = 73728;
constexpr int LDS_EXTRA = 512;
constexpr int LDS_BYTES = LDS_MAIN + LDS_EXTRA + 16;

#ifndef N_LAUNCH_MODE
#define N_LAUNCH_MODE 0
#endif

constexpr size_t al(size_t x) { return (x + 255) & ~(size_t)255; }
constexpr size_t WS_CTL    = 0;
constexpr size_t CTL_BYTES = 32768;
constexpr size_t CNT_OFF   = 16384;
constexpr size_t WS_MOD    = WS_CTL + CTL_BYTES;
constexpr size_t WS_TAB    = al(WS_MOD + (size_t)2 * 9 * 6144 * 4);
constexpr size_t WS_WINT   = al(WS_TAB + 2 * 64 * 16 * 4 + 64);
constexpr size_t WS_W2T    = al(WS_WINT + (size_t)2 * 8192 * 1024 * 2);
constexpr size_t WS_A2T    = al(WS_W2T + (size_t)2 * 2 * 512 * 64 * 2);
constexpr size_t WS_G2T    = al(WS_A2T + (size_t)2 * 2 * 512 * 64 * 2);
constexpr size_t WS_WBT    = al(WS_G2T + (size_t)2 * 512 * 192 * 2);
constexpr size_t WS_WOT    = al(WS_WBT + (size_t)2 * 3 * 1024 * 512 * 2);
constexpr size_t WS_RHI    = al(WS_WOT + (size_t)2 * 1024 * 1024 * 2);
constexpr size_t WS_RLO    = al(WS_RHI + (size_t)2 * 128 * 1024 * 2);
constexpr size_t WS_W1T    = al(WS_RLO + (size_t)2 * 128 * 1024 * 2);
constexpr size_t WS_W2ET   = al(WS_W1T + (size_t)2 * 32 * 2048 * 1024 * 2);
constexpr size_t WS_XRES   = al(WS_W2ET + (size_t)2 * 32 * 1024 * 1024 * 2);
constexpr size_t WS_H      = al(WS_XRES + (size_t)NT * 1024 * 4);
constexpr size_t SZ512     = (size_t)NT * 512 * 2;
constexpr size_t WS_Q      = al(WS_H + (size_t)NT * 1024 * 2);
constexpr size_t WS_K      = al(WS_Q + SZ512);
constexpr size_t WS_VT     = al(WS_K + SZ512);
constexpr size_t WS_SB     = al(WS_VT + SZ512);
constexpr size_t WS_RR     = al(WS_SB + 3 * SZ512);
constexpr size_t WS_RK     = al(WS_RR + SZ512);
constexpr size_t WS_RV     = al(WS_RK + SZ512);
constexpr size_t WS_KKB    = al(WS_RV + SZ512);
constexpr size_t WS_GL     = al(WS_KKB + SZ512);
constexpr size_t WS_LORA   = al(WS_GL + (size_t)NT * 3072 * 2);
constexpr size_t WS_WDEC   = al(WS_LORA + SZ512);
constexpr size_t WS_BV     = al(WS_WDEC + 2 * SZ512);
constexpr size_t WS_KE     = al(WS_BV + 2 * SZ512);
constexpr size_t WS_GG     = al(WS_KE + 2 * SZ512);
constexpr size_t WS_Y      = al(WS_GG + SZ512);
constexpr size_t WS_ODA    = al(WS_Y + (size_t)2 * NT * 512 * 4);
constexpr size_t WS_MB     = al(WS_ODA + 3 * SZ512);
constexpr size_t WS_H2HI   = al(WS_MB + (size_t)NT * 1024 * 2);
constexpr size_t WS_H2LO   = al(WS_H2HI + (size_t)NT * 1024 * 2);
constexpr size_t WS_LOG    = al(WS_H2LO + (size_t)NT * 1024 * 2);
constexpr size_t WS_TOKL   = al(WS_LOG + (size_t)NT * 32 * 4);
constexpr size_t WS_GATE   = al(WS_TOKL + (size_t)32 * NT * 4);
constexpr size_t WS_ACT    = al(WS_GATE + (size_t)NT * 4 * 4);
constexpr size_t WS_YB     = al(WS_ACT + (size_t)(NT * 4 + 128) * 1024 * 2);
constexpr size_t WS_END    = al(WS_YB + (size_t)NT * 4 * 1024 * 2);

struct Args {
    const float* in[34];
    float* out;
    unsigned char* ws;
    int ph_lo, ph_hi;
};

__device__ __forceinline__ bfu f2bf(float f) {
    unsigned u = __float_as_uint(f);
    u += 0x7FFFu + ((u >> 16) & 1u);
    return (bfu)(u >> 16);
}
__device__ __forceinline__ float bf2f(bfu b) { return __uint_as_float(((unsigned)b) << 16); }
__device__ __forceinline__ unsigned pack2(float a, float b) { return (unsigned)f2bf(a) | ((unsigned)f2bf(b) << 16); }
__device__ __forceinline__ float bflo(unsigned u) { return __uint_as_float(u << 16); }
__device__ __forceinline__ float bfhi(unsigned u) { return __uint_as_float(u & 0xFFFF0000u); }
__device__ __forceinline__ float sigmoidf_(float x) { return 1.0f / (1.0f + __expf(-x)); }
__device__ __forceinline__ float tanhf_(float x) { float e = __expf(2.0f * x); return 1.0f - 2.0f / (e + 1.0f); }
__device__ __forceinline__ float wave_sum(float v) {
#pragma unroll
    for (int o = 32; o >= 1; o >>= 1) v += __shfl_xor(v, o);
    return v;
}
template <int CTRL>
__device__ __forceinline__ float dppf(float x) {
    return __int_as_float(__builtin_amdgcn_update_dpp(0, __float_as_int(x), CTRL, 0xF, 0xF, true));
}
__device__ __forceinline__ float red16(float x) {
    x += dppf<0xB1>(x);
    x += dppf<0x4E>(x);
    x += dppf<0x124>(x);
    x += dppf<0x128>(x);
    return x;
}

#define XB_TMO      128
#define XB_XCNT(j)  (256  + 64 * (j))
#define XB_XSUB(j)  (1280 + 64 * (j))
#define XB_XGEN(j)  (2304 + 64 * (j))
#define XB_TOP      3328
#define XB_TOPGEN   3392
#define XCD_BAR_WORDS 3456
#define XB_SPIN_CAP (1u << 22)
#define LAS __attribute__((address_space(3)))

__device__ __forceinline__ unsigned xb_ld(unsigned* p)              { return __hip_atomic_load(p, __ATOMIC_RELAXED, __HIP_MEMORY_SCOPE_AGENT); }
__device__ __forceinline__ unsigned xb_add(unsigned* p, unsigned v) { return __hip_atomic_fetch_add(p, v, __ATOMIC_RELAXED, __HIP_MEMORY_SCOPE_AGENT); }
__device__ __forceinline__ unsigned xb_xcc_id() { return (unsigned)__builtin_amdgcn_s_getreg((3 << 11) | 20) & 0xFu; }
#define XB_SPIN(cond, bar) do { unsigned _sp = 0; while (cond) { __builtin_amdgcn_s_sleep(1); \
    if ((++_sp & 255u) == 0u) { if (xb_ld(&(bar)[XB_TMO])) break; if (_sp > XB_SPIN_CAP) { atomicAdd(&(bar)[XB_TMO], 1u); break; } } } } while (0)

struct XcdBarrier { unsigned* bar; unsigned x; volatile LAS unsigned* st; };

__device__ __forceinline__ XcdBarrier xcd_barrier_post(unsigned* bar, volatile LAS unsigned* st) {
    XcdBarrier b; b.bar = bar; b.x = xb_xcc_id(); b.st = st;
    if (threadIdx.x == 0) (void)xb_add(&bar[XB_XCNT(b.x)], 1u);
    return b;
}
__device__ __forceinline__ void xcd_barrier_complete(unsigned* bar, unsigned x, unsigned& nloc, unsigned& nx) {
    const unsigned G = gridDim.x * gridDim.y * gridDim.z;
    unsigned sum, cnt, mine, sp = 0u;
    for (;;) {
        sum = 0u; cnt = 0u; mine = 0u;
#pragma unroll
        for (unsigned j = 0; j < 16; ++j) { const unsigned c = xb_ld(&bar[XB_XCNT(j)]); sum += c; cnt += (c > 0u) ? 1u : 0u; mine = (j == x) ? c : mine; }
        if (sum == G) break;
        __builtin_amdgcn_s_sleep(1);
        if ((++sp & 255u) == 0u) { if (xb_ld(&bar[XB_TMO])) break; if (sp > XB_SPIN_CAP) { atomicAdd(&bar[XB_TMO], 1u); break; } }
    }
    nloc = mine > 0u ? mine : 1u; nx = cnt > 0u ? cnt : 1u;
}
__device__ __forceinline__ void xcd_barrier(const XcdBarrier& b) {
    asm volatile("s_waitcnt vmcnt(0)" ::: "memory");
    __syncthreads();
    if (threadIdx.x == 0) {
        unsigned* bar = b.bar;
        __builtin_amdgcn_s_waitcnt(0);
        unsigned nloc = b.st[0], nx = b.st[1];
        if (nloc == 0u) { xcd_barrier_complete(bar, b.x, nloc, nx); b.st[0] = nloc; b.st[1] = nx; }
        const unsigned old = xb_add(&bar[XB_XSUB(b.x)], 1u);
        const unsigned gen = old / nloc;
        if (old + 1u == (gen + 1u) * nloc) {
            __builtin_amdgcn_fence(__ATOMIC_RELEASE, "agent");
            asm volatile("s_waitcnt vmcnt(0)" ::: "memory");
            const unsigned og = xb_add(&bar[XB_TOP], 1u);
            const unsigned tg = og / nx;
            if (og + 1u == (tg + 1u) * nx) xb_add(&bar[XB_TOPGEN], 1u);
            else XB_SPIN(xb_ld(&bar[XB_TOPGEN]) == tg, bar);
            __builtin_amdgcn_fence(__ATOMIC_ACQUIRE, "agent");
            xb_add(&bar[XB_XGEN(b.x)], 1u);
            asm volatile("s_waitcnt vmcnt(0)" ::: "memory");
        } else {
            XB_SPIN(xb_ld(&bar[XB_XGEN(b.x)]) == gen, bar);
            __builtin_amdgcn_fence(__ATOMIC_ACQUIRE, "agent");
            asm volatile("s_waitcnt vmcnt(0)" ::: "memory");
        }
    }
    __syncthreads();
}

constexpr int LROW = 144;
constexpr int LTILE = 128 * LROW;

template <int NI>
__device__ __forceinline__ void gemm_loop(f32x4 (&acc)[4][NI], const bfu* __restrict__ A, int lda, const int (&arow)[4],
                                          const bfu* __restrict__ Bt, int ldb, int n0, int K, char* smem, int tid) {
    const int kc = tid & 7, tr = tid >> 3;
    const int wave = tid >> 6, lane = tid & 63, wm = wave >> 1, wn = wave & 1, g = lane >> 4, c = lane & 15;
    size_t aoff[4], boff[NI];
#pragma unroll
    for (int i = 0; i < 4; ++i) aoff[i] = (size_t)arow[i] * lda + kc * 8;
#pragma unroll
    for (int i = 0; i < NI; ++i) boff[i] = (size_t)(n0 + tr + 32 * i) * ldb + kc * 8;
    const int wofs = tr * LROW + kc * 16;
    const int aofs = (wm * 64 + c) * LROW + g * 16;
    const int bofs = (wn * (16 * NI) + c) * LROW + g * 16;
    const int nk = K >> 6;
    uint4 ra[4], rb[NI];
#pragma unroll
    for (int i = 0; i < 4; ++i) ra[i] = *(const uint4*)(A + aoff[i]);
#pragma unroll
    for (int i = 0; i < NI; ++i) rb[i] = *(const uint4*)(Bt + boff[i]);
#pragma unroll
    for (int i = 0; i < 4; ++i) *(uint4*)(smem + wofs + i * 32 * LROW) = ra[i];
#pragma unroll
    for (int i = 0; i < NI; ++i) *(uint4*)(smem + 2 * LTILE + wofs + i * 32 * LROW) = rb[i];
    __syncthreads();
    for (int kt = 0; kt < nk; ++kt) {
        const int cur = kt & 1;
        const bool more = (kt + 1 < nk);
        if (more) {
#pragma unroll
            for (int i = 0; i < 4; ++i) ra[i] = *(const uint4*)(A + aoff[i] + (size_t)(kt + 1) * 64);
#pragma unroll
            for (int i = 0; i < NI; ++i) rb[i] = *(const uint4*)(Bt + boff[i] + (size_t)(kt + 1) * 64);
        }
        const char* As = smem + cur * LTILE;
        const char* Bs = smem + 2 * LTILE + cur * LTILE;
#pragma unroll
        for (int ks = 0; ks < 2; ++ks) {
            bf16x8 af[4], bq[NI];
#pragma unroll
            for (int mi = 0; mi < 4; ++mi) af[mi] = *(const bf16x8*)(As + aofs + mi * 16 * LROW + ks * 64);
#pragma unroll
            for (int ni = 0; ni < NI; ++ni) bq[ni] = *(const bf16x8*)(Bs + bofs + ni * 16 * LROW + ks * 64);
#pragma unroll
            for (int mi = 0; mi < 4; ++mi)
#pragma unroll
                for (int ni = 0; ni < NI; ++ni)
                    acc[mi][ni] = __builtin_amdgcn_mfma_f32_16x16x32_bf16(af[mi], bq[ni], acc[mi][ni], 0, 0, 0);
        }
        if (more) {
            char* Aw = smem + (cur ^ 1) * LTILE;
            char* Bw = smem + 2 * LTILE + (cur ^ 1) * LTILE;
#pragma unroll
            for (int i = 0; i < 4; ++i) *(uint4*)(Aw + wofs + i * 32 * LROW) = ra[i];
#pragma unroll
            for (int i = 0; i < NI; ++i) *(uint4*)(Bw + wofs + i * 32 * LROW) = rb[i];
        }
        __syncthreads();
    }
}
template <int NI>
__device__ __forceinline__ void zero_acc(f32x4 (&acc)[4][NI]) {
#pragma unroll
    for (int mi = 0; mi < 4; ++mi)
#pragma unroll
        for (int ni = 0; ni < NI; ++ni) acc[mi][ni] = (f32x4){0.f, 0.f, 0.f, 0.f};
}
__device__ __forceinline__ void ident_rows(int (&arow)[4], int m0, int tid) {
#pragma unroll
    for (int i = 0; i < 4; ++i) arow[i] = m0 + (tid >> 3) + 32 * i;
}

struct TJob { const float* src; bfu* dst; bfu* dst2; int K, N, lds, ldd, Kd, Nd, mode; };

__device__ __forceinline__ void tr_tile(const TJob& jb, int tk, int tn, char* smem, int tid) {
    float* tile = (float*)smem;
    const int k0 = tk * 64, n0 = tn * 64;
    __syncthreads();
#pragma unroll
    for (int i = 0; i < 16; ++i) {
        const int kk = (tid >> 6) + 4 * i, nn = tid & 63;
        const int k = k0 + kk, n = n0 + nn;
        int ns = n;
        if (jb.mode == 1) { const int G = n >> 5, hh = (n >> 4) & 1, ii = n & 15; ns = hh * 1024 + G * 16 + ii; }
        float v = 0.f;
        if (k < jb.K && n < jb.N) v = jb.src[(size_t)k * jb.lds + ns];
        tile[kk * 65 + nn] = v;
    }
    __syncthreads();
#pragma unroll
    for (int i = 0; i < 16; ++i) {
        const int nn = (tid >> 6) + 4 * i, kk = tid & 63;
        const float v = tile[kk * 65 + nn];
        const size_t o = (size_t)(n0 + nn) * jb.ldd + k0 + kk;
        const bfu hi = f2bf(v);
        jb.dst[o] = hi;
        if (jb.mode == 2) jb.dst2[o] = f2bf(v - bf2f(hi));
    }
}

__device__ __forceinline__ void misc_job(const Args& a, int j, TJob& jb) {
    const int l = j / 16, q = j % 16;
    unsigned char* ws = a.ws;
    jb.dst2 = nullptr; jb.mode = 0;
    bfu* wint = (bfu*)(ws + WS_WINT) + (size_t)l * 8192 * 1024;
    if (q == 0) { jb.src = a.in[8] + (size_t)l * 1024 * 7680; jb.K = 1024; jb.N = 7680; jb.lds = 7680; jb.dst = wint; jb.ldd = 1024; jb.Kd = 1024; jb.Nd = 7680; }
    else if (q <= 2) { const int d = q - 1; jb.src = a.in[13] + (size_t)(l * 2 + d) * 1024 * 64; jb.K = 1024; jb.N = 64; jb.lds = 64; jb.dst = wint + (size_t)(7680 + 64 * d) * 1024; jb.ldd = 1024; jb.Kd = 1024; jb.Nd = 64; }
    else if (q <= 4) { const int d = q - 3; jb.src = a.in[16] + (size_t)(l * 2 + d) * 1024 * 64; jb.K = 1024; jb.N = 64; jb.lds = 64; jb.dst = wint + (size_t)(7808 + 64 * d) * 1024; jb.ldd = 1024; jb.Kd = 1024; jb.Nd = 64; }
    else if (q == 5) { jb.src = a.in[18] + (size_t)l * 1024 * 160; jb.K = 1024; jb.N = 160; jb.lds = 160; jb.dst = wint + (size_t)7936 * 1024; jb.ldd = 1024; jb.Kd = 1024; jb.Nd = 256; }
    else if (q <= 7) { const int d = q - 6; jb.src = a.in[14] + (size_t)(l * 2 + d) * 64 * 512; jb.K = 64; jb.N = 512; jb.lds = 512; jb.dst = (bfu*)(ws + WS_W2T) + (size_t)(l * 2 + d) * 512 * 64; jb.ldd = 64; jb.Kd = 64; jb.Nd = 512; }
    else if (q <= 9) { const int d = q - 8; jb.src = a.in[17] + (size_t)(l * 2 + d) * 64 * 512; jb.K = 64; jb.N = 512; jb.lds = 512; jb.dst = (bfu*)(ws + WS_A2T) + (size_t)(l * 2 + d) * 512 * 64; jb.ldd = 64; jb.Kd = 64; jb.Nd = 512; }
    else if (q == 10) { jb.src = a.in[19] + (size_t)l * 160 * 512; jb.K = 160; jb.N = 512; jb.lds = 512; jb.dst = (bfu*)(ws + WS_G2T) + (size_t)l * 512 * 192; jb.ldd = 192; jb.Kd = 192; jb.Nd = 512; }
    else if (q <= 13) { const int n = q - 11; jb.src = a.in[25] + (size_t)(l * 3 + n) * 512 * 1024; jb.K = 512; jb.N = 1024; jb.lds = 1024; jb.dst = (bfu*)(ws + WS_WBT) + (size_t)(l * 3 + n) * 1024 * 512; jb.ldd = 512; jb.Kd = 512; jb.Nd = 1024; }
    else if (q == 14) { jb.src = a.in[26] + (size_t)l * 1024 * 1024; jb.K = 1024; jb.N = 1024; jb.lds = 1024; jb.dst = (bfu*)(ws + WS_WOT) + (size_t)l * 1024 * 1024; jb.ldd = 1024; jb.Kd = 1024; jb.Nd = 1024; }
    else { jb.src = a.in[27] + (size_t)l * 1024 * 32; jb.K = 1024; jb.N = 32; jb.lds = 32; jb.dst = (bfu*)(ws + WS_RHI) + (size_t)l * 128 * 1024; jb.dst2 = (bfu*)(ws + WS_RLO) + (size_t)l * 128 * 1024; jb.ldd = 1024; jb.Kd = 1024; jb.Nd = 128; jb.mode = 2; }
}

__device__ __forceinline__ void phase_prep(const Args& a, char* smem, int tid, int bid, int nb) {
    unsigned char* ws = a.ws;
    const int n_exp_tiles = 2 * 32 * 768;
    for (int it = bid; it < n_exp_tiles; it += nb) {
        const int le = it / 768, r = it % 768;
        TJob jb; jb.dst2 = nullptr;
        int tk, tn;
        if (r < 512) {
            jb.src = a.in[29] + (size_t)le * 1024 * 2048; jb.K = 1024; jb.N = 2048; jb.lds = 2048; jb.mode = 1;
            jb.dst = (bfu*)(ws + WS_W1T) + (size_t)le * 2048 * 1024; jb.ldd = 1024; jb.Kd = 1024; jb.Nd = 2048;
            tk = r >> 5; tn = r & 31;
        } else {
            const int r2 = r - 512;
            jb.src = a.in[31] + (size_t)le * 1024 * 1024; jb.K = 1024; jb.N = 1024; jb.lds = 1024; jb.mode = 0;
            jb.dst = (bfu*)(ws + WS_W2ET) + (size_t)le * 1024 * 1024; jb.ldd = 1024; jb.Kd = 1024; jb.Nd = 1024;
            tk = r2 >> 4; tn = r2 & 15;
        }
        tr_tile(jb, tk, tn, smem, tid);
    }
    {
        int base = 0;
        for (int j = 0; j < 32; ++j) {
            TJob jb; misc_job(a, j, jb);
            const int tks = jb.Kd >> 6, tns = jb.Nd >> 6, nt = tks * tns;
            int first = ((bid - base) % nb + nb) % nb;
            for (int t = first; t < nt; t += nb) tr_tile(jb, t / tns, t % tns, smem, tid);
            base = (base + nt) % nb;
        }
    }
    __syncthreads();
    for (int it = bid; it < 192; it += nb) {
        const int l = it / 96, jb0 = (it % 96) * 64;
        float* sl = (float*)smem;
        float* red = (float*)(smem + 36864);
        __syncthreads();
        for (int i = tid; i < 9 * 1024; i += NTHREADS) {
            const int m = i >> 10, k = i & 1023;
            const float v = (m < 8) ? a.in[1][m * 1024 + k] : a.in[3][k];
            sl[i] = v / (1.0f + __expf(-v));
        }
        __syncthreads();
        const int kq = tid >> 4, jv = tid & 15;
        float acc[9][4];
#pragma unroll
        for (int m = 0; m < 9; ++m) { acc[m][0] = 0.f; acc[m][1] = 0.f; acc[m][2] = 0.f; acc[m][3] = 0.f; }
        const float* wm = a.in[4] + (size_t)l * 1024 * 6144 + jb0 + jv * 4;
#pragma unroll 4
        for (int kk = 0; kk < 64; ++kk) {
            const int k = kq * 64 + kk;
            const float4 w = *(const float4*)(wm + (size_t)k * 6144);
#pragma unroll
            for (int m = 0; m < 9; ++m) {
                const float s = sl[m * 1024 + k];
                acc[m][0] += s * w.x; acc[m][1] += s * w.y; acc[m][2] += s * w.z; acc[m][3] += s * w.w;
            }
        }
#pragma unroll
        for (int m = 0; m < 9; ++m)
#pragma unroll
            for (int e = 0; e < 4; ++e) red[(kq * 9 + m) * 64 + jv * 4 + e] = acc[m][e];
        __syncthreads();
        for (int i = tid; i < 9 * 64; i += NTHREADS) {
            const int m = i >> 6, jj = i & 63;
            float s = 0.f;
#pragma unroll
            for (int q = 0; q < 16; ++q) s += red[(q * 9 + m) * 64 + jj];
            ((float*)(ws + WS_MOD))[(size_t)(l * 9 + m) * 6144 + jb0 + jj] = s + a.in[5][l * 6144 + jb0 + jj];
        }
    }
    if (bid == 0) {
        float* tab = (float*)(ws + WS_TAB);
        for (int i = tid; i < 1024; i += NTHREADS) {
            const int pos = i >> 4, j = i & 15;
            const float inv = exp2f(-(float)j * (13.287712379549449f / 16.0f));
            const double ang = (double)((float)pos * inv);
            double rev = ang * 0.15915494309189535;
            rev -= floor(rev);
            tab[i] = __builtin_amdgcn_cosf((float)rev);
            tab[1024 + i] = __builtin_amdgcn_sinf((float)rev);
        }
        if (tid < 2) {
            const float* lv = a.in[9] + tid * 256;
            float s1 = 0.f, s2 = 0.f;
            for (int i = 0; i < 64; ++i) { s1 += lv[i] * lv[64 + i]; s2 += lv[128 + i] * lv[192 + i]; }
            const float lam_init = (tid == 0) ? 0.2f : (0.8f - 0.6f * 0.7408182206817179f);
            tab[2048 + tid] = __expf(s1) - __expf(s2) + lam_init;
        }
    }
}

__device__ __forceinline__ void store_h_row(bfu* dst, const float (&y)[16], int lane) {
#pragma unroll
    for (int i = 0; i < 4; ++i) {
        uint2 p; p.x = pack2(y[i * 4 + 0], y[i * 4 + 1]); p.y = pack2(y[i * 4 + 2], y[i * 4 + 3]);
        *(uint2*)(dst + i * 256 + lane * 4) = p;
    }
}
__device__ __forceinline__ void norm_mod(const float (&v)[16], float (&y)[16], const float* g, const float* shift, const float* scale, int lane) {
    float ss = 0.f;
#pragma unroll
    for (int i = 0; i < 16; ++i) ss += v[i] * v[i];
    ss = wave_sum(ss);
    const float rs = rsqrtf(ss * (1.0f / 1024.0f) + 1e-6f);
#pragma unroll
    for (int i = 0; i < 4; ++i) {
        const int col = i * 256 + lane * 4;
        const float4 gg = *(const float4*)(g + col);
        const float4 sh = *(const float4*)(shift + col);
        const float4 sc = *(const float4*)(scale + col);
        y[i * 4 + 0] = v[i * 4 + 0] * rs * gg.x * (1.0f + sc.x) + sh.x;
        y[i * 4 + 1] = v[i * 4 + 1] * rs * gg.y * (1.0f + sc.y) + sh.y;
        y[i * 4 + 2] = v[i * 4 + 2] * rs * gg.z * (1.0f + sc.z) + sh.z;
        y[i * 4 + 3] = v[i * 4 + 3] * rs * gg.w * (1.0f + sc.w) + sh.w;
    }
}

__device__ __forceinline__ void phase_norm1_l0(const Args& a, int tid, int bid, int nb) {
    const int wave = tid >> 6, lane = tid & 63;
    float* xres = (float*)(a.ws + WS_XRES);
    bfu* H = (bfu*)(a.ws + WS_H);
    const float* mod = (const float*)(a.ws + WS_MOD);
    for (int row = bid * 4 + wave; row < NT; row += nb * 4) {
        const int b = row / TB, t = row % TB;
        const float* src = (t < SEQ) ? (a.in[0] + ((size_t)b * SEQ + t) * 1024) : (a.in[2] + ((size_t)b * CTX + (t - SEQ)) * 1024);
        const int m = (t < SEQ) ? b : 8;
        float v[16], y[16];
#pragma unroll
        for (int i = 0; i < 4; ++i) {
            const float4 x4 = *(const float4*)(src + i * 256 + lane * 4);
            v[i * 4 + 0] = x4.x; v[i * 4 + 1] = x4.y; v[i * 4 + 2] = x4.z; v[i * 4 + 3] = x4.w;
            *(float4*)(xres + (size_t)row * 1024 + i * 256 + lane * 4) = x4;
        }
        const float* md = mod + (size_t)(0 * 9 + m) * 6144;
        norm_mod(v, y, a.in[6], md + 0, md + 1024, lane);
        store_h_row(H + (size_t)row * 1024, y, lane);
    }
}

__device__ __forceinline__ void phase_norm2(const Args& a, int l, int tid, int bid, int nb) {
    const int wave = tid >> 6, lane = tid & 63;
    const float* xres = (const float*)(a.ws + WS_XRES);
    bfu* HI = (bfu*)(a.ws + WS_H2HI);
    bfu* LO = (bfu*)(a.ws + WS_H2LO);
    const float* mod = (const float*)(a.ws + WS_MOD);
    for (int row = bid * 4 + wave; row < NT; row += nb * 4) {
        const int b = row / TB, t = row % TB;
        if (l == 1 && t >= SEQ) continue;
        const int m = (t < SEQ) ? b : 8;
        float v[16], y[16], lo[16];
#pragma unroll
        for (int i = 0; i < 4; ++i) {
            const float4 x4 = *(const float4*)(xres + (size_t)row * 1024 + i * 256 + lane * 4);
            v[i * 4 + 0] = x4.x; v[i * 4 + 1] = x4.y; v[i * 4 + 2] = x4.z; v[i * 4 + 3] = x4.w;
        }
        const float* md = mod + (size_t)(l * 9 + m) * 6144;
        norm_mod(v, y, a.in[7] + l * 1024, md + 3 * 1024, md + 4 * 1024, lane);
#pragma unroll
        for (int i = 0; i < 16; ++i) lo[i] = y[i] - bf2f(f2bf(y[i]));
        store_h_row(HI + (size_t)row * 1024, y, lane);
        store_h_row(LO + (size_t)row * 1024, lo, lane);
    }
}

__device__ __forceinline__ void phase_combine(const Args& a, int l, int tid, int bid, int nb) {
    const int wave = tid >> 6, lane = tid & 63;
    float* xres = (float*)(a.ws + WS_XRES);
    const bfu* YB = (const bfu*)(a.ws + WS_YB);
    bfu* H = (bfu*)(a.ws + WS_H);
    const float* mod = (const float*)(a.ws + WS_MOD);
    for (int row = bid * 4 + wave; row < NT; row += nb * 4) {
        const int b = row / TB, t = row % TB;
        if (l == 1 && t >= SEQ) continue;
        const int m = (t < SEQ) ? b : 8;
        const float* md = mod + (size_t)(l * 9 + m) * 6144;
        float v[16], y[16];
#pragma unroll
        for (int i = 0; i < 4; ++i) {
            const int col = i * 256 + lane * 4;
            const float4 x4 = *(const float4*)(xres + (size_t)row * 1024 + col);
            float f0 = 0.f, f1 = 0.f, f2 = 0.f, f3 = 0.f;
#pragma unroll
            for (int k = 0; k < 4; ++k) {
                const uint2 p = *(const uint2*)(YB + ((size_t)row * 4 + k) * 1024 + col);
                f0 += bflo(p.x); f1 += bfhi(p.x); f2 += bflo(p.y); f3 += bfhi(p.y);
            }
            const float4 gf = *(const float4*)(md + 5 * 1024 + col);
            v[i * 4 + 0] = x4.x + gf.x * f0; v[i * 4 + 1] = x4.y + gf.y * f1;
            v[i * 4 + 2] = x4.z + gf.z * f2; v[i * 4 + 3] = x4.w + gf.w * f3;
        }
        if (l == 0) {
#pragma unroll
            for (int i = 0; i < 4; ++i)
                *(float4*)(xres + (size_t)row * 1024 + i * 256 + lane * 4) = make_float4(v[i * 4], v[i * 4 + 1], v[i * 4 + 2], v[i * 4 + 3]);
            const float* md1 = mod + (size_t)(1 * 9 + m) * 6144;
            norm_mod(v, y, a.in[6] + 1024, md1 + 0, md1 + 1024, lane);
            store_h_row(H + (size_t)row * 1024, y, lane);
        } else {
            float ss = 0.f;
#pragma unroll
            for (int i = 0; i < 16; ++i) ss += v[i] * v[i];
            ss = wave_sum(ss);
            const float rs = rsqrtf(ss * (1.0f / 1024.0f) + 1e-6f);
            float* o = a.out + ((size_t)b * SEQ + t) * 1024;
#pragma unroll
            for (int i = 0; i < 4; ++i) {
                const int col = i * 256 + lane * 4;
                const float4 gg = *(const float4*)(a.in[33] + col);
                *(float4*)(o + col) = make_float4(v[i * 4] * rs * gg.x, v[i * 4 + 1] * rs * gg.y, v[i * 4 + 2] * rs * gg.z, v[i * 4 + 3] * rs * gg.w);
            }
        }
    }
}

__device__ __forceinline__ void phase_gemm_in(const Args& a, int l, char* smem, int tid, int bid, int nb) {
    unsigned char* ws = a.ws;
    const bfu* H = (const bfu*)(ws + WS_H);
    const bfu* W = (const bfu*)(ws + WS_WINT) + (size_t)l * 8192 * 1024;
    const float* tab = (const float*)(ws + WS_TAB);
    const int wave = tid >> 6, lane = tid & 63, wm = wave >> 1, wn = wave & 1, g = lane >> 4, c = lane & 15;
    for (int it = bid; it < 144 * 64; it += nb) {
        const int mt = it >> 6, nt = it & 63;
        const int m0 = mt * 128, n0 = nt * 128;
        int arow[4]; ident_rows(arow, m0, tid);
        f32x4 acc[4][4]; zero_acc<4>(acc);
        gemm_loop<4>(acc, H, 1024, arow, W, 1024, n0, 1024, smem, tid);
        const int colbase = n0 + wn * 64;
        const int rowbase = m0 + wm * 64;
        if (nt < 8) {
            bfu* dst = (bfu*)(ws + (nt < 4 ? WS_Q : WS_K));
            const int cc = colbase & 511;
            const float qs = (nt < 4) ? 0.18033688011112042f : 1.0f;
#pragma unroll
            for (int mi = 0; mi < 4; ++mi)
#pragma unroll
                for (int r = 0; r < 4; ++r) {
                    const int row = rowbase + mi * 16 + g * 4 + r;
                    const int t = row % TB;
                    float x0 = acc[mi][0][r], x1 = acc[mi][1][r], x2 = acc[mi][2][r], x3 = acc[mi][3][r];
                    if (t < SEQ) {
                        const int pr = t >> 6, pc = t & 63;
                        const float cr = tab[pr * 16 + c], sr = tab[1024 + pr * 16 + c];
                        const float c2 = tab[pc * 16 + c], s2 = tab[1024 + pc * 16 + c];
                        const float y0 = x0 * cr - x1 * sr, y1 = x0 * sr + x1 * cr;
                        const float y2 = x2 * c2 - x3 * s2, y3 = x2 * s2 + x3 * c2;
                        x0 = y0; x1 = y1; x2 = y2; x3 = y3;
                    }
                    bfu* d = dst + (size_t)row * 512 + cc + c;
                    d[0] = f2bf(x0 * qs); d[16] = f2bf(x1 * qs); d[32] = f2bf(x2 * qs); d[48] = f2bf(x3 * qs);
                }
        } else if (nt < 12) {
            bfu* VT = (bfu*)(ws + WS_VT);
            const int b = m0 / TB;
            const int tb0 = (m0 % TB) + wm * 64;
#pragma unroll
            for (int ni = 0; ni < 4; ++ni) {
                const int cc = colbase - 1024 + ni * 16 + c;
                const int head = cc >> 7, dim = cc & 127;
                bfu* d = VT + ((size_t)(b * 4 + head) * 128 + dim) * TB;
#pragma unroll
                for (int mi = 0; mi < 4; ++mi) {
                    uint2 p; p.x = pack2(acc[mi][ni][0], acc[mi][ni][1]); p.y = pack2(acc[mi][ni][2], acc[mi][ni][3]);
                    *(uint2*)(d + tb0 + mi * 16 + g * 4) = p;
                }
            }
        } else if (nt < 36) {
            bfu* dst; int cc;
            if (nt < 24) { const int q = colbase - 1536; dst = (bfu*)(ws + WS_SB) + (size_t)(q >> 9) * NT * 512; cc = q & 511; }
            else if (nt < 28) { dst = (bfu*)(ws + WS_RR); cc = colbase - 3072; }
            else if (nt < 32) { dst = (bfu*)(ws + WS_RK); cc = colbase - 3584; }
            else { dst = (bfu*)(ws + WS_RV); cc = colbase - 4096; }
#pragma unroll
            for (int mi = 0; mi < 4; ++mi)
#pragma unroll
                for (int ni = 0; ni < 4; ++ni)
#pragma unroll
                    for (int r = 0; r < 4; ++r) {
                        const int row = rowbase + mi * 16 + g * 4 + r;
                        dst[(size_t)row * 512 + cc + ni * 16 + c] = f2bf(acc[mi][ni][r]);
                    }
            if (nt >= 28 && nt < 32) {
                bfu* KKB = (bfu*)(ws + WS_KKB);
                const float* kkw = a.in[20] + l * 512 + cc;
                float w4[4];
#pragma unroll
                for (int ni = 0; ni < 4; ++ni) w4[ni] = kkw[ni * 16 + c];
#pragma unroll
                for (int mi = 0; mi < 4; ++mi)
#pragma unroll
                    for (int r = 0; r < 4; ++r) {
                        float s = 0.f;
#pragma unroll
                        for (int ni = 0; ni < 4; ++ni) { const float q = acc[mi][ni][r] * w4[ni]; s += q * q; }
                        s = red16(s);
                        const float inv = rsqrtf(fmaxf(s, 1e-24f));
                        const int row = rowbase + mi * 16 + g * 4 + r;
#pragma unroll
                        for (int ni = 0; ni < 4; ++ni)
                            KKB[(size_t)row * 512 + cc + ni * 16 + c] = f2bf(acc[mi][ni][r] * w4[ni] * inv);
                    }
            }
        } else if (nt < 60) {
            bfu* GL = (bfu*)(ws + WS_GL);
            const int cc = colbase - 4608;
#pragma unroll
            for (int mi = 0; mi < 4; ++mi)
#pragma unroll
                for (int ni = 0; ni < 4; ++ni)
#pragma unroll
                    for (int r = 0; r < 4; ++r) {
                        const int row = rowbase + mi * 16 + g * 4 + r;
                        GL[(size_t)row * 3072 + cc + ni * 16 + c] = f2bf(sigmoidf_(acc[mi][ni][r]));
                    }
        } else {
            bfu* LO = (bfu*)(ws + WS_LORA);
            const int cc = colbase - 7680;
#pragma unroll
            for (int mi = 0; mi < 4; ++mi)
#pragma unroll
                for (int ni = 0; ni < 4; ++ni)
#pragma unroll
                    for (int r = 0; r < 4; ++r) {
                        const int row = rowbase + mi * 16 + g * 4 + r;
                        float v = acc[mi][ni][r];
                        if (nt == 60) v = tanhf_(v); else if (nt >= 62) v = sigmoidf_(v);
                        LO[(size_t)row * 512 + cc + ni * 16 + c] = f2bf(v);
                    }
        }
    }
}

__device__ __forceinline__ void phase_stage2(const Args& a, int l, char* smem, int tid, int bid, int nb) {
    unsigned char* ws = a.ws;
    const bfu* LO = (const bfu*)(ws + WS_LORA);
    const int wave = tid >> 6, lane = tid & 63, wm = wave >> 1, wn = wave & 1, g = lane >> 4, c = lane & 15;
    for (int it = bid; it < 5 * 144 * 4; it += nb) {
        const int which = it / 576, r0 = it % 576, mt = r0 >> 2, nt = r0 & 3;
        const int m0 = mt * 128, n0 = nt * 128;
        int arow[4]; ident_rows(arow, m0, tid);
        f32x4 acc[4][4]; zero_acc<4>(acc);
        const int rowbase = m0 + wm * 64, colbase = n0 + wn * 64;
        if (which < 2) {
            const int d = which;
            gemm_loop<4>(acc, LO + 64 * d, 512, arow, (const bfu*)(ws + WS_W2T) + (size_t)(l * 2 + d) * 512 * 64, 64, n0, 64, smem, tid);
            bfu* WD = (bfu*)(ws + WS_WDEC) + (size_t)d * NT * 512;
            const float* w0 = a.in[12] + (l * 2 + d) * 512;
#pragma unroll
            for (int ni = 0; ni < 4; ++ni) {
                const int col = colbase + ni * 16 + c;
                const float w0c = w0[col];
#pragma unroll
                for (int mi = 0; mi < 4; ++mi)
#pragma unroll
                    for (int r = 0; r < 4; ++r) {
                        const int row = rowbase + mi * 16 + g * 4 + r;
                        WD[(size_t)row * 512 + col] = f2bf(__expf(-0.606531f * sigmoidf_(w0c + acc[mi][ni][r])));
                    }
            }
        } else if (which < 4) {
            const int d = which - 2;
            gemm_loop<4>(acc, LO + 128 + 64 * d, 512, arow, (const bfu*)(ws + WS_A2T) + (size_t)(l * 2 + d) * 512 * 64, 64, n0, 64, smem, tid);
            bfu* BV = (bfu*)(ws + WS_BV) + (size_t)d * NT * 512;
            bfu* KE = (bfu*)(ws + WS_KE) + (size_t)d * NT * 512;
            const bfu* RK = (const bfu*)(ws + WS_RK);
            const bfu* KKB = (const bfu*)(ws + WS_KKB);
            const float* a0 = a.in[15] + (l * 2 + d) * 512;
            const float* ka = a.in[21] + l * 512;
#pragma unroll
            for (int ni = 0; ni < 4; ++ni) {
                const int col = colbase + ni * 16 + c;
                const float a0c = a0[col], kac = ka[col];
#pragma unroll
                for (int mi = 0; mi < 4; ++mi)
#pragma unroll
                    for (int r = 0; r < 4; ++r) {
                        const int row = rowbase + mi * 16 + g * 4 + r;
                        const float av = sigmoidf_(a0c + acc[mi][ni][r]);
                        const float k = bf2f(RK[(size_t)row * 512 + col]);
                        const float kk = bf2f(KKB[(size_t)row * 512 + col]);
                        KE[(size_t)row * 512 + col] = f2bf(k * (1.0f + (av - 1.0f) * kac));
                        BV[(size_t)row * 512 + col] = f2bf(kk * av);
                    }
            }
        } else {
            gemm_loop<4>(acc, LO + 256, 512, arow, (const bfu*)(ws + WS_G2T) + (size_t)l * 512 * 192, 192, n0, 192, smem, tid);
            bfu* GG = (bfu*)(ws + WS_GG);
#pragma unroll
            for (int mi = 0; mi < 4; ++mi)
#pragma unroll
                for (int ni = 0; ni < 4; ++ni)
#pragma unroll
                    for (int r = 0; r < 4; ++r) {
                        const int row = rowbase + mi * 16 + g * 4 + r;
                        GG[(size_t)row * 512 + colbase + ni * 16 + c] = f2bf(acc[mi][ni][r]);
                    }
        }
    }
    {
        const bfu* SB = (const bfu*)(ws + WS_SB);
        const bfu* SG = SB + (size_t)NT * 512;
        const bfu* SX = SG + (size_t)NT * 512;
        bfu* OSC = (bfu*)(ws + WS_ODA) + (size_t)NT * 512;
        const float* cw = a.in[11] + l * 3 * 512;
        for (int i = bid * NTHREADS + tid; i < NT * 64; i += nb * NTHREADS) {
            const int row = i >> 6, c8 = (i & 63) * 8;
            const int t = row % TB;
            if (l == 1 && t >= SEQ) continue;
            const bool hasp = (t != 0 && t != SEQ);
            const bool hasn = (t != SEQ - 1 && t != TB - 1);
            float u[3][8];
#pragma unroll
            for (int j = 0; j < 3; ++j) {
                const bool ok = (j == 1) || (j == 0 ? hasp : hasn);
                if (ok) {
                    const size_t o = (size_t)(row + j - 1) * 512 + c8;
                    const uint4 pg = *(const uint4*)(SG + o), px = *(const uint4*)(SX + o);
                    u[j][0] = bflo(pg.x) * bflo(px.x); u[j][1] = bfhi(pg.x) * bfhi(px.x);
                    u[j][2] = bflo(pg.y) * bflo(px.y); u[j][3] = bfhi(pg.y) * bfhi(px.y);
                    u[j][4] = bflo(pg.z) * bflo(px.z); u[j][5] = bfhi(pg.z) * bfhi(px.z);
                    u[j][6] = bflo(pg.w) * bflo(px.w); u[j][7] = bfhi(pg.w) * bfhi(px.w);
                } else {
#pragma unroll
                    for (int e = 0; e < 8; ++e) u[j][e] = 0.f;
                }
            }
            const uint4 pb = *(const uint4*)(SB + (size_t)row * 512 + c8);
            float sbv[8] = {bflo(pb.x), bfhi(pb.x), bflo(pb.y), bfhi(pb.y), bflo(pb.z), bfhi(pb.z), bflo(pb.w), bfhi(pb.w)};
            float o[8];
#pragma unroll
            for (int e = 0; e < 8; ++e)
                o[e] = sbv[e] * (cw[c8 + e] * u[0][e] + cw[512 + c8 + e] * u[1][e] + cw[1024 + c8 + e] * u[2][e]);
            uint4 po; po.x = pack2(o[0], o[1]); po.y = pack2(o[2], o[3]); po.z = pack2(o[4], o[5]); po.w = pack2(o[6], o[7]);
            *(uint4*)(OSC + (size_t)row * 512 + c8) = po;
        }
    }
}

__device__ __forceinline__ int scan_tok(int d, int idx) {
    if (d == 0) return (idx < CTX) ? (SEQ + idx) : (idx - CTX);
    return (idx < CTX) ? (TB - 1 - idx) : (SEQ - 1 - (idx - CTX));
}
struct StepRaw { uint2 w, kk, b, ke, r; unsigned v; };

__device__ __forceinline__ void scan_item(const Args& a, int l, int item, int tid) {
    unsigned char* ws = a.ws;
    const int wave = tid >> 6, lane = tid & 63;
    const int sub = item & 3, d = (item >> 2) & 1, h = (item >> 3) & 7, b = item >> 6;
    const int rg = sub * 4 + wave;
    const int i = rg * 4 + (lane >> 4), jg = lane & 15;
    const bfu* WD = (const bfu*)(ws + WS_WDEC) + (size_t)d * NT * 512 + h * 64 + jg * 4;
    const bfu* KK = (const bfu*)(ws + WS_KKB) + h * 64 + jg * 4;
    const bfu* BV = (const bfu*)(ws + WS_BV) + (size_t)d * NT * 512 + h * 64 + jg * 4;
    const bfu* KE = (const bfu*)(ws + WS_KE) + (size_t)d * NT * 512 + h * 64 + jg * 4;
    const bfu* RR = (const bfu*)(ws + WS_RR) + h * 64 + jg * 4;
    const bfu* RV = (const bfu*)(ws + WS_RV) + h * 64 + i;
    float* Y = (float*)(ws + WS_Y) + (size_t)d * NT * 512 + h * 64 + i;
    const size_t rb = (size_t)b * TB;
    float s0 = 0.f, s1 = 0.f, s2 = 0.f, s3 = 0.f;
    constexpr int U = 4;
    StepRaw nx[U];
#pragma unroll
    for (int u = 0; u < U; ++u) {
        const size_t o = (rb + scan_tok(d, u)) * 512;
        nx[u].w = *(const uint2*)(WD + o); nx[u].kk = *(const uint2*)(KK + o); nx[u].b = *(const uint2*)(BV + o);
        nx[u].ke = *(const uint2*)(KE + o); nx[u].r = *(const uint2*)(RR + o); nx[u].v = RV[o];
    }
    for (int base = 0; base < TB; base += U) {
        StepRaw cu[U];
#pragma unroll
        for (int u = 0; u < U; ++u) cu[u] = nx[u];
        if (base + U < TB) {
#pragma unroll
            for (int u = 0; u < U; ++u) {
                const size_t o = (rb + scan_tok(d, base + U + u)) * 512;
                nx[u].w = *(const uint2*)(WD + o); nx[u].kk = *(const uint2*)(KK + o); nx[u].b = *(const uint2*)(BV + o);
                nx[u].ke = *(const uint2*)(KE + o); nx[u].r = *(const uint2*)(RR + o); nx[u].v = RV[o];
            }
        }
#pragma unroll
        for (int u = 0; u < U; ++u) {
            const float k0 = bflo(cu[u].kk.x), k1 = bfhi(cu[u].kk.x), k2 = bflo(cu[u].kk.y), k3 = bfhi(cu[u].kk.y);
            float sk = s0 * k0 + s1 * k1 + s2 * k2 + s3 * k3;
            sk = red16(sk);
            const float v = bf2f((bfu)cu[u].v);
            s0 = s0 * bflo(cu[u].w.x) + (v * bflo(cu[u].ke.x) - sk * bflo(cu[u].b.x));
            s1 = s1 * bfhi(cu[u].w.x) + (v * bfhi(cu[u].ke.x) - sk * bfhi(cu[u].b.x));
            s2 = s2 * bflo(cu[u].w.y) + (v * bflo(cu[u].ke.y) - sk * bflo(cu[u].b.y));
            s3 = s3 * bfhi(cu[u].w.y) + (v * bfhi(cu[u].ke.y) - sk * bfhi(cu[u].b.y));
            float y = s0 * bflo(cu[u].r.x) + s1 * bfhi(cu[u].r.x) + s2 * bflo(cu[u].r.y) + s3 * bfhi(cu[u].r.y);
            y = red16(y);
            const int tt = scan_tok(d, base + u);
            if (jg == 0 && (l == 0 || tt < SEQ)) Y[(rb + tt) * 512] = y;
        }
    }
}

constexpr int KROW = 272;
constexpr int VROW = 144;
__device__ __forceinline__ void attn_item(const Args& a, int l, int item, char* smem, int tid) {
    unsigned char* ws = a.ws;
    const int wave = tid >> 6, lane = tid & 63, g = lane >> 4, c = lane & 15;
    int b, head, r0, kt0;
    if (item < 1024) { b = item >> 7; head = (item >> 5) & 3; r0 = b * TB + (item & 31) * 64; kt0 = 0; }
    else { const int j = item - 1024; b = j >> 4; head = (j >> 2) & 3; r0 = b * TB + SEQ + (j & 3) * 64; kt0 = 32; }
    const bfu* Q = (const bfu*)(ws + WS_Q);
    const bfu* Kp = (const bfu*)(ws + WS_K) + (size_t)b * TB * 512 + head * 128;
    const bfu* Vp = (const bfu*)(ws + WS_VT) + (size_t)(b * 4 + head) * 128 * TB;
    char* Ks = smem;
    char* Vs = smem + 64 * KROW;
    const int qrow = r0 + wave * 16 + c;
    bf16x8 q1[2], q2[2];
#pragma unroll
    for (int ks = 0; ks < 2; ++ks) {
        q1[ks] = *(const bf16x8*)(Q + (size_t)qrow * 512 + head * 128 + ks * 32 + g * 8);
        q2[ks] = *(const bf16x8*)(Q + (size_t)qrow * 512 + head * 128 + 64 + ks * 32 + g * 8);
    }
    float m1 = -1e30f, m2 = -1e30f, l1 = 0.f, l2 = 0.f;
    f32x4 o1[8], o2[8];
#pragma unroll
    for (int mt = 0; mt < 8; ++mt) { o1[mt] = (f32x4){0.f, 0.f, 0.f, 0.f}; o2[mt] = (f32x4){0.f, 0.f, 0.f, 0.f}; }
    for (int kt = kt0; kt < 36; ++kt) {
        __syncthreads();
#pragma unroll
        for (int i = 0; i < 4; ++i) {
            const int key = (tid >> 4) + 16 * i, ch = tid & 15;
            *(uint4*)(Ks + key * KROW + ch * 16) = *(const uint4*)(Kp + (size_t)(kt * 64 + key) * 512 + ch * 8);
            const int dim = (tid >> 3) + 32 * i, cv = tid & 7;
            *(uint4*)(Vs + dim * VROW + cv * 16) = *(const uint4*)(Vp + (size_t)dim * TB + kt * 64 + cv * 8);
        }
        __syncthreads();
        f32x4 s1[4], s2[4];
#pragma unroll
        for (int kq = 0; kq < 4; ++kq) {
            s1[kq] = (f32x4){0.f, 0.f, 0.f, 0.f}; s2[kq] = (f32x4){0.f, 0.f, 0.f, 0.f};
#pragma unroll
            for (int ks = 0; ks < 2; ++ks) {
                const bf16x8 a1 = *(const bf16x8*)(Ks + (kq * 16 + c) * KROW + ks * 64 + g * 16);
                const bf16x8 a2 = *(const bf16x8*)(Ks + (kq * 16 + c) * KROW + 128 + ks * 64 + g * 16);
                s1[kq] = __builtin_amdgcn_mfma_f32_16x16x32_bf16(a1, q1[ks], s1[kq], 0, 0, 0);
                s2[kq] = __builtin_amdgcn_mfma_f32_16x16x32_bf16(a2, q2[ks], s2[kq], 0, 0, 0);
            }
        }
        float mx1 = s1[0][0], mx2 = s2[0][0];
#pragma unroll
        for (int kq = 0; kq < 4; ++kq)
#pragma unroll
            for (int r = 0; r < 4; ++r) { mx1 = fmaxf(mx1, s1[kq][r]); mx2 = fmaxf(mx2, s2[kq][r]); }
        mx1 = fmaxf(mx1, __shfl_xor(mx1, 16)); mx1 = fmaxf(mx1, __shfl_xor(mx1, 32));
        mx2 = fmaxf(mx2, __shfl_xor(mx2, 16)); mx2 = fmaxf(mx2, __shfl_xor(mx2, 32));
        const float mn1 = fmaxf(m1, mx1), mn2 = fmaxf(m2, mx2);
        const float al1 = exp2f(m1 - mn1), al2 = exp2f(m2 - mn2);
        m1 = mn1; m2 = mn2;
        float ps1 = 0.f, ps2 = 0.f;
        bf16x8 pb1[2], pb2[2];
#pragma unroll
        for (int kk = 0; kk < 2; ++kk) {
            float p[8], q[8];
#pragma unroll
            for (int e = 0; e < 4; ++e) {
                p[e] = exp2f(s1[2 * kk][e] - mn1); p[4 + e] = exp2f(s1[2 * kk + 1][e] - mn1);
                q[e] = exp2f(s2[2 * kk][e] - mn2); q[4 + e] = exp2f(s2[2 * kk + 1][e] - mn2);
            }
#pragma unroll
            for (int e = 0; e < 8; ++e) { ps1 += p[e]; ps2 += q[e]; pb1[kk][e] = (short)f2bf(p[e]); pb2[kk][e] = (short)f2bf(q[e]); }
        }
        l1 = l1 * al1 + ps1; l2 = l2 * al2 + ps2;
#pragma unroll
        for (int mt = 0; mt < 8; ++mt) {
            o1[mt] *= al1; o2[mt] *= al2;
#pragma unroll
            for (int kk = 0; kk < 2; ++kk) {
                const uint2 v0 = *(const uint2*)(Vs + (mt * 16 + c) * VROW + (kk * 32 + g * 4) * 2);
                const uint2 v1 = *(const uint2*)(Vs + (mt * 16 + c) * VROW + (kk * 32 + 16 + g * 4) * 2);
                union { uint4 u; bf16x8 v; } av; av.u = make_uint4(v0.x, v0.y, v1.x, v1.y);
                o1[mt] = __builtin_amdgcn_mfma_f32_16x16x32_bf16(av.v, pb1[kk], o1[mt], 0, 0, 0);
                o2[mt] = __builtin_amdgcn_mfma_f32_16x16x32_bf16(av.v, pb2[kk], o2[mt], 0, 0, 0);
            }
        }
    }
    l1 += __shfl_xor(l1, 16); l1 += __shfl_xor(l1, 32);
    l2 += __shfl_xor(l2, 16); l2 += __shfl_xor(l2, 32);
    const float lam = ((const float*)(ws + WS_TAB))[2048 + l];
    const float lam_init = (l == 0) ? 0.2f : (0.8f - 0.6f * 0.7408182206817179f);
    const float i1 = 1.0f / l1, i2 = lam / l2;
    float ss = 0.f;
#pragma unroll
    for (int mt = 0; mt < 8; ++mt)
#pragma unroll
        for (int r = 0; r < 4; ++r) { const float v = o1[mt][r] * i1 - o2[mt][r] * i2; o1[mt][r] = v; ss += v * v; }
    ss += __shfl_xor(ss, 16); ss += __shfl_xor(ss, 32);
    const float rs = rsqrtf(ss * (1.0f / 128.0f) + 1e-5f) * (1.0f - lam_init);
    bfu* ODA = (bfu*)(ws + WS_ODA);
    const float* sg = a.in[10] + l * 128;
#pragma unroll
    for (int mt = 0; mt < 8; ++mt) {
        const int dim = mt * 16 + g * 4;
        const float4 gg = *(const float4*)(sg + dim);
        uint2 p; p.x = pack2(o1[mt][0] * rs * gg.x, o1[mt][1] * rs * gg.y); p.y = pack2(o1[mt][2] * rs * gg.z, o1[mt][3] * rs * gg.w);
        *(uint2*)(ODA + (size_t)qrow * 512 + head * 128 + dim) = p;
    }
}

__device__ __forceinline__ void phase_mix(const Args& a, int l, char* smem, int tid, int bid, int nb) {
    for (int it = bid; it < 512; it += nb) scan_item(a, l, it, tid);
    const int n_attn = (l == 0) ? 1152 : 1024;
    for (int it = bid; it < n_attn; it += nb) attn_item(a, l, it, smem, tid);
}

__device__ __forceinline__ void phase_post(const Args& a, int l, int tid, int bid, int nb) {
    unsigned char* ws = a.ws;
    const int wave = tid >> 6, lane = tid & 63;
    const float* Y0 = (const float*)(ws + WS_Y);
    const float* Y1 = Y0 + (size_t)NT * 512;
    const bfu* RR = (const bfu*)(ws + WS_RR);
    const bfu* RV = (const bfu*)(ws + WS_RV);
    const bfu* KE0 = (const bfu*)(ws + WS_KE);
    const bfu* KE1 = KE0 + (size_t)NT * 512;
    const bfu* GG = (const bfu*)(ws + WS_GG);
    bfu* ORW = (bfu*)(ws + WS_ODA) + (size_t)2 * NT * 512;
    const float* lg = a.in[23] + l * 512;
    const float* lb = a.in[24] + l * 512;
    const float* rk = a.in[22] + l * 512;
    for (int row = bid * 4 + wave; row < NT; row += nb * 4) {
        const int t = row % TB;
        if (l == 1 && t >= SEQ) continue;
        const size_t o = (size_t)row * 512 + lane * 8;
        float y[8];
        {
            const float4 a0 = *(const float4*)(Y0 + o), a1 = *(const float4*)(Y0 + o + 4);
            const float4 b0 = *(const float4*)(Y1 + o), b1 = *(const float4*)(Y1 + o + 4);
            y[0] = a0.x + b0.x; y[1] = a0.y + b0.y; y[2] = a0.z + b0.z; y[3] = a0.w + b0.w;
            y[4] = a1.x + b1.x; y[5] = a1.y + b1.y; y[6] = a1.z + b1.z; y[7] = a1.w + b1.w;
        }
        float s = 0.f;
#pragma unroll
        for (int e = 0; e < 8; ++e) s += y[e];
        s += __shfl_xor(s, 1); s += __shfl_xor(s, 2); s += __shfl_xor(s, 4);
        const float mu = s * (1.0f / 64.0f);
        float vs = 0.f;
#pragma unroll
        for (int e = 0; e < 8; ++e) { const float dlt = y[e] - mu; vs += dlt * dlt; }
        vs += __shfl_xor(vs, 1); vs += __shfl_xor(vs, 2); vs += __shfl_xor(vs, 4);
        const float rstd = rsqrtf(vs * (1.0f / 64.0f) + 64e-5f);
        const uint4 pr = *(const uint4*)(RR + o), pv = *(const uint4*)(RV + o), pk0 = *(const uint4*)(KE0 + o), pk1 = *(const uint4*)(KE1 + o), pg = *(const uint4*)(GG + o);
        const float r8[8] = {bflo(pr.x), bfhi(pr.x), bflo(pr.y), bfhi(pr.y), bflo(pr.z), bfhi(pr.z), bflo(pr.w), bfhi(pr.w)};
        const float v8[8] = {bflo(pv.x), bfhi(pv.x), bflo(pv.y), bfhi(pv.y), bflo(pv.z), bfhi(pv.z), bflo(pv.w), bfhi(pv.w)};
        const float k8[8] = {bflo(pk0.x) + bflo(pk1.x), bfhi(pk0.x) + bfhi(pk1.x), bflo(pk0.y) + bflo(pk1.y), bfhi(pk0.y) + bfhi(pk1.y),
                             bflo(pk0.z) + bflo(pk1.z), bfhi(pk0.z) + bfhi(pk1.z), bflo(pk0.w) + bflo(pk1.w), bfhi(pk0.w) + bfhi(pk1.w)};
        const float g8[8] = {bflo(pg.x), bfhi(pg.x), bflo(pg.y), bfhi(pg.y), bflo(pg.z), bfhi(pg.z), bflo(pg.w), bfhi(pg.w)};
        float ds = 0.f;
#pragma unroll
        for (int e = 0; e < 8; ++e) ds += r8[e] * k8[e] * rk[lane * 8 + e];
        ds += __shfl_xor(ds, 1); ds += __shfl_xor(ds, 2); ds += __shfl_xor(ds, 4);
        float ov[8];
#pragma unroll
        for (int e = 0; e < 8; ++e) ov[e] = ((y[e] - mu) * rstd * lg[lane * 8 + e] + lb[lane * 8 + e] + ds * v8[e]) * g8[e];
        uint4 po; po.x = pack2(ov[0], ov[1]); po.y = pack2(ov[2], ov[3]); po.z = pack2(ov[4], ov[5]); po.w = pack2(ov[6], ov[7]);
        *(uint4*)(ORW + o) = po;
    }
}

__device__ __forceinline__ void phase_merge(const Args& a, int l, char* smem, int tid, int bid, int nb) {
    unsigned char* ws = a.ws;
    const int wave = tid >> 6, lane = tid & 63, wm = wave >> 1, wn = wave & 1, g = lane >> 4, c = lane & 15;
    const bfu* GL = (const bfu*)(ws + WS_GL);
    bfu* MB = (bfu*)(ws + WS_MB);
    for (int it = bid; it < 144 * 16; it += nb) {
        const int mt = it >> 4, nt = it & 15;
        if (l == 1 && (mt % 18) >= 16) continue;
        const int m0 = mt * 128, n0 = nt * 64;
        int arow[4]; ident_rows(arow, m0, tid);
        const int rowbase = m0 + wm * 64, colbase = n0 + wn * 32;
        f32x4 tot[4][2]; zero_acc<2>(tot);
        for (int n = 0; n < 3; ++n) {
            f32x4 acc[4][2]; zero_acc<2>(acc);
            gemm_loop<2>(acc, (const bfu*)(ws + WS_ODA) + (size_t)n * NT * 512, 512, arow,
                         (const bfu*)(ws + WS_WBT) + (size_t)(l * 3 + n) * 1024 * 512, 512, n0, 512, smem, tid);
#pragma unroll
            for (int mi = 0; mi < 4; ++mi)
#pragma unroll
                for (int ni = 0; ni < 2; ++ni)
#pragma unroll
                    for (int r = 0; r < 4; ++r) {
                        const int row = rowbase + mi * 16 + g * 4 + r;
                        const float gate = bf2f(GL[(size_t)row * 3072 + n * 1024 + colbase + ni * 16 + c]);
                        tot[mi][ni][r] += gate * acc[mi][ni][r];
                    }
        }
#pragma unroll
        for (int mi = 0; mi < 4; ++mi)
#pragma unroll
            for (int ni = 0; ni < 2; ++ni)
#pragma unroll
                for (int r = 0; r < 4; ++r) {
                    const int row = rowbase + mi * 16 + g * 4 + r;
                    MB[(size_t)row * 1024 + colbase + ni * 16 + c] = f2bf(tot[mi][ni][r]);
                }
    }
}

__device__ __forceinline__ void phase_wout(const Args& a, int l, char* smem, int tid, int bid, int nb) {
    unsigned char* ws = a.ws;
    const int wave = tid >> 6, lane = tid & 63, wm = wave >> 1, wn = wave & 1, g = lane >> 4, c = lane & 15;
    float* xres = (float*)(ws + WS_XRES);
    const float* mod = (const float*)(ws + WS_MOD);
    for (int it = bid; it < 144 * 8; it += nb) {
        const int mt = it >> 3, nt = it & 7;
        if (l == 1 && (mt % 18) >= 16) continue;
        const int m0 = mt * 128, n0 = nt * 128;
        int arow[4]; ident_rows(arow, m0, tid);
        f32x4 acc[4][4]; zero_acc<4>(acc);
        gemm_loop<4>(acc, (const bfu*)(ws + WS_MB), 1024, arow, (const bfu*)(ws + WS_WOT) + (size_t)l * 1024 * 1024, 1024, n0, 1024, smem, tid);
        const int rowbase = m0 + wm * 64, colbase = n0 + wn * 64;
        const int b = m0 / TB, m = ((m0 % TB) < SEQ) ? b : 8;
        const float* ga = mod + (size_t)(l * 9 + m) * 6144 + 2 * 1024;
#pragma unroll
        for (int ni = 0; ni < 4; ++ni) {
            const int col = colbase + ni * 16 + c;
            const float gac = ga[col];
#pragma unroll
            for (int mi = 0; mi < 4; ++mi)
#pragma unroll
                for (int r = 0; r < 4; ++r) {
                    const int row = rowbase + mi * 16 + g * 4 + r;
                    xres[(size_t)row * 1024 + col] += gac * acc[mi][ni][r];
                }
        }
    }
}

__device__ __forceinline__ void phase_router(const Args& a, int l, char* smem, int tid, int bid, int nb) {
    unsigned char* ws = a.ws;
    const int wave = tid >> 6, lane = tid & 63, wm = wave >> 1, wn = wave & 1, g = lane >> 4, c = lane & 15;
    const bfu* HI = (const bfu*)(ws + WS_H2HI);
    const bfu* LO = (const bfu*)(ws + WS_H2LO);
    const bfu* RH = (const bfu*)(ws + WS_RHI) + (size_t)l * 128 * 1024;
    const bfu* RL = (const bfu*)(ws + WS_RLO) + (size_t)l * 128 * 1024;
    float* LG = (float*)(ws + WS_LOG);
    for (int mt = bid; mt < 144; mt += nb) {
        if (l == 1 && (mt % 18) >= 16) continue;
        const int m0 = mt * 128;
        int arow[4]; ident_rows(arow, m0, tid);
        f32x4 acc[4][4]; zero_acc<4>(acc);
        gemm_loop<4>(acc, HI, 1024, arow, RH, 1024, 0, 1024, smem, tid);
        gemm_loop<4>(acc, HI, 1024, arow, RL, 1024, 0, 1024, smem, tid);
        gemm_loop<4>(acc, LO, 1024, arow, RH, 1024, 0, 1024, smem, tid);
        if (wn == 0) {
#pragma unroll
            for (int ni = 0; ni < 2; ++ni) {
                const int col = ni * 16 + c;
                const float bias = a.in[28][l * 32 + col];
#pragma unroll
                for (int mi = 0; mi < 4; ++mi)
#pragma unroll
                    for (int r = 0; r < 4; ++r) {
                        const int row = m0 + wm * 64 + mi * 16 + g * 4 + r;
                        LG[(size_t)row * 32 + col] = acc[mi][ni][r] + bias;
                    }
            }
        }
    }
}

__device__ __forceinline__ void phase_topk(const Args& a, int l, char* smem, int tid, int bid, int nb) {
    unsigned char* ws = a.ws;
    const float* LG = (const float*)(ws + WS_LOG);
    int* cnt = (int*)(ws + CNT_OFF) + l * 32;
    int* TOKL = (int*)(ws + WS_TOKL);
    float* GATE = (float*)(ws + WS_GATE);
    int* lcnt = (int*)smem;
    int* lbase = lcnt + 32;
    for (int blk = bid; blk < NT / NTHREADS; blk += nb) {
        const int row = blk * NTHREADS + tid;
        const int t = row % TB;
        const bool active = !(l == 1 && t >= SEQ);
        __syncthreads();
        if (tid < 32) lcnt[tid] = 0;
        __syncthreads();
        int ei[4] = {0, 0, 0, 0}; float ev[4] = {0.f, 0.f, 0.f, 0.f}; int lr[4] = {0, 0, 0, 0};
        if (active) {
            float v[32];
#pragma unroll
            for (int q = 0; q < 8; ++q) {
                const float4 x4 = *(const float4*)(LG + (size_t)row * 32 + q * 4);
                v[q * 4] = x4.x; v[q * 4 + 1] = x4.y; v[q * 4 + 2] = x4.z; v[q * 4 + 3] = x4.w;
            }
#pragma unroll
            for (int k = 0; k < 4; ++k) {
                float best = -3.0e38f; int bi = 0;
#pragma unroll
                for (int e = 0; e < 32; ++e) { const bool tk = v[e] > best; best = tk ? v[e] : best; bi = tk ? e : bi; }
                ei[k] = bi; ev[k] = best;
#pragma unroll
                for (int e = 0; e < 32; ++e) v[e] = (e == bi) ? -3.0e38f : v[e];
            }
            const float e1 = __expf(ev[1] - ev[0]), e2 = __expf(ev[2] - ev[0]), e3 = __expf(ev[3] - ev[0]);
            const float inv = 1.0f / (1.0f + e1 + e2 + e3);
            ev[0] = inv; ev[1] = e1 * inv; ev[2] = e2 * inv; ev[3] = e3 * inv;
#pragma unroll
            for (int k = 0; k < 4; ++k) lr[k] = atomicAdd(&lcnt[ei[k]], 1);
        }
        __syncthreads();
        if (tid < 32) lbase[tid] = (lcnt[tid] > 0) ? atomicAdd(&cnt[tid], lcnt[tid]) : 0;
        __syncthreads();
        if (active) {
#pragma unroll
            for (int k = 0; k < 4; ++k) {
                const int pos = lbase[ei[k]] + lr[k];
                const int id = row * 4 + k;
                TOKL[(size_t)ei[k] * NT + pos] = id;
                GATE[id] = ev[k];
            }
        }
    }
}

__device__ __forceinline__ void expert_prefix(const Args& a, int l, int* sm, int tid) {
    const int* cnt = (const int*)(a.ws + CNT_OFF) + l * 32;
    __syncthreads();
    if (tid == 0) {
        int tp = 0, rp = 0;
        for (int e = 0; e < 32; ++e) {
            const int cn = cnt[e];
            sm[e] = cn; sm[32 + e] = tp; sm[65 + e] = rp;
            tp += (cn + 127) >> 7; rp += cn;
        }
        sm[64] = tp; sm[97] = rp;
    }
    __syncthreads();
}

__device__ __forceinline__ void phase_gemm1(const Args& a, int l, char* smem, int tid, int bid, int nb) {
    unsigned char* ws = a.ws;
    int* pre = (int*)(smem + LDS_MAIN);
    expert_prefix(a, l, pre, tid);
    const int wave = tid >> 6, lane = tid & 63, wm = wave >> 1, wn = wave & 1, g = lane >> 4, c = lane & 15;
    const int ntiles = pre[64] * 16;
    const int* TOKL = (const int*)(ws + WS_TOKL);
    const bfu* HI = (const bfu*)(ws + WS_H2HI);
    bfu* ACT = (bfu*)(ws + WS_ACT);
    for (int it = bid; it < ntiles; it += nb) {
        const int tix = it >> 4, nt = it & 15;
        int e = 0;
        while (pre[32 + e + 1] <= tix) ++e;
        const int mt = tix - pre[32 + e];
        const int cn = pre[e], rs = pre[65 + e];
        const int* tl = TOKL + (size_t)e * NT;
        int arow[4];
#pragma unroll
        for (int i = 0; i < 4; ++i) {
            int ri = mt * 128 + (tid >> 3) + 32 * i;
            ri = (ri < cn) ? ri : 0;
            arow[i] = tl[ri] >> 2;
        }
        f32x4 acc[4][4]; zero_acc<4>(acc);
        gemm_loop<4>(acc, HI, 1024, arow, (const bfu*)(ws + WS_W1T) + (size_t)(l * 32 + e) * 2048 * 1024, 1024, nt * 128, 1024, smem, tid);
        const float* b1 = a.in[30] + (size_t)(l * 32 + e) * 2048;
#pragma unroll
        for (int p = 0; p < 2; ++p) {
            const int acol = nt * 64 + wn * 32 + p * 16 + c;
            const float bg = b1[acol], bl = b1[1024 + acol];
#pragma unroll
            for (int mi = 0; mi < 4; ++mi)
#pragma unroll
                for (int r = 0; r < 4; ++r) {
                    const int grow = mt * 128 + wm * 64 + mi * 16 + g * 4 + r;
                    if (grow < cn) {
                        const float glu = fminf(acc[mi][2 * p][r] + bg, 7.0f);
                        const float lin = fminf(fmaxf(acc[mi][2 * p + 1][r] + bl, -7.0f), 7.0f);
                        ACT[(size_t)(rs + grow) * 1024 + acol] = f2bf(glu * sigmoidf_(1.702f * glu) * (lin + 1.0f));
                    }
                }
        }
    }
}

__device__ __forceinline__ void phase_gemm2(const Args& a, int l, char* smem, int tid, int bid, int nb) {
    unsigned char* ws = a.ws;
    int* pre = (int*)(smem + LDS_MAIN);
    expert_prefix(a, l, pre, tid);
    const int wave = tid >> 6, lane = tid & 63, wm = wave >> 1, wn = wave & 1, g = lane >> 4, c = lane & 15;
    const int ntiles = pre[64] * 8;
    const int* TOKL = (const int*)(ws + WS_TOKL);
    const float* GATE = (const float*)(ws + WS_GATE);
    const bfu* ACT = (const bfu*)(ws + WS_ACT);
    bfu* YB = (bfu*)(ws + WS_YB);
    for (int it = bid; it < ntiles; it += nb) {
        const int tix = it >> 3, nt = it & 7;
        int e = 0;
        while (pre[32 + e + 1] <= tix) ++e;
        const int mt = tix - pre[32 + e];
        const int cn = pre[e], rs = pre[65 + e];
        const int* tl = TOKL + (size_t)e * NT;
        int arow[4];
#pragma unroll
        for (int i = 0; i < 4; ++i) {
            int ri = mt * 128 + (tid >> 3) + 32 * i;
            ri = (ri < cn) ? ri : (cn - 1);
            arow[i] = rs + ri;
        }
        f32x4 acc[4][4]; zero_acc<4>(acc);
        gemm_loop<4>(acc, ACT, 1024, arow, (const bfu*)(ws + WS_W2ET) + (size_t)(l * 32 + e) * 1024 * 1024, 1024, nt * 128, 1024, smem, tid);
        const float* b2 = a.in[32] + (size_t)(l * 32 + e) * 1024;
#pragma unroll
        for (int mi = 0; mi < 4; ++mi)
#pragma unroll
            for (int r = 0; r < 4; ++r) {
                const int grow = mt * 128 + wm * 64 + mi * 16 + g * 4 + r;
                if (grow < cn) {
                    const int id = tl[grow];
                    const float gate = GATE[id];
#pragma unroll
                    for (int ni = 0; ni < 4; ++ni) {
                        const int col = nt * 128 + wn * 64 + ni * 16 + c;
                        YB[(size_t)id * 1024 + col] = f2bf((acc[mi][ni][r] + b2[col]) * gate);
                    }
                }
            }
    }
}

constexpr int N_PHASES = 2 + 12 * NL;

__global__ void __launch_bounds__(NTHREADS, 2) fwd(Args a) {
    extern __shared__ __attribute__((aligned(16))) char dyn_smem[];
    char* smem = dyn_smem + 16;
    const int tid0 = threadIdx.x, bid0 = blockIdx.x, nb0 = gridDim.x;
    const int tid = tid0;
    const bool multi = (a.ph_hi - a.ph_lo) > 1;
    XcdBarrier bar;
    bar.bar = (unsigned*)(a.ws + WS_CTL); bar.x = 0; bar.st = (volatile LAS unsigned*)dyn_smem;
    if (multi) {
        if (tid == 0) *(uint4*)dyn_smem = make_uint4(0u, 0u, 0u, 0u);
        __syncthreads();
        bar = xcd_barrier_post((unsigned*)(a.ws + WS_CTL), (volatile LAS unsigned*)dyn_smem);
    }
#ifndef PHASE_MASK
#define PHASE_MASK 0xFFFFFFFFu
#endif
#define RUN_PHASE(KIND, ID, CALL) do { if constexpr (((PHASE_MASK) >> (KIND)) & 1u) { const int _id = (ID); if (_id >= a.ph_lo && _id < a.ph_hi) { \
    int tid = tid0, bid = bid0, nb = nb0; asm volatile("" : "+v"(tid), "+s"(bid), "+s"(nb)); CALL; if (_id + 1 < a.ph_hi) xcd_barrier(bar); } } } while (0)
    RUN_PHASE(0, 0, phase_prep(a, smem, tid, bid, nb));
    RUN_PHASE(1, 1, phase_norm1_l0(a, tid, bid, nb));
    for (int l = 0; l < NL; ++l) {
        const int base = 2 + 12 * l;
        RUN_PHASE(2, base + 0, phase_gemm_in(a, l, smem, tid, bid, nb));
        RUN_PHASE(3, base + 1, phase_stage2(a, l, smem, tid, bid, nb));
        RUN_PHASE(4, base + 2, phase_mix(a, l, smem, tid, bid, nb));
        RUN_PHASE(5, base + 3, phase_post(a, l, tid, bid, nb));
        RUN_PHASE(6, base + 4, phase_merge(a, l, smem, tid, bid, nb));
        RUN_PHASE(7, base + 5, phase_wout(a, l, smem, tid, bid, nb));
        RUN_PHASE(8, base + 6, phase_norm2(a, l, tid, bid, nb));
        RUN_PHASE(9, base + 7, phase_router(a, l, smem, tid, bid, nb));
        RUN_PHASE(10, base + 8, phase_topk(a, l, smem, tid, bid, nb));
        RUN_PHASE(11, base + 9, phase_gemm1(a, l, smem, tid, bid, nb));
        RUN_PHASE(12, base + 10, phase_gemm2(a, l, smem, tid, bid, nb));
        RUN_PHASE(13, base + 11, phase_combine(a, l, tid, bid, nb));
    }
}

extern "C" void kernel_launch(void* const* d_in, const int* in_sizes, int n_in,
                              void* d_out, int out_size, void* d_ws, size_t ws_size,
                              hipStream_t stream) {
    static int grid = 0;
    if (grid == 0) {
        if (n_in != 34 || ws_size < WS_END) { fprintf(stderr, "kernel_launch: bad inputs (n_in %d, ws %zu < %zu)\n", n_in, ws_size, (size_t)WS_END); grid = -1; return; }
        int dev = 0, cus = 0, per_cu = 0;
        hipGetDevice(&dev);
        hipDeviceGetAttribute(&cus, hipDeviceAttributeMultiprocessorCount, dev);
        if (hipFuncSetAttribute((const void*)fwd, hipFuncAttributeMaxDynamicSharedMemorySize, LDS_BYTES) != hipSuccess) { fprintf(stderr, "hipFuncSetAttribute failed\n"); grid = -1; return; }
        hipOccupancyMaxActiveBlocksPerMultiprocessor(&per_cu, (const void*)fwd, NTHREADS, LDS_BYTES);
        (void)hipGetLastError();
        if (per_cu < 1) per_cu = 1;
        grid = cus * (per_cu < 2 ? per_cu : 2);
    }
    if (grid < 0) return;
    hipMemsetAsync((char*)d_ws + WS_CTL, 0, CTL_BYTES, stream);
    Args a{};
    for (int i = 0; i < 34; ++i) a.in[i] = (const float*)d_in[i];
    a.out = (float*)d_out; a.ws = (unsigned char*)d_ws;
#if N_LAUNCH_MODE == 1
    a.ph_lo = 0; a.ph_hi = N_PHASES;
    hipLaunchKernelGGL(fwd, dim3(grid), dim3(NTHREADS), LDS_BYTES, stream, a);
#else
    for (int p = 0; p < N_PHASES; ++p) {
        a.ph_lo = p; a.ph_hi = p + 1;
        hipLaunchKernelGGL(fwd, dim3(grid), dim3(NTHREADS), LDS_BYTES, stream, a);
    }
#endif
}
```

```cpp
#include <hip/hip_runtime.h>
#include <stdint.h>
#include <stdio.h>

typedef unsigned short bfu;
using bf16x8 = __attribute__((ext_vector_type(8))) short;
using f32x4  = __attribute__((ext_vector_type(4))) float;

constexpr int NB = 8, SEQ = 2048, CTX = 256, TB = 2304, NT = NB * TB, DM = 1024, NL = 2;
constexpr int NEXP = 32;
constexpr int NTHREADS = 512;
constexpr int NW = NTHREADS / 64;
constexpr int LDS_MAIN = 131072;
constexpr int LDS_EXTRA = 4096;
constexpr int LDS_BYTES = LDS_MAIN + LDS_EXTRA + 16;

#ifndef N_LAUNCH_MODE
#define N_LAUNCH_MODE 1
#endif

constexpr size_t al(size_t x) { return (x + 255) & ~(size_t)255; }
constexpr size_t WS_CTL    = 0;
constexpr size_t CTL_BYTES = 32768;
constexpr size_t CNT_OFF   = 16384;
constexpr size_t WS_MOD    = WS_CTL + CTL_BYTES;
constexpr size_t WS_TAB    = al(WS_MOD + (size_t)2 * 9 * 6144 * 4);
constexpr size_t WS_WINT   = al(WS_TAB + 2 * 64 * 16 * 4 + 64);
constexpr size_t WS_S2T    = al(WS_WINT + (size_t)2 * 8192 * 1024 * 2);
constexpr size_t WS_WBT    = al(WS_S2T + (size_t)2 * 2560 * 512 * 2);
constexpr size_t WS_WOT    = al(WS_WBT + (size_t)2 * 3 * 1024 * 512 * 2);
constexpr size_t WS_RT     = al(WS_WOT + (size_t)2 * 1024 * 3072 * 2);
constexpr size_t WS_W1T    = al(WS_RT + (size_t)2 * 256 * 2048 * 2);
constexpr size_t WS_W2ET   = al(WS_W1T + (size_t)2 * 32 * 2048 * 1024 * 2);
constexpr size_t WS_XRES   = al(WS_W2ET + (size_t)2 * 32 * 1024 * 1024 * 2);
constexpr size_t WS_H      = al(WS_XRES + (size_t)NT * 1024 * 4);
constexpr size_t SZ512     = (size_t)NT * 512 * 2;
constexpr size_t WS_Q      = al(WS_H + (size_t)NT * 1024 * 2);
constexpr size_t WS_K      = al(WS_Q + SZ512);
constexpr size_t WS_VT     = al(WS_K + SZ512);
constexpr size_t WS_SB     = al(WS_VT + SZ512);
constexpr size_t WS_RR     = al(WS_SB + 3 * SZ512);
constexpr size_t WS_RK     = al(WS_RR + SZ512);
constexpr size_t WS_RV     = al(WS_RK + SZ512);
constexpr size_t WS_KKB    = al(WS_RV + SZ512);
constexpr size_t WS_GL     = al(WS_KKB + SZ512);
constexpr size_t WS_LORA   = al(WS_GL + (size_t)NT * 3072 * 2);
constexpr size_t WS_WDEC   = al(WS_LORA + SZ512);
constexpr size_t WS_BV     = al(WS_WDEC + 2 * SZ512);
constexpr size_t WS_KE     = al(WS_BV + 2 * SZ512);
constexpr size_t WS_GG     = al(WS_KE + 2 * SZ512);
constexpr size_t WS_Y      = al(WS_GG + SZ512);
constexpr size_t WS_ODA    = al(WS_Y + (size_t)2 * NT * 512 * 4);
constexpr size_t WS_MB     = al(WS_ODA + 3 * SZ512);
constexpr size_t WS_H2HI   = al(WS_MB + (size_t)NT * 1024 * 2);
constexpr size_t WS_H2LO   = al(WS_H2HI + (size_t)NT * 1024 * 2);
constexpr size_t WS_LOG    = al(WS_H2LO + (size_t)NT * 1024 * 2);
constexpr size_t WS_TOKL   = al(WS_LOG + (size_t)NT * 32 * 4);
constexpr size_t WS_GATE   = al(WS_TOKL + (size_t)32 * NT * 4);
constexpr size_t WS_GATEL  = al(WS_GATE + (size_t)NT * 4 * 4);
constexpr size_t WS_ACT    = al(WS_GATEL + (size_t)32 * NT * 4);
constexpr size_t WS_YB     = al(WS_ACT + (size_t)(NT * 4 + 8192) * 1024 * 2);
constexpr size_t WS_END    = al(WS_YB + (size_t)NT * 4 * 1024 * 2);

struct Args {
    const float* in[34];
    float* out;
    unsigned char* ws;
    int ph_lo, ph_hi;
};
#define GAS __attribute__((address_space(1)))
__device__ __forceinline__ unsigned char* wsp(const Args& a) {
    GAS unsigned char* p = (GAS unsigned char*)a.ws; asm volatile("" : "+s"(p)); return (unsigned char*)p; }


typedef __bf16 bf16x2_t __attribute__((ext_vector_type(2)));
typedef float f32x2_t __attribute__((ext_vector_type(2)));
typedef unsigned u32x2_t __attribute__((ext_vector_type(2)));
typedef unsigned u32x4_t __attribute__((ext_vector_type(4)));
__device__ __forceinline__ bfu f2bf(float f) { return __builtin_bit_cast(bfu, (__bf16)f); }
__device__ __forceinline__ float bf2f(bfu b) { return __uint_as_float(((unsigned)b) << 16); }
__device__ __forceinline__ unsigned pack2(float a, float b) { f32x2_t v = {a, b}; return __builtin_bit_cast(unsigned, __builtin_convertvector(v, bf16x2_t)); }
__device__ __forceinline__ float bflo(unsigned u) { return __uint_as_float(u << 16); }
__device__ __forceinline__ float bfhi(unsigned u) { return __uint_as_float(u & 0xFFFF0000u); }
__device__ __forceinline__ float sigmoidf_(float x) { return __builtin_amdgcn_rcpf(1.0f + __builtin_amdgcn_exp2f(-1.4426950408889634f * x)); }
__device__ __forceinline__ float tanhf_(float x) { const float e = __builtin_amdgcn_exp2f(2.8853900817779268f * x); return 1.0f - 2.0f * __builtin_amdgcn_rcpf(e + 1.0f); }
__device__ __forceinline__ int lane_id_() { int l; asm volatile("v_mbcnt_lo_u32_b32 %0, -1, 0\n\tv_mbcnt_hi_u32_b32 %0, -1, %0" : "=v"(l)); return l; }
__device__ __forceinline__ float shx_(float v, int m) { return __int_as_float(__builtin_amdgcn_ds_bpermute((lane_id_() ^ m) << 2, __float_as_int(v))); }
__device__ __forceinline__ float shf_(float v, int src) { return __int_as_float(__builtin_amdgcn_ds_bpermute(src << 2, __float_as_int(v))); }
__device__ __forceinline__ float wave_sum_shfl(float v) {
#pragma unroll
    for (int o = 32; o >= 1; o >>= 1) v += shx_(v, o);
    return v;
}
__device__ __forceinline__ float fmax3_(float a, float b, float c) { float r; asm("v_max3_f32 %0, %1, %2, %3" : "=v"(r) : "v"(a), "v"(b), "v"(c)); return r; }
__device__ __forceinline__ float ex2_(float x) { return __builtin_amdgcn_exp2f(x); }
template <int CTRL>
__device__ __forceinline__ float dppf(float x) {
    return __int_as_float(__builtin_amdgcn_update_dpp(0, __float_as_int(x), CTRL, 0xF, 0xF, true));
}
__device__ __forceinline__ float red16(float x) {
    x += dppf<0xB1>(x);
    x += dppf<0x4E>(x);
    x += dppf<0x124>(x);
    x += dppf<0x128>(x);
    return x;
}
__device__ __forceinline__ float wave_sum(float v) {
    v = red16(v);
    const float s0 = __int_as_float(__builtin_amdgcn_readlane(__float_as_int(v), 0)), s1 = __int_as_float(__builtin_amdgcn_readlane(__float_as_int(v), 16));
    const float s2 = __int_as_float(__builtin_amdgcn_readlane(__float_as_int(v), 32)), s3 = __int_as_float(__builtin_amdgcn_readlane(__float_as_int(v), 48));
    return (s0 + s1) + (s2 + s3);
}

#define XB_TMO      128
#define XB_XCNT(j)  (256  + 64 * (j))
#define XB_XSUB(j)  (1280 + 64 * (j))
#define XB_XGEN(j)  (2304 + 64 * (j))
#define XB_TOP      3328
#define XB_TOPGEN   3392
#define XCD_BAR_WORDS 3456
#define XB_SPIN_CAP (1u << 22)
#define LAS __attribute__((address_space(3)))

__device__ __forceinline__ unsigned xb_ld(unsigned* p)              { return __hip_atomic_load(p, __ATOMIC_RELAXED, __HIP_MEMORY_SCOPE_AGENT); }
__device__ __forceinline__ unsigned xb_add(unsigned* p, unsigned v) { return __hip_atomic_fetch_add(p, v, __ATOMIC_RELAXED, __HIP_MEMORY_SCOPE_AGENT); }
__device__ __forceinline__ unsigned xb_xcc_id() { return (unsigned)__builtin_amdgcn_s_getreg((3 << 11) | 20) & 0xFu; }
#define XB_SPIN(cond, bar) do { unsigned _sp = 0; while (cond) { __builtin_amdgcn_s_sleep(1); \
    if ((++_sp & 255u) == 0u) { if (xb_ld(&(bar)[XB_TMO])) break; if (_sp > XB_SPIN_CAP) { atomicAdd(&(bar)[XB_TMO], 1u); break; } } } } while (0)

struct XcdBarrier { unsigned* bar; unsigned x; volatile LAS unsigned* st; };

__device__ __forceinline__ XcdBarrier xcd_barrier_post(unsigned* bar, volatile LAS unsigned* st) {
    XcdBarrier b; b.bar = bar; b.x = xb_xcc_id(); b.st = st;
    if (threadIdx.x == 0) (void)xb_add(&bar[XB_XCNT(b.x)], 1u);
    return b;
}
__device__ __forceinline__ void xcd_barrier_complete(unsigned* bar, unsigned x, unsigned& nloc, unsigned& nx) {
    const unsigned G = gridDim.x * gridDim.y * gridDim.z;
    unsigned sum, cnt, mine, sp = 0u;
    for (;;) {
        sum = 0u; cnt = 0u; mine = 0u;
#pragma unroll
        for (unsigned j = 0; j < 16; ++j) { const unsigned c = xb_ld(&bar[XB_XCNT(j)]); sum += c; cnt += (c > 0u) ? 1u : 0u; mine = (j == x) ? c : mine; }
        if (sum == G) break;
        __builtin_amdgcn_s_sleep(1);
        if ((++sp & 255u) == 0u) { if (xb_ld(&bar[XB_TMO])) break; if (sp > XB_SPIN_CAP) { atomicAdd(&bar[XB_TMO], 1u); break; } }
    }
    nloc = mine > 0u ? mine : 1u; nx = cnt > 0u ? cnt : 1u;
}
__device__ __forceinline__ void xcd_barrier(const XcdBarrier& b, int wave_s) {
    asm volatile("s_waitcnt vmcnt(0)" ::: "memory");
    __syncthreads();
    if (wave_s == 0 && lane_id_() == 0) {
        unsigned* bar = b.bar;
        __builtin_amdgcn_s_waitcnt(0);
        unsigned nloc = b.st[0], nx = b.st[1];
        if (nloc == 0u) { xcd_barrier_complete(bar, b.x, nloc, nx); b.st[0] = nloc; b.st[1] = nx; }
        const unsigned old = xb_add(&bar[XB_XSUB(b.x)], 1u);
        const unsigned gen = old / nloc;
        if (old + 1u == (gen + 1u) * nloc) {
            __builtin_amdgcn_fence(__ATOMIC_RELEASE, "agent");
            asm volatile("s_waitcnt vmcnt(0)" ::: "memory");
            const unsigned og = xb_add(&bar[XB_TOP], 1u);
            const unsigned tg = og / nx;
            if (og + 1u == (tg + 1u) * nx) xb_add(&bar[XB_TOPGEN], 1u);
            else XB_SPIN(xb_ld(&bar[XB_TOPGEN]) == tg, bar);
            __builtin_amdgcn_fence(__ATOMIC_ACQUIRE, "agent");
            xb_add(&bar[XB_XGEN(b.x)], 1u);
            asm volatile("s_waitcnt vmcnt(0)" ::: "memory");
        } else {
            XB_SPIN(xb_ld(&bar[XB_XGEN(b.x)]) == gen, bar);
            __builtin_amdgcn_fence(__ATOMIC_ACQUIRE, "agent");
            asm volatile("s_waitcnt vmcnt(0)" ::: "memory");
        }
    }
    __syncthreads();
}

constexpr int LROW = 144;
constexpr int LTILE = 256 * LROW;
constexpr int LTILEB = 128 * LROW;

template <int NI>
__device__ __forceinline__ void gemm_loop(f32x4 (&acc)[4][NI], const bfu* __restrict__ A, int lda, const int (&arow)[4],
                                          const bfu* __restrict__ Bt, int ldb, int n0, int K, char* smem, int tid) {
    const int kc = tid & 7, tr = tid >> 3;
    const int wave = tid >> 6, lane = tid & 63, wm = wave >> 1, wn = wave & 1, g = lane >> 4, c = lane & 15;
    const bfu* pa0 = A + (size_t)arow[0] * lda + kc * 8;
    const bfu* pa1 = A + (size_t)arow[1] * lda + kc * 8;
    const bfu* pa2 = A + (size_t)arow[2] * lda + kc * 8;
    const bfu* pa3 = A + (size_t)arow[3] * lda + kc * 8;
    const bfu* pb0 = Bt + (size_t)(n0 + tr) * ldb + kc * 8;
    const bfu* pb1 = Bt + (size_t)(n0 + tr + ((NI == 4) ? 64 : 0)) * ldb + kc * 8;
    const int wofs = tr * LROW + kc * 16;
    const int aofs = (wm * 64 + c) * LROW + g * 16;
    const int bofs = (wn * (16 * NI) + c) * LROW + g * 16;
    const int nk = K >> 6;
    uint4 ra0 = *(const uint4*)pa0, ra1 = *(const uint4*)pa1, ra2 = *(const uint4*)pa2, ra3 = *(const uint4*)pa3;
    uint4 rb0 = *(const uint4*)pb0, rb1 = *(const uint4*)pb1;
    *(uint4*)(smem + wofs) = ra0; *(uint4*)(smem + wofs + 64 * LROW) = ra1; *(uint4*)(smem + wofs + 128 * LROW) = ra2; *(uint4*)(smem + wofs + 192 * LROW) = ra3;
    *(uint4*)(smem + 2 * LTILE + wofs) = rb0;
    if (NI == 4) *(uint4*)(smem + 2 * LTILE + wofs + 64 * LROW) = rb1;
    __syncthreads();
    for (int kt = 0; kt < nk; ++kt) {
        const int cur = kt & 1;
        const bool more = (kt + 1 < nk);
        if (more) {
            const size_t ko = (size_t)(kt + 1) * 64;
            ra0 = *(const uint4*)(pa0 + ko); ra1 = *(const uint4*)(pa1 + ko); ra2 = *(const uint4*)(pa2 + ko); ra3 = *(const uint4*)(pa3 + ko);
            rb0 = *(const uint4*)(pb0 + ko); rb1 = *(const uint4*)(pb1 + ko);
        }
        const char* As = smem + cur * LTILE;
        const char* Bs = smem + 2 * LTILE + cur * LTILEB;
#pragma unroll
        for (int ks = 0; ks < 2; ++ks) {
            bf16x8 af[4], bq[NI];
#pragma unroll
            for (int mi = 0; mi < 4; ++mi) af[mi] = *(const bf16x8*)(As + aofs + mi * 16 * LROW + ks * 64);
#pragma unroll
            for (int ni = 0; ni < NI; ++ni) bq[ni] = *(const bf16x8*)(Bs + bofs + ni * 16 * LROW + ks * 64);
#pragma unroll
            for (int mi = 0; mi < 4; ++mi)
#pragma unroll
                for (int ni = 0; ni < NI; ++ni)
                    acc[mi][ni] = __builtin_amdgcn_mfma_f32_16x16x32_bf16(af[mi], bq[ni], acc[mi][ni], 0, 0, 0);
        }
        if (more) {
            char* Aw = smem + (cur ^ 1) * LTILE;
            char* Bw = smem + 2 * LTILE + (cur ^ 1) * LTILEB;
            *(uint4*)(Aw + wofs) = ra0; *(uint4*)(Aw + wofs + 64 * LROW) = ra1; *(uint4*)(Aw + wofs + 128 * LROW) = ra2; *(uint4*)(Aw + wofs + 192 * LROW) = ra3;
            *(uint4*)(Bw + wofs) = rb0;
            if (NI == 4) *(uint4*)(Bw + wofs + 64 * LROW) = rb1;
        }
        __syncthreads();
    }
}
template <int NI>
__device__ __forceinline__ void zero_acc(f32x4 (&acc)[4][NI]) {
#pragma unroll
    for (int mi = 0; mi < 4; ++mi)
#pragma unroll
        for (int ni = 0; ni < NI; ++ni) acc[mi][ni] = (f32x4){0.f, 0.f, 0.f, 0.f};
}
__device__ __forceinline__ void ident_rows(int (&arow)[4], int m0, int tid) {
#pragma unroll
    for (int i = 0; i < 4; ++i) arow[i] = m0 + (tid >> 3) + 64 * i;
}

namespace g8 {
constexpr int BM = 256, BK = 64, HALF = 128, HTB = HALF * BK * 2, STAGE_BYTES = 8 * HTB, NXCD = 8, WGM = 8;
__device__ __forceinline__ int lds_byte(int r, int c) { const int st = (r >> 4) * 2 + (c >> 5), rr = r & 15, cc = c & 31, ob = rr * 64 + cc * 2; return st * 1024 + (ob ^ (((ob >> 9) & 1) << 5)); }
__device__ __forceinline__ void stage_rc(int b, int& R, int& C) { const int st = b / 1024, sb = b % 1024, swz = sb ^ (((sb >> 9) & 1) << 5); R = (st >> 1) * 16 + swz / 64; C = (st & 1) * 32 + (swz % 64) / 2; }
__device__ __forceinline__ int perm32(int rho) { const int n = rho >> 4, i = rho & 15; return 8 * (i >> 2) + 4 * n + (i & 3); }

struct Unit { const char* A; const char* B; int pm, pn, e, cn; };
__device__ __forceinline__ int uni(int v) { return __builtin_amdgcn_readfirstlane(v); }

__device__ __forceinline__ bool static_tile(int i, int G, int c, int nM, int nN, int& pm, int& pn) {
    const int nwg = nM * nN;
    const long L = (long)i * G + c; if (L >= nwg) return false;
    int wgid = (int)L; { const int q = nwg / NXCD, r = nwg % NXCD, xcd = wgid % NXCD, off = wgid / NXCD; wgid = (xcd < r ? xcd * (q + 1) : r * (q + 1) + (xcd - r) * q) + off; }
    const int nig = WGM * nN, gid = wgid / nig, fm = gid * WGM, gsz = (nM - fm) < WGM ? (nM - fm) : WGM;
    pm = fm + ((wgid % nig) % gsz); pn = (wgid % nig) / gsz; return true;
}

template <class Epi, class Sched>
__device__ __forceinline__ void gemm8(LAS unsigned char* lds, const Sched& S, const Epi& E, int K, int tid) {
    const int wid = __builtin_amdgcn_readfirstlane(tid >> 6), lane = tid & 63, wr = wid >> 2, wc = wid & 3, fr = lane & 15, fq = lane >> 4;
    const int nt = K / BK;
    unsigned voffB[2];
#pragma unroll
    for (int i = 0; i < 2; ++i) { int R_, C_; stage_rc(tid * 16 + i * 8192, R_, C_); const int Rb = Epi::PERM ? ((R_ & ~31) + perm32(R_ & 31)) : R_;
        voffB[i] = (unsigned)(Rb * S.ldb + C_) * 2u; }
    const size_t kstep = (size_t)(BK * 2);
    const size_t hstepB = (size_t)HALF * S.ldb * 2;
    const unsigned ldsw = (unsigned)wid * 1024u;
    const int aoff = lds_byte(wr * 64 + fr, fq * 8), boff = lds_byte(wc * 32 + fr, fq * 8);
#define G8_SA(b, h) (((b) * 2 + (h)) * HTB)
#define G8_SB(b, h) ((4 + (b) * 2 + (h)) * HTB)
#define G8_STAGEB(bufoff, gbase) do { _Pragma("unroll") for (int _i = 0; _i < 2; ++_i) { unsigned _o = voffB[_i]; asm volatile("" : "+v"(_o)); \
        __builtin_amdgcn_global_load_lds((const unsigned*)((const char*)(gbase) + _o), (LAS unsigned*)(lds + (bufoff) + ldsw + _i * 8192), 16, 0, 0); } } while (0)
#define G8_STAGEA(bufoff, gbase, VA, h) do { _Pragma("unroll") for (int _i = 0; _i < 2; ++_i) { unsigned _o = (VA)[h][_i]; asm volatile("" : "+v"(_o)); \
        __builtin_amdgcn_global_load_lds((const unsigned*)((const char*)(gbase) + _o), (LAS unsigned*)(lds + (bufoff) + ldsw + _i * 8192), 16, 0, 0); } } while (0)
#define G8_LDA(dst, b, h) do { _Pragma("unroll") for (int m = 0; m < 4; ++m) _Pragma("unroll") for (int k = 0; k < 2; ++k) dst[m][k] = *(const LAS bf16x8*)(lds + G8_SA(b, h) + aoff + m * 2048 + k * 1024); } while (0)
#define G8_LDB(dst, b, h) do { _Pragma("unroll") for (int n = 0; n < 2; ++n) _Pragma("unroll") for (int k = 0; k < 2; ++k) dst[n][k] = *(const LAS bf16x8*)(lds + G8_SB(b, h) + boff + n * 2048 + k * 1024); } while (0)
#define G8_MMA(ai, bj, At, Bt) do { __builtin_amdgcn_s_setprio(1); _Pragma("unroll") for (int m = 0; m < 4; ++m) _Pragma("unroll") for (int n = 0; n < 2; ++n) _Pragma("unroll") for (int k = 0; k < 2; ++k) \
        acc[ai][bj][m][n] = __builtin_amdgcn_mfma_f32_16x16x32_bf16(Bt[n][k], At[m][k], acc[ai][bj][m][n], 0, 0, 0); __builtin_amdgcn_s_setprio(0); } while (0)
#define G8_WAIT_V(n) asm volatile("s_waitcnt vmcnt(" #n ")" ::: "memory")
#define G8_WAIT_L(n) asm volatile("s_waitcnt lgkmcnt(" #n ")" ::: "memory")
#define G8_BAR __builtin_amdgcn_s_barrier()
#define G8_SCHED __builtin_amdgcn_sched_barrier(0)
#define G8_VOFF(VA, U) do { _Pragma("unroll") for (int _i = 0; _i < 2; ++_i) { int _R, _C; stage_rc(tid * 16 + _i * 8192, _R, _C); _Pragma("unroll") for (int _h = 0; _h < 2; ++_h) { \
        int _row = _R + _h * HALF; if (Sched::GATHER) S.rows(U, _row, _row); VA[_h][_i] = (unsigned)(_row * S.lda + _C) * 2u; } } } while (0)
    Unit cur, nxt; int ui = 0;
    if (!S.next(0, cur)) return;
    f32x4 acc[2][2][4][2];
#pragma unroll
    for (int a = 0; a < 2; ++a)
#pragma unroll
        for (int b = 0; b < 2; ++b)
#pragma unroll
            for (int m = 0; m < 4; ++m)
#pragma unroll
                for (int n = 0; n < 2; ++n) acc[a][b][m][n] = (f32x4){0.f, 0.f, 0.f, 0.f};
    bf16x8 At[4][2], B0[2][2], B1[2][2];
    unsigned cva[2][2], nva[2][2]; int nidx[2][2];
    G8_VOFF(cva, cur);
    const char* cA = cur.A; const char* cB = cur.B;
    G8_STAGEB(G8_SB(0, 0), cB); G8_STAGEA(G8_SA(0, 0), cA, cva, 0); G8_STAGEB(G8_SB(0, 1), cB + hstepB); G8_STAGEA(G8_SA(0, 1), cA, cva, 1);
    if (wr == 1) G8_BAR;
    G8_WAIT_V(4); G8_BAR;
    G8_STAGEB(G8_SB(1, 0), cB + kstep); G8_STAGEA(G8_SA(1, 0), cA + kstep, cva, 0); G8_STAGEB(G8_SB(1, 1), cB + hstepB + kstep);
    G8_WAIT_V(6); G8_BAR;
    for (;;) {
        const bool has_next = S.next(ui + 1, nxt);
        const char* nA = has_next ? nxt.A : cA; const char* nB = has_next ? nxt.B : cB;
        if constexpr (Sched::GATHER) {
            if (has_next) {
#pragma unroll
                for (int _i = 0; _i < 2; ++_i) { int _R, _C; stage_rc(tid * 16 + _i * 8192, _R, _C);
#pragma unroll
                    for (int _h = 0; _h < 2; ++_h) { int _row = _R + _h * HALF; S.rows(nxt, _row, _row); nidx[_h][_i] = _row; } }
            }
        }
        for (int t = 0; t < nt; t += 2) {
            const bool last = (t == nt - 2);
            const char* a1 = cA + (size_t)(t + 1) * kstep;
            const char* a2 = last ? nA : cA + (size_t)(t + 2) * kstep; const char* b2 = last ? nB : cB + (size_t)(t + 2) * kstep;
            const char* a3 = a2 + kstep; const char* b3 = b2 + kstep;
            if constexpr (Sched::GATHER) {
                if (last && has_next) {
#pragma unroll
                    for (int _i = 0; _i < 2; ++_i) { int _R, _C; stage_rc(tid * 16 + _i * 8192, _R, _C);
#pragma unroll
                        for (int _h = 0; _h < 2; ++_h) nva[_h][_i] = (unsigned)(nidx[_h][_i] * S.lda + _C) * 2u; }
                }
            }
            const bool use_n = Sched::GATHER && last && has_next;
            G8_LDB(B0, 0, 0); G8_SCHED; G8_LDA(At, 0, 0); G8_STAGEA(G8_SA(1, 1), a1, cva, 1);
            G8_WAIT_L(8); G8_BAR; G8_WAIT_L(0); G8_MMA(0, 0, At, B0); G8_BAR; G8_SCHED;
            G8_LDB(B1, 0, 1); G8_STAGEB(G8_SB(0, 0), b2);
            G8_BAR; G8_WAIT_L(0); G8_MMA(0, 1, At, B1); G8_BAR;
            G8_LDA(At, 0, 1); if (use_n) { G8_STAGEA(G8_SA(0, 0), a2, nva, 0); } else { G8_STAGEA(G8_SA(0, 0), a2, cva, 0); }
            G8_BAR; G8_WAIT_L(0); G8_MMA(1, 0, At, B0); G8_BAR; G8_SCHED;
            G8_STAGEB(G8_SB(0, 1), b2 + hstepB);
            G8_WAIT_V(6); G8_BAR; G8_MMA(1, 1, At, B1); G8_BAR;
            G8_LDB(B0, 1, 0); G8_SCHED; G8_LDA(At, 1, 0); if (use_n) { G8_STAGEA(G8_SA(0, 1), a2, nva, 1); } else { G8_STAGEA(G8_SA(0, 1), a2, cva, 1); }
            G8_WAIT_L(8); G8_BAR; G8_WAIT_L(0); G8_MMA(0, 0, At, B0); G8_BAR; G8_SCHED;
            G8_LDB(B1, 1, 1); G8_STAGEB(G8_SB(1, 0), b3);
            G8_BAR; G8_WAIT_L(0); G8_MMA(0, 1, At, B1); G8_BAR;
            G8_LDA(At, 1, 1); if (use_n) { G8_STAGEA(G8_SA(1, 0), a3, nva, 0); } else { G8_STAGEA(G8_SA(1, 0), a3, cva, 0); }
            G8_BAR; G8_WAIT_L(0); G8_MMA(1, 0, At, B0); G8_BAR; G8_SCHED;
            G8_STAGEB(G8_SB(1, 1), b3 + hstepB);
            G8_WAIT_V(6); G8_BAR; G8_MMA(1, 1, At, B1); G8_BAR;
        }
        E(acc, cur, wr, wc, fr, fq);
        if (!has_next) break;
#pragma unroll
        for (int a = 0; a < 2; ++a)
#pragma unroll
            for (int b = 0; b < 2; ++b)
#pragma unroll
                for (int m = 0; m < 4; ++m)
#pragma unroll
                    for (int n = 0; n < 2; ++n) acc[a][b][m][n] = (f32x4){0.f, 0.f, 0.f, 0.f};
        cur = nxt; cA = nA; cB = nB; ++ui;
        if constexpr (Sched::GATHER) {
#pragma unroll
            for (int _h = 0; _h < 2; ++_h) { cva[_h][0] = nva[_h][0]; cva[_h][1] = nva[_h][1]; }
        }
    }
    G8_WAIT_V(0);
    if (wr == 0) G8_BAR;
    G8_BAR;
#undef G8_SA
#undef G8_SB
#undef G8_STAGEA
#undef G8_STAGEB
#undef G8_LDA
#undef G8_LDB
#undef G8_MMA
#undef G8_WAIT_V
#undef G8_WAIT_L
#undef G8_BAR
#undef G8_SCHED
#undef G8_VOFF
}
}

struct TJob { const float* src; bfu* dst; bfu* dst2; int K, N, lds, ldd, Kd, Nd, mode; };

__device__ __forceinline__ void tr_tile(const TJob& jb, int tk, int tn, char* smem, int tid) {
    float* tile = (float*)smem;
    const int k0 = tk * 64, n0 = tn * 64;
    __syncthreads();
#pragma unroll
    for (int i = 0; i < 8; ++i) {
        const int kk = (tid >> 6) + 8 * i, nn = tid & 63;
        const int k = k0 + kk, n = n0 + nn;
        int ns = n;
        if (jb.mode == 1) { const int G = n >> 5, hh = (n >> 4) & 1, ii = n & 15; ns = hh * 1024 + G * 16 + ii; }
        float v = 0.f;
        if (k < jb.K && n < jb.N) v = jb.src[(size_t)k * jb.lds + ns];
        tile[kk * 65 + nn] = v;
    }
    __syncthreads();
#pragma unroll
    for (int i = 0; i < 8; ++i) {
        const int nn = (tid >> 6) + 8 * i, kk = tid & 63;
        const float v = tile[kk * 65 + nn];
        const size_t o = (size_t)(n0 + nn) * jb.ldd + k0 + kk;
        const bfu hi = f2bf(v);
        if (jb.mode == 2) { if (n0 + nn < jb.N) { jb.dst[o] = hi; jb.dst[o + 1024] = hi; jb.dst2[o] = f2bf(v - bf2f(hi)); } }
        else jb.dst[o] = hi;
    }
}

__device__ __forceinline__ void tr_tile256(const float* __restrict__ src, int lds, bfu* __restrict__ dst, int ldd, int mode, int tk, int tn, char* smem, int tid) {
    float* tile = (float*)smem;
    const int k0 = tk * 64, n0 = tn * 256;
    __syncthreads();
    float4 v[8];
#pragma unroll
    for (int i = 0; i < 8; ++i) {
        const int kk = (tid >> 6) + 8 * i, c4 = (tid & 63) * 4;
        int ns = n0 + c4;
        if (mode == 1) { const int n = n0 + c4; ns = ((n >> 4) & 1) * 1024 + (n >> 5) * 16 + (n & 15); }
        v[i] = *(const float4*)(src + (size_t)(k0 + kk) * lds + ns);
    }
#pragma unroll
    for (int i = 0; i < 8; ++i) {
        const int kk = (tid >> 6) + 8 * i, c4 = (tid & 63) * 4;
        float* t = tile + kk * 257 + c4;
        t[0] = v[i].x; t[1] = v[i].y; t[2] = v[i].z; t[3] = v[i].w;
    }
    __syncthreads();
#pragma unroll
    for (int i = 0; i < 4; ++i) {
        const int nn = (tid >> 3) + 64 * i, k8 = (tid & 7) * 8;
        const float* t = tile + k8 * 257 + nn;
        uint4 p;
        p.x = pack2(t[0], t[257]); p.y = pack2(t[2 * 257], t[3 * 257]); p.z = pack2(t[4 * 257], t[5 * 257]); p.w = pack2(t[6 * 257], t[7 * 257]);
        *(uint4*)(dst + (size_t)(n0 + nn) * ldd + k0 + k8) = p;
    }
}

__device__ __forceinline__ void misc_job(const Args& a, int j, TJob& jb) {
    const int l = j / 16, q = j % 16;
    unsigned char* ws = wsp(a);
    jb.dst2 = nullptr; jb.mode = 0;
    bfu* wint = (bfu*)(ws + WS_WINT) + (size_t)l * 8192 * 1024;
    if (q == 0) { jb.src = a.in[8] + (size_t)l * 1024 * 7680; jb.K = 1024; jb.N = 7680; jb.lds = 7680; jb.dst = wint; jb.ldd = 1024; jb.Kd = 1024; jb.Nd = 7680; }
    else if (q <= 2) { const int d = q - 1; jb.src = a.in[13] + (size_t)(l * 2 + d) * 1024 * 64; jb.K = 1024; jb.N = 64; jb.lds = 64; jb.dst = wint + (size_t)(7680 + 64 * d) * 1024; jb.ldd = 1024; jb.Kd = 1024; jb.Nd = 64; }
    else if (q <= 4) { const int d = q - 3; jb.src = a.in[16] + (size_t)(l * 2 + d) * 1024 * 64; jb.K = 1024; jb.N = 64; jb.lds = 64; jb.dst = wint + (size_t)(7808 + 64 * d) * 1024; jb.ldd = 1024; jb.Kd = 1024; jb.Nd = 64; }
    else if (q == 5) { jb.src = a.in[18] + (size_t)l * 1024 * 160; jb.K = 1024; jb.N = 160; jb.lds = 160; jb.dst = wint + (size_t)7936 * 1024; jb.ldd = 1024; jb.Kd = 1024; jb.Nd = 256; }
    else if (q <= 7) { const int d = q - 6; jb.src = a.in[14] + (size_t)(l * 2 + d) * 64 * 512; jb.K = 64; jb.N = 512; jb.lds = 512; jb.dst = (bfu*)(ws + WS_S2T) + (size_t)l * 2560 * 512 + (size_t)(512 * d) * 512 + 64 * d; jb.ldd = 512; jb.Kd = 64; jb.Nd = 512; }
    else if (q <= 9) { const int d = q - 8; jb.src = a.in[17] + (size_t)(l * 2 + d) * 64 * 512; jb.K = 64; jb.N = 512; jb.lds = 512; jb.dst = (bfu*)(ws + WS_S2T) + (size_t)l * 2560 * 512 + (size_t)(1024 + 512 * d) * 512 + 128 + 64 * d; jb.ldd = 512; jb.Kd = 64; jb.Nd = 512; }
    else if (q == 10) { jb.src = a.in[19] + (size_t)l * 160 * 512; jb.K = 160; jb.N = 512; jb.lds = 512; jb.dst = (bfu*)(ws + WS_S2T) + (size_t)l * 2560 * 512 + (size_t)2048 * 512 + 256; jb.ldd = 512; jb.Kd = 192; jb.Nd = 512; }
    else if (q <= 13) { const int n = q - 11; jb.src = a.in[25] + (size_t)(l * 3 + n) * 512 * 1024; jb.K = 512; jb.N = 1024; jb.lds = 1024; jb.dst = (bfu*)(ws + WS_WBT) + (size_t)(l * 3 + n) * 1024 * 512; jb.ldd = 512; jb.Kd = 512; jb.Nd = 1024; }
    else if (q == 14) { jb.src = a.in[26] + (size_t)l * 1024 * 1024; jb.K = 1024; jb.N = 1024; jb.lds = 1024; jb.dst = (bfu*)(ws + WS_WOT) + (size_t)l * 1024 * 1024; jb.ldd = 1024; jb.Kd = 1024; jb.Nd = 1024; }
    else { jb.src = a.in[27] + (size_t)l * 1024 * 32; jb.K = 1024; jb.N = 32; jb.lds = 32; jb.dst = (bfu*)(ws + WS_RT) + (size_t)l * 256 * 2048; jb.dst2 = jb.dst + (size_t)128 * 2048; jb.ldd = 2048; jb.Kd = 1024; jb.Nd = 64; jb.mode = 2; }
}

__device__ __forceinline__ void phase_prep(const Args& a, char* smem, int tid, int bid, int nb) {
    unsigned char* ws = wsp(a);
    for (int it = bid + 12288; it < 12288 + 1280; it += nb) {
        if (it < 12288) {
            const int le = it / 192, r = it % 192;
            if (r < 128) tr_tile256(a.in[29] + (size_t)le * 1024 * 2048, 2048, (bfu*)(ws + WS_W1T) + (size_t)le * 2048 * 1024, 1024, 1, r >> 3, r & 7, smem, tid);
            else { const int r2 = r - 128; tr_tile256(a.in[31] + (size_t)le * 1024 * 1024, 1024, (bfu*)(ws + WS_W2ET) + (size_t)le * 1024 * 1024, 1024, 0, r2 >> 2, r2 & 3, smem, tid); }
        } else {
            const int j = it - 12288, l = j / 640, r = j % 640;
            if (r < 480) tr_tile256(a.in[8] + (size_t)l * 1024 * 7680, 7680, (bfu*)(ws + WS_WINT) + (size_t)l * 8192 * 1024, 1024, 0, r / 30, r % 30, smem, tid);
            else if (r < 576) { const int r2 = r - 480, n = r2 >> 5, q = r2 & 31; tr_tile256(a.in[25] + (size_t)(l * 3 + n) * 512 * 1024, 1024, (bfu*)(ws + WS_WBT) + (size_t)(l * 3 + n) * 1024 * 512, 512, 0, q >> 2, q & 3, smem, tid); }
            else { const int r2 = r - 576;
                for (int cpy = 0; cpy < 1; ++cpy) tr_tile256(a.in[26] + (size_t)l * 1024 * 1024, 1024, (bfu*)(ws + WS_WOT) + (size_t)l * 1024 * 3072 + cpy * 1024, 3072, 0, r2 >> 2, r2 & 3, smem, tid); }
        }
    }
    {
        int base = 0;
        for (int j = 0; j < 32; ++j) {
            TJob jb; misc_job(a, j, jb);
            const int q_ = j % 16;
            const bool fastdone = (q_ == 0) || (q_ >= 11 && q_ <= 15);
            const int tks = jb.Kd >> 6, tns = jb.Nd >> 6, nt = fastdone ? 0 : tks * tns;
            int first = ((bid - base) % nb + nb) % nb;
            for (int t = first; t < nt; t += nb) tr_tile(jb, t / tns, t % tns, smem, tid);
            base = (base + nt) % nb;
        }
    }
    __syncthreads();
    for (int it = bid; it < 192; it += nb) {
        const int l = it / 96, jb0 = (it % 96) * 64;
        float* sl = (float*)smem;
        float* red = (float*)(smem + 36864);
        __syncthreads();
        for (int i = tid; i < 9 * 1024; i += NTHREADS) {
            const int m = i >> 10, k = i & 1023;
            const float v = (m < 8) ? a.in[1][m * 1024 + k] : a.in[3][k];
            sl[i] = v / (1.0f + __expf(-v));
        }
        __syncthreads();
        const int kq = tid >> 4, jv = tid & 15;
        float acc[9][4];
#pragma unroll
        for (int m = 0; m < 9; ++m) { acc[m][0] = 0.f; acc[m][1] = 0.f; acc[m][2] = 0.f; acc[m][3] = 0.f; }
        const float* wm = a.in[4] + (size_t)l * 1024 * 6144 + jb0 + jv * 4;
#pragma unroll 4
        for (int kk = 0; kk < 32; ++kk) {
            const int k = kq * 32 + kk;
            const float4 w = *(const float4*)(wm + (size_t)k * 6144);
#pragma unroll
            for (int m = 0; m < 9; ++m) {
                const float s = sl[m * 1024 + k];
                acc[m][0] += s * w.x; acc[m][1] += s * w.y; acc[m][2] += s * w.z; acc[m][3] += s * w.w;
            }
        }
#pragma unroll
        for (int m = 0; m < 9; ++m)
#pragma unroll
            for (int e = 0; e < 4; ++e) red[(kq * 9 + m) * 64 + jv * 4 + e] = acc[m][e];
        __syncthreads();
        for (int i = tid; i < 9 * 64; i += NTHREADS) {
            const int m = i >> 6, jj = i & 63;
            float s = 0.f;
#pragma unroll
            for (int q = 0; q < 32; ++q) s += red[(q * 9 + m) * 64 + jj];
            ((float*)(ws + WS_MOD))[(size_t)(l * 9 + m) * 6144 + jb0 + jj] = s + a.in[5][l * 6144 + jb0 + jj];
        }
    }
    if (bid == 0) {
        float* tab = (float*)(ws + WS_TAB);
        for (int i = tid; i < 1024; i += NTHREADS) {
            const int pos = i >> 4, j = i & 15;
            const float inv = exp2f(-(float)j * (13.287712379549449f / 16.0f));
            const double ang = (double)((float)pos * inv);
            double rev = ang * 0.15915494309189535;
            rev -= floor(rev);
            tab[i] = __builtin_amdgcn_cosf((float)rev);
            tab[1024 + i] = __builtin_amdgcn_sinf((float)rev);
        }
        if (tid < 2) {
            const float* lv = a.in[9] + tid * 256;
            float s1 = 0.f, s2 = 0.f;
            for (int i = 0; i < 64; ++i) { s1 += lv[i] * lv[64 + i]; s2 += lv[128 + i] * lv[192 + i]; }
            const float lam_init = (tid == 0) ? 0.2f : (0.8f - 0.6f * 0.7408182206817179f);
            tab[2048 + tid] = __expf(s1) - __expf(s2) + lam_init;
        }
    }
}

__device__ __forceinline__ void store_h_row(bfu* dst, const float (&y)[16], int lane) {
#pragma unroll
    for (int i = 0; i < 4; ++i) {
        uint2 p; p.x = pack2(y[i * 4 + 0], y[i * 4 + 1]); p.y = pack2(y[i * 4 + 2], y[i * 4 + 3]);
        *(uint2*)(dst + i * 256 + lane * 4) = p;
    }
}
__device__ __forceinline__ void norm_mod(const float (&v)[16], float (&y)[16], const float* g, const float* shift, const float* scale, int lane) {
    float ss = 0.f;
#pragma unroll
    for (int i = 0; i < 16; ++i) ss += v[i] * v[i];
    ss = wave_sum(ss);
    const float rs = rsqrtf(ss * (1.0f / 1024.0f) + 1e-6f);
#pragma unroll
    for (int i = 0; i < 4; ++i) {
        const int col = i * 256 + lane * 4;
        const float4 gg = *(const float4*)(g + col);
        const float4 sh = *(const float4*)(shift + col);
        const float4 sc = *(const float4*)(scale + col);
        y[i * 4 + 0] = v[i * 4 + 0] * rs * gg.x * (1.0f + sc.x) + sh.x;
        y[i * 4 + 1] = v[i * 4 + 1] * rs * gg.y * (1.0f + sc.y) + sh.y;
        y[i * 4 + 2] = v[i * 4 + 2] * rs * gg.z * (1.0f + sc.z) + sh.z;
        y[i * 4 + 3] = v[i * 4 + 3] * rs * gg.w * (1.0f + sc.w) + sh.w;
    }
}

__device__ __forceinline__ void phase_norm1_l0(const Args& a, int tid, int bid, int nb) {
    const int wave = tid >> 6, lane = tid & 63;
    float* xres = (float*)(wsp(a) + WS_XRES);
    bfu* H = (bfu*)(wsp(a) + WS_H);
    const float* mod = (const float*)(wsp(a) + WS_MOD);
    for (int row = bid * NW + wave; row < NT; row += nb * NW) {
        const int b = row / TB, t = row % TB;
        const float* src = (t < SEQ) ? (a.in[0] + ((size_t)b * SEQ + t) * 1024) : (a.in[2] + ((size_t)b * CTX + (t - SEQ)) * 1024);
        const int m = (t < SEQ) ? b : 8;
        float v[16], y[16];
#pragma unroll
        for (int i = 0; i < 4; ++i) {
            const float4 x4 = *(const float4*)(src + i * 256 + lane * 4);
            v[i * 4 + 0] = x4.x; v[i * 4 + 1] = x4.y; v[i * 4 + 2] = x4.z; v[i * 4 + 3] = x4.w;
            *(float4*)(xres + (size_t)row * 1024 + i * 256 + lane * 4) = x4;
        }
        const float* md = mod + (size_t)(0 * 9 + m) * 6144;
        norm_mod(v, y, a.in[6], md + 0, md + 1024, lane);
        store_h_row(H + (size_t)row * 1024, y, lane);
    }
}

__device__ __forceinline__ void phase_norm2(const Args& a, int l, int tid, int bid, int nb) {
    const int wave = tid >> 6, lane = tid & 63;
    const float* xres = (const float*)(wsp(a) + WS_XRES);
    bfu* HI = (bfu*)(wsp(a) + WS_H2HI);
    bfu* LO = (bfu*)(wsp(a) + WS_H2LO);
    const float* mod = (const float*)(wsp(a) + WS_MOD);
    for (int row = bid * NW + wave; row < NT; row += nb * NW) {
        const int b = row / TB, t = row % TB;
        if (l == 1 && t >= SEQ) continue;
        const int m = (t < SEQ) ? b : 8;
        float v[16], y[16], lo[16];
#pragma unroll
        for (int i = 0; i < 4; ++i) {
            const float4 x4 = *(const float4*)(xres + (size_t)row * 1024 + i * 256 + lane * 4);
            v[i * 4 + 0] = x4.x; v[i * 4 + 1] = x4.y; v[i * 4 + 2] = x4.z; v[i * 4 + 3] = x4.w;
        }
        const float* md = mod + (size_t)(l * 9 + m) * 6144;
        norm_mod(v, y, a.in[7] + l * 1024, md + 3 * 1024, md + 4 * 1024, lane);
#pragma unroll
        for (int i = 0; i < 16; ++i) lo[i] = y[i] - bf2f(f2bf(y[i]));
        store_h_row(HI + (size_t)row * 2048, y, lane);
        store_h_row(HI + (size_t)row * 2048 + 1024, lo, lane);
        store_h_row((bfu*)(wsp(a) + WS_H) + (size_t)row * 1024, y, lane);
    }
}

__device__ __forceinline__ void phase_combine(const Args& a, int l, int tid, int bid, int nb) {
    const int wave = tid >> 6, lane = tid & 63;
    float* xres = (float*)(wsp(a) + WS_XRES);
    const bfu* YB = (const bfu*)(wsp(a) + WS_YB);
    bfu* H = (bfu*)(wsp(a) + WS_H);
    const float* mod = (const float*)(wsp(a) + WS_MOD);
    for (int row = bid * NW + wave; row < NT; row += nb * NW) {
        const int b = row / TB, t = row % TB;
        if (l == 1 && t >= SEQ) continue;
        const int m = (t < SEQ) ? b : 8;
        const float* md = mod + (size_t)(l * 9 + m) * 6144;
        float v[16], y[16];
#pragma unroll
        for (int i = 0; i < 4; ++i) {
            const int col = i * 256 + lane * 4;
            const float4 x4 = *(const float4*)(xres + (size_t)row * 1024 + col);
            float f0 = 0.f, f1 = 0.f, f2 = 0.f, f3 = 0.f;
#pragma unroll
            for (int k = 0; k < 4; ++k) {
                const uint2 p = *(const uint2*)(YB + ((size_t)row * 4 + k) * 1024 + col);
                f0 += bflo(p.x); f1 += bfhi(p.x); f2 += bflo(p.y); f3 += bfhi(p.y);
            }
            const float4 gf = *(const float4*)(md + 5 * 1024 + col);
            v[i * 4 + 0] = x4.x + gf.x * f0; v[i * 4 + 1] = x4.y + gf.y * f1;
            v[i * 4 + 2] = x4.z + gf.z * f2; v[i * 4 + 3] = x4.w + gf.w * f3;
        }
        if (l == 0) {
#pragma unroll
            for (int i = 0; i < 4; ++i)
                *(float4*)(xres + (size_t)row * 1024 + i * 256 + lane * 4) = make_float4(v[i * 4], v[i * 4 + 1], v[i * 4 + 2], v[i * 4 + 3]);
            const float* md1 = mod + (size_t)(1 * 9 + m) * 6144;
            norm_mod(v, y, a.in[6] + 1024, md1 + 0, md1 + 1024, lane);
            store_h_row(H + (size_t)row * 1024, y, lane);
        } else {
            float ss = 0.f;
#pragma unroll
            for (int i = 0; i < 16; ++i) ss += v[i] * v[i];
            ss = wave_sum(ss);
            const float rs = rsqrtf(ss * (1.0f / 1024.0f) + 1e-6f);
            float* o = a.out + ((size_t)b * SEQ + t) * 1024;
#pragma unroll
            for (int i = 0; i < 4; ++i) {
                const int col = i * 256 + lane * 4;
                const float4 gg = *(const float4*)(a.in[33] + col);
                *(float4*)(o + col) = make_float4(v[i * 4] * rs * gg.x, v[i * 4 + 1] * rs * gg.y, v[i * 4 + 2] * rs * gg.z, v[i * 4 + 3] * rs * gg.w);
            }
        }
    }
}

__device__ __forceinline__ void phase_gemm_in(const Args& a, int l, char* smem, int tid, int bid, int nb) {
    unsigned char* ws = wsp(a);
    const bfu* H = (const bfu*)(ws + WS_H);
    const bfu* W = (const bfu*)(ws + WS_WINT) + (size_t)l * 8192 * 1024;
    const float* tab = (const float*)(ws + WS_TAB);
    const int wave = tid >> 6, lane = tid & 63, wm = wave >> 1, wn = wave & 1, g = lane >> 4, c = lane & 15;
    for (int it = bid; it < 72 * 64; it += nb) {
        const int mt = it >> 6, nt = it & 63;
        const int m0 = mt * 256, n0 = nt * 128;
        int arow[4]; ident_rows(arow, m0, tid);
        f32x4 acc[4][4]; zero_acc<4>(acc);
        gemm_loop<4>(acc, H, 1024, arow, W, 1024, n0, 1024, smem, tid);
        const int colbase = n0 + wn * 64;
        const int rowbase = m0 + wm * 64;
        if (nt < 8) {
            bfu* dst = (bfu*)(ws + (nt < 4 ? WS_Q : WS_K));
            const int cc = colbase & 511;
            const float qs = (nt < 4) ? 0.18033688011112042f : 1.0f;
#pragma unroll
            for (int mi = 0; mi < 4; ++mi)
#pragma unroll
                for (int r = 0; r < 4; ++r) {
                    const int row = rowbase + mi * 16 + g * 4 + r;
                    const int t = row % TB;
                    float x0 = acc[mi][0][r], x1 = acc[mi][1][r], x2 = acc[mi][2][r], x3 = acc[mi][3][r];
                    if (t < SEQ) {
                        const int pr = t >> 6, pc = t & 63;
                        const float cr = tab[pr * 16 + c], sr = tab[1024 + pr * 16 + c];
                        const float c2 = tab[pc * 16 + c], s2 = tab[1024 + pc * 16 + c];
                        const float y0 = x0 * cr - x1 * sr, y1 = x0 * sr + x1 * cr;
                        const float y2 = x2 * c2 - x3 * s2, y3 = x2 * s2 + x3 * c2;
                        x0 = y0; x1 = y1; x2 = y2; x3 = y3;
                    }
                    bfu* d = dst + (size_t)row * 512 + cc + c;
                    d[0] = f2bf(x0 * qs); d[16] = f2bf(x1 * qs); d[32] = f2bf(x2 * qs); d[48] = f2bf(x3 * qs);
                }
        } else if (nt < 12) {
            bfu* VT = (bfu*)(ws + WS_VT);
            const int b = m0 / TB;
            const int tb0 = (m0 % TB) + wm * 64;
#pragma unroll
            for (int ni = 0; ni < 4; ++ni) {
                const int cc = colbase - 1024 + ni * 16 + c;
                const int head = cc >> 7, dim = cc & 127;
                bfu* d = VT + ((size_t)(b * 4 + head) * 128 + dim) * TB;
#pragma unroll
                for (int mi = 0; mi < 4; ++mi) {
                    uint2 p; p.x = pack2(acc[mi][ni][0], acc[mi][ni][1]); p.y = pack2(acc[mi][ni][2], acc[mi][ni][3]);
                    *(uint2*)(d + tb0 + mi * 16 + g * 4) = p;
                }
            }
        } else if (nt < 36) {
            bfu* dst; int cc;
            if (nt < 24) { const int q = colbase - 1536; dst = (bfu*)(ws + WS_SB) + (size_t)(q >> 9) * NT * 512; cc = q & 511; }
            else if (nt < 28) { dst = (bfu*)(ws + WS_RR); cc = colbase - 3072; }
            else if (nt < 32) { dst = (bfu*)(ws + WS_RK); cc = colbase - 3584; }
            else { dst = (bfu*)(ws + WS_RV); cc = colbase - 4096; }
#pragma unroll
            for (int mi = 0; mi < 4; ++mi)
#pragma unroll
                for (int ni = 0; ni < 4; ++ni)
#pragma unroll
                    for (int r = 0; r < 4; ++r) {
                        const int row = rowbase + mi * 16 + g * 4 + r;
                        dst[(size_t)row * 512 + cc + ni * 16 + c] = f2bf(acc[mi][ni][r]);
                    }
            if (nt >= 28 && nt < 32) {
                bfu* KKB = (bfu*)(ws + WS_KKB);
                const float* kkw = a.in[20] + l * 512 + cc;
                float w4[4];
#pragma unroll
                for (int ni = 0; ni < 4; ++ni) w4[ni] = kkw[ni * 16 + c];
#pragma unroll
                for (int mi = 0; mi < 4; ++mi)
#pragma unroll
                    for (int r = 0; r < 4; ++r) {
                        float s = 0.f;
#pragma unroll
                        for (int ni = 0; ni < 4; ++ni) { const float q = acc[mi][ni][r] * w4[ni]; s += q * q; }
                        s = red16(s);
                        const float inv = rsqrtf(fmaxf(s, 1e-24f));
                        const int row = rowbase + mi * 16 + g * 4 + r;
#pragma unroll
                        for (int ni = 0; ni < 4; ++ni)
                            KKB[(size_t)row * 512 + cc + ni * 16 + c] = f2bf(acc[mi][ni][r] * w4[ni] * inv);
                    }
            }
        } else if (nt < 60) {
            bfu* GL = (bfu*)(ws + WS_GL);
            const int cc = colbase - 4608;
#pragma unroll
            for (int mi = 0; mi < 4; ++mi)
#pragma unroll
                for (int ni = 0; ni < 4; ++ni)
#pragma unroll
                    for (int r = 0; r < 4; ++r) {
                        const int row = rowbase + mi * 16 + g * 4 + r;
                        GL[(size_t)row * 3072 + cc + ni * 16 + c] = f2bf(sigmoidf_(acc[mi][ni][r]));
                    }
        } else {
            bfu* LO = (bfu*)(ws + WS_LORA);
            const int cc = colbase - 7680;
#pragma unroll
            for (int mi = 0; mi < 4; ++mi)
#pragma unroll
                for (int ni = 0; ni < 4; ++ni)
#pragma unroll
                    for (int r = 0; r < 4; ++r) {
                        const int row = rowbase + mi * 16 + g * 4 + r;
                        float v = acc[mi][ni][r];
                        if (nt == 60) v = tanhf_(v); else if (nt >= 62) v = sigmoidf_(v);
                        LO[(size_t)row * 512 + cc + ni * 16 + c] = f2bf(v);
                    }
        }
    }
}

struct SchedDense {
    static constexpr bool GATHER = false;
    const char* A; const char* B; int lda, ldb, nM, nN, G, c, skip9;
    __device__ __forceinline__ bool next(int i, g8::Unit& u) const {
        int pm, pn; if (!g8::static_tile(i, G, c, nM, nN, pm, pn)) return false;
        if (skip9) pm += pm >> 3;
        pm = g8::uni(pm); pn = g8::uni(pn);
        u.pm = pm; u.pn = pn; u.e = 0; u.cn = 0;
        u.A = A + (size_t)pm * 256 * lda * 2; u.B = B + (size_t)pn * 256 * ldb * 2; return true;
    }
    __device__ __forceinline__ void rows(const g8::Unit&, int, int&) const {}
};
__device__ __forceinline__ uint2 pack4(const f32x4& v) { uint2 p; p.x = pack2(v[0], v[1]); p.y = pack2(v[2], v[3]); return p; }

struct EpiIn {
    static constexpr bool PERM = true;
    unsigned char* ws; int l;
    __device__ __forceinline__ void operator()(const f32x4 (&acc)[2][2][4][2], const g8::Unit& u, int wr, int wc, int fr, int fq) const {
        const int pn = u.pn;
        const int row0 = u.pm * 256 + wr * 64 + fr;
        const int colw = 32 * wc + 8 * fq;
        if (pn < 4) {
            bfu* dst = (bfu*)(ws + (pn < 2 ? WS_Q : WS_K)) + (pn & 1) * 256 + colw;
            const float* tab = (const float*)(ws + WS_TAB);
            const float qs = (pn < 2) ? 0.18033688011112042f : 1.0f;
            const bool colrot = (wc & 1) != 0;
            const bool latent = ((u.pm % 9) != 8);
            const float sgn = (fq < 2) ? -1.0f : 1.0f;
            const int fo = 8 * (fq & 1);
#pragma unroll
            for (int ai = 0; ai < 2; ++ai)
#pragma unroll
                for (int m = 0; m < 4; ++m) {
                    const int row = row0 + ai * 128 + m * 16;
                    const int t = row % TB;
                    const int pos = colrot ? (t & 63) : ((t >> 6) & 31);
                    f32x4 cs[2], sn[2];
#pragma unroll
                    for (int n = 0; n < 2; ++n) { cs[n] = *(const f32x4*)(tab + pos * 16 + fo + 4 * n); sn[n] = *(const f32x4*)(tab + 1024 + pos * 16 + fo + 4 * n); }
#pragma unroll
                    for (int bj = 0; bj < 2; ++bj) {
                        uint2 pk[2];
#pragma unroll
                        for (int n = 0; n < 2; ++n) {
                            f32x4 x = acc[ai][bj][m][n];
                            if (latent) {
                                f32x4 p;
                                p[0] = shx_(x[0], 32); p[1] = shx_(x[1], 32); p[2] = shx_(x[2], 32); p[3] = shx_(x[3], 32);
                                x = x * cs[n] + (p * sn[n]) * sgn;
                            }
                            pk[n] = pack4(x * qs);
                        }
                        *(uint4*)(dst + (size_t)row * 512 + bj * 128) = make_uint4(pk[0].x, pk[0].y, pk[1].x, pk[1].y);
                    }
                }
        } else if (pn < 6) {
            bfu* VT = (bfu*)(ws + WS_VT);
            const int rbase = u.pm * 256;
            const int b = rbase / TB, t0 = (rbase % TB) + wr * 64 + fr;
#pragma unroll
            for (int bj = 0; bj < 2; ++bj)
#pragma unroll
                for (int n = 0; n < 2; ++n) {
                    const int cc = (pn - 4) * 256 + bj * 128 + colw + n * 4;
                    const int head = cc >> 7, dim = cc & 127;
                    bfu* d = VT + ((size_t)(b * 4 + head) * 128 + dim) * TB + t0;
#pragma unroll
                    for (int ai = 0; ai < 2; ++ai)
#pragma unroll
                        for (int m = 0; m < 4; ++m)
#pragma unroll
                            for (int j = 0; j < 4; ++j) d[(size_t)j * TB + ai * 128 + m * 16] = f2bf(acc[ai][bj][m][n][j]);
                }
        } else {
            bfu* dst; int ld, kind;
            if (pn < 18) { dst = (bfu*)(ws + WS_SB) + (size_t)((pn - 6) >> 1) * NT * 512 + ((pn - 6) & 1) * 256; ld = 512; kind = 0; }
            else if (pn < 30) { dst = (bfu*)(ws + WS_GL) + (pn - 18) * 256; ld = 3072; kind = 1; }
            else { dst = (bfu*)(ws + WS_LORA) + (pn - 30) * 256; ld = 512; kind = (pn == 31) ? 1 : 2; }
            dst += colw;
#pragma unroll
            for (int ai = 0; ai < 2; ++ai)
#pragma unroll
                for (int m = 0; m < 4; ++m) {
                    bfu* d = dst + (size_t)(row0 + ai * 128 + m * 16) * ld;
#pragma unroll
                    for (int bj = 0; bj < 2; ++bj) {
                        uint2 pk[2];
#pragma unroll
                        for (int n = 0; n < 2; ++n) {
                            f32x4 v = acc[ai][bj][m][n];
                            if (kind == 1) { v[0] = sigmoidf_(v[0]); v[1] = sigmoidf_(v[1]); v[2] = sigmoidf_(v[2]); v[3] = sigmoidf_(v[3]); }
                            else if (kind == 2 && bj == 0) { v[0] = tanhf_(v[0]); v[1] = tanhf_(v[1]); v[2] = tanhf_(v[2]); v[3] = tanhf_(v[3]); }
                            pk[n] = pack4(v);
                        }
                        *(uint4*)(d + bj * 128) = make_uint4(pk[0].x, pk[0].y, pk[1].x, pk[1].y);
                    }
                }
        }
    }
};

__device__ __forceinline__ void phase_gemm_in8(const Args& a, int l, char* smem, int tid, int bid, int nb) {
    SchedDense S;
    S.A = (const char*)(wsp(a) + WS_H); S.B = (const char*)(wsp(a) + WS_WINT) + (size_t)l * 8192 * 1024 * 2;
    S.lda = 1024; S.ldb = 1024; S.nM = 72; S.nN = 32; S.G = nb; S.c = bid; S.skip9 = 0;
    EpiIn E; E.ws = wsp(a); E.l = l;
    g8::gemm8(( LAS unsigned char*)smem, S, E, 1024, tid);
}

__device__ __forceinline__ int scan_tok(int d, int idx) {
    if (d == 0) return (idx < CTX) ? (SEQ + idx) : (idx - CTX);
    return (idx < CTX) ? (TB - 1 - idx) : (SEQ - 1 - (idx - CTX));
}
struct StepRaw { uint2 w, kk, b, ke, r; unsigned v; };

__device__ __forceinline__ void scan_item(const Args& a, int l, int item, int tid) {
    unsigned char* ws = wsp(a);
    const int wave = tid >> 6, lane = tid & 63;
    const int sub = item & 1, d = (item >> 1) & 1, h = (item >> 2) & 7, b = item >> 5;
    const int rg = sub * 8 + wave;
    const int i = rg * 4 + (lane >> 4), jg = lane & 15;
    const bfu* WD = (const bfu*)(ws + WS_WDEC) + (size_t)d * NT * 512 + h * 64 + jg * 4;
    const bfu* KK = (const bfu*)(ws + WS_KKB) + h * 64 + jg * 4;
    const bfu* BV = (const bfu*)(ws + WS_BV) + (size_t)d * NT * 512 + h * 64 + jg * 4;
    const bfu* KE = (const bfu*)(ws + WS_KE) + (size_t)d * NT * 512 + h * 64 + jg * 4;
    const bfu* RR = (const bfu*)(ws + WS_RR) + h * 64 + jg * 4;
    const bfu* RV = (const bfu*)(ws + WS_RV) + h * 64 + i;
    float* Y = (float*)(ws + WS_Y) + (size_t)d * NT * 512 + h * 64 + i;
    const size_t rb = (size_t)b * TB;
    float s0 = 0.f, s1 = 0.f, s2 = 0.f, s3 = 0.f;
    constexpr int U = 4;
    StepRaw nx[U];
#pragma unroll
    for (int u = 0; u < U; ++u) {
        const size_t o = (rb + scan_tok(d, u)) * 512;
        nx[u].w = *(const uint2*)(WD + o); nx[u].kk = *(const uint2*)(KK + o); nx[u].b = *(const uint2*)(BV + o);
        nx[u].ke = *(const uint2*)(KE + o); nx[u].r = *(const uint2*)(RR + o); nx[u].v = RV[o];
    }
    for (int base = 0; base < TB; base += U) {
        StepRaw cu[U];
#pragma unroll
        for (int u = 0; u < U; ++u) cu[u] = nx[u];
        if (base + U < TB) {
#pragma unroll
            for (int u = 0; u < U; ++u) {
                const size_t o = (rb + scan_tok(d, base + U + u)) * 512;
                nx[u].w = *(const uint2*)(WD + o); nx[u].kk = *(const uint2*)(KK + o); nx[u].b = *(const uint2*)(BV + o);
                nx[u].ke = *(const uint2*)(KE + o); nx[u].r = *(const uint2*)(RR + o); nx[u].v = RV[o];
            }
        }
#pragma unroll
        for (int u = 0; u < U; ++u) {
            const float k0 = bflo(cu[u].kk.x), k1 = bfhi(cu[u].kk.x), k2 = bflo(cu[u].kk.y), k3 = bfhi(cu[u].kk.y);
            float sk = s0 * k0 + s1 * k1 + s2 * k2 + s3 * k3;
            sk = red16(sk);
            const float v = bf2f((bfu)cu[u].v);
            s0 = s0 * bflo(cu[u].w.x) + (v * bflo(cu[u].ke.x) - sk * (k0 * bflo(cu[u].b.x)));
            s1 = s1 * bfhi(cu[u].w.x) + (v * bfhi(cu[u].ke.x) - sk * (k1 * bfhi(cu[u].b.x)));
            s2 = s2 * bflo(cu[u].w.y) + (v * bflo(cu[u].ke.y) - sk * (k2 * bflo(cu[u].b.y)));
            s3 = s3 * bfhi(cu[u].w.y) + (v * bfhi(cu[u].ke.y) - sk * (k3 * bfhi(cu[u].b.y)));
            float y = s0 * bflo(cu[u].r.x) + s1 * bfhi(cu[u].r.x) + s2 * bflo(cu[u].r.y) + s3 * bfhi(cu[u].r.y);
            y = red16(y);
            const int tt = scan_tok(d, base + u);
            if (jg == 0 && (l == 0 || tt < SEQ)) Y[(rb + tt) * 512] = y;
        }
    }
}

__device__ __forceinline__ void cvt_expert_tile(const Args& a, unsigned char* ws, int l, int t, int sub, int lane) {
    const int e = t / 768, r = t % 768;
    const float* src; bfu* dst; int lds, tk, tn; bool w1;
    if (r < 512) { w1 = true; src = a.in[29] + (size_t)(l * 32 + e) * 1024 * 2048; lds = 2048; dst = (bfu*)(ws + WS_W1T) + (size_t)(l * 32 + e) * 2048 * 1024; tk = r >> 5; tn = r & 31; }
    else { const int r2 = r - 512; w1 = false; src = a.in[31] + (size_t)(l * 32 + e) * 1024 * 1024; lds = 1024; dst = (bfu*)(ws + WS_W2ET) + (size_t)(l * 32 + e) * 1024 * 1024; tk = r2 >> 4; tn = r2 & 15; }
    const int kq = lane >> 4, n4 = lane & 15;
    const int nd = tn * 64 + n4 * 4;
    const int ns = w1 ? (((nd >> 7) & 1) * 1024 + (nd >> 8) * 128 + (nd & 127)) : nd;
    const float* sp = src + (size_t)(tk * 64 + sub * 32 + kq * 8) * lds + ns;
    float4 v[8];
#pragma unroll
    for (int i = 0; i < 8; ++i) v[i] = *(const float4*)(sp + (size_t)i * lds);
    bfu* dp = dst + (size_t)nd * 1024 + tk * 64 + sub * 32 + kq * 8;
#pragma unroll
    for (int c = 0; c < 4; ++c) {
        uint4 p0;
#define CV_(i) (c == 0 ? v[i].x : c == 1 ? v[i].y : c == 2 ? v[i].z : v[i].w)
        p0.x = pack2(CV_(0), CV_(1)); p0.y = pack2(CV_(2), CV_(3)); p0.z = pack2(CV_(4), CV_(5)); p0.w = pack2(CV_(6), CV_(7));
#undef CV_
        *(uint4*)(dp + (size_t)c * 1024) = p0;
    }
}

constexpr int SC_CH = 32;
constexpr int SC_STEP = 5 * 64 + 4;
constexpr int SC_BUF = SC_CH * (SC_STEP + 32) * 4;
struct ScanStep { f32x4 w[2], kq[4], b[2], e[2]; float br, kr, v; };
__device__ __forceinline__ void scan_item2(const Args& a, int l, int item, char* smem, int tid) {
    unsigned char* ws = wsp(a);
    const int wave = tid >> 6, lane = tid & 63;
    const int half = item & 1, d = (item >> 1) & 1, h = (item >> 2) & 7, b = item >> 5;
    const int rloc = (wave & 3) * 8 + (lane >> 3), jg = lane & 7;
    const int ss = tid >> 4, sj = tid & 15;
    const bfu* WD = (const bfu*)(ws + WS_WDEC) + (size_t)d * NT * 512 + h * 64 + sj * 4;
    const bfu* AV = (const bfu*)(ws + WS_BV) + (size_t)d * NT * 512 + h * 64 + sj * 4;
    const bfu* RK = (const bfu*)(ws + WS_RK) + h * 64 + sj * 4;
    const bfu* RR = (const bfu*)(ws + WS_RR) + h * 64 + sj * 4;
    const bfu* RV = (const bfu*)(ws + WS_RV) + h * 64 + half * 32 + sj * 2;
    float* Y = (float*)(ws + WS_Y) + (size_t)d * NT * 512 + h * 64 + half * 32 + sj * 2;
    const f32x4 kkw = *(const f32x4*)(a.in[20] + l * 512 + h * 64 + sj * 4);
    const f32x4 kaw = *(const f32x4*)(a.in[21] + l * 512 + h * 64 + sj * 4);
    const size_t rb = (size_t)b * TB;
    float* ybuf0 = (float*)(smem + 2 * SC_BUF);
    uint2 rw, rk, ra, rr; unsigned rv;
#define SC_LOAD(chunk) do { const size_t _o = (rb + scan_tok(d, (chunk) * SC_CH + ss)) * 512; \
        rw = *(const uint2*)(WD + _o); rk = *(const uint2*)(RK + _o); ra = *(const uint2*)(AV + _o); rr = *(const uint2*)(RR + _o); rv = *(const unsigned*)(RV + _o); } while (0)
#define SC_WRITE(bufp) do { float* _b = (float*)(bufp) + ss * SC_STEP + sj * 4; \
        const f32x4 _k = {bflo(rk.x), bfhi(rk.x), bflo(rk.y), bfhi(rk.y)}; const f32x4 _a = {bflo(ra.x), bfhi(ra.x), bflo(ra.y), bfhi(ra.y)}; \
        const f32x4 _w = {bflo(rw.x), bfhi(rw.x), bflo(rw.y), bfhi(rw.y)}; const f32x4 _r = {bflo(rr.x), bfhi(rr.x), bflo(rr.y), bfhi(rr.y)}; \
        f32x4 _q = _k * kkw; float _s = _q[0] * _q[0] + _q[1] * _q[1] + _q[2] * _q[2] + _q[3] * _q[3]; _s = red16(_s); \
        _q *= rsqrtf(fmaxf(_s, 1e-24f)); \
        const f32x4 _bb = _q * _a; const f32x4 _ke = _k * (1.0f + (_a - 1.0f) * kaw); \
        float _br = _bb[0] * _r[0] + _bb[1] * _r[1] + _bb[2] * _r[2] + _bb[3] * _r[3]; _br = red16(_br); \
        float _kr = _ke[0] * _r[0] + _ke[1] * _r[1] + _ke[2] * _r[2] + _ke[3] * _r[3]; _kr = red16(_kr); \
        const f32x4 _wr = _w * _r; float* _kq = (float*)(bufp) + ss * SC_STEP + 64 + sj * 8; \
        *(f32x4*)(_b) = _w; *(f32x4*)(_kq) = (f32x4){_q[0], _wr[0], _q[1], _wr[1]}; *(f32x4*)(_kq + 4) = (f32x4){_q[2], _wr[2], _q[3], _wr[3]}; \
        *(f32x4*)(_b + 192) = _bb; *(f32x4*)(_b + 256) = _ke; \
        if (sj == 0) { float* _sc = (float*)(bufp) + ss * SC_STEP + 320; _sc[0] = _br; _sc[1] = _kr; } \
        float* _v = (float*)(bufp) + SC_CH * SC_STEP + ss * 32 + sj * 2; _v[0] = bflo(rv); _v[1] = bfhi(rv); } while (0)
#define SC_FETCH(dst, st) do { const float* _p = vec + (st) * SC_STEP; \
        dst.w[0] = *(const f32x4*)(_p); dst.w[1] = *(const f32x4*)(_p + 4); \
        dst.kq[0] = *(const f32x4*)(_p + 64 + jg * 8); dst.kq[1] = *(const f32x4*)(_p + 68 + jg * 8); dst.kq[2] = *(const f32x4*)(_p + 72 + jg * 8); dst.kq[3] = *(const f32x4*)(_p + 76 + jg * 8); \
        dst.b[0] = *(const f32x4*)(_p + 192); dst.b[1] = *(const f32x4*)(_p + 196); dst.e[0] = *(const f32x4*)(_p + 256); dst.e[1] = *(const f32x4*)(_p + 260); \
        const float2 _s2 = *(const float2*)(_p + 320 - jg * 8); dst.br = _s2.x; dst.kr = _s2.y; dst.v = vv[(st) * 32]; } while (0)
#define SC_BODY(cu, st) do { \
        f32x2_t d2 = {0.f, 0.f};                           \
        d2 += (f32x2_t){sA[0], sA[0]} * (f32x2_t){cu.kq[0][0], cu.kq[0][1]}; d2 += (f32x2_t){sA[1], sA[1]} * (f32x2_t){cu.kq[0][2], cu.kq[0][3]}; \
        d2 += (f32x2_t){sA[2], sA[2]} * (f32x2_t){cu.kq[1][0], cu.kq[1][1]}; d2 += (f32x2_t){sA[3], sA[3]} * (f32x2_t){cu.kq[1][2], cu.kq[1][3]}; \
        d2 += (f32x2_t){sB[0], sB[0]} * (f32x2_t){cu.kq[2][0], cu.kq[2][1]}; d2 += (f32x2_t){sB[1], sB[1]} * (f32x2_t){cu.kq[2][2], cu.kq[2][3]}; \
        d2 += (f32x2_t){sB[2], sB[2]} * (f32x2_t){cu.kq[3][0], cu.kq[3][1]}; d2 += (f32x2_t){sB[3], sB[3]} * (f32x2_t){cu.kq[3][2], cu.kq[3][3]}; \
        float sk = d2[0], z = d2[1]; \
        sk += dppf<0xB1>(sk); z += dppf<0xB1>(z); \
        sk += dppf<0x4E>(sk); z += dppf<0x4E>(z); \
        sk += dppf<0x141>(sk); z += dppf<0x141>(z); \
        sA = sA * cu.w[0] + (cu.e[0] * cu.v - cu.b[0] * sk); \
        sB = sB * cu.w[1] + (cu.e[1] * cu.v - cu.b[1] * sk); \
        const float _y = z - sk * cu.br + cu.v * cu.kr; \
        yq[(st) >> 3] = (jg == ((st) & 7)) ? _y : yq[(st) >> 3]; } while (0)
    __syncthreads();
    SC_LOAD(0);
    SC_WRITE(smem);
    __syncthreads();
    f32x4 sA = {0.f, 0.f, 0.f, 0.f}, sB = {0.f, 0.f, 0.f, 0.f};
    constexpr int NCH = TB / SC_CH;
    for (int ch = 0; ch < NCH; ++ch) {
        const char* cur = smem + (ch & 1) * SC_BUF;
        float* ybuf = ybuf0 + (ch & 1) * SC_CH * 32;
        if (ch + 1 < NCH) SC_LOAD(ch + 1);
        if (wave >= 4) {
            { const int c2 = (ch + (item % 3)) % NCH, pos = c2 % 3;
              if (pos != 0) cvt_expert_tile(a, ws, l, (item * 4 + (wave - 4)) + 1024 * (c2 / 3), pos - 1, lane); }
        } else {
            const float* vec = (const float*)cur + jg * 8;
            const float* vv = (const float*)cur + SC_CH * SC_STEP + rloc;
            float yq[4] = {0.f, 0.f, 0.f, 0.f};
            ScanStep c0, c1, c2;
            SC_FETCH(c0, 0);
            SC_FETCH(c1, 1);
#pragma unroll
            for (int st = 0; st < SC_CH; st += 3) {
                if (st + 2 < SC_CH) SC_FETCH(c2, st + 2);
                SC_BODY(c0, st);
                if (st + 1 < SC_CH) {
                    if (st + 3 < SC_CH) SC_FETCH(c0, st + 3);
                    SC_BODY(c1, st + 1);
                }
                if (st + 2 < SC_CH) {
                    if (st + 4 < SC_CH) SC_FETCH(c1, st + 4);
                    SC_BODY(c2, st + 2);
                }
            }
#pragma unroll
            for (int o = 0; o < 4; ++o) ybuf[(o * 8 + jg) * 32 + rloc] = yq[o];
        }
        if (ch + 1 < NCH) SC_WRITE(smem + ((ch + 1) & 1) * SC_BUF);
        __syncthreads();
        const int tok = scan_tok(d, ch * SC_CH + ss);
        const float2 yy = *(const float2*)(ybuf + ss * 32 + sj * 2);
        if (l == 0 || tok < SEQ) *(float2*)(Y + (rb + tok) * 512) = yy;
    }
#undef SC_LOAD
#undef SC_WRITE
#undef SC_FETCH
#undef SC_BODY
}

constexpr int KROW = 272;
constexpr int VROW = 144;
__device__ __forceinline__ void attn_item(const Args& a, int l, int item, char* smem, int tid) {
    unsigned char* ws = wsp(a);
    const int wave = tid >> 6, lane = tid & 63, g = lane >> 4, c = lane & 15;
    int b, head, r0, kt0;
    if (item < 512) { b = item >> 6; head = (item >> 4) & 3; r0 = b * TB + (item & 15) * 128; kt0 = 0; }
    else { const int j = item - 512; b = j >> 3; head = (j >> 1) & 3; r0 = b * TB + SEQ + (j & 1) * 128; kt0 = 32; }
    const bfu* Q = (const bfu*)(ws + WS_Q);
    const bfu* Kp = (const bfu*)(ws + WS_K) + (size_t)b * TB * 512 + head * 128;
    const bfu* Vp = (const bfu*)(ws + WS_VT) + (size_t)(b * 4 + head) * 128 * TB;
    char* Ks = smem;
    char* Vs = smem + 64 * KROW;
    const int qrow = r0 + wave * 16 + c;
    bf16x8 q1[2], q2[2];
#pragma unroll
    for (int ks = 0; ks < 2; ++ks) {
        q1[ks] = *(const bf16x8*)(Q + (size_t)qrow * 512 + head * 128 + ks * 32 + g * 8);
        q2[ks] = *(const bf16x8*)(Q + (size_t)qrow * 512 + head * 128 + 64 + ks * 32 + g * 8);
    }
    float m1 = -1e30f, m2 = -1e30f, l1 = 0.f, l2 = 0.f;
    f32x4 o1[8], o2[8];
#pragma unroll
    for (int mt = 0; mt < 8; ++mt) { o1[mt] = (f32x4){0.f, 0.f, 0.f, 0.f}; o2[mt] = (f32x4){0.f, 0.f, 0.f, 0.f}; }
    for (int kt = kt0; kt < 36; ++kt) {
        __syncthreads();
#pragma unroll
        for (int i = 0; i < 2; ++i) {
            const int key = (tid >> 4) + 32 * i, ch = tid & 15;
            *(uint4*)(Ks + key * KROW + ch * 16) = *(const uint4*)(Kp + (size_t)(kt * 64 + key) * 512 + ch * 8);
            const int dim = (tid >> 3) + 64 * i, cv = tid & 7;
            *(uint4*)(Vs + dim * VROW + cv * 16) = *(const uint4*)(Vp + (size_t)dim * TB + kt * 64 + cv * 8);
        }
        __syncthreads();
        f32x4 s1[4], s2[4];
#pragma unroll
        for (int kq = 0; kq < 4; ++kq) {
            s1[kq] = (f32x4){0.f, 0.f, 0.f, 0.f}; s2[kq] = (f32x4){0.f, 0.f, 0.f, 0.f};
#pragma unroll
            for (int ks = 0; ks < 2; ++ks) {
                const bf16x8 a1 = *(const bf16x8*)(Ks + (kq * 16 + c) * KROW + ks * 64 + g * 16);
                const bf16x8 a2 = *(const bf16x8*)(Ks + (kq * 16 + c) * KROW + 128 + ks * 64 + g * 16);
                s1[kq] = __builtin_amdgcn_mfma_f32_16x16x32_bf16(a1, q1[ks], s1[kq], 0, 0, 0);
                s2[kq] = __builtin_amdgcn_mfma_f32_16x16x32_bf16(a2, q2[ks], s2[kq], 0, 0, 0);
            }
        }
        float mx1 = s1[0][0], mx2 = s2[0][0];
#pragma unroll
        for (int kq = 0; kq < 4; ++kq)
#pragma unroll
            for (int r = 0; r < 4; ++r) { mx1 = fmaxf(mx1, s1[kq][r]); mx2 = fmaxf(mx2, s2[kq][r]); }
        mx1 = fmaxf(mx1, shx_(mx1, 16)); mx1 = fmaxf(mx1, shx_(mx1, 32));
        mx2 = fmaxf(mx2, shx_(mx2, 16)); mx2 = fmaxf(mx2, shx_(mx2, 32));
        const float mn1 = fmaxf(m1, mx1), mn2 = fmaxf(m2, mx2);
        const float al1 = exp2f(m1 - mn1), al2 = exp2f(m2 - mn2);
        m1 = mn1; m2 = mn2;
        float ps1 = 0.f, ps2 = 0.f;
        bf16x8 pb1[2], pb2[2];
#pragma unroll
        for (int kk = 0; kk < 2; ++kk) {
            float p[8], q[8];
#pragma unroll
            for (int e = 0; e < 4; ++e) {
                p[e] = exp2f(s1[2 * kk][e] - mn1); p[4 + e] = exp2f(s1[2 * kk + 1][e] - mn1);
                q[e] = exp2f(s2[2 * kk][e] - mn2); q[4 + e] = exp2f(s2[2 * kk + 1][e] - mn2);
            }
#pragma unroll
            for (int e = 0; e < 8; ++e) { ps1 += p[e]; ps2 += q[e]; pb1[kk][e] = (short)f2bf(p[e]); pb2[kk][e] = (short)f2bf(q[e]); }
        }
        l1 = l1 * al1 + ps1; l2 = l2 * al2 + ps2;
#pragma unroll
        for (int mt = 0; mt < 8; ++mt) {
            o1[mt] *= al1; o2[mt] *= al2;
#pragma unroll
            for (int kk = 0; kk < 2; ++kk) {
                const uint2 v0 = *(const uint2*)(Vs + (mt * 16 + c) * VROW + (kk * 32 + g * 4) * 2);
                const uint2 v1 = *(const uint2*)(Vs + (mt * 16 + c) * VROW + (kk * 32 + 16 + g * 4) * 2);
                union { uint4 u; bf16x8 v; } av; av.u = make_uint4(v0.x, v0.y, v1.x, v1.y);
                o1[mt] = __builtin_amdgcn_mfma_f32_16x16x32_bf16(av.v, pb1[kk], o1[mt], 0, 0, 0);
                o2[mt] = __builtin_amdgcn_mfma_f32_16x16x32_bf16(av.v, pb2[kk], o2[mt], 0, 0, 0);
            }
        }
    }
    l1 += shx_(l1, 16); l1 += shx_(l1, 32);
    l2 += shx_(l2, 16); l2 += shx_(l2, 32);
    const float lam = ((const float*)(ws + WS_TAB))[2048 + l];
    const float lam_init = (l == 0) ? 0.2f : (0.8f - 0.6f * 0.7408182206817179f);
    const float i1 = 1.0f / l1, i2 = lam / l2;
    float ss = 0.f;
#pragma unroll
    for (int mt = 0; mt < 8; ++mt)
#pragma unroll
        for (int r = 0; r < 4; ++r) { const float v = o1[mt][r] * i1 - o2[mt][r] * i2; o1[mt][r] = v; ss += v * v; }
    ss += shx_(ss, 16); ss += shx_(ss, 32);
    const float rs = rsqrtf(ss * (1.0f / 128.0f) + 1e-5f) * (1.0f - lam_init);
    bfu* ODA = (bfu*)(ws + WS_ODA);
    const float* sg = a.in[10] + l * 128;
#pragma unroll
    for (int mt = 0; mt < 8; ++mt) {
        const int dim = mt * 16 + g * 4;
        const float4 gg = *(const float4*)(sg + dim);
        uint2 p; p.x = pack2(o1[mt][0] * rs * gg.x, o1[mt][1] * rs * gg.y); p.y = pack2(o1[mt][2] * rs * gg.z, o1[mt][3] * rs * gg.w);
        *(uint2*)(ODA + (size_t)qrow * 512 + head * 128 + dim) = p;
    }
}

struct SlabAddr { const float* src; bfu* dst; int lds; };
__device__ __forceinline__ void slab_addr(const Args& a, unsigned char* ws, int l, int sid, int tid, SlabAddr& A) {
    const int e = sid / 768, r = sid % 768;
    const int n = tid & 63, kq = tid >> 6;
    if (r < 512) {
        const int tk = r >> 5, tn = r & 31, nd = tn * 64 + n;
        const int ns = ((nd >> 7) & 1) * 1024 + (nd >> 8) * 128 + (nd & 127);
        A.lds = 2048; A.src = a.in[29] + (size_t)(l * 32 + e) * 1024 * 2048 + (size_t)(tk * 64 + kq * 8) * 2048 + ns;
        A.dst = (bfu*)(ws + WS_W1T) + (size_t)(l * 32 + e) * 2048 * 1024 + (size_t)nd * 1024 + tk * 64 + kq * 8;
    } else {
        const int r2 = r - 512, tk = r2 >> 4, tn = r2 & 15, nd = tn * 64 + n;
        A.lds = 1024; A.src = a.in[31] + (size_t)(l * 32 + e) * 1024 * 1024 + (size_t)(tk * 64 + kq * 8) * 1024 + nd;
        A.dst = (bfu*)(ws + WS_W2ET) + (size_t)(l * 32 + e) * 1024 * 1024 + (size_t)nd * 1024 + tk * 64 + kq * 8;
    }
}

constexpr int AT_BUF = 64 * KROW + 128 * VROW;
__device__ __forceinline__ void attn_item2(const Args& a, int l, int item, char* smem, int tid) {
    unsigned char* ws = wsp(a);
    const int wave = tid >> 6, lane = tid & 63, g = lane >> 4, c = lane & 15;
    int b, head, r0, kt0;
    if (item < 512) { b = item >> 6; head = (item >> 4) & 3; r0 = b * TB + (item & 15) * 128; kt0 = 0; }
    else { const int j = item - 512; b = j >> 3; head = (j >> 1) & 3; r0 = b * TB + SEQ + (j & 1) * 128; kt0 = 32; }
    const bfu* Q = (const bfu*)(ws + WS_Q);
    const char* Kb = (const char*)(ws + WS_K) + ((size_t)b * TB * 512 + head * 128) * 2;
    const char* Vb = (const char*)(ws + WS_VT) + (size_t)(b * 4 + head) * 128 * TB * 2;
    const unsigned klo = (unsigned)((tid >> 4) * 512 + (tid & 15) * 8) * 2u, vlo = (unsigned)((tid >> 3) * TB + (tid & 7) * 8) * 2u;
    const bool piggy = (item < 512);
    const int pe = item >> 4, pi16 = item & 15;
    const char* ps1 = (const char*)(a.in[29] + ((size_t)(l * 32 + pe) * 1024 + pi16 * 64) * 2048);
    const char* ps2 = (const char*)(a.in[31] + ((size_t)(l * 32 + pe) * 1024 + (pi16 >> 2) * 64) * 1024 + (pi16 & 3) * 256);
    char* pd1 = (char*)((bfu*)(ws + WS_W1T) + (size_t)(l * 32 + pe) * 2048 * 1024 + pi16 * 64);
    char* pd2 = (char*)((bfu*)(ws + WS_W2ET) + (size_t)(l * 32 + pe) * 1024 * 1024 + (size_t)((pi16 & 3) * 256) * 1024 + (pi16 >> 2) * 64);
    const unsigned pls1 = (unsigned)((tid >> 6) * 8 * 2048 + (tid & 63)) * 4u, pls2 = (unsigned)((tid >> 6) * 8 * 1024 + (tid & 63)) * 4u;
    const unsigned pld = (unsigned)((tid & 63) * 1024 + (tid >> 6) * 8) * 2u;
    const int kw = (tid >> 4) * KROW + (tid & 15) * 16;
    const int vw = 64 * KROW + (tid >> 3) * VROW + (tid & 7) * 16;
    const int qrow = r0 + wave * 16 + c;
    bf16x8 q1[2], q2[2];
#pragma unroll
    for (int ks = 0; ks < 2; ++ks) {
        q1[ks] = *(const bf16x8*)(Q + (size_t)qrow * 512 + head * 128 + ks * 32 + g * 8);
        q2[ks] = *(const bf16x8*)(Q + (size_t)qrow * 512 + head * 128 + 64 + ks * 32 + g * 8);
    }
    bf16x8 ones;
#pragma unroll
    for (int e = 0; e < 8; ++e) ones[e] = (short)0x3F80;
    float m1 = 0.f, m2 = 0.f;
    f32x4 o1[8], o2[8], ls1 = {0.f, 0.f, 0.f, 0.f}, ls2 = {0.f, 0.f, 0.f, 0.f};
#pragma unroll
    for (int mt = 0; mt < 8; ++mt) { o1[mt] = (f32x4){0.f, 0.f, 0.f, 0.f}; o2[mt] = (f32x4){0.f, 0.f, 0.f, 0.f}; }
    u32x4_t rk0, rk1, rv0, rv1;
#define AT_LOAD(kt) do { GAS const char* kb_ = (GAS const char*)(Kb + (size_t)(kt) * 65536); GAS const char* kb2_ = kb_ + 32768; GAS const char* vb_ = (GAS const char*)(Vb + (kt) * 128); GAS const char* vb2_ = vb_ + 64 * TB * 2; \
        unsigned ko_ = klo, vo_ = vlo; asm volatile("" : "+v"(ko_), "+v"(vo_), "+s"(kb_), "+s"(kb2_), "+s"(vb_), "+s"(vb2_)); \
        rk0 = *(GAS const u32x4_t*)(kb_ + ko_); rk1 = *(GAS const u32x4_t*)(kb2_ + ko_); rv0 = *(GAS const u32x4_t*)(vb_ + vo_); rv1 = *(GAS const u32x4_t*)(vb2_ + vo_); } while (0)
#define AT_WRITE(bufp) do { *(u32x4_t*)((bufp) + kw) = rk0; *(u32x4_t*)((bufp) + kw + 32 * KROW) = rk1; *(u32x4_t*)((bufp) + vw) = rv0; *(u32x4_t*)((bufp) + vw + 64 * VROW) = rv1; } while (0)
    __syncthreads();
    AT_LOAD(kt0);
    AT_WRITE(smem);
    AT_LOAD(kt0 + 1);
    AT_WRITE(smem + AT_BUF);
    __syncthreads();
    const bool lag = (wave >= 4);
    if (lag) __builtin_amdgcn_s_barrier();
    int bi = 0;
    for (int kt = kt0; kt < 36; ++kt) {
        const char* Ks = smem + bi * AT_BUF;
        const char* Vs = Ks + 64 * KROW;
        if (kt + 2 < 36) AT_LOAD(kt + 2);
        float sv[8];
        if (piggy) {
            const bool pw1 = (kt < 32);
            const char* su = pw1 ? ps1 + ((((kt >> 1) & 1) * 1024 + (kt >> 2) * 128 + (kt & 1) * 64) * 4) : ps2 + (kt - 32) * 256;
            const int ldsb = pw1 ? 8192 : 4096;
            unsigned so_ = pw1 ? pls1 : pls2; asm volatile("" : "+v"(so_));
#pragma unroll
            for (int i = 0; i < 8; ++i) { GAS const char* bi = (GAS const char*)(su + (size_t)(i * ldsb)); asm volatile("" : "+s"(bi)); sv[i] = *(GAS const float*)(bi + so_); }
        }
        f32x4 s1[4], s2[4];
        {
            const char* kp = Ks + c * KROW + g * 16;
            bf16x8 ka[4], kb[4];
#pragma unroll
            for (int f = 0; f < 4; ++f) ka[f] = *(const bf16x8*)(kp + (f & 1) * 128 + (f >> 1) * 64);
#pragma unroll
            for (int kq = 0; kq < 4; ++kq) {
                if (kq < 3) {
#pragma unroll
                    for (int f = 0; f < 4; ++f) kb[f] = *(const bf16x8*)(kp + (kq + 1) * 16 * KROW + (f & 1) * 128 + (f >> 1) * 64);
                }
                __builtin_amdgcn_sched_barrier(0);
                s1[kq] = (f32x4){-m1, -m1, -m1, -m1}; s2[kq] = (f32x4){-m2, -m2, -m2, -m2};
                __builtin_amdgcn_s_setprio(1);
                s1[kq] = __builtin_amdgcn_mfma_f32_16x16x32_bf16(ka[0], q1[0], s1[kq], 0, 0, 0);
                s2[kq] = __builtin_amdgcn_mfma_f32_16x16x32_bf16(ka[1], q2[0], s2[kq], 0, 0, 0);
                s1[kq] = __builtin_amdgcn_mfma_f32_16x16x32_bf16(ka[2], q1[1], s1[kq], 0, 0, 0);
                s2[kq] = __builtin_amdgcn_mfma_f32_16x16x32_bf16(ka[3], q2[1], s2[kq], 0, 0, 0);
                __builtin_amdgcn_s_setprio(0);
                __builtin_amdgcn_sched_barrier(0);
#pragma unroll
                for (int f = 0; f < 4; ++f) ka[f] = kb[f];
            }
        }
        float mx1 = fmax3_(s1[0][0], s1[0][1], s1[0][2]), mx2 = fmax3_(s2[0][0], s2[0][1], s2[0][2]);
        mx1 = fmax3_(mx1, s1[0][3], s1[1][0]); mx2 = fmax3_(mx2, s2[0][3], s2[1][0]);
        mx1 = fmax3_(mx1, s1[1][1], s1[1][2]); mx2 = fmax3_(mx2, s2[1][1], s2[1][2]);
        mx1 = fmax3_(mx1, s1[1][3], s1[2][0]); mx2 = fmax3_(mx2, s2[1][3], s2[2][0]);
        mx1 = fmax3_(mx1, s1[2][1], s1[2][2]); mx2 = fmax3_(mx2, s2[2][1], s2[2][2]);
        mx1 = fmax3_(mx1, s1[2][3], s1[3][0]); mx2 = fmax3_(mx2, s2[2][3], s2[3][0]);
        mx1 = fmax3_(mx1, s1[3][1], s1[3][2]); mx2 = fmax3_(mx2, s2[3][1], s2[3][2]);
        mx1 = fmax3_(mx1, s1[3][3], mx1); mx2 = fmax3_(mx2, s2[3][3], mx2);
        const bool first = (kt == kt0);
        if (first || __any((mx1 > 8.0f) || (mx2 > 8.0f))) {
            asm volatile("; attn rescale" ::: "memory");
            mx1 = fmaxf(mx1, shx_(mx1, 16)); mx1 = fmaxf(mx1, shx_(mx1, 32));
            mx2 = fmaxf(mx2, shx_(mx2, 16)); mx2 = fmaxf(mx2, shx_(mx2, 32));
            const float d1 = first ? mx1 : fmaxf(mx1, 0.f), d2 = first ? mx2 : fmaxf(mx2, 0.f);
            const float al1 = first ? 1.0f : ex2_(-d1), al2 = first ? 1.0f : ex2_(-d2);
            m1 += d1; m2 += d2;
            ls1 *= al1; ls2 *= al2;
#pragma unroll
            for (int mt = 0; mt < 8; ++mt) { o1[mt] *= al1; o2[mt] *= al2; }
#pragma unroll
            for (int kq = 0; kq < 4; ++kq) { s1[kq] -= d1; s2[kq] -= d2; }
        }
        bf16x8 pb1[2], pb2[2];
#pragma unroll
        for (int kk = 0; kk < 2; ++kk) {
            union { unsigned u[4]; bf16x8 v; } t1, t2;
            t1.u[0] = pack2(ex2_(s1[2 * kk][0]), ex2_(s1[2 * kk][1])); t1.u[1] = pack2(ex2_(s1[2 * kk][2]), ex2_(s1[2 * kk][3]));
            t1.u[2] = pack2(ex2_(s1[2 * kk + 1][0]), ex2_(s1[2 * kk + 1][1])); t1.u[3] = pack2(ex2_(s1[2 * kk + 1][2]), ex2_(s1[2 * kk + 1][3]));
            t2.u[0] = pack2(ex2_(s2[2 * kk][0]), ex2_(s2[2 * kk][1])); t2.u[1] = pack2(ex2_(s2[2 * kk][2]), ex2_(s2[2 * kk][3]));
            t2.u[2] = pack2(ex2_(s2[2 * kk + 1][0]), ex2_(s2[2 * kk + 1][1])); t2.u[3] = pack2(ex2_(s2[2 * kk + 1][2]), ex2_(s2[2 * kk + 1][3]));
            pb1[kk] = t1.v; pb2[kk] = t2.v;
        }
        asm volatile("" ::: "memory"); __builtin_amdgcn_s_barrier(); asm volatile("" ::: "memory");
#pragma unroll
        for (int kk = 0; kk < 2; ++kk) {
            ls1 = __builtin_amdgcn_mfma_f32_16x16x32_bf16(ones, pb1[kk], ls1, 0, 0, 0);
            ls2 = __builtin_amdgcn_mfma_f32_16x16x32_bf16(ones, pb2[kk], ls2, 0, 0, 0);
        }
        {
            const char* vp = Vs + c * VROW + g * 8;
            uint2 va[4], vb[4];
#pragma unroll
            for (int f = 0; f < 4; ++f) va[f] = *(const uint2*)(vp + (f >> 1) * 64 + (f & 1) * 32);
#pragma unroll
            for (int mt = 0; mt < 8; ++mt) {
                if (mt < 7) {
#pragma unroll
                    for (int f = 0; f < 4; ++f) vb[f] = *(const uint2*)(vp + (mt + 1) * 16 * VROW + (f >> 1) * 64 + (f & 1) * 32);
                }
                __builtin_amdgcn_sched_barrier(0);
                union { uint4 u; bf16x8 v; } av0, av1;
                av0.u = make_uint4(va[0].x, va[0].y, va[1].x, va[1].y);
                av1.u = make_uint4(va[2].x, va[2].y, va[3].x, va[3].y);
                __builtin_amdgcn_s_setprio(1);
                o1[mt] = __builtin_amdgcn_mfma_f32_16x16x32_bf16(av0.v, pb1[0], o1[mt], 0, 0, 0);
                o2[mt] = __builtin_amdgcn_mfma_f32_16x16x32_bf16(av0.v, pb2[0], o2[mt], 0, 0, 0);
                o1[mt] = __builtin_amdgcn_mfma_f32_16x16x32_bf16(av1.v, pb1[1], o1[mt], 0, 0, 0);
                o2[mt] = __builtin_amdgcn_mfma_f32_16x16x32_bf16(av1.v, pb2[1], o2[mt], 0, 0, 0);
                __builtin_amdgcn_s_setprio(0);
                __builtin_amdgcn_sched_barrier(0);
#pragma unroll
                for (int f = 0; f < 4; ++f) va[f] = vb[f];
            }
        }
        if (piggy) {
            const u32x4_t p = {pack2(sv[0], sv[1]), pack2(sv[2], sv[3]), pack2(sv[4], sv[5]), pack2(sv[6], sv[7])};
            GAS char* du = (GAS char*)((kt < 32) ? pd1 + (size_t)kt * 131072 : pd2 + (size_t)(kt - 32) * 131072);
            unsigned do_ = pld; asm volatile("" : "+v"(do_), "+s"(du));
            *(GAS u32x4_t*)(du + do_) = p;
        }
        if (kt + 2 < 36) { const int bw = (bi == 0) ? 2 : bi - 1; AT_WRITE(smem + bw * AT_BUF); }
        asm volatile("s_waitcnt lgkmcnt(0)" ::: "memory"); __builtin_amdgcn_s_barrier(); asm volatile("" ::: "memory");
        bi = (bi == 2) ? 0 : bi + 1;
    }
    if (!lag) __builtin_amdgcn_s_barrier();
#undef AT_LOAD
#undef AT_WRITE
    const float lam = ((const float*)(ws + WS_TAB))[2048 + l];
    const float lam_init = (l == 0) ? 0.2f : (0.8f - 0.6f * 0.7408182206817179f);
    const float i1 = 1.0f / ls1[0], i2 = lam / ls2[0];
    float ss = 0.f;
#pragma unroll
    for (int mt = 0; mt < 8; ++mt)
#pragma unroll
        for (int r = 0; r < 4; ++r) { const float v = o1[mt][r] * i1 - o2[mt][r] * i2; o1[mt][r] = v; ss += v * v; }
    ss += shx_(ss, 16); ss += shx_(ss, 32);
    const float rs = rsqrtf(ss * (1.0f / 128.0f) + 1e-5f) * (1.0f - lam_init);
    bfu* ODA = (bfu*)(ws + WS_ODA);
    const float* sg = a.in[10] + l * 128;
#pragma unroll
    for (int mt = 0; mt < 8; ++mt) {
        const int dim = mt * 16 + g * 4;
        const float4 gg = *(const float4*)(sg + dim);
        uint2 p; p.x = pack2(o1[mt][0] * rs * gg.x, o1[mt][1] * rs * gg.y); p.y = pack2(o1[mt][2] * rs * gg.z, o1[mt][3] * rs * gg.w);
        *(uint2*)(ODA + (size_t)qrow * 512 + head * 128 + dim) = p;
    }
}

constexpr int CK = 16, NCK = TB / CK, NCHUNK = 128 * NCK;
constexpr size_t WS_CEB  = WS_H2HI;
constexpr size_t WS_CW1  = WS_YB;
constexpr size_t WS_CRH  = WS_CW1 + (size_t)NCHUNK * 1024 * 2;
constexpr size_t WS_CUV  = WS_CRH + (size_t)NCHUNK * 1024 * 2;
constexpr size_t WS_CV   = WS_CUV + (size_t)NCHUNK * 1024 * 2;
constexpr size_t WS_CG   = WS_ACT;
constexpr size_t WS_CPC  = WS_ACT + (size_t)NCHUNK * 512 * 2;
__device__ __forceinline__ int kperm(int jp) { return (jp & 32) + 8 * ((jp >> 2) & 3) + 4 * ((jp >> 4) & 1) + (jp & 3); }
__device__ __forceinline__ bf16x8 neg8(bf16x8 v) { union { bf16x8 v; uint4 u; } t; t.v = v; t.u.x ^= 0x80008000u; t.u.y ^= 0x80008000u; t.u.z ^= 0x80008000u; t.u.w ^= 0x80008000u; return t.v; }
__device__ __forceinline__ bf16x8 zero8() { bf16x8 z; for (int e = 0; e < 8; ++e) z[e] = 0; return z; }
__device__ __forceinline__ bf16x8 ldpad8(const char* p, int g) {
    union { bf16x8 v; uint4 u; } t; t.v = *(const bf16x8*)(p + (g & 1) * 16);
    const unsigned m = (g < 2) ? 0xFFFFFFFFu : 0u; t.u.x &= m; t.u.y &= m; t.u.z &= m; t.u.w &= m; return t.v; }

__device__ __forceinline__ void chunk_pre(const Args& a, unsigned char* ws, int l, int cid, char* L, int lane) {
    const int g = lane >> 4, c = lane & 15;
    const int seq = cid / NCK, ck = cid - seq * NCK;
    const int d = seq & 1, h = (seq >> 1) & 7, b = seq >> 4;
    const bfu* WD = (const bfu*)(ws + WS_WDEC) + (size_t)d * NT * 512;
    const bfu* AV = (const bfu*)(ws + WS_BV) + (size_t)d * NT * 512;
    const bfu* RK = (const bfu*)(ws + WS_RK);
    const bfu* RR = (const bfu*)(ws + WS_RR);
    const bfu* RV = (const bfu*)(ws + WS_RV);
    float KH[4][4], BH[4][4], EH[4][4], RH[4][4], BT[4][4], ET[4][4], VV[4][4], PC[4];
    {
        float kq[4][4], av[4][4], ww[4][4], rr[4][4], ssq[4] = {0.f, 0.f, 0.f, 0.f};
        {
            const size_t ro = ((size_t)b * TB + scan_tok(d, ck * CK + (lane >> 2))) * 512 + h * 64 + (lane & 3) * 16;
            const uint4 w0 = *(const uint4*)(WD + ro), w1_ = *(const uint4*)(WD + ro + 8), k0 = *(const uint4*)(RK + ro), k1 = *(const uint4*)(RK + ro + 8);
            const uint4 a0 = *(const uint4*)(AV + ro), a1 = *(const uint4*)(AV + ro + 8), r0_ = *(const uint4*)(RR + ro), r1_ = *(const uint4*)(RR + ro + 8);
            const uint4 v0 = *(const uint4*)(RV + ro), v1 = *(const uint4*)(RV + ro + 8);
            char* sp = L + (lane >> 2) * 128 + (lane & 3) * 32;
            *(uint4*)(sp) = w0; *(uint4*)(sp + 16) = w1_; *(uint4*)(sp + 2048) = k0; *(uint4*)(sp + 2064) = k1;
            *(uint4*)(sp + 4096) = a0; *(uint4*)(sp + 4112) = a1; *(uint4*)(sp + 6144) = r0_; *(uint4*)(sp + 6160) = r1_;
            *(uint4*)(sp + 8192) = v0; *(uint4*)(sp + 8208) = v1;
            asm volatile("s_waitcnt lgkmcnt(0)" ::: "memory");
#pragma unroll
            for (int r = 0; r < 4; ++r)
#pragma unroll
                for (int nt = 0; nt < 4; ++nt) {
                    const char* ep = L + (4 * g + r) * 128 + (16 * nt + c) * 2;
                    ww[nt][r] = bf2f(*(const bfu*)(ep)); kq[nt][r] = bf2f(*(const bfu*)(ep + 2048)); av[nt][r] = bf2f(*(const bfu*)(ep + 4096));
                    rr[nt][r] = bf2f(*(const bfu*)(ep + 6144)); VV[nt][r] = bf2f(*(const bfu*)(ep + 8192));
                }
            asm volatile("s_waitcnt lgkmcnt(0)" ::: "memory");
        }
#pragma unroll
        for (int nt = 0; nt < 4; ++nt) {
            const float kkw = a.in[20][l * 512 + h * 64 + 16 * nt + c], kaw = a.in[21][l * 512 + h * 64 + 16 * nt + c];
#pragma unroll
            for (int r = 0; r < 4; ++r) {
                const float k = kq[nt][r];
                EH[nt][r] = k * (1.0f + (av[nt][r] - 1.0f) * kaw);
                kq[nt][r] = k * kkw;
                ssq[r] += kq[nt][r] * kq[nt][r];
            }
        }
#pragma unroll
        for (int r = 0; r < 4; ++r) ssq[r] = rsqrtf(fmaxf(red16(ssq[r]), 1e-24f));
#pragma unroll
        for (int nt = 0; nt < 4; ++nt) {
            float cp[4];
            cp[0] = ww[nt][0]; cp[1] = cp[0] * ww[nt][1]; cp[2] = cp[1] * ww[nt][2]; cp[3] = cp[2] * ww[nt][3];
            const float t0 = shf_(cp[3], c), t1 = shf_(cp[3], c + 16), t2 = shf_(cp[3], c + 32), t3 = shf_(cp[3], c + 48);
            const float pre = ((g > 0) ? t0 : 1.0f) * ((g > 1) ? t1 : 1.0f) * ((g > 2) ? t2 : 1.0f);
            const float pc = (t0 * t1) * (t2 * t3);
            PC[nt] = pc;
#pragma unroll
            for (int r = 0; r < 4; ++r) {
                const float P = pre * cp[r], Pm = (r == 0) ? pre : pre * cp[r - 1];
                const float iP = __builtin_amdgcn_rcpf(P);
                const float kkn = kq[nt][r] * ssq[r], bb = kkn * av[nt][r], ke = EH[nt][r];
                KH[nt][r] = kkn * Pm; BH[nt][r] = bb * iP; EH[nt][r] = ke * iP; RH[nt][r] = rr[nt][r] * P;
                BT[nt][r] = bb * (pc * iP); ET[nt][r] = ke * (pc * iP);
            }
        }
    }
    char* R0 = L; char* R1 = L + 8192;
#pragma unroll
    for (int nt = 0; nt < 4; ++nt) {
#pragma unroll
        for (int r = 0; r < 4; ++r) {
            const int o = (4 * g + r) * 128 + (16 * nt + c) * 2;
            *(bfu*)(R0 + o) = f2bf(KH[nt][r]); *(bfu*)(R0 + 2048 + o) = f2bf(RH[nt][r]);
            *(bfu*)(R0 + 4096 + o) = f2bf(BH[nt][r]); *(bfu*)(R0 + 6144 + o) = f2bf(EH[nt][r]);
        }
        const int ot = (16 * nt + c) * 32 + 8 * g;
        uint2 p;
        p.x = pack2(KH[nt][0], KH[nt][1]); p.y = pack2(KH[nt][2], KH[nt][3]); *(uint2*)(R1 + ot) = p;
        p.x = pack2(VV[nt][0], VV[nt][1]); p.y = pack2(VV[nt][2], VV[nt][3]); *(uint2*)(R1 + 2048 + ot) = p;
        p.x = pack2(BT[nt][0], BT[nt][1]); p.y = pack2(BT[nt][2], BT[nt][3]); *(uint2*)(R1 + 4096 + ot) = p;
        p.x = pack2(ET[nt][0], ET[nt][1]); p.y = pack2(ET[nt][2], ET[nt][3]); *(uint2*)(R1 + 6144 + ot) = p;
    }
    const f32x4 z4 = {0.f, 0.f, 0.f, 0.f};
#define RM_(X, ks) (*(const bf16x8*)(R0 + (X) + c * 128 + (ks) * 64 + g * 16))
#define TR_(base, tile) ldpad8((base) + (16 * (tile) + c) * 32, g)
#define MM_(off) ldpad8(R0 + (off) + c * 32, g)
    f32x4 Am = z4, Bmm = z4, Grb = z4, Grk = z4;
#pragma unroll
    for (int ks = 0; ks < 2; ++ks) {
        const bf16x8 kh = RM_(0, ks), rh = RM_(2048, ks), bh = RM_(4096, ks), eh = RM_(6144, ks);
        Am = __builtin_amdgcn_mfma_f32_16x16x32_bf16(kh, bh, Am, 0, 0, 0);
        Bmm = __builtin_amdgcn_mfma_f32_16x16x32_bf16(kh, eh, Bmm, 0, 0, 0);
        Grb = __builtin_amdgcn_mfma_f32_16x16x32_bf16(rh, bh, Grb, 0, 0, 0);
        Grk = __builtin_amdgcn_mfma_f32_16x16x32_bf16(rh, eh, Grk, 0, 0, 0);
    }
#pragma unroll
    for (int r = 0; r < 4; ++r) {
        const int t = 4 * g + r;
        if (c >= t) { Am[r] = 0.f; Bmm[r] = 0.f; }
        if (c > t) { Grb[r] = 0.f; Grk[r] = 0.f; }
    }
    asm volatile("s_waitcnt lgkmcnt(0)" ::: "memory");
    float* Af = (float*)(R0 + 2048);
#pragma unroll
    for (int r = 0; r < 4; ++r) Af[(4 * g + r) * 16 + c] = Am[r];
    asm volatile("s_waitcnt lgkmcnt(0)" ::: "memory");
    float Tc[16];
#pragma unroll
    for (int t = 0; t < 16; ++t) {
        float acc = (t == c) ? 1.0f : 0.0f, acc2 = 0.0f;
#pragma unroll
        for (int s_ = 0; s_ < t; ++s_) { if (s_ & 1) acc2 -= Af[t * 16 + s_] * Tc[s_]; else acc -= Af[t * 16 + s_] * Tc[s_]; }
        Tc[t] = acc + acc2;
    }
    asm volatile("s_waitcnt lgkmcnt(0)" ::: "memory");
#pragma unroll
    for (int t = 0; t < 16; ++t) *(bfu*)(R0 + t * 32 + c * 2) = f2bf(Tc[t]);
#pragma unroll
    for (int r = 0; r < 4; ++r) {
        const int o = (4 * g + r) * 32 + c * 2;
        *(bfu*)(R0 + 512 + o) = f2bf(Bmm[r]); *(bfu*)(R0 + 1024 + o) = f2bf(Grb[r]); *(bfu*)(R0 + 1536 + o) = f2bf(Grk[r]);
    }
    asm volatile("s_waitcnt lgkmcnt(0)" ::: "memory");
    const bf16x8 mT = MM_(0), mBm = MM_(512), mGrb = MM_(1024), mGrk = MM_(1536);
    const bf16x8 mNGrb = neg8(mGrb);
    char* W1T = R0 + 2048; char* UvT = R0 + 4096; char* BmVT = R0 + 6144;
#pragma unroll
    for (int nt = 0; nt < 4; ++nt) {
        const f32x4 x = __builtin_amdgcn_mfma_f32_16x16x32_bf16(mBm, TR_(R1 + 2048, nt), z4, 0, 0, 0);
        *(uint2*)(BmVT + (16 * nt + c) * 32 + 8 * g) = pack4(x);
        const f32x4 w1 = __builtin_amdgcn_mfma_f32_16x16x32_bf16(mT, TR_(R1, nt), z4, 0, 0, 0);
        {
            const int pos = kperm(16 * nt + c);
            const int fo = ((pos >> 5) * 512 + ((pos >> 3) & 3) * 128 + (pos & 7)) * 2;
#pragma unroll
            for (int r = 0; r < 4; ++r) { *(bfu*)(W1T + fo + (4 * g + r) * 16) = f2bf(w1[r]); *(bfu*)(UvT + fo + (4 * g + r) * 16) = f2bf(RH[nt][r]); }
        }
    }
    asm volatile("s_waitcnt lgkmcnt(0)" ::: "memory");
    {
        bfu* W1P = (bfu*)(ws + WS_CW1) + (size_t)cid * 1024 + lane * 8;
        bfu* RHP = (bfu*)(ws + WS_CRH) + (size_t)cid * 1024 + lane * 8;
        *(uint4*)(W1P) = *(const uint4*)(W1T + lane * 16); *(uint4*)(W1P + 512) = *(const uint4*)(W1T + 1024 + lane * 16);
        *(uint4*)(RHP) = *(const uint4*)(UvT + lane * 16); *(uint4*)(RHP + 512) = *(const uint4*)(UvT + 1024 + lane * 16);
    }
#pragma unroll
    for (int nt = 0; nt < 4; ++nt) {
        const f32x4 uv = __builtin_amdgcn_mfma_f32_16x16x32_bf16(mT, TR_(BmVT, nt), z4, 0, 0, 0);
        *(uint2*)((bfu*)(ws + WS_CUV) + (size_t)cid * 1024 + nt * 256 + lane * 4) = pack4(uv);
        uint2 pv; pv.x = pack2(VV[nt][0], VV[nt][1]); pv.y = pack2(VV[nt][2], VV[nt][3]);
        *(uint2*)((bfu*)(ws + WS_CV) + (size_t)cid * 1024 + nt * 256 + lane * 4) = pv;
        uint4 eb; eb.x = pack2(ET[nt][0], ET[nt][1]); eb.y = pack2(ET[nt][2], ET[nt][3]); eb.z = pack2(BT[nt][0], BT[nt][1]); eb.w = pack2(BT[nt][2], BT[nt][3]);
        *(uint4*)((bfu*)(ws + WS_CEB) + (size_t)cid * 2048 + nt * 512 + lane * 8) = eb;
        if (g == 0) ((bfu*)(ws + WS_CPC))[(size_t)cid * 64 + (c >> 2) * 16 + nt * 4 + (c & 3)] = f2bf(PC[nt]);
    }
    {
        const uint2 gk = *(const uint2*)(R0 + 1536 + c * 32 + 8 * g), gb = *(const uint2*)(R0 + 1024 + c * 32 + 8 * g);
        *(uint4*)((bfu*)(ws + WS_CG) + (size_t)cid * 512 + lane * 8) = make_uint4(gk.x, gk.y, gb.x, gb.y);
    }
    asm volatile("s_waitcnt lgkmcnt(0)" ::: "memory");
#undef RM_
#undef TR_
#undef MM_
}

constexpr int CS_W1 = 0, CS_RH = 2048, CS_EB = 4096, CS_G = 8192, CS_UV = 9216, CS_V = 11264, CS_PC = 13312, CS_SLOT = 13568, CS_D = 8;
__device__ __forceinline__ void chain_dma(unsigned char* ws, LAS unsigned char* slot, size_t cid, int w4, int lane) {
#pragma unroll
    for (int q = 0; q < 4; ++q) {
        const int p = w4 + 4 * q;
        const char* src; int dst; bool on = true;
        if (p < 2) { src = (const char*)(ws + WS_CW1) + cid * 2048 + p * 1024; dst = CS_W1 + p * 1024; }
        else if (p < 4) { src = (const char*)(ws + WS_CRH) + cid * 2048 + (p - 2) * 1024; dst = CS_RH + (p - 2) * 1024; }
        else if (p < 8) { src = (const char*)(ws + WS_CEB) + cid * 4096 + (p - 4) * 1024; dst = CS_EB + (p - 4) * 1024; }
        else if (p < 9) { src = (const char*)(ws + WS_CG) + cid * 1024; dst = CS_G; }
        else if (p < 11) { src = (const char*)(ws + WS_CUV) + cid * 2048 + (p - 9) * 1024; dst = CS_UV + (p - 9) * 1024; }
        else if (p < 13) { src = (const char*)(ws + WS_CV) + cid * 2048 + (p - 11) * 1024; dst = CS_V + (p - 11) * 1024; }
        else if (p < 14) { src = (const char*)(ws + WS_CPC) + cid * 128; dst = CS_PC; on = (lane < 8); }
        else continue;
        if (on) __builtin_amdgcn_global_load_lds((const unsigned*)(src + lane * 16), (LAS unsigned*)(slot + dst), 16, 0, 0);
    }
}
__device__ __forceinline__ void chunk_chain_blk(const Args& a, unsigned char* ws, int l, int seq, char* smem, int tid) {
    const int wave = tid >> 6, lane = tid & 63, g = lane >> 4, c = lane & 15;
    const int d = seq & 1, h = (seq >> 1) & 7, b = seq >> 4;
    const int nt = wave & 3;
    const int wvu = __builtin_amdgcn_readfirstlane(wave);
    const int w4u = wvu & 3;
    LAS unsigned char* ring = (LAS unsigned char*)smem;
    const size_t cbase = (size_t)seq * NCK;
    float* Y = (float*)(ws + WS_Y) + (size_t)d * NT * 512 + h * 64 + 16 * nt + c;
    f32x4 Z[4];
#pragma unroll
    for (int mt = 0; mt < 4; ++mt) Z[mt] = (f32x4){0.f, 0.f, 0.f, 0.f};
    __syncthreads();
    if (wvu >= 4) {
        for (int k = 0; k < CS_D - 1; ++k) chain_dma(ws, ring + k * CS_SLOT, cbase + k, w4u, lane);
        asm volatile("s_waitcnt vmcnt(18)" ::: "memory");
    }
    __builtin_amdgcn_s_barrier();
    for (int ck = 0; ck < NCK; ++ck) {
        if (wvu >= 4) {
            if (ck + CS_D - 1 < NCK) chain_dma(ws, ring + ((ck + CS_D - 1) % CS_D) * CS_SLOT, cbase + ck + CS_D - 1, w4u, lane);
            if (ck + CS_D - 1 < NCK) asm volatile("s_waitcnt vmcnt(18)" ::: "memory"); else asm volatile("s_waitcnt vmcnt(0)" ::: "memory");
        } else {
            const LAS unsigned char* sl = ring + (ck % CS_D) * CS_SLOT;
            bf16x8 zb[2];
#pragma unroll
            for (int s_ = 0; s_ < 2; ++s_) {
                union { unsigned u[4]; bf16x8 v; } t;
                t.u[0] = pack2(Z[2 * s_][0], Z[2 * s_][1]); t.u[1] = pack2(Z[2 * s_][2], Z[2 * s_][3]);
                t.u[2] = pack2(Z[2 * s_ + 1][0], Z[2 * s_ + 1][1]); t.u[3] = pack2(Z[2 * s_ + 1][2], Z[2 * s_ + 1][3]);
                zb[s_] = t.v;
            }
            const u32x2_t uvq = *(const LAS u32x2_t*)(sl + CS_UV + nt * 512 + lane * 8);
            const u32x2_t vvq = *(const LAS u32x2_t*)(sl + CS_V + nt * 512 + lane * 8);
            f32x4 u = {-bflo(uvq.x), -bfhi(uvq.x), -bflo(uvq.y), -bfhi(uvq.y)};
            u = __builtin_amdgcn_mfma_f32_16x16x32_bf16(neg8(*(const LAS bf16x8*)(sl + CS_W1 + lane * 16)), zb[0], u, 0, 0, 0);
            u = __builtin_amdgcn_mfma_f32_16x16x32_bf16(neg8(*(const LAS bf16x8*)(sl + CS_W1 + 1024 + lane * 16)), zb[1], u, 0, 0, 0);
            f32x4 y = {0.f, 0.f, 0.f, 0.f};
            y = __builtin_amdgcn_mfma_f32_16x16x32_bf16(*(const LAS bf16x8*)(sl + CS_RH + lane * 16), zb[0], y, 0, 0, 0);
            y = __builtin_amdgcn_mfma_f32_16x16x32_bf16(*(const LAS bf16x8*)(sl + CS_RH + 1024 + lane * 16), zb[1], y, 0, 0, 0);
            union { unsigned q[4]; bf16x8 v; } b2; b2.q[0] = vvq.x; b2.q[1] = vvq.y; b2.q[2] = pack2(u[0], u[1]); b2.q[3] = pack2(u[2], u[3]);
            y = __builtin_amdgcn_mfma_f32_16x16x32_bf16(*(const LAS bf16x8*)(sl + CS_G + lane * 16), b2.v, y, 0, 0, 0);
            const u32x4_t pq0 = *(const LAS u32x4_t*)(sl + CS_PC + g * 32), pq1 = *(const LAS u32x4_t*)(sl + CS_PC + g * 32 + 16);
#pragma unroll
            for (int mt = 0; mt < 4; ++mt) {
                const u32x4_t pq = (mt < 2) ? pq0 : pq1;
                const unsigned p01 = (mt & 1) ? pq.z : pq.x, p23 = (mt & 1) ? pq.w : pq.y;
                const f32x4 zi = {Z[mt][0] * bflo(p01), Z[mt][1] * bfhi(p01), Z[mt][2] * bflo(p23), Z[mt][3] * bfhi(p23)};
                Z[mt] = __builtin_amdgcn_mfma_f32_16x16x32_bf16(*(const LAS bf16x8*)(sl + CS_EB + mt * 1024 + lane * 16), b2.v, zi, 0, 0, 0);
            }
            if ((l == 0) || (ck >= CTX / CK)) {
#pragma unroll
                for (int r = 0; r < 4; ++r) Y[((size_t)b * TB + scan_tok(d, ck * CK + 4 * g + r)) * 512] = y[r];
            }
            asm volatile("s_waitcnt lgkmcnt(0)" ::: "memory");
        }
        __builtin_amdgcn_s_barrier();
    }
    asm volatile("s_waitcnt vmcnt(0)" ::: "memory");
    __syncthreads();
}

__device__ __forceinline__ void phase_chunkpre(const Args& a, int l, char* smem, int tid, int bid, int nb) {
    unsigned char* ws = wsp(a);
    const int wave = tid >> 6, lane = tid & 63;
    char* L = smem + wave * 16384;
    for (int cid = bid * NW + wave; cid < NCHUNK; cid += nb * NW) chunk_pre(a, ws, l, cid, L, lane);
}
__device__ __forceinline__ void phase_mix(const Args& a, int l, char* smem, int tid, int bid, int nb) {
    unsigned char* ws = wsp(a);
    const int wave = tid >> 6, lane = tid & 63;
    for (int seq = bid; seq < 128; seq += nb) chunk_chain_blk(a, ws, l, seq, smem, tid);
    if (bid >= 128 || nb <= 128) {
        const int nconv = (nb > 128) ? (nb - 128) * NW : nb * NW;
        const int me = (nb > 128) ? ((bid - 128) * NW + wave) : (bid * NW + wave);
        for (int j = me; j < 6144; j += nconv) {
            const int t = (j / 192) * 768 + 512 + 64 + (j % 192);
            cvt_expert_tile(a, ws, l, t, 0, lane); cvt_expert_tile(a, ws, l, t, 1, lane);
        }
    }
    const int nq = (l == 0) ? 72 : 64;
    const int x0 = (int)(xb_xcc_id() & 7u);
    int* qbase = (int*)(ws + CNT_OFF + 4096) + l * 8 * 64;
    int* qsl = (int*)(smem + LDS_MAIN + 448);
    for (int dx = 0; dx < 8; ++dx) {
        const int x = (x0 + dx) & 7;
        int* qctr = qbase + x * 64;
        for (;;) {
            __syncthreads();
            if (tid == 0) *qsl = atomicAdd(qctr, 1);
            __syncthreads();
            const int sq = __builtin_amdgcn_readfirstlane(*qsl);
            if (sq >= nq) break;
            const int it = (sq < 64) ? (x + 8 * (sq >> 4)) * 16 + (sq & 15) : 512 + (x + 8 * ((sq - 64) >> 1)) * 2 + ((sq - 64) & 1);
            attn_item2(a, l, it, smem, tid);
        }
    }
}

__device__ __forceinline__ void phase_post(const Args& a, int l, int tid, int bid, int nb) {
    unsigned char* ws = wsp(a);
    const int wave = tid >> 6, lane = tid & 63;
    const float* Y0 = (const float*)(ws + WS_Y);
    const float* Y1 = Y0 + (size_t)NT * 512;
    const bfu* RR = (const bfu*)(ws + WS_RR);
    const bfu* RV = (const bfu*)(ws + WS_RV);
    const bfu* RKp = (const bfu*)(ws + WS_RK);
    const bfu* AV0 = (const bfu*)(ws + WS_BV);
    const bfu* AV1 = AV0 + (size_t)NT * 512;
    const float* kap = a.in[21] + l * 512;
    const bfu* GG = (const bfu*)(ws + WS_GG);
    bfu* ORW = (bfu*)(ws + WS_ODA) + (size_t)2 * NT * 512;
    const float* lg = a.in[23] + l * 512;
    const float* lb = a.in[24] + l * 512;
    const float* rk = a.in[22] + l * 512;
    for (int row = bid * NW + wave; row < NT; row += nb * NW) {
        const int t = row % TB;
        if (l == 1 && t >= SEQ) continue;
        const size_t o = (size_t)row * 512 + lane * 8;
        float y[8];
        {
            const float4 a0 = *(const float4*)(Y0 + o), a1 = *(const float4*)(Y0 + o + 4);
            const float4 b0 = *(const float4*)(Y1 + o), b1 = *(const float4*)(Y1 + o + 4);
            y[0] = a0.x + b0.x; y[1] = a0.y + b0.y; y[2] = a0.z + b0.z; y[3] = a0.w + b0.w;
            y[4] = a1.x + b1.x; y[5] = a1.y + b1.y; y[6] = a1.z + b1.z; y[7] = a1.w + b1.w;
        }
        float s = 0.f;
#pragma unroll
        for (int e = 0; e < 8; ++e) s += y[e];
        s += shx_(s, 1); s += shx_(s, 2); s += shx_(s, 4);
        const float mu = s * (1.0f / 64.0f);
        float vs = 0.f;
#pragma unroll
        for (int e = 0; e < 8; ++e) { const float dlt = y[e] - mu; vs += dlt * dlt; }
        vs += shx_(vs, 1); vs += shx_(vs, 2); vs += shx_(vs, 4);
        const float rstd = rsqrtf(vs * (1.0f / 64.0f) + 64e-5f);
        const uint4 pr = *(const uint4*)(RR + o), pv = *(const uint4*)(RV + o), pk0 = *(const uint4*)(AV0 + o), pk1 = *(const uint4*)(AV1 + o), pg = *(const uint4*)(GG + o), pkk = *(const uint4*)(RKp + o);
        const float r8[8] = {bflo(pr.x), bfhi(pr.x), bflo(pr.y), bfhi(pr.y), bflo(pr.z), bfhi(pr.z), bflo(pr.w), bfhi(pr.w)};
        const float v8[8] = {bflo(pv.x), bfhi(pv.x), bflo(pv.y), bfhi(pv.y), bflo(pv.z), bfhi(pv.z), bflo(pv.w), bfhi(pv.w)};
        const float as8[8] = {bflo(pk0.x) + bflo(pk1.x), bfhi(pk0.x) + bfhi(pk1.x), bflo(pk0.y) + bflo(pk1.y), bfhi(pk0.y) + bfhi(pk1.y),
                              bflo(pk0.z) + bflo(pk1.z), bfhi(pk0.z) + bfhi(pk1.z), bflo(pk0.w) + bflo(pk1.w), bfhi(pk0.w) + bfhi(pk1.w)};
        const float kr8[8] = {bflo(pkk.x), bfhi(pkk.x), bflo(pkk.y), bfhi(pkk.y), bflo(pkk.z), bfhi(pkk.z), bflo(pkk.w), bfhi(pkk.w)};
        float k8[8];
#pragma unroll
        for (int e = 0; e < 8; ++e) k8[e] = kr8[e] * (2.0f + (as8[e] - 2.0f) * kap[lane * 8 + e]);
        const float g8[8] = {bflo(pg.x), bfhi(pg.x), bflo(pg.y), bfhi(pg.y), bflo(pg.z), bfhi(pg.z), bflo(pg.w), bfhi(pg.w)};
        float ds = 0.f;
#pragma unroll
        for (int e = 0; e < 8; ++e) ds += r8[e] * k8[e] * rk[lane * 8 + e];
        ds += shx_(ds, 1); ds += shx_(ds, 2); ds += shx_(ds, 4);
        float ov[8];
#pragma unroll
        for (int e = 0; e < 8; ++e) ov[e] = ((y[e] - mu) * rstd * lg[lane * 8 + e] + lb[lane * 8 + e] + ds * v8[e]) * g8[e];
        uint4 po; po.x = pack2(ov[0], ov[1]); po.y = pack2(ov[2], ov[3]); po.z = pack2(ov[4], ov[5]); po.w = pack2(ov[6], ov[7]);
        *(uint4*)(ORW + o) = po;
    }
}

__device__ __forceinline__ void phase_merge(const Args& a, int l, char* smem, int tid, int bid, int nb) {
    unsigned char* ws = wsp(a);
    const int wave = tid >> 6, lane = tid & 63, wm = wave >> 1, wn = wave & 1, g = lane >> 4, c = lane & 15;
    const bfu* GL = (const bfu*)(ws + WS_GL);
    bfu* MB = (bfu*)(ws + WS_MB);
    for (int it = bid; it < 72 * 16; it += nb) {
        const int mt = it >> 4, nt = it & 15;
        if (l == 1 && (mt % 9) == 8) continue;
        const int m0 = mt * 256, n0 = nt * 64;
        int arow[4]; ident_rows(arow, m0, tid);
        const int rowbase = m0 + wm * 64, colbase = n0 + wn * 32;
        f32x4 tot[4][2]; zero_acc<2>(tot);
        for (int n = 0; n < 3; ++n) {
            f32x4 acc[4][2]; zero_acc<2>(acc);
            gemm_loop<2>(acc, (const bfu*)(ws + WS_ODA) + (size_t)n * NT * 512, 512, arow,
                         (const bfu*)(ws + WS_WBT) + (size_t)(l * 3 + n) * 1024 * 512, 512, n0, 512, smem, tid);
#pragma unroll
            for (int mi = 0; mi < 4; ++mi)
#pragma unroll
                for (int ni = 0; ni < 2; ++ni)
#pragma unroll
                    for (int r = 0; r < 4; ++r) {
                        const int row = rowbase + mi * 16 + g * 4 + r;
                        const float gate = bf2f(GL[(size_t)row * 3072 + n * 1024 + colbase + ni * 16 + c]);
                        tot[mi][ni][r] += gate * acc[mi][ni][r];
                    }
        }
#pragma unroll
        for (int mi = 0; mi < 4; ++mi)
#pragma unroll
            for (int ni = 0; ni < 2; ++ni)
#pragma unroll
                for (int r = 0; r < 4; ++r) {
                    const int row = rowbase + mi * 16 + g * 4 + r;
                    MB[(size_t)row * 1024 + colbase + ni * 16 + c] = f2bf(tot[mi][ni][r]);
                }
    }
}

__device__ __forceinline__ void phase_wout(const Args& a, int l, char* smem, int tid, int bid, int nb) {
    unsigned char* ws = wsp(a);
    const int wave = tid >> 6, lane = tid & 63, wm = wave >> 1, wn = wave & 1, g = lane >> 4, c = lane & 15;
    float* xres = (float*)(ws + WS_XRES);
    const float* mod = (const float*)(ws + WS_MOD);
    for (int it = bid; it < 72 * 8; it += nb) {
        const int mt = it >> 3, nt = it & 7;
        if (l == 1 && (mt % 9) == 8) continue;
        const int m0 = mt * 256, n0 = nt * 128;
        int arow[4]; ident_rows(arow, m0, tid);
        f32x4 acc[4][4]; zero_acc<4>(acc);
        gemm_loop<4>(acc, (const bfu*)(ws + WS_MB), 1024, arow, (const bfu*)(ws + WS_WOT) + (size_t)l * 1024 * 1024, 1024, n0, 1024, smem, tid);
        const int rowbase = m0 + wm * 64, colbase = n0 + wn * 64;
        const int b = m0 / TB, m = ((m0 % TB) < SEQ) ? b : 8;
        const float* ga = mod + (size_t)(l * 9 + m) * 6144 + 2 * 1024;
#pragma unroll
        for (int ni = 0; ni < 4; ++ni) {
            const int col = colbase + ni * 16 + c;
            const float gac = ga[col];
#pragma unroll
            for (int mi = 0; mi < 4; ++mi)
#pragma unroll
                for (int r = 0; r < 4; ++r) {
                    const int row = rowbase + mi * 16 + g * 4 + r;
                    xres[(size_t)row * 1024 + col] += gac * acc[mi][ni][r];
                }
        }
    }
}

__device__ __forceinline__ void phase_topk(const Args& a, int l, char* smem, int tid, int bid, int nb) {
    unsigned char* ws = wsp(a);
    const float* LG = (const float*)(ws + WS_LOG);
    int* cnt = (int*)(ws + CNT_OFF) + l * 32;
    int* TOKL = (int*)(ws + WS_TOKL);
    float* GATE = (float*)(ws + WS_GATE);
    int* lcnt = (int*)smem;
    int* lbase = lcnt + 32;
    for (int blk = bid; blk < NT / NTHREADS; blk += nb) {
        const int row = blk * NTHREADS + tid;
        const int t = row % TB;
        const bool active = !(l == 1 && t >= SEQ);
        __syncthreads();
        if (tid < 32) lcnt[tid] = 0;
        __syncthreads();
        int ei[4] = {0, 0, 0, 0}; float ev[4] = {0.f, 0.f, 0.f, 0.f}; int lr[4] = {0, 0, 0, 0};
        if (active) {
            float v[32];
#pragma unroll
            for (int q = 0; q < 8; ++q) {
                const float4 x4 = *(const float4*)(LG + (size_t)row * 32 + q * 4);
                v[q * 4] = x4.x; v[q * 4 + 1] = x4.y; v[q * 4 + 2] = x4.z; v[q * 4 + 3] = x4.w;
            }
#pragma unroll
            for (int k = 0; k < 4; ++k) {
                float best = -3.0e38f; int bi = 0;
#pragma unroll
                for (int e = 0; e < 32; ++e) { const bool tk = v[e] > best; best = tk ? v[e] : best; bi = tk ? e : bi; }
                ei[k] = bi; ev[k] = best;
#pragma unroll
                for (int e = 0; e < 32; ++e) v[e] = (e == bi) ? -3.0e38f : v[e];
            }
            const float e1 = __expf(ev[1] - ev[0]), e2 = __expf(ev[2] - ev[0]), e3 = __expf(ev[3] - ev[0]);
            const float inv = 1.0f / (1.0f + e1 + e2 + e3);
            ev[0] = inv; ev[1] = e1 * inv; ev[2] = e2 * inv; ev[3] = e3 * inv;
#pragma unroll
            for (int k = 0; k < 4; ++k) lr[k] = atomicAdd(&lcnt[ei[k]], 1);
        }
        __syncthreads();
        if (tid < 32) lbase[tid] = (lcnt[tid] > 0) ? atomicAdd(&cnt[tid], lcnt[tid]) : 0;
        __syncthreads();
        if (active) {
#pragma unroll
            for (int k = 0; k < 4; ++k) {
                const int pos = lbase[ei[k]] + lr[k];
                const int id = row * 4 + k;
                TOKL[(size_t)ei[k] * NT + pos] = id;
                ((float*)(ws + WS_GATEL))[(size_t)ei[k] * NT + pos] = ev[k];
            }
        }
    }
}

__device__ __forceinline__ void expert_prefix(const Args& a, int l, int* sm, int tid) {
    const int* cnt = (const int*)(wsp(a) + CNT_OFF) + l * 32;
    __syncthreads();
    if (tid == 0) {
        int tp = 0, rp = 0;
        for (int e = 0; e < 32; ++e) {
            const int cn = cnt[e];
            sm[e] = cn; sm[32 + e] = tp; sm[65 + e] = rp;
            tp += (cn + 255) >> 8; rp += cn;
        }
        sm[64] = tp; sm[97] = rp;
    }
    __syncthreads();
}

__device__ __forceinline__ void phase_gemm1(const Args& a, int l, char* smem, int tid, int bid, int nb) {
    unsigned char* ws = wsp(a);
    int* pre = (int*)(smem + LDS_MAIN);
    expert_prefix(a, l, pre, tid);
    const int wave = tid >> 6, lane = tid & 63, wm = wave >> 1, wn = wave & 1, g = lane >> 4, c = lane & 15;
    const int ntiles = pre[64] * 16;
    const int* TOKL = (const int*)(ws + WS_TOKL);
    const bfu* HI = (const bfu*)(ws + WS_H2HI);
    bfu* ACT = (bfu*)(ws + WS_ACT);
    for (int it = bid; it < ntiles; it += nb) {
        const int tix = it >> 4, nt = it & 15;
        int e = 0;
        while (pre[32 + e + 1] <= tix) ++e;
        const int mt = tix - pre[32 + e];
        const int cn = pre[e], rs = pre[65 + e];
        const int* tl = TOKL + (size_t)e * NT;
        int arow[4];
#pragma unroll
        for (int i = 0; i < 4; ++i) {
            int ri = mt * 256 + (tid >> 3) + 64 * i;
            ri = (ri < cn) ? ri : 0;
            arow[i] = tl[ri] >> 2;
        }
        f32x4 acc[4][4]; zero_acc<4>(acc);
        gemm_loop<4>(acc, HI, 1024, arow, (const bfu*)(ws + WS_W1T) + (size_t)(l * 32 + e) * 2048 * 1024, 1024, nt * 128, 1024, smem, tid);
        const float* b1 = a.in[30] + (size_t)(l * 32 + e) * 2048;
#pragma unroll
        for (int p = 0; p < 2; ++p) {
            const int acol = nt * 64 + wn * 32 + p * 16 + c;
            const float bg = b1[acol], bl = b1[1024 + acol];
#pragma unroll
            for (int mi = 0; mi < 4; ++mi)
#pragma unroll
                for (int r = 0; r < 4; ++r) {
                    const int grow = mt * 256 + wm * 64 + mi * 16 + g * 4 + r;
                    if (grow < cn) {
                        const float glu = fminf(acc[mi][2 * p][r] + bg, 7.0f);
                        const float lin = fminf(fmaxf(acc[mi][2 * p + 1][r] + bl, -7.0f), 7.0f);
                        ACT[(size_t)(rs + grow) * 1024 + acol] = f2bf(glu * sigmoidf_(1.702f * glu) * (lin + 1.0f));
                    }
                }
        }
    }
}

__device__ __forceinline__ void phase_gemm2(const Args& a, int l, char* smem, int tid, int bid, int nb) {
    unsigned char* ws = wsp(a);
    int* pre = (int*)(smem + LDS_MAIN);
    expert_prefix(a, l, pre, tid);
    const int wave = tid >> 6, lane = tid & 63, wm = wave >> 1, wn = wave & 1, g = lane >> 4, c = lane & 15;
    const int ntiles = pre[64] * 8;
    const int* TOKL = (const int*)(ws + WS_TOKL);
    const float* GATE = (const float*)(ws + WS_GATE);
    const bfu* ACT = (const bfu*)(ws + WS_ACT);
    bfu* YB = (bfu*)(ws + WS_YB);
    for (int it = bid; it < ntiles; it += nb) {
        const int tix = it >> 3, nt = it & 7;
        int e = 0;
        while (pre[32 + e + 1] <= tix) ++e;
        const int mt = tix - pre[32 + e];
        const int cn = pre[e], rs = pre[65 + e];
        const int* tl = TOKL + (size_t)e * NT;
        int arow[4];
#pragma unroll
        for (int i = 0; i < 4; ++i) {
            int ri = mt * 256 + (tid >> 3) + 64 * i;
            ri = (ri < cn) ? ri : (cn - 1);
            arow[i] = rs + ri;
        }
        f32x4 acc[4][4]; zero_acc<4>(acc);
        gemm_loop<4>(acc, ACT, 1024, arow, (const bfu*)(ws + WS_W2ET) + (size_t)(l * 32 + e) * 1024 * 1024, 1024, nt * 128, 1024, smem, tid);
        const float* b2 = a.in[32] + (size_t)(l * 32 + e) * 1024;
#pragma unroll
        for (int mi = 0; mi < 4; ++mi)
#pragma unroll
            for (int r = 0; r < 4; ++r) {
                const int grow = mt * 256 + wm * 64 + mi * 16 + g * 4 + r;
                if (grow < cn) {
                    const int id = tl[grow];
                    const float gate = GATE[id];
#pragma unroll
                    for (int ni = 0; ni < 4; ++ni) {
                        const int col = nt * 128 + wn * 64 + ni * 16 + c;
                        YB[(size_t)id * 1024 + col] = f2bf((acc[mi][ni][r] + b2[col]) * gate);
                    }
                }
            }
    }
}

struct EpiWout {
    static constexpr bool PERM = true;
    unsigned char* ws; int l;
    __device__ __forceinline__ void operator()(const f32x4 (&acc)[2][2][4][2], const g8::Unit& u, int wr, int wc, int fr, int fq) const {
        float* xres = (float*)(ws + WS_XRES);
        const int rbase = u.pm * 256;
        const int b = rbase / TB, mm = ((rbase % TB) < SEQ) ? b : 8;
        const float* ga = (const float*)(ws + WS_MOD) + (size_t)(l * 9 + mm) * 6144 + 2 * 1024;
        const int col0 = u.pn * 256 + 32 * wc + 8 * fq;
        f32x4 gv[2][2];
#pragma unroll
        for (int bj = 0; bj < 2; ++bj)
#pragma unroll
            for (int n = 0; n < 2; ++n) gv[bj][n] = *(const f32x4*)(ga + col0 + bj * 128 + n * 4);
#pragma unroll
        for (int ai = 0; ai < 2; ++ai)
#pragma unroll
            for (int m = 0; m < 4; ++m) {
                float* rp = xres + (size_t)(rbase + ai * 128 + wr * 64 + m * 16 + fr) * 1024 + col0;
#pragma unroll
                for (int bj = 0; bj < 2; ++bj)
#pragma unroll
                    for (int n = 0; n < 2; ++n) {
                        f32x4 x = *(const f32x4*)(rp + bj * 128 + n * 4);
                        x += gv[bj][n] * acc[ai][bj][m][n];
                        *(f32x4*)(rp + bj * 128 + n * 4) = x;
                    }
            }
    }
};
__device__ __forceinline__ void phase_wout8(const Args& a, int l, char* smem, int tid, int bid, int nb) {
    SchedDense S;
    S.A = (const char*)(wsp(a) + WS_GL); S.B = (const char*)(wsp(a) + WS_WOT) + (size_t)l * 1024 * 3072 * 2;
    S.lda = 3072; S.ldb = 3072; S.nM = 64; S.nN = 4; S.G = nb; S.c = bid; S.skip9 = 1;
    EpiWout E; E.ws = wsp(a); E.l = l;
    g8::gemm8((LAS unsigned char*)smem, S, E, 1024, tid);
    if (l == 0) {
        unsigned char* ws = wsp(a);
        const int wave = tid >> 6, lane = tid & 63, wm = wave >> 1, wn = wave & 1, g = lane >> 4, c = lane & 15;
        float* xres = (float*)(ws + WS_XRES);
        const float* ga = (const float*)(ws + WS_MOD) + (size_t)(l * 9 + 8) * 6144 + 2 * 1024;
        __syncthreads();
        for (int it = bid; it < 128; it += nb) {
            const int mt = (it >> 4) * 9 + 8, nt = it & 15;
            const int m0 = mt * 256, n0 = nt * 64;
            int arow[4]; ident_rows(arow, m0, tid);
            f32x4 acc[4][2]; zero_acc<2>(acc);
            gemm_loop<2>(acc, (const bfu*)(ws + WS_MB), 1024, arow, (const bfu*)(ws + WS_WOT) + (size_t)l * 1024 * 3072, 3072, n0, 1024, smem, tid);
            const int rowbase = m0 + wm * 64, colbase = n0 + wn * 32;
#pragma unroll
            for (int ni = 0; ni < 2; ++ni) {
                const int col = colbase + ni * 16 + c;
                const float gac = ga[col];
#pragma unroll
                for (int mi = 0; mi < 4; ++mi)
#pragma unroll
                    for (int r = 0; r < 4; ++r) {
                        const int row = rowbase + mi * 16 + g * 4 + r;
                        xres[(size_t)row * 1024 + col] += gac * acc[mi][ni][r];
                    }
            }
        }
    }
}

struct SchedMerge {
    static constexpr bool GATHER = false;
    unsigned char* ws; int l, lda, ldb, nM, G, c, skip9;
    __device__ __forceinline__ bool next(int i, g8::Unit& u) const {
        const int j = i / 3, n = g8::uni(i - 3 * j);
        int pm, pn; if (!g8::static_tile(j, G, c, nM, 4, pm, pn)) return false;
        if (skip9) pm += pm >> 3;
        pm = g8::uni(pm); pn = g8::uni(pn);
        u.pm = pm; u.pn = pn; u.e = n; u.cn = 0;
        u.A = (const char*)(ws + WS_ODA) + ((size_t)n * NT * 512 + (size_t)pm * 256 * 512) * 2;
        u.B = (const char*)(ws + WS_WBT) + ((size_t)(l * 3 + n) * 1024 * 512 + (size_t)pn * 256 * 512) * 2;
        return true;
    }
    __device__ __forceinline__ void rows(const g8::Unit&, int, int&) const {}
};
struct EpiMerge {
    static constexpr bool PERM = true;
    unsigned char* ws;
    __device__ __forceinline__ void operator()(const f32x4 (&acc)[2][2][4][2], const g8::Unit& u, int wr, int wc, int fr, int fq) const {
        bfu* GL = (bfu*)(ws + WS_GL);
        const int col0 = u.pn * 256 + 32 * wc + 8 * fq;
        const int go = u.e * 1024;
        const bool first = (u.e == 0);
#pragma unroll
        for (int ai = 0; ai < 2; ++ai)
#pragma unroll
            for (int m = 0; m < 4; ++m) {
                bfu* rp = GL + (size_t)(u.pm * 256 + ai * 128 + wr * 64 + m * 16 + fr) * 3072 + col0;
#pragma unroll
                for (int bj = 0; bj < 2; ++bj) {
                    const uint4 gp = *(const uint4*)(rp + go + bj * 128);
                    uint4 zp = make_uint4(0u, 0u, 0u, 0u);
                    if (!first) zp = *(const uint4*)(rp + bj * 128);
                    f32x4 v0 = acc[ai][bj][m][0], v1 = acc[ai][bj][m][1];
                    v0[0] = v0[0] * bflo(gp.x) + bflo(zp.x); v0[1] = v0[1] * bfhi(gp.x) + bfhi(zp.x); v0[2] = v0[2] * bflo(gp.y) + bflo(zp.y); v0[3] = v0[3] * bfhi(gp.y) + bfhi(zp.y);
                    v1[0] = v1[0] * bflo(gp.z) + bflo(zp.z); v1[1] = v1[1] * bfhi(gp.z) + bfhi(zp.z); v1[2] = v1[2] * bflo(gp.w) + bflo(zp.w); v1[3] = v1[3] * bfhi(gp.w) + bfhi(zp.w);
                    const uint2 lo = pack4(v0), hi = pack4(v1);
                    *(uint4*)(rp + bj * 128) = make_uint4(lo.x, lo.y, hi.x, hi.y);
                }
            }
    }
};
__device__ __forceinline__ void phase_merge8(const Args& a, int l, char* smem, int tid, int bid, int nb) {
    SchedMerge S; S.ws = wsp(a); S.l = l; S.lda = 512; S.ldb = 512; S.nM = 64; S.G = nb; S.c = bid; S.skip9 = 1;
    EpiMerge E; E.ws = wsp(a);
    g8::gemm8((LAS unsigned char*)smem, S, E, 512, tid);
    if (l == 0) {
        unsigned char* ws = wsp(a);
        const int wave = tid >> 6, lane = tid & 63, wm = wave >> 1, wn = wave & 1, g = lane >> 4, c = lane & 15;
        const bfu* GL = (const bfu*)(ws + WS_GL);
        bfu* MB = (bfu*)(ws + WS_MB);
        __syncthreads();
        for (int it = bid; it < 128; it += nb) {
            const int mt = (it >> 4) * 9 + 8, nt = it & 15;
            const int m0 = mt * 256, n0 = nt * 64;
            int arow[4]; ident_rows(arow, m0, tid);
            const int rowbase = m0 + wm * 64, colbase = n0 + wn * 32;
            f32x4 tot[4][2]; zero_acc<2>(tot);
            for (int n = 0; n < 3; ++n) {
                f32x4 acc[4][2]; zero_acc<2>(acc);
                gemm_loop<2>(acc, (const bfu*)(ws + WS_ODA) + (size_t)n * NT * 512, 512, arow,
                             (const bfu*)(ws + WS_WBT) + (size_t)(l * 3 + n) * 1024 * 512, 512, n0, 512, smem, tid);
#pragma unroll
                for (int mi = 0; mi < 4; ++mi)
#pragma unroll
                    for (int ni = 0; ni < 2; ++ni)
#pragma unroll
                        for (int r = 0; r < 4; ++r) {
                            const int row = rowbase + mi * 16 + g * 4 + r;
                            const float gate = bf2f(GL[(size_t)row * 3072 + n * 1024 + colbase + ni * 16 + c]);
                            tot[mi][ni][r] += gate * acc[mi][ni][r];
                        }
            }
#pragma unroll
            for (int mi = 0; mi < 4; ++mi)
#pragma unroll
                for (int ni = 0; ni < 2; ++ni)
#pragma unroll
                    for (int r = 0; r < 4; ++r) {
                        const int row = rowbase + mi * 16 + g * 4 + r;
                        MB[(size_t)row * 1024 + colbase + ni * 16 + c] = f2bf(tot[mi][ni][r]);
                    }
        }
    }
}

constexpr int N2_RPW = 9;
#ifndef N2_SWAP16
#define N2_SWAP16 1
#endif
__device__ __forceinline__ float rowmax16(float x) {
    x = fmaxf(x, dppf<0xB1>(x)); x = fmaxf(x, dppf<0x4E>(x)); x = fmaxf(x, dppf<0x124>(x)); x = fmaxf(x, dppf<0x128>(x));
    return x;
}
__device__ __forceinline__ void phase_n2rt(const Args& a, int l, char* smem, int tid, int bid, int nb) {
    unsigned char* ws = wsp(a);
    const int wave = tid >> 6, lane = tid & 63;
    float* RT = (float*)smem;
    int* lcnt = (int*)(smem + LDS_MAIN);
    int* lbase = lcnt + 32;
    int* rec_e = (int*)(smem + LDS_MAIN + 512);
    int* rec_r = rec_e + NW * N2_RPW * 4;
    float* rec_g = (float*)(rec_r + NW * N2_RPW * 4);
    const float* xres = (const float*)(ws + WS_XRES);
    bfu* H = (bfu*)(ws + WS_H);
    const float* mod = (const float*)(ws + WS_MOD);
    int* cnt = (int*)(ws + CNT_OFF) + l * 32;
    int* TOKL = (int*)(ws + WS_TOKL);
    float* GATEL = (float*)(ws + WS_GATEL);
    __syncthreads();
    {
        const float* Rs = a.in[27] + (size_t)l * 1024 * 32;
        for (int idx = tid; idx < 8192; idx += NTHREADS) {
            const int k = idx & 1023, e4 = idx >> 10;
            const float4 r = *(const float4*)(Rs + (size_t)k * 32 + e4 * 4);
            RT[(e4 * 4 + 0) * 1024 + k] = r.x; RT[(e4 * 4 + 1) * 1024 + k] = r.y; RT[(e4 * 4 + 2) * 1024 + k] = r.z; RT[(e4 * 4 + 3) * 1024 + k] = r.w;
        }
    }
    const float bias = a.in[28][l * 32 + (lane >> 1)];
    const int stride = nb * NW;
    const bool b5 = (lane & 32) != 0, b4 = (lane & 16) != 0, b3 = (lane & 8) != 0, b2 = (lane & 4) != 0, b1 = (lane & 2) != 0;
    for (int r0 = bid * NW + wave; r0 - wave - bid * NW < NT; r0 += N2_RPW * stride) {
        __syncthreads();
        if (tid < 32) lcnt[tid] = 0;
        __syncthreads();
        float4 vn[4];
        if (r0 < NT) {
#pragma unroll
            for (int i = 0; i < 4; ++i) vn[i] = *(const float4*)(xres + (size_t)r0 * 1024 + i * 256 + lane * 4);
        }
        for (int kk = 0; kk < N2_RPW; ++kk) {
            const int row = r0 + kk * stride;
            if (row >= NT) { if (lane < 4) rec_e[(wave * N2_RPW + kk) * 4 + lane] = -1; continue; }
            const int b = row / TB, t = row % TB;
            float v[16];
#pragma unroll
            for (int i = 0; i < 4; ++i) { v[i * 4 + 0] = vn[i].x; v[i * 4 + 1] = vn[i].y; v[i * 4 + 2] = vn[i].z; v[i * 4 + 3] = vn[i].w; }
            if (kk + 1 < N2_RPW && row + stride < NT) {
#pragma unroll
                for (int i = 0; i < 4; ++i) vn[i] = *(const float4*)(xres + (size_t)(row + stride) * 1024 + i * 256 + lane * 4);
            }
            if (l == 1 && t >= SEQ) { if (lane < 4) rec_e[(wave * N2_RPW + kk) * 4 + lane] = -1; continue; }
            const int m = (t < SEQ) ? b : 8;
            const float* md = mod + (size_t)(l * 9 + m) * 6144;
            float y[16];
            norm_mod(v, y, a.in[7] + l * 1024, md + 3 * 1024, md + 4 * 1024, lane);
            store_h_row(H + (size_t)row * 1024, y, lane);
            f32x2_t acc2[32];
#pragma unroll
            for (int e = 0; e < 32; ++e) acc2[e] = (f32x2_t){0.f, 0.f};
            {
                const float* rp = RT + lane * 4;
                f32x4 ra[6], rb[6];
#define N2_LD(dst, bt) do { _Pragma("unroll") for (int q = 0; q < 6; ++q) { const int pe = (bt) * 6 + q; if (pe < 128) dst[q] = *(const f32x4*)(rp + (pe & 31) * 1024 + (pe >> 5) * 256); } } while (0)
#define N2_FM(src, bt) do { _Pragma("unroll") for (int q = 0; q < 6; ++q) { const int pe = (bt) * 6 + q; if (pe < 128) { const int e = pe & 31, i_ = pe >> 5; \
                    const f32x2_t y01 = {y[i_ * 4 + 0], y[i_ * 4 + 1]}, y23 = {y[i_ * 4 + 2], y[i_ * 4 + 3]}; const f32x2_t r01 = {src[q][0], src[q][1]}, r23 = {src[q][2], src[q][3]}; \
                    acc2[e] = y01 * r01 + acc2[e]; acc2[e] = y23 * r23 + acc2[e]; } } } while (0)
                N2_LD(ra, 0);
#pragma unroll
                for (int bt = 0; bt < 22; bt += 2) {
                    N2_LD(rb, bt + 1);
                    __builtin_amdgcn_sched_barrier(0);
                    N2_FM(ra, bt);
                    __builtin_amdgcn_sched_barrier(0);
                    if (bt + 2 < 22) N2_LD(ra, bt + 2);
                    __builtin_amdgcn_sched_barrier(0);
                    N2_FM(rb, bt + 1);
                    __builtin_amdgcn_sched_barrier(0);
                }
#undef N2_LD
#undef N2_FM
            }
            float acc[32];
#pragma unroll
            for (int e = 0; e < 32; ++e) acc[e] = acc2[e][0] + acc2[e][1];
            float S[16], U[8], T4[4], W2[2];
#pragma unroll
            for (int j = 0; j < 16; ++j) {
                const auto r = __builtin_amdgcn_permlane32_swap(__float_as_uint(acc[j]), __float_as_uint(acc[16 + j]), false, false);
                S[j] = __uint_as_float(r[0]) + __uint_as_float(r[1]);
            }
#pragma unroll
            for (int j = 0; j < 8; ++j) {
#if N2_SWAP16
                const auto r = __builtin_amdgcn_permlane16_swap(__float_as_uint(S[j]), __float_as_uint(S[8 + j]), false, false);
                U[j] = __uint_as_float(r[0]) + __uint_as_float(r[1]);
#else
                const float keep = b4 ? S[8 + j] : S[j], send = b4 ? S[j] : S[8 + j];
                U[j] = keep + shx_(send, 16);
#endif
            }
#pragma unroll
            for (int j = 0; j < 4; ++j) { const float keep = b3 ? U[4 + j] : U[j], send = b3 ? U[j] : U[4 + j]; T4[j] = keep + dppf<0x128>(send); }
#pragma unroll
            for (int j = 0; j < 2; ++j) { const float keep = b2 ? T4[2 + j] : T4[j], send = b2 ? T4[j] : T4[2 + j]; W2[j] = keep + shx_(send, 4); }
            float X;
            { const float keep = b1 ? W2[1] : W2[0], send = b1 ? W2[0] : W2[1]; X = keep + dppf<0x4E>(send); }
            X += dppf<0xB1>(X);
            float lg = X + bias;
            int ei[4]; float ev[4];
#pragma unroll
            for (int k = 0; k < 4; ++k) {
                const float rm = rowmax16(lg);
                const float m0 = __int_as_float(__builtin_amdgcn_readlane(__float_as_int(rm), 0)), m1 = __int_as_float(__builtin_amdgcn_readlane(__float_as_int(rm), 16));
                const float m2 = __int_as_float(__builtin_amdgcn_readlane(__float_as_int(rm), 32)), m3 = __int_as_float(__builtin_amdgcn_readlane(__float_as_int(rm), 48));
                const float mx = fmaxf(fmaxf(m0, m1), fmaxf(m2, m3));
                const unsigned long long bm = __ballot(lg == mx);
                const int e = (__ffsll((long long)bm) - 1) >> 1;
                ei[k] = e; ev[k] = mx;
                lg = ((lane >> 1) == e) ? -3.0e38f : lg;
            }
            const float e1 = __expf(ev[1] - ev[0]), e2 = __expf(ev[2] - ev[0]), e3 = __expf(ev[3] - ev[0]);
            const float inv = 1.0f / (1.0f + e1 + e2 + e3);
            if (lane < 4) {
                const int es = (lane == 0) ? ei[0] : (lane == 1) ? ei[1] : (lane == 2) ? ei[2] : ei[3];
                const float gs = ((lane == 0) ? 1.0f : (lane == 1) ? e1 : (lane == 2) ? e2 : e3) * inv;
                const int lr = atomicAdd(&lcnt[es], 1);
                const int ro = (wave * N2_RPW + kk) * 4 + lane;
                rec_e[ro] = es; rec_r[ro] = lr; rec_g[ro] = gs;
            }
        }
        __syncthreads();
        if (tid < 32) lbase[tid] = (lcnt[tid] > 0) ? atomicAdd(&cnt[tid], lcnt[tid]) : 0;
        __syncthreads();
        if (lane < N2_RPW * 4) {
            const int kk = lane >> 2, k = lane & 3;
            const int ro = (wave * N2_RPW + kk) * 4 + k;
            const int e = rec_e[ro];
            if (e >= 0) {
                const int row = r0 + kk * stride;
                const int pos = lbase[e] + rec_r[ro];
                TOKL[(size_t)e * NT + pos] = row * 4 + k;
                GATEL[(size_t)e * NT + pos] = rec_g[ro];
            }
        }
    }
}

struct SchedG1 {
    static constexpr bool GATHER = true;
    unsigned char* ws; const int* pre; int l, lda, ldb, G, c; mutable int hint;
    __device__ __forceinline__ bool next(int i, g8::Unit& u) const {
        const int total = pre[64] * 8;
        const long L0 = (long)i * G + c; if (L0 >= total) return false;
        int L = (int)L0; { const int q = total / 8, r = total % 8, xcd = L % 8, off = L / 8; L = (xcd < r ? xcd * (q + 1) : r * (q + 1) + (xcd - r) * q) + off; }
        const int tix = g8::uni(L >> 3), pn = g8::uni(L & 7);
        int e = (pre[32 + hint] <= tix) ? hint : 0; while (pre[32 + e + 1] <= tix) ++e;
        e = g8::uni(e); hint = e;
        u.e = e; u.cn = g8::uni(pre[e]); u.pm = g8::uni(tix - pre[32 + e]); u.pn = pn;
        u.A = (const char*)(ws + WS_H);
        u.B = (const char*)(ws + WS_W1T) + ((size_t)(l * 32 + e) * 2048 + (size_t)pn * 256) * 1024 * 2;
        return true;
    }
    __device__ __forceinline__ void rows(const g8::Unit& u, int r, int& idx) const {
        int ri = u.pm * 256 + r; ri = (ri < u.cn) ? ri : 0;
        idx = ((const int*)(ws + WS_TOKL))[(size_t)u.e * NT + ri] >> 2;
    }
};
struct EpiG1 {
    static constexpr bool PERM = true;
    unsigned char* ws; const int* pre; const float* b1l;
    __device__ __forceinline__ void operator()(const f32x4 (&acc)[2][2][4][2], const g8::Unit& u, int wr, int wc, int fr, int fq) const {
        bfu* ACT = (bfu*)(ws + WS_ACT);
        const float* b1 = b1l + (size_t)u.e * 2048;
        const size_t rbase = (size_t)(pre[32 + u.e] + u.pm) * 256 + wr * 64 + fr;
        const int ac0 = u.pn * 128 + 32 * wc + 8 * fq;
        f32x4 bg[2], bl[2];
#pragma unroll
        for (int n = 0; n < 2; ++n) { bg[n] = *(const f32x4*)(b1 + ac0 + 4 * n); bl[n] = *(const f32x4*)(b1 + 1024 + ac0 + 4 * n); }
#pragma unroll
        for (int ai = 0; ai < 2; ++ai)
#pragma unroll
            for (int m = 0; m < 4; ++m) {
                uint2 pk[2];
#pragma unroll
                for (int n = 0; n < 2; ++n) {
                    f32x4 o;
#pragma unroll
                    for (int j = 0; j < 4; ++j) {
                        const float glu = fminf(acc[ai][0][m][n][j] + bg[n][j], 7.0f);
                        const float lin = fminf(fmaxf(acc[ai][1][m][n][j] + bl[n][j], -7.0f), 7.0f);
                        o[j] = glu * sigmoidf_(1.702f * glu) * (lin + 1.0f);
                    }
                    pk[n] = pack4(o);
                }
                *(uint4*)(ACT + (rbase + ai * 128 + m * 16) * 1024 + ac0) = make_uint4(pk[0].x, pk[0].y, pk[1].x, pk[1].y);
            }
    }
};
struct SchedG2 {
    static constexpr bool GATHER = false;
    unsigned char* ws; const int* pre; int l, lda, ldb, G, c; mutable int hint;
    __device__ __forceinline__ bool next(int i, g8::Unit& u) const {
        const int total = pre[64] * 4;
        const long L0 = (long)i * G + c; if (L0 >= total) return false;
        int L = (int)L0; { const int q = total / 8, r = total % 8, xcd = L % 8, off = L / 8; L = (xcd < r ? xcd * (q + 1) : r * (q + 1) + (xcd - r) * q) + off; }
        const int tix = g8::uni(L >> 2), pn = g8::uni(L & 3);
        int e = (pre[32 + hint] <= tix) ? hint : 0; while (pre[32 + e + 1] <= tix) ++e;
        e = g8::uni(e); hint = e;
        u.e = e; u.cn = g8::uni(pre[e]); u.pm = g8::uni(tix - pre[32 + e]); u.pn = pn;
        u.A = (const char*)(ws + WS_ACT) + (size_t)tix * 256 * 1024 * 2;
        u.B = (const char*)(ws + WS_W2ET) + ((size_t)(l * 32 + e) * 1024 + (size_t)pn * 256) * 1024 * 2;
        return true;
    }
    __device__ __forceinline__ void rows(const g8::Unit&, int, int&) const {}
};
struct EpiG2 {
    static constexpr bool PERM = true;
    unsigned char* ws; const float* b2l;
    __device__ __forceinline__ void operator()(const f32x4 (&acc)[2][2][4][2], const g8::Unit& u, int wr, int wc, int fr, int fq) const {
        bfu* YB = (bfu*)(ws + WS_YB);
        const int* tl = (const int*)(ws + WS_TOKL) + (size_t)u.e * NT;
        const float* gl = (const float*)(ws + WS_GATEL) + (size_t)u.e * NT;
        const float* b2 = b2l + (size_t)u.e * 1024;
        const int col0 = u.pn * 256 + 32 * wc + 8 * fq;
        f32x4 bv[2][2];
#pragma unroll
        for (int bj = 0; bj < 2; ++bj)
#pragma unroll
            for (int n = 0; n < 2; ++n) bv[bj][n] = *(const f32x4*)(b2 + col0 + bj * 128 + n * 4);
        int ids[2][4]; float gts[2][4];
#pragma unroll
        for (int ai = 0; ai < 2; ++ai)
#pragma unroll
            for (int m = 0; m < 4; ++m) {
                int ri = u.pm * 256 + ai * 128 + wr * 64 + m * 16 + fr; ri = (ri < u.cn) ? ri : 0;
                ids[ai][m] = tl[ri]; gts[ai][m] = gl[ri];
            }
#pragma unroll
        for (int ai = 0; ai < 2; ++ai)
#pragma unroll
            for (int m = 0; m < 4; ++m) {
                const int ri = u.pm * 256 + ai * 128 + wr * 64 + m * 16 + fr;
                if (ri < u.cn) {
                    const float gate = gts[ai][m];
                    bfu* rp = YB + (size_t)ids[ai][m] * 1024 + col0;
#pragma unroll
                    for (int bj = 0; bj < 2; ++bj) {
                        const uint2 lo = pack4((acc[ai][bj][m][0] + bv[bj][0]) * gate), hi = pack4((acc[ai][bj][m][1] + bv[bj][1]) * gate);
                        *(uint4*)(rp + bj * 128) = make_uint4(lo.x, lo.y, hi.x, hi.y);
                    }
                }
            }
    }
};
__device__ __forceinline__ void expert_prefix8(const Args& a, int l, int* sm, int tid) {
    const int* cnt = (const int*)(wsp(a) + CNT_OFF) + l * 32;
    __syncthreads();
    if (tid == 0) {
        int tp = 0;
        for (int e = 0; e < 32; ++e) { const int cn = cnt[e]; sm[e] = cn; sm[32 + e] = tp; tp += (cn + 255) >> 8; }
        sm[64] = tp;
    }
    __syncthreads();
}
__device__ __forceinline__ void phase_gemm1_8(const Args& a, int l, char* smem, int tid, int bid, int nb) {
    int* pre = (int*)(smem + LDS_MAIN);
    expert_prefix8(a, l, pre, tid);
    SchedG1 S; S.ws = wsp(a); S.pre = pre; S.l = l; S.lda = 1024; S.ldb = 1024; S.G = nb; S.c = bid; S.hint = 0;
    EpiG1 E; E.ws = wsp(a); E.pre = pre; E.b1l = a.in[30] + (size_t)l * 32 * 2048;
    g8::gemm8((LAS unsigned char*)smem, S, E, 1024, tid);
}
__device__ __forceinline__ void phase_gemm2_8(const Args& a, int l, char* smem, int tid, int bid, int nb) {
    int* pre = (int*)(smem + LDS_MAIN);
    expert_prefix8(a, l, pre, tid);
    SchedG2 S; S.ws = wsp(a); S.pre = pre; S.l = l; S.lda = 1024; S.ldb = 1024; S.G = nb; S.c = bid; S.hint = 0;
    EpiG2 E; E.ws = wsp(a); E.b2l = a.in[32] + (size_t)l * 32 * 1024;
    g8::gemm8((LAS unsigned char*)smem, S, E, 1024, tid);
}

struct EpiS2 {
    static constexpr bool PERM = true;
    unsigned char* ws; const float* w0; const float* a0;
    __device__ __forceinline__ void operator()(const f32x4 (&acc)[2][2][4][2], const g8::Unit& u, int wr, int wc, int fr, int fq) const {
        const int kind = u.pn >> 1;
        const int col0 = (u.pn & 1) * 256 + 32 * wc + 8 * fq;
        bfu* dst; const float* bias = nullptr;
        if (kind < 2) { dst = (bfu*)(ws + WS_WDEC) + (size_t)kind * NT * 512; bias = w0 + kind * 512; }
        else if (kind < 4) { dst = (bfu*)(ws + WS_BV) + (size_t)(kind - 2) * NT * 512; bias = a0 + (kind - 2) * 512; }
        else dst = (bfu*)(ws + WS_GG);
        f32x4 bv[2][2];
#pragma unroll
        for (int bj = 0; bj < 2; ++bj)
#pragma unroll
            for (int n = 0; n < 2; ++n) bv[bj][n] = bias ? *(const f32x4*)(bias + col0 + bj * 128 + n * 4) : (f32x4){0.f, 0.f, 0.f, 0.f};
#pragma unroll
        for (int ai = 0; ai < 2; ++ai)
#pragma unroll
            for (int m = 0; m < 4; ++m) {
                bfu* d = dst + (size_t)(u.pm * 256 + ai * 128 + wr * 64 + m * 16 + fr) * 512 + col0;
#pragma unroll
                for (int bj = 0; bj < 2; ++bj) {
                    uint2 pk[2];
#pragma unroll
                    for (int n = 0; n < 2; ++n) {
                        f32x4 v = acc[ai][bj][m][n] + bv[bj][n];
                        if (kind < 2) { v[0] = ex2_(-0.87503925f * sigmoidf_(v[0])); v[1] = ex2_(-0.87503925f * sigmoidf_(v[1])); v[2] = ex2_(-0.87503925f * sigmoidf_(v[2])); v[3] = ex2_(-0.87503925f * sigmoidf_(v[3])); }
                        else if (kind < 4) { v[0] = sigmoidf_(v[0]); v[1] = sigmoidf_(v[1]); v[2] = sigmoidf_(v[2]); v[3] = sigmoidf_(v[3]); }
                        pk[n] = pack4(v);
                    }
                    *(uint4*)(d + bj * 128) = make_uint4(pk[0].x, pk[0].y, pk[1].x, pk[1].y);
                }
            }
    }
};
__device__ __forceinline__ void phase_stage2_8(const Args& a, int l, char* smem, int tid, int bid, int nb) {
    unsigned char* ws = wsp(a);
    {
        SchedDense S;
        S.A = (const char*)(ws + WS_LORA); S.B = (const char*)(ws + WS_S2T) + (size_t)l * 2560 * 512 * 2;
        S.lda = 512; S.ldb = 512; S.nM = 72; S.nN = 10; S.G = nb; S.c = bid; S.skip9 = 0;
        EpiS2 E; E.ws = ws; E.w0 = a.in[12] + l * 1024; E.a0 = a.in[15] + l * 1024;
        g8::gemm8((LAS unsigned char*)smem, S, E, 512, tid);
    }
    {
        const bfu* SB = (const bfu*)(ws + WS_SB);
        const bfu* SG = SB + (size_t)NT * 512;
        const bfu* SX = SG + (size_t)NT * 512;
        bfu* OSC = (bfu*)(ws + WS_ODA) + (size_t)NT * 512;
        const float* cw = a.in[11] + l * 3 * 512;
        for (int i = bid * NTHREADS + tid; i < NT * 64; i += nb * NTHREADS) {
            const int row = i >> 6, c8 = (i & 63) * 8;
            const int t = row % TB;
            if (l == 1 && t >= SEQ) continue;
            const bool hasp = (t != 0 && t != SEQ);
            const bool hasn = (t != SEQ - 1 && t != TB - 1);
            float u[3][8];
#pragma unroll
            for (int j = 0; j < 3; ++j) {
                const bool ok = (j == 1) || (j == 0 ? hasp : hasn);
                if (ok) {
                    const size_t o = (size_t)(row + j - 1) * 512 + c8;
                    const uint4 pg = *(const uint4*)(SG + o), px = *(const uint4*)(SX + o);
                    u[j][0] = bflo(pg.x) * bflo(px.x); u[j][1] = bfhi(pg.x) * bfhi(px.x);
                    u[j][2] = bflo(pg.y) * bflo(px.y); u[j][3] = bfhi(pg.y) * bfhi(px.y);
                    u[j][4] = bflo(pg.z) * bflo(px.z); u[j][5] = bfhi(pg.z) * bfhi(px.z);
                    u[j][6] = bflo(pg.w) * bflo(px.w); u[j][7] = bfhi(pg.w) * bfhi(px.w);
                } else {
#pragma unroll
                    for (int e = 0; e < 8; ++e) u[j][e] = 0.f;
                }
            }
            const uint4 pb = *(const uint4*)(SB + (size_t)row * 512 + c8);
            float sbv[8] = {bflo(pb.x), bfhi(pb.x), bflo(pb.y), bfhi(pb.y), bflo(pb.z), bfhi(pb.z), bflo(pb.w), bfhi(pb.w)};
            float o[8];
#pragma unroll
            for (int e = 0; e < 8; ++e)
                o[e] = sbv[e] * (cw[c8 + e] * u[0][e] + cw[512 + c8 + e] * u[1][e] + cw[1024 + c8 + e] * u[2][e]);
            uint4 po; po.x = pack2(o[0], o[1]); po.y = pack2(o[2], o[3]); po.z = pack2(o[4], o[5]); po.w = pack2(o[6], o[7]);
            *(uint4*)(OSC + (size_t)row * 512 + c8) = po;
        }
    }
}

struct EpiRouter {
    static constexpr bool PERM = true;
    unsigned char* ws; const float* bias;
    __device__ __forceinline__ void operator()(const f32x4 (&acc)[2][2][4][2], const g8::Unit& u, int wr, int wc, int fr, int fq) const {
        if (wc != 0) return;
        float* LG = (float*)(ws + WS_LOG);
#pragma unroll
        for (int n = 0; n < 2; ++n) {
            const f32x4 bv = *(const f32x4*)(bias + 8 * fq + 4 * n);
#pragma unroll
            for (int ai = 0; ai < 2; ++ai)
#pragma unroll
                for (int m = 0; m < 4; ++m) {
                    const size_t row = (size_t)(u.pm * 256 + ai * 128 + wr * 64 + m * 16 + fr);
                    *(f32x4*)(LG + row * 32 + 8 * fq + 4 * n) = acc[ai][0][m][n] + acc[ai][1][m][n] + bv;
                }
        }
    }
};
__device__ __forceinline__ void phase_router8(const Args& a, int l, char* smem, int tid, int bid, int nb) {
    SchedDense S;
    S.A = (const char*)(wsp(a) + WS_H2HI); S.B = (const char*)(wsp(a) + WS_RT) + (size_t)l * 256 * 2048 * 2;
    S.lda = 2048; S.ldb = 2048; S.nM = (l == 0) ? 72 : 64; S.nN = 1; S.G = nb; S.c = bid; S.skip9 = (l == 1);
    EpiRouter E; E.ws = wsp(a); E.bias = a.in[28] + l * 32;
    g8::gemm8((LAS unsigned char*)smem, S, E, 2048, tid);
}

constexpr int N_PHASES = 2 + 11 * NL;

__global__ void __launch_bounds__(NTHREADS, 2) fwd(Args a0) {
    extern __shared__ __attribute__((aligned(16))) char dyn_smem[];
    char* smem = dyn_smem + 16;
    const int tid = threadIdx.x, bid0 = blockIdx.x, nb0 = gridDim.x;
    const int wave_s = __builtin_amdgcn_readfirstlane(tid >> 6);
    const bool multi = (a0.ph_hi - a0.ph_lo) > 1;
    XcdBarrier bar;
    bar.bar = (unsigned*)(a0.ws + WS_CTL); bar.x = 0; bar.st = (volatile LAS unsigned*)dyn_smem;
    if (multi) {
        if (tid == 0) *(uint4*)dyn_smem = make_uint4(0u, 0u, 0u, 0u);
        __syncthreads();
        bar = xcd_barrier_post((unsigned*)(a0.ws + WS_CTL), (volatile LAS unsigned*)dyn_smem);
    }
#ifndef REP_MASK
#define REP_MASK 0u
#define REP_N 1
#endif
#ifndef PHASE_MASK
#define PHASE_MASK 0xFFFFFFFFu
#endif
#define RUN_PHASE(KIND, ID, CALL) do { if constexpr (((PHASE_MASK) >> (KIND)) & 1u) { const int _id = (ID); if (_id >= a0.ph_lo && _id < a0.ph_hi) { \
    for (int _r = 0; _r < ((((REP_MASK) >> (KIND)) & 1u) ? REP_N : 1); ++_r) { int tid = (wave_s << 6) | lane_id_(), bid = bid0, nb = nb0; const Args& a = a0; asm volatile("" : "+v"(tid), "+s"(bid), "+s"(nb)); CALL; } if (_id + 1 < a0.ph_hi) xcd_barrier(bar, wave_s); } } } while (0)
    RUN_PHASE(0, 0, phase_prep(a, smem, tid, bid, nb));
    RUN_PHASE(1, 1, phase_norm1_l0(a, tid, bid, nb));
    for (int l = 0; l < NL; ++l) {
        const int base = 2 + 11 * l;
        RUN_PHASE(2, base + 0, phase_gemm_in8(a, l, smem, tid, bid, nb));
        RUN_PHASE(3, base + 1, phase_stage2_8(a, l, smem, tid, bid, nb));
        RUN_PHASE(14, base + 2, phase_chunkpre(a, l, smem, tid, bid, nb));
        RUN_PHASE(4, base + 3, phase_mix(a, l, smem, tid, bid, nb));
        RUN_PHASE(5, base + 4, phase_post(a, l, tid, bid, nb));
        RUN_PHASE(6, base + 5, phase_merge8(a, l, smem, tid, bid, nb));
        RUN_PHASE(7, base + 6, phase_wout8(a, l, smem, tid, bid, nb));
        RUN_PHASE(8, base + 7, phase_n2rt(a, l, smem, tid, bid, nb));
        RUN_PHASE(11, base + 8, phase_gemm1_8(a, l, smem, tid, bid, nb));
        RUN_PHASE(12, base + 9, phase_gemm2_8(a, l, smem, tid, bid, nb));
        RUN_PHASE(13, base + 10, phase_combine(a, l, tid, bid, nb));
    }
}

extern "C" void kernel_launch(void* const* d_in, const int* in_sizes, int n_in,
                              void* d_out, int out_size, void* d_ws, size_t ws_size,
                              hipStream_t stream) {
    static int grid = 0;
    if (grid == 0) {
        if (n_in != 34 || ws_size < WS_END) { fprintf(stderr, "kernel_launch: bad inputs (n_in %d, ws %zu < %zu)\n", n_in, ws_size, (size_t)WS_END); grid = -1; return; }
        int dev = 0, cus = 0, per_cu = 0;
        hipGetDevice(&dev);
        hipDeviceGetAttribute(&cus, hipDeviceAttributeMultiprocessorCount, dev);
        if (hipFuncSetAttribute((const void*)fwd, hipFuncAttributeMaxDynamicSharedMemorySize, LDS_BYTES) != hipSuccess) { fprintf(stderr, "hipFuncSetAttribute failed\n"); grid = -1; return; }
        hipOccupancyMaxActiveBlocksPerMultiprocessor(&per_cu, (const void*)fwd, NTHREADS, LDS_BYTES);
        (void)hipGetLastError();
        if (per_cu < 1) per_cu = 1;
        grid = cus;
    }
    if (grid < 0) return;
    hipMemsetAsync((char*)d_ws + WS_CTL, 0, CTL_BYTES, stream);
    hipMemsetAsync((char*)d_ws + WS_S2T, 0, (size_t)2 * 2560 * 512 * 2, stream);
    Args a{};
    for (int i = 0; i < 34; ++i) a.in[i] = (const float*)d_in[i];
    a.out = (float*)d_out; a.ws = (unsigned char*)d_ws;
#if N_LAUNCH_MODE == 1
    a.ph_lo = 0; a.ph_hi = N_PHASES;
    hipLaunchKernelGGL(fwd, dim3(grid), dim3(NTHREADS), LDS_BYTES, stream, a);
#else
    for (int p = 0; p < N_PHASES; ++p) {
        a.ph_lo = p; a.ph_hi = p + 1;
        hipLaunchKernelGGL(fwd, dim3(grid), dim3(NTHREADS), LDS_BYTES, stream, a);
    }
#endif
}
```

```cpp
#include <hip/hip_runtime.h>
#include <stdint.h>
#include <stdio.h>

typedef unsigned short bfu;
using bf16x8 = __attribute__((ext_vector_type(8))) short;
using f32x4  = __attribute__((ext_vector_type(4))) float;

constexpr int NB = 8, SEQ = 2048, CTX = 256, TB = 2304, NT = NB * TB, DM = 1024, NL = 2;
constexpr int NEXP = 32;
constexpr int NTHREADS = 512;
constexpr int NW = NTHREADS / 64;
constexpr int LDS_MAIN = 131072;
constexpr int LDS_EXTRA = 4096;
constexpr int LDS_BYTES = LDS_MAIN + LDS_EXTRA + 16;

#ifndef N_LAUNCH_MODE
#define N_LAUNCH_MODE 1
#endif

constexpr size_t al(size_t x) { return (x + 255) & ~(size_t)255; }
constexpr size_t WS_CTL    = 0;
constexpr size_t CTL_BYTES = 32768;
constexpr size_t CNT_OFF   = 16384;
constexpr size_t WS_MOD    = WS_CTL + CTL_BYTES;
constexpr size_t WS_TAB    = al(WS_MOD + (size_t)2 * 9 * 6144 * 4);
constexpr size_t WS_WINT   = al(WS_TAB + 2 * 64 * 16 * 4 + 64);
constexpr size_t WS_S2T    = al(WS_WINT + (size_t)2 * 8192 * 1024 * 2);
constexpr size_t WS_WBT    = al(WS_S2T + (size_t)2 * 2560 * 512 * 2);
constexpr size_t WS_WOT    = al(WS_WBT + (size_t)2 * 3 * 1024 * 512 * 2);
constexpr size_t WS_RT     = al(WS_WOT + (size_t)2 * 1024 * 3072 * 2);
constexpr size_t WS_W1T    = al(WS_RT + (size_t)2 * 256 * 2048 * 2);
constexpr size_t WS_W2ET   = al(WS_W1T + (size_t)2 * 32 * 2048 * 1024 * 2);
constexpr size_t WS_XRES   = al(WS_W2ET + (size_t)2 * 32 * 1024 * 1024 * 2);
constexpr size_t WS_H      = al(WS_XRES + (size_t)NT * 1024 * 4);
constexpr size_t SZ512     = (size_t)NT * 512 * 2;
constexpr size_t WS_Q      = al(WS_H + (size_t)NT * 1024 * 2);
constexpr size_t WS_K      = al(WS_Q + SZ512);
constexpr size_t WS_VT     = al(WS_K + SZ512);
constexpr size_t WS_SB     = al(WS_VT + SZ512);
constexpr size_t WS_RR     = al(WS_SB + 3 * SZ512);
constexpr size_t WS_RK     = al(WS_RR + SZ512);
constexpr size_t WS_RV     = al(WS_RK + SZ512);
constexpr size_t WS_KKB    = al(WS_RV + SZ512);
constexpr size_t WS_GL     = al(WS_KKB + SZ512);
constexpr size_t WS_LORA   = al(WS_GL + (size_t)NT * 3072 * 2);
constexpr size_t WS_WDEC   = al(WS_LORA + SZ512);
constexpr size_t WS_BV     = al(WS_WDEC + 2 * SZ512);
constexpr size_t WS_KE     = al(WS_BV + 2 * SZ512);
constexpr size_t WS_GG     = al(WS_KE + 2 * SZ512);
constexpr size_t WS_Y      = al(WS_GG + SZ512);
constexpr size_t WS_ODA    = al(WS_Y + (size_t)2 * NT * 512 * 4);
constexpr size_t WS_MB     = al(WS_ODA + 3 * SZ512);
constexpr size_t WS_H2HI   = al(WS_MB + (size_t)NT * 1024 * 2);
constexpr size_t WS_H2LO   = al(WS_H2HI + (size_t)NT * 1024 * 2);
constexpr size_t WS_LOG    = al(WS_H2LO + (size_t)NT * 1024 * 2);
constexpr size_t WS_TOKL   = al(WS_LOG + (size_t)NT * 32 * 4);
constexpr size_t WS_GATE   = al(WS_TOKL + (size_t)32 * NT * 4);
constexpr size_t WS_GATEL  = al(WS_GATE + (size_t)NT * 4 * 4);
constexpr size_t WS_ACT    = al(WS_GATEL + (size_t)32 * NT * 4);
constexpr size_t WS_YB     = al(WS_ACT + (size_t)(NT * 4 + 8192) * 1024 * 2);
constexpr size_t WS_END    = al(WS_YB + (size_t)NT * 4 * 1024 * 2);

struct Args {
    const float* in[34];
    float* out;
    unsigned char* ws;
    int ph_lo, ph_hi;
};
#define GAS __attribute__((address_space(1)))
__device__ __forceinline__ unsigned char* wsp(const Args& a) {
    GAS unsigned char* p = (GAS unsigned char*)a.ws; asm volatile("" : "+s"(p)); return (unsigned char*)p; }


typedef __bf16 bf16x2_t __attribute__((ext_vector_type(2)));
typedef float f32x2_t __attribute__((ext_vector_type(2)));
typedef unsigned u32x2_t __attribute__((ext_vector_type(2)));
typedef unsigned u32x4_t __attribute__((ext_vector_type(4)));
__device__ __forceinline__ bfu f2bf(float f) { return __builtin_bit_cast(bfu, (__bf16)f); }
__device__ __forceinline__ float bf2f(bfu b) { return __uint_as_float(((unsigned)b) << 16); }
__device__ __forceinline__ unsigned pack2(float a, float b) { f32x2_t v = {a, b}; return __builtin_bit_cast(unsigned, __builtin_convertvector(v, bf16x2_t)); }
__device__ __forceinline__ float bflo(unsigned u) { return __uint_as_float(u << 16); }
__device__ __forceinline__ float bfhi(unsigned u) { return __uint_as_float(u & 0xFFFF0000u); }
__device__ __forceinline__ float sigmoidf_(float x) { return __builtin_amdgcn_rcpf(1.0f + __builtin_amdgcn_exp2f(-1.4426950408889634f * x)); }
__device__ __forceinline__ float tanhf_(float x) { const float e = __builtin_amdgcn_exp2f(2.8853900817779268f * x); return 1.0f - 2.0f * __builtin_amdgcn_rcpf(e + 1.0f); }
__device__ __forceinline__ int lane_id_() { int l; asm volatile("v_mbcnt_lo_u32_b32 %0, -1, 0\n\tv_mbcnt_hi_u32_b32 %0, -1, %0" : "=v"(l)); return l; }
__device__ __forceinline__ float shx_(float v, int m) { return __int_as_float(__builtin_amdgcn_ds_bpermute((lane_id_() ^ m) << 2, __float_as_int(v))); }
__device__ __forceinline__ float shf_(float v, int src) { return __int_as_float(__builtin_amdgcn_ds_bpermute(src << 2, __float_as_int(v))); }
__device__ __forceinline__ float wave_sum_shfl(float v) {
#pragma unroll
    for (int o = 32; o >= 1; o >>= 1) v += shx_(v, o);
    return v;
}
__device__ __forceinline__ float fmax3_(float a, float b, float c) { float r; asm("v_max3_f32 %0, %1, %2, %3" : "=v"(r) : "v"(a), "v"(b), "v"(c)); return r; }
__device__ __forceinline__ float ex2_(float x) { return __builtin_amdgcn_exp2f(x); }
template <int CTRL>
__device__ __forceinline__ float dppf(float x) {
    return __int_as_float(__builtin_amdgcn_update_dpp(0, __float_as_int(x), CTRL, 0xF, 0xF, true));
}
__device__ __forceinline__ float red16(float x) {
    x += dppf<0xB1>(x);
    x += dppf<0x4E>(x);
    x += dppf<0x124>(x);
    x += dppf<0x128>(x);
    return x;
}
__device__ __forceinline__ float wave_sum(float v) {
    v = red16(v);
    const float s0 = __int_as_float(__builtin_amdgcn_readlane(__float_as_int(v), 0)), s1 = __int_as_float(__builtin_amdgcn_readlane(__float_as_int(v), 16));
    const float s2 = __int_as_float(__builtin_amdgcn_readlane(__float_as_int(v), 32)), s3 = __int_as_float(__builtin_amdgcn_readlane(__float_as_int(v), 48));
    return (s0 + s1) + (s2 + s3);
}

#define XB_TMO      128
#define XB_XCNT(j)  (256  + 64 * (j))
#define XB_XSUB(j)  (1280 + 64 * (j))
#define XB_XGEN(j)  (2304 + 64 * (j))
#define XB_TOP      3328
#define XB_TOPGEN   3392
#define XCD_BAR_WORDS 3456
#define XB_SPIN_CAP (1u << 22)
#define LAS __attribute__((address_space(3)))

__device__ __forceinline__ unsigned xb_ld(unsigned* p)              { return __hip_atomic_load(p, __ATOMIC_RELAXED, __HIP_MEMORY_SCOPE_AGENT); }
__device__ __forceinline__ unsigned xb_add(unsigned* p, unsigned v) { return __hip_atomic_fetch_add(p, v, __ATOMIC_RELAXED, __HIP_MEMORY_SCOPE_AGENT); }
__device__ __forceinline__ unsigned xb_xcc_id() { return (unsigned)__builtin_amdgcn_s_getreg((3 << 11) | 20) & 0xFu; }
#define XB_SPIN(cond, bar) do { unsigned _sp = 0; while (cond) { __builtin_amdgcn_s_sleep(1); \
    if ((++_sp & 255u) == 0u) { if (xb_ld(&(bar)[XB_TMO])) break; if (_sp > XB_SPIN_CAP) { atomicAdd(&(bar)[XB_TMO], 1u); break; } } } } while (0)

struct XcdBarrier { unsigned* bar; unsigned x; volatile LAS unsigned* st; };

__device__ __forceinline__ XcdBarrier xcd_barrier_post(unsigned* bar, volatile LAS unsigned* st) {
    XcdBarrier b; b.bar = bar; b.x = xb_xcc_id(); b.st = st;
    if (threadIdx.x == 0) (void)xb_add(&bar[XB_XCNT(b.x)], 1u);
    return b;
}
__device__ __forceinline__ void xcd_barrier_complete(unsigned* bar, unsigned x, unsigned& nloc, unsigned& nx) {
    const unsigned G = gridDim.x * gridDim.y * gridDim.z;
    unsigned sum, cnt, mine, sp = 0u;
    for (;;) {
        sum = 0u; cnt = 0u; mine = 0u;
#pragma unroll
        for (unsigned j = 0; j < 16; ++j) { const unsigned c = xb_ld(&bar[XB_XCNT(j)]); sum += c; cnt += (c > 0u) ? 1u : 0u; mine = (j == x) ? c : mine; }
        if (sum == G) break;
        __builtin_amdgcn_s_sleep(1);
        if ((++sp & 255u) == 0u) { if (xb_ld(&bar[XB_TMO])) break; if (sp > XB_SPIN_CAP) { atomicAdd(&bar[XB_TMO], 1u); break; } }
    }
    nloc = mine > 0u ? mine : 1u; nx = cnt > 0u ? cnt : 1u;
}
__device__ __forceinline__ void xcd_barrier(const XcdBarrier& b, int wave_s) {
    asm volatile("s_waitcnt vmcnt(0)" ::: "memory");
    __syncthreads();
    if (wave_s == 0 && lane_id_() == 0) {
        unsigned* bar = b.bar;
        __builtin_amdgcn_s_waitcnt(0);
        unsigned nloc = b.st[0], nx = b.st[1];
        if (nloc == 0u) { xcd_barrier_complete(bar, b.x, nloc, nx); b.st[0] = nloc; b.st[1] = nx; }
        const unsigned old = xb_add(&bar[XB_XSUB(b.x)], 1u);
        const unsigned gen = old / nloc;
        if (old + 1u == (gen + 1u) * nloc) {
            __builtin_amdgcn_fence(__ATOMIC_RELEASE, "agent");
            asm volatile("s_waitcnt vmcnt(0)" ::: "memory");
            const unsigned og = xb_add(&bar[XB_TOP], 1u);
            const unsigned tg = og / nx;
            if (og + 1u == (tg + 1u) * nx) xb_add(&bar[XB_TOPGEN], 1u);
            else XB_SPIN(xb_ld(&bar[XB_TOPGEN]) == tg, bar);
            __builtin_amdgcn_fence(__ATOMIC_ACQUIRE, "agent");
            xb_add(&bar[XB_XGEN(b.x)], 1u);
            asm volatile("s_waitcnt vmcnt(0)" ::: "memory");
        } else {
            XB_SPIN(xb_ld(&bar[XB_XGEN(b.x)]) == gen, bar);
            __builtin_amdgcn_fence(__ATOMIC_ACQUIRE, "agent");
            asm volatile("s_waitcnt vmcnt(0)" ::: "memory");
        }
    }
    __syncthreads();
}

constexpr int LROW = 144;
constexpr int LTILE = 256 * LROW;
constexpr int LTILEB = 128 * LROW;

template <int NI>
__device__ __forceinline__ void gemm_loop(f32x4 (&acc)[4][NI], const bfu* __restrict__ A, int lda, const int (&arow)[4],
                                          const bfu* __restrict__ Bt, int ldb, int n0, int K, char* smem, int tid) {
    const int kc = tid & 7, tr = tid >> 3;
    const int wave = tid >> 6, lane = tid & 63, wm = wave >> 1, wn = wave & 1, g = lane >> 4, c = lane & 15;
    const bfu* pa0 = A + (size_t)arow[0] * lda + kc * 8;
    const bfu* pa1 = A + (size_t)arow[1] * lda + kc * 8;
    const bfu* pa2 = A + (size_t)arow[2] * lda + kc * 8;
    const bfu* pa3 = A + (size_t)arow[3] * lda + kc * 8;
    const bfu* pb0 = Bt + (size_t)(n0 + tr) * ldb + kc * 8;
    const bfu* pb1 = Bt + (size_t)(n0 + tr + ((NI == 4) ? 64 : 0)) * ldb + kc * 8;
    const int wofs = tr * LROW + kc * 16;
    const int aofs = (wm * 64 + c) * LROW + g * 16;
    const int bofs = (wn * (16 * NI) + c) * LROW + g * 16;
    const int nk = K >> 6;
    uint4 ra0 = *(const uint4*)pa0, ra1 = *(const uint4*)pa1, ra2 = *(const uint4*)pa2, ra3 = *(const uint4*)pa3;
    uint4 rb0 = *(const uint4*)pb0, rb1 = *(const uint4*)pb1;
    *(uint4*)(smem + wofs) = ra0; *(uint4*)(smem + wofs + 64 * LROW) = ra1; *(uint4*)(smem + wofs + 128 * LROW) = ra2; *(uint4*)(smem + wofs + 192 * LROW) = ra3;
    *(uint4*)(smem + 2 * LTILE + wofs) = rb0;
    if (NI == 4) *(uint4*)(smem + 2 * LTILE + wofs + 64 * LROW) = rb1;
    __syncthreads();
    for (int kt = 0; kt < nk; ++kt) {
        const int cur = kt & 1;
        const bool more = (kt + 1 < nk);
        if (more) {
            const size_t ko = (size_t)(kt + 1) * 64;
            ra0 = *(const uint4*)(pa0 + ko); ra1 = *(const uint4*)(pa1 + ko); ra2 = *(const uint4*)(pa2 + ko); ra3 = *(const uint4*)(pa3 + ko);
            rb0 = *(const uint4*)(pb0 + ko); rb1 = *(const uint4*)(pb1 + ko);
        }
        const char* As = smem + cur * LTILE;
        const char* Bs = smem + 2 * LTILE + cur * LTILEB;
#pragma unroll
        for (int ks = 0; ks < 2; ++ks) {
            bf16x8 af[4], bq[NI];
#pragma unroll
            for (int mi = 0; mi < 4; ++mi) af[mi] = *(const bf16x8*)(As + aofs + mi * 16 * LROW + ks * 64);
#pragma unroll
            for (int ni = 0; ni < NI; ++ni) bq[ni] = *(const bf16x8*)(Bs + bofs + ni * 16 * LROW + ks * 64);
#pragma unroll
            for (int mi = 0; mi < 4; ++mi)
#pragma unroll
                for (int ni = 0; ni < NI; ++ni)
                    acc[mi][ni] = __builtin_amdgcn_mfma_f32_16x16x32_bf16(af[mi], bq[ni], acc[mi][ni], 0, 0, 0);
        }
        if (more) {
            char* Aw = smem + (cur ^ 1) * LTILE;
            char* Bw = smem + 2 * LTILE + (cur ^ 1) * LTILEB;
            *(uint4*)(Aw + wofs) = ra0; *(uint4*)(Aw + wofs + 64 * LROW) = ra1; *(uint4*)(Aw + wofs + 128 * LROW) = ra2; *(uint4*)(Aw + wofs + 192 * LROW) = ra3;
            *(uint4*)(Bw + wofs) = rb0;
            if (NI == 4) *(uint4*)(Bw + wofs + 64 * LROW) = rb1;
        }
        __syncthreads();
    }
}
template <int NI>
__device__ __forceinline__ void zero_acc(f32x4 (&acc)[4][NI]) {
#pragma unroll
    for (int mi = 0; mi < 4; ++mi)
#pragma unroll
        for (int ni = 0; ni < NI; ++ni) acc[mi][ni] = (f32x4){0.f, 0.f, 0.f, 0.f};
}
__device__ __forceinline__ void ident_rows(int (&arow)[4], int m0, int tid) {
#pragma unroll
    for (int i = 0; i < 4; ++i) arow[i] = m0 + (tid >> 3) + 64 * i;
}

namespace g8 {
constexpr int BM = 256, BK = 64, HALF = 128, HTB = HALF * BK * 2, STAGE_BYTES = 8 * HTB, NXCD = 8, WGM = 8;
__device__ __forceinline__ int lds_byte(int r, int c) { const int st = (r >> 4) * 2 + (c >> 5), rr = r & 15, cc = c & 31, ob = rr * 64 + cc * 2; return st * 1024 + (ob ^ (((ob >> 9) & 1) << 5)); }
__device__ __forceinline__ void stage_rc(int b, int& R, int& C) { const int st = b / 1024, sb = b % 1024, swz = sb ^ (((sb >> 9) & 1) << 5); R = (st >> 1) * 16 + swz / 64; C = (st & 1) * 32 + (swz % 64) / 2; }
__device__ __forceinline__ int perm32(int rho) { const int n = rho >> 4, i = rho & 15; return 8 * (i >> 2) + 4 * n + (i & 3); }

struct Unit { const char* A; const char* B; int pm, pn, e, cn; };
__device__ __forceinline__ int uni(int v) { return __builtin_amdgcn_readfirstlane(v); }

__device__ __forceinline__ bool static_tile(int i, int G, int c, int nM, int nN, int& pm, int& pn) {
    const int nwg = nM * nN;
    const long L = (long)i * G + c; if (L >= nwg) return false;
    int wgid = (int)L; { const int q = nwg / NXCD, r = nwg % NXCD, xcd = wgid % NXCD, off = wgid / NXCD; wgid = (xcd < r ? xcd * (q + 1) : r * (q + 1) + (xcd - r) * q) + off; }
    const int nig = WGM * nN, gid = wgid / nig, fm = gid * WGM, gsz = (nM - fm) < WGM ? (nM - fm) : WGM;
    pm = fm + ((wgid % nig) % gsz); pn = (wgid % nig) / gsz; return true;
}

template <class Epi, class Sched>
__device__ __forceinline__ void gemm8(LAS unsigned char* lds, const Sched& S, const Epi& E, int K, int tid) {
    const int wid = __builtin_amdgcn_readfirstlane(tid >> 6), lane = tid & 63, wr = wid >> 2, wc = wid & 3, fr = lane & 15, fq = lane >> 4;
    const int nt = K / BK;
    unsigned voffB[2];
#pragma unroll
    for (int i = 0; i < 2; ++i) { int R_, C_; stage_rc(tid * 16 + i * 8192, R_, C_); const int Rb = Epi::PERM ? ((R_ & ~31) + perm32(R_ & 31)) : R_;
        voffB[i] = (unsigned)(Rb * S.ldb + C_) * 2u; }
    const size_t kstep = (size_t)(BK * 2);
    const size_t hstepB = (size_t)HALF * S.ldb * 2;
    const unsigned ldsw = (unsigned)wid * 1024u;
    const int aoff = lds_byte(wr * 64 + fr, fq * 8), boff = lds_byte(wc * 32 + fr, fq * 8);
#define G8_SA(b, h) (((b) * 2 + (h)) * HTB)
#define G8_SB(b, h) ((4 + (b) * 2 + (h)) * HTB)
#define G8_STAGEB(bufoff, gbase) do { _Pragma("unroll") for (int _i = 0; _i < 2; ++_i) { unsigned _o = voffB[_i]; asm volatile("" : "+v"(_o)); \
        __builtin_amdgcn_global_load_lds((const unsigned*)((const char*)(gbase) + _o), (LAS unsigned*)(lds + (bufoff) + ldsw + _i * 8192), 16, 0, 0); } } while (0)
#define G8_STAGEA(bufoff, gbase, VA, h) do { _Pragma("unroll") for (int _i = 0; _i < 2; ++_i) { unsigned _o = (VA)[h][_i]; asm volatile("" : "+v"(_o)); \
        __builtin_amdgcn_global_load_lds((const unsigned*)((const char*)(gbase) + _o), (LAS unsigned*)(lds + (bufoff) + ldsw + _i * 8192), 16, 0, 0); } } while (0)
#define G8_LDA(dst, b, h) do { _Pragma("unroll") for (int m = 0; m < 4; ++m) _Pragma("unroll") for (int k = 0; k < 2; ++k) dst[m][k] = *(const LAS bf16x8*)(lds + G8_SA(b, h) + aoff + m * 2048 + k * 1024); } while (0)
#define G8_LDB(dst, b, h) do { _Pragma("unroll") for (int n = 0; n < 2; ++n) _Pragma("unroll") for (int k = 0; k < 2; ++k) dst[n][k] = *(const LAS bf16x8*)(lds + G8_SB(b, h) + boff + n * 2048 + k * 1024); } while (0)
#define G8_MMA(ai, bj, At, Bt) do { __builtin_amdgcn_s_setprio(1); _Pragma("unroll") for (int m = 0; m < 4; ++m) _Pragma("unroll") for (int n = 0; n < 2; ++n) _Pragma("unroll") for (int k = 0; k < 2; ++k) \
        acc[ai][bj][m][n] = __builtin_amdgcn_mfma_f32_16x16x32_bf16(Bt[n][k], At[m][k], acc[ai][bj][m][n], 0, 0, 0); __builtin_amdgcn_s_setprio(0); } while (0)
#define G8_WAIT_V(n) asm volatile("s_waitcnt vmcnt(" #n ")" ::: "memory")
#define G8_WAIT_L(n) asm volatile("s_waitcnt lgkmcnt(" #n ")" ::: "memory")
#define G8_BAR __builtin_amdgcn_s_barrier()
#define G8_SCHED __builtin_amdgcn_sched_barrier(0)
#define G8_VOFF(VA, U) do { _Pragma("unroll") for (int _i = 0; _i < 2; ++_i) { int _R, _C; stage_rc(tid * 16 + _i * 8192, _R, _C); _Pragma("unroll") for (int _h = 0; _h < 2; ++_h) { \
        int _row = _R + _h * HALF; if (Sched::GATHER) S.rows(U, _row, _row); VA[_h][_i] = (unsigned)(_row * S.lda + _C) * 2u; } } } while (0)
    Unit cur, nxt; int ui = 0;
    if (!S.next(0, cur)) return;
    f32x4 acc[2][2][4][2];
#pragma unroll
    for (int a = 0; a < 2; ++a)
#pragma unroll
        for (int b = 0; b < 2; ++b)
#pragma unroll
            for (int m = 0; m < 4; ++m)
#pragma unroll
                for (int n = 0; n < 2; ++n) acc[a][b][m][n] = (f32x4){0.f, 0.f, 0.f, 0.f};
    bf16x8 At[4][2], B0[2][2], B1[2][2];
    unsigned cva[2][2], nva[2][2]; int nidx[2][2];
    G8_VOFF(cva, cur);
    const char* cA = cur.A; const char* cB = cur.B;
    G8_STAGEB(G8_SB(0, 0), cB); G8_STAGEA(G8_SA(0, 0), cA, cva, 0); G8_STAGEB(G8_SB(0, 1), cB + hstepB); G8_STAGEA(G8_SA(0, 1), cA, cva, 1);
    if (wr == 1) G8_BAR;
    G8_WAIT_V(4); G8_BAR;
    G8_STAGEB(G8_SB(1, 0), cB + kstep); G8_STAGEA(G8_SA(1, 0), cA + kstep, cva, 0); G8_STAGEB(G8_SB(1, 1), cB + hstepB + kstep);
    G8_WAIT_V(6); G8_BAR;
    for (;;) {
        const bool has_next = S.next(ui + 1, nxt);
        const char* nA = has_next ? nxt.A : cA; const char* nB = has_next ? nxt.B : cB;
        if constexpr (Sched::GATHER) {
            if (has_next) {
#pragma unroll
                for (int _i = 0; _i < 2; ++_i) { int _R, _C; stage_rc(tid * 16 + _i * 8192, _R, _C);
#pragma unroll
                    for (int _h = 0; _h < 2; ++_h) { int _row = _R + _h * HALF; S.rows(nxt, _row, _row); nidx[_h][_i] = _row; } }
            }
        }
        for (int t = 0; t < nt; t += 2) {
            const bool last = (t == nt - 2);
            const char* a1 = cA + (size_t)(t + 1) * kstep;
            const char* a2 = last ? nA : cA + (size_t)(t + 2) * kstep; const char* b2 = last ? nB : cB + (size_t)(t + 2) * kstep;
            const char* a3 = a2 + kstep; const char* b3 = b2 + kstep;
            if constexpr (Sched::GATHER) {
                if (last && has_next) {
#pragma unroll
                    for (int _i = 0; _i < 2; ++_i) { int _R, _C; stage_rc(tid * 16 + _i * 8192, _R, _C);
#pragma unroll
                        for (int _h = 0; _h < 2; ++_h) nva[_h][_i] = (unsigned)(nidx[_h][_i] * S.lda + _C) * 2u; }
                }
            }
            const bool use_n = Sched::GATHER && last && has_next;
            G8_LDB(B0, 0, 0); G8_SCHED; G8_LDA(At, 0, 0); G8_STAGEA(G8_SA(1, 1), a1, cva, 1);
            G8_WAIT_L(8); G8_BAR; G8_WAIT_L(0); G8_MMA(0, 0, At, B0); G8_BAR; G8_SCHED;
            G8_LDB(B1, 0, 1); G8_STAGEB(G8_SB(0, 0), b2);
            G8_BAR; G8_WAIT_L(0); G8_MMA(0, 1, At, B1); G8_BAR;
            G8_LDA(At, 0, 1); if (use_n) { G8_STAGEA(G8_SA(0, 0), a2, nva, 0); } else { G8_STAGEA(G8_SA(0, 0), a2, cva, 0); }
            G8_BAR; G8_WAIT_L(0); G8_MMA(1, 0, At, B0); G8_BAR; G8_SCHED;
            G8_STAGEB(G8_SB(0, 1), b2 + hstepB);
            G8_WAIT_V(6); G8_BAR; G8_MMA(1, 1, At, B1); G8_BAR;
            G8_LDB(B0, 1, 0); G8_SCHED; G8_LDA(At, 1, 0); if (use_n) { G8_STAGEA(G8_SA(0, 1), a2, nva, 1); } else { G8_STAGEA(G8_SA(0, 1), a2, cva, 1); }
            G8_WAIT_L(8); G8_BAR; G8_WAIT_L(0); G8_MMA(0, 0, At, B0); G8_BAR; G8_SCHED;
            G8_LDB(B1, 1, 1); G8_STAGEB(G8_SB(1, 0), b3);
            G8_BAR; G8_WAIT_L(0); G8_MMA(0, 1, At, B1); G8_BAR;
            G8_LDA(At, 1, 1); if (use_n) { G8_STAGEA(G8_SA(1, 0), a3, nva, 0); } else { G8_STAGEA(G8_SA(1, 0), a3, cva, 0); }
            G8_BAR; G8_WAIT_L(0); G8_MMA(1, 0, At, B0); G8_BAR; G8_SCHED;
            G8_STAGEB(G8_SB(1, 1), b3 + hstepB);
            G8_WAIT_V(6); G8_BAR; G8_MMA(1, 1, At, B1); G8_BAR;
        }
        E(acc, cur, wr, wc, fr, fq);
        if (!has_next) break;
#pragma unroll
        for (int a = 0; a < 2; ++a)
#pragma unroll
            for (int b = 0; b < 2; ++b)
#pragma unroll
                for (int m = 0; m < 4; ++m)
#pragma unroll
                    for (int n = 0; n < 2; ++n) acc[a][b][m][n] = (f32x4){0.f, 0.f, 0.f, 0.f};
        cur = nxt; cA = nA; cB = nB; ++ui;
        if constexpr (Sched::GATHER) {
#pragma unroll
            for (int _h = 0; _h < 2; ++_h) { cva[_h][0] = nva[_h][0]; cva[_h][1] = nva[_h][1]; }
        }
    }
    G8_WAIT_V(0);
    if (wr == 0) G8_BAR;
    G8_BAR;
#undef G8_SA
#undef G8_SB
#undef G8_STAGEA
#undef G8_STAGEB
#undef G8_LDA
#undef G8_LDB
#undef G8_MMA
#undef G8_WAIT_V
#undef G8_WAIT_L
#undef G8_BAR
#undef G8_SCHED
#undef G8_VOFF
}
}

struct TJob { const float* src; bfu* dst; bfu* dst2; int K, N, lds, ldd, Kd, Nd, mode; };

__device__ __forceinline__ void tr_tile(const TJob& jb, int tk, int tn, char* smem, int tid) {
    float* tile = (float*)smem;
    const int k0 = tk * 64, n0 = tn * 64;
    __syncthreads();
#pragma unroll
    for (int i = 0; i < 8; ++i) {
        const int kk = (tid >> 6) + 8 * i, nn = tid & 63;
        const int k = k0 + kk, n = n0 + nn;
        int ns = n;
        if (jb.mode == 1) { const int G = n >> 5, hh = (n >> 4) & 1, ii = n & 15; ns = hh * 1024 + G * 16 + ii; }
        float v = 0.f;
        if (k < jb.K && n < jb.N) v = jb.src[(size_t)k * jb.lds + ns];
        tile[kk * 65 + nn] = v;
    }
    __syncthreads();
#pragma unroll
    for (int i = 0; i < 8; ++i) {
        const int nn = (tid >> 6) + 8 * i, kk = tid & 63;
        const float v = tile[kk * 65 + nn];
        const size_t o = (size_t)(n0 + nn) * jb.ldd + k0 + kk;
        const bfu hi = f2bf(v);
        if (jb.mode == 2) { if (n0 + nn < jb.N) { jb.dst[o] = hi; jb.dst[o + 1024] = hi; jb.dst2[o] = f2bf(v - bf2f(hi)); } }
        else jb.dst[o] = hi;
    }
}

__device__ __forceinline__ void tr_tile256(const float* __restrict__ src, int lds, bfu* __restrict__ dst, int ldd, int mode, int tk, int tn, char* smem, int tid) {
    float* tile = (float*)smem;
    const int k0 = tk * 64, n0 = tn * 256;
    __syncthreads();
    float4 v[8];
#pragma unroll
    for (int i = 0; i < 8; ++i) {
        const int kk = (tid >> 6) + 8 * i, c4 = (tid & 63) * 4;
        int ns = n0 + c4;
        if (mode == 1) { const int n = n0 + c4; ns = ((n >> 4) & 1) * 1024 + (n >> 5) * 16 + (n & 15); }
        v[i] = *(const float4*)(src + (size_t)(k0 + kk) * lds + ns);
    }
#pragma unroll
    for (int i = 0; i < 8; ++i) {
        const int kk = (tid >> 6) + 8 * i, c4 = (tid & 63) * 4;
        float* t = tile + kk * 257 + c4;
        t[0] = v[i].x; t[1] = v[i].y; t[2] = v[i].z; t[3] = v[i].w;
    }
    __syncthreads();
#pragma unroll
    for (int i = 0; i < 4; ++i) {
        const int nn = (tid >> 3) + 64 * i, k8 = (tid & 7) * 8;
        const float* t = tile + k8 * 257 + nn;
        uint4 p;
        p.x = pack2(t[0], t[257]); p.y = pack2(t[2 * 257], t[3 * 257]); p.z = pack2(t[4 * 257], t[5 * 257]); p.w = pack2(t[6 * 257], t[7 * 257]);
        *(uint4*)(dst + (size_t)(n0 + nn) * ldd + k0 + k8) = p;
    }
}

__device__ __forceinline__ void misc_job(const Args& a, int j, TJob& jb) {
    const int l = j / 16, q = j % 16;
    unsigned char* ws = wsp(a);
    jb.dst2 = nullptr; jb.mode = 0;
    bfu* wint = (bfu*)(ws + WS_WINT) + (size_t)l * 8192 * 1024;
    if (q == 0) { jb.src = a.in[8] + (size_t)l * 1024 * 7680; jb.K = 1024; jb.N = 7680; jb.lds = 7680; jb.dst = wint; jb.ldd = 1024; jb.Kd = 1024; jb.Nd = 7680; }
    else if (q <= 2) { const int d = q - 1; jb.src = a.in[13] + (size_t)(l * 2 + d) * 1024 * 64; jb.K = 1024; jb.N = 64; jb.lds = 64; jb.dst = wint + (size_t)(7680 + 64 * d) * 1024; jb.ldd = 1024; jb.Kd = 1024; jb.Nd = 64; }
    else if (q <= 4) { const int d = q - 3; jb.src = a.in[16] + (size_t)(l * 2 + d) * 1024 * 64; jb.K = 1024; jb.N = 64; jb.lds = 64; jb.dst = wint + (size_t)(7808 + 64 * d) * 1024; jb.ldd = 1024; jb.Kd = 1024; jb.Nd = 64; }
    else if (q == 5) { jb.src = a.in[18] + (size_t)l * 1024 * 160; jb.K = 1024; jb.N = 160; jb.lds = 160; jb.dst = wint + (size_t)7936 * 1024; jb.ldd = 1024; jb.Kd = 1024; jb.Nd = 256; }
    else if (q <= 7) { const int d = q - 6; jb.src = a.in[14] + (size_t)(l * 2 + d) * 64 * 512; jb.K = 64; jb.N = 512; jb.lds = 512; jb.dst = (bfu*)(ws + WS_S2T) + (size_t)l * 2560 * 512 + (size_t)(512 * d) * 512 + 64 * d; jb.ldd = 512; jb.Kd = 64; jb.Nd = 512; }
    else if (q <= 9) { const int d = q - 8; jb.src = a.in[17] + (size_t)(l * 2 + d) * 64 * 512; jb.K = 64; jb.N = 512; jb.lds = 512; jb.dst = (bfu*)(ws + WS_S2T) + (size_t)l * 2560 * 512 + (size_t)(1024 + 512 * d) * 512 + 128 + 64 * d; jb.ldd = 512; jb.Kd = 64; jb.Nd = 512; }
    else if (q == 10) { jb.src = a.in[19] + (size_t)l * 160 * 512; jb.K = 160; jb.N = 512; jb.lds = 512; jb.dst = (bfu*)(ws + WS_S2T) + (size_t)l * 2560 * 512 + (size_t)2048 * 512 + 256; jb.ldd = 512; jb.Kd = 192; jb.Nd = 512; }
    else if (q <= 13) { const int n = q - 11; jb.src = a.in[25] + (size_t)(l * 3 + n) * 512 * 1024; jb.K = 512; jb.N = 1024; jb.lds = 1024; jb.dst = (bfu*)(ws + WS_WBT) + (size_t)(l * 3 + n) * 1024 * 512; jb.ldd = 512; jb.Kd = 512; jb.Nd = 1024; }
    else if (q == 14) { jb.src = a.in[26] + (size_t)l * 1024 * 1024; jb.K = 1024; jb.N = 1024; jb.lds = 1024; jb.dst = (bfu*)(ws + WS_WOT) + (size_t)l * 1024 * 1024; jb.ldd = 1024; jb.Kd = 1024; jb.Nd = 1024; }
    else { jb.src = a.in[27] + (size_t)l * 1024 * 32; jb.K = 1024; jb.N = 32; jb.lds = 32; jb.dst = (bfu*)(ws + WS_RT) + (size_t)l * 256 * 2048; jb.dst2 = jb.dst + (size_t)128 * 2048; jb.ldd = 2048; jb.Kd = 1024; jb.Nd = 64; jb.mode = 2; }
}

__device__ __forceinline__ void phase_prep(const Args& a, char* smem, int tid, int bid, int nb) {
    unsigned char* ws = wsp(a);
    for (int it = bid + 12288; it < 12288 + 1280; it += nb) {
        if (it < 12288) {
            const int le = it / 192, r = it % 192;
            if (r < 128) tr_tile256(a.in[29] + (size_t)le * 1024 * 2048, 2048, (bfu*)(ws + WS_W1T) + (size_t)le * 2048 * 1024, 1024, 1, r >> 3, r & 7, smem, tid);
            else { const int r2 = r - 128; tr_tile256(a.in[31] + (size_t)le * 1024 * 1024, 1024, (bfu*)(ws + WS_W2ET) + (size_t)le * 1024 * 1024, 1024, 0, r2 >> 2, r2 & 3, smem, tid); }
        } else {
            const int j = it - 12288, l = j / 640, r = j % 640;
            if (r < 480) tr_tile256(a.in[8] + (size_t)l * 1024 * 7680, 7680, (bfu*)(ws + WS_WINT) + (size_t)l * 8192 * 1024, 1024, 0, r / 30, r % 30, smem, tid);
            else if (r < 576) { const int r2 = r - 480, n = r2 >> 5, q = r2 & 31; tr_tile256(a.in[25] + (size_t)(l * 3 + n) * 512 * 1024, 1024, (bfu*)(ws + WS_WBT) + (size_t)(l * 3 + n) * 1024 * 512, 512, 0, q >> 2, q & 3, smem, tid); }
            else { const int r2 = r - 576;
                for (int cpy = 0; cpy < 1; ++cpy) tr_tile256(a.in[26] + (size_t)l * 1024 * 1024, 1024, (bfu*)(ws + WS_WOT) + (size_t)l * 1024 * 3072 + cpy * 1024, 3072, 0, r2 >> 2, r2 & 3, smem, tid); }
        }
    }
    {
        int base = 0;
        for (int j = 0; j < 32; ++j) {
            TJob jb; misc_job(a, j, jb);
            const int q_ = j % 16;
            const bool fastdone = (q_ == 0) || (q_ >= 11 && q_ <= 15);
            const int tks = jb.Kd >> 6, tns = jb.Nd >> 6, nt = fastdone ? 0 : tks * tns;
            int first = ((bid - base) % nb + nb) % nb;
            for (int t = first; t < nt; t += nb) tr_tile(jb, t / tns, t % tns, smem, tid);
            base = (base + nt) % nb;
        }
    }
    __syncthreads();
    for (int it = bid; it < 192; it += nb) {
        const int l = it / 96, jb0 = (it % 96) * 64;
        float* sl = (float*)smem;
        float* red = (float*)(smem + 36864);
        __syncthreads();
        for (int i = tid; i < 9 * 1024; i += NTHREADS) {
            const int m = i >> 10, k = i & 1023;
            const float v = (m < 8) ? a.in[1][m * 1024 + k] : a.in[3][k];
            sl[i] = v / (1.0f + __expf(-v));
        }
        __syncthreads();
        const int kq = tid >> 4, jv = tid & 15;
        float acc[9][4];
#pragma unroll
        for (int m = 0; m < 9; ++m) { acc[m][0] = 0.f; acc[m][1] = 0.f; acc[m][2] = 0.f; acc[m][3] = 0.f; }
        const float* wm = a.in[4] + (size_t)l * 1024 * 6144 + jb0 + jv * 4;
#pragma unroll 4
        for (int kk = 0; kk < 32; ++kk) {
            const int k = kq * 32 + kk;
            const float4 w = *(const float4*)(wm + (size_t)k * 6144);
#pragma unroll
            for (int m = 0; m < 9; ++m) {
                const float s = sl[m * 1024 + k];
                acc[m][0] += s * w.x; acc[m][1] += s * w.y; acc[m][2] += s * w.z; acc[m][3] += s * w.w;
            }
        }
#pragma unroll
        for (int m = 0; m < 9; ++m)
#pragma unroll
            for (int e = 0; e < 4; ++e) red[(kq * 9 + m) * 64 + jv * 4 + e] = acc[m][e];
        __syncthreads();
        for (int i = tid; i < 9 * 64; i += NTHREADS) {
            const int m = i >> 6, jj = i & 63;
            float s = 0.f;
#pragma unroll
            for (int q = 0; q < 32; ++q) s += red[(q * 9 + m) * 64 + jj];
            ((float*)(ws + WS_MOD))[(size_t)(l * 9 + m) * 6144 + jb0 + jj] = s + a.in[5][l * 6144 + jb0 + jj];
        }
    }
    if (bid == 0) {
        float* tab = (float*)(ws + WS_TAB);
        for (int i = tid; i < 1024; i += NTHREADS) {
            const int pos = i >> 4, j = i & 15;
            const float inv = exp2f(-(float)j * (13.287712379549449f / 16.0f));
            const double ang = (double)((float)pos * inv);
            double rev = ang * 0.15915494309189535;
            rev -= floor(rev);
            tab[i] = __builtin_amdgcn_cosf((float)rev);
            tab[1024 + i] = __builtin_amdgcn_sinf((float)rev);
        }
        if (tid < 2) {
            const float* lv = a.in[9] + tid * 256;
            float s1 = 0.f, s2 = 0.f;
            for (int i = 0; i < 64; ++i) { s1 += lv[i] * lv[64 + i]; s2 += lv[128 + i] * lv[192 + i]; }
            const float lam_init = (tid == 0) ? 0.2f : (0.8f - 0.6f * 0.7408182206817179f);
            tab[2048 + tid] = __expf(s1) - __expf(s2) + lam_init;
        }
    }
}

__device__ __forceinline__ void store_h_row(bfu* dst, const float (&y)[16], int lane) {
#pragma unroll
    for (int i = 0; i < 4; ++i) {
        uint2 p; p.x = pack2(y[i * 4 + 0], y[i * 4 + 1]); p.y = pack2(y[i * 4 + 2], y[i * 4 + 3]);
        *(uint2*)(dst + i * 256 + lane * 4) = p;
    }
}
__device__ __forceinline__ void norm_mod(const float (&v)[16], float (&y)[16], const float* g, const float* shift, const float* scale, int lane) {
    float ss = 0.f;
#pragma unroll
    for (int i = 0; i < 16; ++i) ss += v[i] * v[i];
    ss = wave_sum(ss);
    const float rs = rsqrtf(ss * (1.0f / 1024.0f) + 1e-6f);
#pragma unroll
    for (int i = 0; i < 4; ++i) {
        const int col = i * 256 + lane * 4;
        const float4 gg = *(const float4*)(g + col);
        const float4 sh = *(const float4*)(shift + col);
        const float4 sc = *(const float4*)(scale + col);
        y[i * 4 + 0] = v[i * 4 + 0] * rs * gg.x * (1.0f + sc.x) + sh.x;
        y[i * 4 + 1] = v[i * 4 + 1] * rs * gg.y * (1.0f + sc.y) + sh.y;
        y[i * 4 + 2] = v[i * 4 + 2] * rs * gg.z * (1.0f + sc.z) + sh.z;
        y[i * 4 + 3] = v[i * 4 + 3] * rs * gg.w * (1.0f + sc.w) + sh.w;
    }
}

__device__ __forceinline__ void phase_norm1_l0(const Args& a, int tid, int bid, int nb) {
    const int wave = tid >> 6, lane = tid & 63;
    bfu* xres = (bfu*)(wsp(a) + WS_XRES);
    bfu* H = (bfu*)(wsp(a) + WS_H);
    const float* mod = (const float*)(wsp(a) + WS_MOD);
    for (int row = bid * NW + wave; row < NT; row += nb * NW) {
        const int b = row / TB, t = row % TB;
        const float* src = (t < SEQ) ? (a.in[0] + ((size_t)b * SEQ + t) * 1024) : (a.in[2] + ((size_t)b * CTX + (t - SEQ)) * 1024);
        const int m = (t < SEQ) ? b : 8;
        float v[16], y[16];
#pragma unroll
        for (int i = 0; i < 4; ++i) {
            const float4 x4 = *(const float4*)(src + i * 256 + lane * 4);
            v[i * 4 + 0] = x4.x; v[i * 4 + 1] = x4.y; v[i * 4 + 2] = x4.z; v[i * 4 + 3] = x4.w;
            { uint2 p; p.x = pack2(x4.x, x4.y); p.y = pack2(x4.z, x4.w); *(uint2*)(xres + (size_t)row * 1024 + i * 256 + lane * 4) = p; }
        }
        const float* md = mod + (size_t)(0 * 9 + m) * 6144;
        norm_mod(v, y, a.in[6], md + 0, md + 1024, lane);
        store_h_row(H + (size_t)row * 1024, y, lane);
    }
}

__device__ __forceinline__ void phase_norm2(const Args& a, int l, int tid, int bid, int nb) {
    const int wave = tid >> 6, lane = tid & 63;
    const float* xres = (const float*)(wsp(a) + WS_XRES);
    bfu* HI = (bfu*)(wsp(a) + WS_H2HI);
    bfu* LO = (bfu*)(wsp(a) + WS_H2LO);
    const float* mod = (const float*)(wsp(a) + WS_MOD);
    for (int row = bid * NW + wave; row < NT; row += nb * NW) {
        const int b = row / TB, t = row % TB;
        if (l == 1 && t >= SEQ) continue;
        const int m = (t < SEQ) ? b : 8;
        float v[16], y[16], lo[16];
#pragma unroll
        for (int i = 0; i < 4; ++i) {
            const float4 x4 = *(const float4*)(xres + (size_t)row * 1024 + i * 256 + lane * 4);
            v[i * 4 + 0] = x4.x; v[i * 4 + 1] = x4.y; v[i * 4 + 2] = x4.z; v[i * 4 + 3] = x4.w;
        }
        const float* md = mod + (size_t)(l * 9 + m) * 6144;
        norm_mod(v, y, a.in[7] + l * 1024, md + 3 * 1024, md + 4 * 1024, lane);
#pragma unroll
        for (int i = 0; i < 16; ++i) lo[i] = y[i] - bf2f(f2bf(y[i]));
        store_h_row(HI + (size_t)row * 2048, y, lane);
        store_h_row(HI + (size_t)row * 2048 + 1024, lo, lane);
        store_h_row((bfu*)(wsp(a) + WS_H) + (size_t)row * 1024, y, lane);
    }
}

__device__ __forceinline__ void phase_combine(const Args& a, int l, int tid, int bid, int nb) {
    const int wave = tid >> 6, lane = tid & 63;
    bfu* xres = (bfu*)(wsp(a) + WS_XRES);
    const bfu* YB = (const bfu*)(wsp(a) + WS_YB);
    bfu* H = (bfu*)(wsp(a) + WS_H);
    const float* mod = (const float*)(wsp(a) + WS_MOD);
    for (int row = bid * NW + wave; row < NT; row += nb * NW) {
        const int b = row / TB, t = row % TB;
        if (l == 1 && t >= SEQ) continue;
        const int m = (t < SEQ) ? b : 8;
        const float* md = mod + (size_t)(l * 9 + m) * 6144;
        float v[16], y[16];
#pragma unroll
        for (int i = 0; i < 4; ++i) {
            const int col = i * 256 + lane * 4;
            const uint2 xp = *(const uint2*)(xres + (size_t)row * 1024 + col);
            const float4 x4 = make_float4(bflo(xp.x), bfhi(xp.x), bflo(xp.y), bfhi(xp.y));
            float f0 = 0.f, f1 = 0.f, f2 = 0.f, f3 = 0.f;
#pragma unroll
            for (int k = 0; k < 4; ++k) {
                const uint2 p = *(const uint2*)(YB + ((size_t)row * 4 + k) * 1024 + col);
                f0 += bflo(p.x); f1 += bfhi(p.x); f2 += bflo(p.y); f3 += bfhi(p.y);
            }
            const float4 gf = *(const float4*)(md + 5 * 1024 + col);
            v[i * 4 + 0] = x4.x + gf.x * f0; v[i * 4 + 1] = x4.y + gf.y * f1;
            v[i * 4 + 2] = x4.z + gf.z * f2; v[i * 4 + 3] = x4.w + gf.w * f3;
        }
        if (l == 0) {
#pragma unroll
            for (int i = 0; i < 4; ++i)
                { uint2 p; p.x = pack2(v[i * 4], v[i * 4 + 1]); p.y = pack2(v[i * 4 + 2], v[i * 4 + 3]); *(uint2*)(xres + (size_t)row * 1024 + i * 256 + lane * 4) = p; }
            const float* md1 = mod + (size_t)(1 * 9 + m) * 6144;
            norm_mod(v, y, a.in[6] + 1024, md1 + 0, md1 + 1024, lane);
            store_h_row(H + (size_t)row * 1024, y, lane);
        } else {
            float ss = 0.f;
#pragma unroll
            for (int i = 0; i < 16; ++i) ss += v[i] * v[i];
            ss = wave_sum(ss);
            const float rs = rsqrtf(ss * (1.0f / 1024.0f) + 1e-6f);
            float* o = a.out + ((size_t)b * SEQ + t) * 1024;
#pragma unroll
            for (int i = 0; i < 4; ++i) {
                const int col = i * 256 + lane * 4;
                const float4 gg = *(const float4*)(a.in[33] + col);
                *(float4*)(o + col) = make_float4(v[i * 4] * rs * gg.x, v[i * 4 + 1] * rs * gg.y, v[i * 4 + 2] * rs * gg.z, v[i * 4 + 3] * rs * gg.w);
            }
        }
    }
}

__device__ __forceinline__ void phase_gemm_in(const Args& a, int l, char* smem, int tid, int bid, int nb) {
    unsigned char* ws = wsp(a);
    const bfu* H = (const bfu*)(ws + WS_H);
    const bfu* W = (const bfu*)(ws + WS_WINT) + (size_t)l * 8192 * 1024;
    const float* tab = (const float*)(ws + WS_TAB);
    const int wave = tid >> 6, lane = tid & 63, wm = wave >> 1, wn = wave & 1, g = lane >> 4, c = lane & 15;
    for (int it = bid; it < 72 * 64; it += nb) {
        const int mt = it >> 6, nt = it & 63;
        const int m0 = mt * 256, n0 = nt * 128;
        int arow[4]; ident_rows(arow, m0, tid);
        f32x4 acc[4][4]; zero_acc<4>(acc);
        gemm_loop<4>(acc, H, 1024, arow, W, 1024, n0, 1024, smem, tid);
        const int colbase = n0 + wn * 64;
        const int rowbase = m0 + wm * 64;
        if (nt < 8) {
            bfu* dst = (bfu*)(ws + (nt < 4 ? WS_Q : WS_K));
            const int cc = colbase & 511;
            const float qs = (nt < 4) ? 0.18033688011112042f : 1.0f;
#pragma unroll
            for (int mi = 0; mi < 4; ++mi)
#pragma unroll
                for (int r = 0; r < 4; ++r) {
                    const int row = rowbase + mi * 16 + g * 4 + r;
                    const int t = row % TB;
                    float x0 = acc[mi][0][r], x1 = acc[mi][1][r], x2 = acc[mi][2][r], x3 = acc[mi][3][r];
                    if (t < SEQ) {
                        const int pr = t >> 6, pc = t & 63;
                        const float cr = tab[pr * 16 + c], sr = tab[1024 + pr * 16 + c];
                        const float c2 = tab[pc * 16 + c], s2 = tab[1024 + pc * 16 + c];
                        const float y0 = x0 * cr - x1 * sr, y1 = x0 * sr + x1 * cr;
                        const float y2 = x2 * c2 - x3 * s2, y3 = x2 * s2 + x3 * c2;
                        x0 = y0; x1 = y1; x2 = y2; x3 = y3;
                    }
                    bfu* d = dst + (size_t)row * 512 + cc + c;
                    d[0] = f2bf(x0 * qs); d[16] = f2bf(x1 * qs); d[32] = f2bf(x2 * qs); d[48] = f2bf(x3 * qs);
                }
        } else if (nt < 12) {
            bfu* VT = (bfu*)(ws + WS_VT);
            const int b = m0 / TB;
            const int tb0 = (m0 % TB) + wm * 64;
#pragma unroll
            for (int ni = 0; ni < 4; ++ni) {
                const int cc = colbase - 1024 + ni * 16 + c;
                const int head = cc >> 7, dim = cc & 127;
                bfu* d = VT + ((size_t)(b * 4 + head) * 128 + dim) * TB;
#pragma unroll
                for (int mi = 0; mi < 4; ++mi) {
                    uint2 p; p.x = pack2(acc[mi][ni][0], acc[mi][ni][1]); p.y = pack2(acc[mi][ni][2], acc[mi][ni][3]);
                    *(uint2*)(d + tb0 + mi * 16 + g * 4) = p;
                }
            }
        } else if (nt < 36) {
            bfu* dst; int cc;
            if (nt < 24) { const int q = colbase - 1536; dst = (bfu*)(ws + WS_SB) + (size_t)(q >> 9) * NT * 512; cc = q & 511; }
            else if (nt < 28) { dst = (bfu*)(ws + WS_RR); cc = colbase - 3072; }
            else if (nt < 32) { dst = (bfu*)(ws + WS_RK); cc = colbase - 3584; }
            else { dst = (bfu*)(ws + WS_RV); cc = colbase - 4096; }
#pragma unroll
            for (int mi = 0; mi < 4; ++mi)
#pragma unroll
                for (int ni = 0; ni < 4; ++ni)
#pragma unroll
                    for (int r = 0; r < 4; ++r) {
                        const int row = rowbase + mi * 16 + g * 4 + r;
                        dst[(size_t)row * 512 + cc + ni * 16 + c] = f2bf(acc[mi][ni][r]);
                    }
            if (nt >= 28 && nt < 32) {
                bfu* KKB = (bfu*)(ws + WS_KKB);
                const float* kkw = a.in[20] + l * 512 + cc;
                float w4[4];
#pragma unroll
                for (int ni = 0; ni < 4; ++ni) w4[ni] = kkw[ni * 16 + c];
#pragma unroll
                for (int mi = 0; mi < 4; ++mi)
#pragma unroll
                    for (int r = 0; r < 4; ++r) {
                        float s = 0.f;
#pragma unroll
                        for (int ni = 0; ni < 4; ++ni) { const float q = acc[mi][ni][r] * w4[ni]; s += q * q; }
                        s = red16(s);
                        const float inv = rsqrtf(fmaxf(s, 1e-24f));
                        const int row = rowbase + mi * 16 + g * 4 + r;
#pragma unroll
                        for (int ni = 0; ni < 4; ++ni)
                            KKB[(size_t)row * 512 + cc + ni * 16 + c] = f2bf(acc[mi][ni][r] * w4[ni] * inv);
                    }
            }
        } else if (nt < 60) {
            bfu* GL = (bfu*)(ws + WS_GL);
            const int cc = colbase - 4608;
#pragma unroll
            for (int mi = 0; mi < 4; ++mi)
#pragma unroll
                for (int ni = 0; ni < 4; ++ni)
#pragma unroll
                    for (int r = 0; r < 4; ++r) {
                        const int row = rowbase + mi * 16 + g * 4 + r;
                        GL[(size_t)row * 3072 + cc + ni * 16 + c] = f2bf(sigmoidf_(acc[mi][ni][r]));
                    }
        } else {
            bfu* LO = (bfu*)(ws + WS_LORA);
            const int cc = colbase - 7680;
#pragma unroll
            for (int mi = 0; mi < 4; ++mi)
#pragma unroll
                for (int ni = 0; ni < 4; ++ni)
#pragma unroll
                    for (int r = 0; r < 4; ++r) {
                        const int row = rowbase + mi * 16 + g * 4 + r;
                        float v = acc[mi][ni][r];
                        if (nt == 60) v = tanhf_(v); else if (nt >= 62) v = sigmoidf_(v);
                        LO[(size_t)row * 512 + cc + ni * 16 + c] = f2bf(v);
                    }
        }
    }
}

struct SchedDense {
    static constexpr bool GATHER = false;
    const char* A; const char* B; int lda, ldb, nM, nN, G, c, skip9;
    __device__ __forceinline__ bool next(int i, g8::Unit& u) const {
        int pm, pn; if (!g8::static_tile(i, G, c, nM, nN, pm, pn)) return false;
        if (skip9) pm += pm >> 3;
        pm = g8::uni(pm); pn = g8::uni(pn);
        u.pm = pm; u.pn = pn; u.e = 0; u.cn = 0;
        u.A = A + (size_t)pm * 256 * lda * 2; u.B = B + (size_t)pn * 256 * ldb * 2; return true;
    }
    __device__ __forceinline__ void rows(const g8::Unit&, int, int&) const {}
};
__device__ __forceinline__ uint2 pack4(const f32x4& v) { uint2 p; p.x = pack2(v[0], v[1]); p.y = pack2(v[2], v[3]); return p; }

struct EpiIn {
    static constexpr bool PERM = true;
    unsigned char* ws; int l;
    __device__ __forceinline__ void operator()(const f32x4 (&acc)[2][2][4][2], const g8::Unit& u, int wr, int wc, int fr, int fq) const {
        const int pn = u.pn;
        const int row0 = u.pm * 256 + wr * 64 + fr;
        const int colw = 32 * wc + 8 * fq;
        if (pn < 4) {
            bfu* dst = (bfu*)(ws + (pn < 2 ? WS_Q : WS_K)) + (pn & 1) * 256 + colw;
            const float* tab = (const float*)(ws + WS_TAB);
            const float qs = (pn < 2) ? 0.18033688011112042f : 1.0f;
            const bool colrot = (wc & 1) != 0;
            const bool latent = ((u.pm % 9) != 8);
            const float sgn = (fq < 2) ? -1.0f : 1.0f;
            const int fo = 8 * (fq & 1);
#pragma unroll
            for (int ai = 0; ai < 2; ++ai)
#pragma unroll
                for (int m = 0; m < 4; ++m) {
                    const int row = row0 + ai * 128 + m * 16;
                    const int t = row % TB;
                    const int pos = colrot ? (t & 63) : ((t >> 6) & 31);
                    f32x4 cs[2], sn[2];
#pragma unroll
                    for (int n = 0; n < 2; ++n) { cs[n] = *(const f32x4*)(tab + pos * 16 + fo + 4 * n); sn[n] = *(const f32x4*)(tab + 1024 + pos * 16 + fo + 4 * n); }
#pragma unroll
                    for (int bj = 0; bj < 2; ++bj) {
                        uint2 pk[2];
#pragma unroll
                        for (int n = 0; n < 2; ++n) {
                            f32x4 x = acc[ai][bj][m][n];
                            if (latent) {
                                f32x4 p;
                                p[0] = shx_(x[0], 32); p[1] = shx_(x[1], 32); p[2] = shx_(x[2], 32); p[3] = shx_(x[3], 32);
                                x = x * cs[n] + (p * sn[n]) * sgn;
                            }
                            pk[n] = pack4(x * qs);
                        }
                        *(uint4*)(dst + (size_t)row * 512 + bj * 128) = make_uint4(pk[0].x, pk[0].y, pk[1].x, pk[1].y);
                    }
                }
        } else if (pn < 6) {
            bfu* VT = (bfu*)(ws + WS_VT);
            const int rbase = u.pm * 256;
            const int b = rbase / TB, t0 = (rbase % TB) + wr * 64 + fr;
#pragma unroll
            for (int bj = 0; bj < 2; ++bj)
#pragma unroll
                for (int n = 0; n < 2; ++n) {
                    const int cc = (pn - 4) * 256 + bj * 128 + colw + n * 4;
                    const int head = cc >> 7, dim = cc & 127;
                    bfu* d = VT + ((size_t)(b * 4 + head) * 128 + dim) * TB + t0;
#pragma unroll
                    for (int ai = 0; ai < 2; ++ai)
#pragma unroll
                        for (int m = 0; m < 4; ++m)
#pragma unroll
                            for (int j = 0; j < 4; ++j) d[(size_t)j * TB + ai * 128 + m * 16] = f2bf(acc[ai][bj][m][n][j]);
                }
        } else {
            bfu* dst; int ld, kind;
            if (pn < 18) { dst = (bfu*)(ws + WS_SB) + (size_t)((pn - 6) >> 1) * NT * 512 + ((pn - 6) & 1) * 256; ld = 512; kind = 0; }
            else if (pn < 30) { dst = (bfu*)(ws + WS_GL) + (pn - 18) * 256; ld = 3072; kind = 1; }
            else { dst = (bfu*)(ws + WS_LORA) + (pn - 30) * 256; ld = 512; kind = (pn == 31) ? 1 : 2; }
            dst += colw;
#pragma unroll
            for (int ai = 0; ai < 2; ++ai)
#pragma unroll
                for (int m = 0; m < 4; ++m) {
                    bfu* d = dst + (size_t)(row0 + ai * 128 + m * 16) * ld;
#pragma unroll
                    for (int bj = 0; bj < 2; ++bj) {
                        uint2 pk[2];
#pragma unroll
                        for (int n = 0; n < 2; ++n) {
                            f32x4 v = acc[ai][bj][m][n];
                            if (kind == 1) { v[0] = sigmoidf_(v[0]); v[1] = sigmoidf_(v[1]); v[2] = sigmoidf_(v[2]); v[3] = sigmoidf_(v[3]); }
                            else if (kind == 2 && bj == 0) { v[0] = tanhf_(v[0]); v[1] = tanhf_(v[1]); v[2] = tanhf_(v[2]); v[3] = tanhf_(v[3]); }
                            pk[n] = pack4(v);
                        }
                        *(uint4*)(d + bj * 128) = make_uint4(pk[0].x, pk[0].y, pk[1].x, pk[1].y);
                    }
                }
        }
    }
};

__device__ __forceinline__ void phase_gemm_in8(const Args& a, int l, char* smem, int tid, int bid, int nb) {
    SchedDense S;
    S.A = (const char*)(wsp(a) + WS_H); S.B = (const char*)(wsp(a) + WS_WINT) + (size_t)l * 8192 * 1024 * 2;
    S.lda = 1024; S.ldb = 1024; S.nM = 72; S.nN = 32; S.G = nb; S.c = bid; S.skip9 = 0;
    EpiIn E; E.ws = wsp(a); E.l = l;
    g8::gemm8(( LAS unsigned char*)smem, S, E, 1024, tid);
}

__device__ __forceinline__ int scan_tok(int d, int idx) {
    if (d == 0) return (idx < CTX) ? (SEQ + idx) : (idx - CTX);
    return (idx < CTX) ? (TB - 1 - idx) : (SEQ - 1 - (idx - CTX));
}
struct StepRaw { uint2 w, kk, b, ke, r; unsigned v; };

__device__ __forceinline__ void scan_item(const Args& a, int l, int item, int tid) {
    unsigned char* ws = wsp(a);
    const int wave = tid >> 6, lane = tid & 63;
    const int sub = item & 1, d = (item >> 1) & 1, h = (item >> 2) & 7, b = item >> 5;
    const int rg = sub * 8 + wave;
    const int i = rg * 4 + (lane >> 4), jg = lane & 15;
    const bfu* WD = (const bfu*)(ws + WS_WDEC) + (size_t)d * NT * 512 + h * 64 + jg * 4;
    const bfu* KK = (const bfu*)(ws + WS_KKB) + h * 64 + jg * 4;
    const bfu* BV = (const bfu*)(ws + WS_BV) + (size_t)d * NT * 512 + h * 64 + jg * 4;
    const bfu* KE = (const bfu*)(ws + WS_KE) + (size_t)d * NT * 512 + h * 64 + jg * 4;
    const bfu* RR = (const bfu*)(ws + WS_RR) + h * 64 + jg * 4;
    const bfu* RV = (const bfu*)(ws + WS_RV) + h * 64 + i;
    float* Y = (float*)(ws + WS_Y) + (size_t)d * NT * 512 + h * 64 + i;
    const size_t rb = (size_t)b * TB;
    float s0 = 0.f, s1 = 0.f, s2 = 0.f, s3 = 0.f;
    constexpr int U = 4;
    StepRaw nx[U];
#pragma unroll
    for (int u = 0; u < U; ++u) {
        const size_t o = (rb + scan_tok(d, u)) * 512;
        nx[u].w = *(const uint2*)(WD + o); nx[u].kk = *(const uint2*)(KK + o); nx[u].b = *(const uint2*)(BV + o);
        nx[u].ke = *(const uint2*)(KE + o); nx[u].r = *(const uint2*)(RR + o); nx[u].v = RV[o];
    }
    for (int base = 0; base < TB; base += U) {
        StepRaw cu[U];
#pragma unroll
        for (int u = 0; u < U; ++u) cu[u] = nx[u];
        if (base + U < TB) {
#pragma unroll
            for (int u = 0; u < U; ++u) {
                const size_t o = (rb + scan_tok(d, base + U + u)) * 512;
                nx[u].w = *(const uint2*)(WD + o); nx[u].kk = *(const uint2*)(KK + o); nx[u].b = *(const uint2*)(BV + o);
                nx[u].ke = *(const uint2*)(KE + o); nx[u].r = *(const uint2*)(RR + o); nx[u].v = RV[o];
            }
        }
#pragma unroll
        for (int u = 0; u < U; ++u) {
            const float k0 = bflo(cu[u].kk.x), k1 = bfhi(cu[u].kk.x), k2 = bflo(cu[u].kk.y), k3 = bfhi(cu[u].kk.y);
            float sk = s0 * k0 + s1 * k1 + s2 * k2 + s3 * k3;
            sk = red16(sk);
            const float v = bf2f((bfu)cu[u].v);
            s0 = s0 * bflo(cu[u].w.x) + (v * bflo(cu[u].ke.x) - sk * (k0 * bflo(cu[u].b.x)));
            s1 = s1 * bfhi(cu[u].w.x) + (v * bfhi(cu[u].ke.x) - sk * (k1 * bfhi(cu[u].b.x)));
            s2 = s2 * bflo(cu[u].w.y) + (v * bflo(cu[u].ke.y) - sk * (k2 * bflo(cu[u].b.y)));
            s3 = s3 * bfhi(cu[u].w.y) + (v * bfhi(cu[u].ke.y) - sk * (k3 * bfhi(cu[u].b.y)));
            float y = s0 * bflo(cu[u].r.x) + s1 * bfhi(cu[u].r.x) + s2 * bflo(cu[u].r.y) + s3 * bfhi(cu[u].r.y);
            y = red16(y);
            const int tt = scan_tok(d, base + u);
            if (jg == 0 && (l == 0 || tt < SEQ)) Y[(rb + tt) * 512] = y;
        }
    }
}

__device__ __forceinline__ void cvt_expert_tile(const Args& a, unsigned char* ws, int l, int t, int sub, int lane) {
    const int e = t / 768, r = t % 768;
    const float* src; bfu* dst; int lds, tk, tn; bool w1;
    if (r < 512) { w1 = true; src = a.in[29] + (size_t)(l * 32 + e) * 1024 * 2048; lds = 2048; dst = (bfu*)(ws + WS_W1T) + (size_t)(l * 32 + e) * 2048 * 1024; tk = r >> 5; tn = r & 31; }
    else { const int r2 = r - 512; w1 = false; src = a.in[31] + (size_t)(l * 32 + e) * 1024 * 1024; lds = 1024; dst = (bfu*)(ws + WS_W2ET) + (size_t)(l * 32 + e) * 1024 * 1024; tk = r2 >> 4; tn = r2 & 15; }
    const int kq = lane >> 4, n4 = lane & 15;
    const int nd = tn * 64 + n4 * 4;
    const int ns = w1 ? (((nd >> 7) & 1) * 1024 + (nd >> 8) * 128 + (nd & 127)) : nd;
    const float* sp = src + (size_t)(tk * 64 + sub * 32 + kq * 8) * lds + ns;
    float4 v[8];
#pragma unroll
    for (int i = 0; i < 8; ++i) v[i] = *(const float4*)(sp + (size_t)i * lds);
    bfu* dp = dst + (size_t)nd * 1024 + tk * 64 + sub * 32 + kq * 8;
#pragma unroll
    for (int c = 0; c < 4; ++c) {
        uint4 p0;
#define CV_(i) (c == 0 ? v[i].x : c == 1 ? v[i].y : c == 2 ? v[i].z : v[i].w)
        p0.x = pack2(CV_(0), CV_(1)); p0.y = pack2(CV_(2), CV_(3)); p0.z = pack2(CV_(4), CV_(5)); p0.w = pack2(CV_(6), CV_(7));
#undef CV_
        *(uint4*)(dp + (size_t)c * 1024) = p0;
    }
}

constexpr int SC_CH = 32;
constexpr int SC_STEP = 5 * 64 + 4;
constexpr int SC_BUF = SC_CH * (SC_STEP + 32) * 4;
struct ScanStep { f32x4 w[2], kq[4], b[2], e[2]; float br, kr, v; };
__device__ __forceinline__ void scan_item2(const Args& a, int l, int item, char* smem, int tid) {
    unsigned char* ws = wsp(a);
    const int wave = tid >> 6, lane = tid & 63;
    const int half = item & 1, d = (item >> 1) & 1, h = (item >> 2) & 7, b = item >> 5;
    const int rloc = (wave & 3) * 8 + (lane >> 3), jg = lane & 7;
    const int ss = tid >> 4, sj = tid & 15;
    const bfu* WD = (const bfu*)(ws + WS_WDEC) + (size_t)d * NT * 512 + h * 64 + sj * 4;
    const bfu* AV = (const bfu*)(ws + WS_BV) + (size_t)d * NT * 512 + h * 64 + sj * 4;
    const bfu* RK = (const bfu*)(ws + WS_RK) + h * 64 + sj * 4;
    const bfu* RR = (const bfu*)(ws + WS_RR) + h * 64 + sj * 4;
    const bfu* RV = (const bfu*)(ws + WS_RV) + h * 64 + half * 32 + sj * 2;
    float* Y = (float*)(ws + WS_Y) + (size_t)d * NT * 512 + h * 64 + half * 32 + sj * 2;
    const f32x4 kkw = *(const f32x4*)(a.in[20] + l * 512 + h * 64 + sj * 4);
    const f32x4 kaw = *(const f32x4*)(a.in[21] + l * 512 + h * 64 + sj * 4);
    const size_t rb = (size_t)b * TB;
    float* ybuf0 = (float*)(smem + 2 * SC_BUF);
    uint2 rw, rk, ra, rr; unsigned rv;
#define SC_LOAD(chunk) do { const size_t _o = (rb + scan_tok(d, (chunk) * SC_CH + ss)) * 512; \
        rw = *(const uint2*)(WD + _o); rk = *(const uint2*)(RK + _o); ra = *(const uint2*)(AV + _o); rr = *(const uint2*)(RR + _o); rv = *(const unsigned*)(RV + _o); } while (0)
#define SC_WRITE(bufp) do { float* _b = (float*)(bufp) + ss * SC_STEP + sj * 4; \
        const f32x4 _k = {bflo(rk.x), bfhi(rk.x), bflo(rk.y), bfhi(rk.y)}; const f32x4 _a = {bflo(ra.x), bfhi(ra.x), bflo(ra.y), bfhi(ra.y)}; \
        const f32x4 _w = {bflo(rw.x), bfhi(rw.x), bflo(rw.y), bfhi(rw.y)}; const f32x4 _r = {bflo(rr.x), bfhi(rr.x), bflo(rr.y), bfhi(rr.y)}; \
        f32x4 _q = _k * kkw; float _s = _q[0] * _q[0] + _q[1] * _q[1] + _q[2] * _q[2] + _q[3] * _q[3]; _s = red16(_s); \
        _q *= rsqrtf(fmaxf(_s, 1e-24f)); \
        const f32x4 _bb = _q * _a; const f32x4 _ke = _k * (1.0f + (_a - 1.0f) * kaw); \
        float _br = _bb[0] * _r[0] + _bb[1] * _r[1] + _bb[2] * _r[2] + _bb[3] * _r[3]; _br = red16(_br); \
        float _kr = _ke[0] * _r[0] + _ke[1] * _r[1] + _ke[2] * _r[2] + _ke[3] * _r[3]; _kr = red16(_kr); \
        const f32x4 _wr = _w * _r; float* _kq = (float*)(bufp) + ss * SC_STEP + 64 + sj * 8; \
        *(f32x4*)(_b) = _w; *(f32x4*)(_kq) = (f32x4){_q[0], _wr[0], _q[1], _wr[1]}; *(f32x4*)(_kq + 4) = (f32x4){_q[2], _wr[2], _q[3], _wr[3]}; \
        *(f32x4*)(_b + 192) = _bb; *(f32x4*)(_b + 256) = _ke; \
        if (sj == 0) { float* _sc = (float*)(bufp) + ss * SC_STEP + 320; _sc[0] = _br; _sc[1] = _kr; } \
        float* _v = (float*)(bufp) + SC_CH * SC_STEP + ss * 32 + sj * 2; _v[0] = bflo(rv); _v[1] = bfhi(rv); } while (0)
#define SC_FETCH(dst, st) do { const float* _p = vec + (st) * SC_STEP; \
        dst.w[0] = *(const f32x4*)(_p); dst.w[1] = *(const f32x4*)(_p + 4); \
        dst.kq[0] = *(const f32x4*)(_p + 64 + jg * 8); dst.kq[1] = *(const f32x4*)(_p + 68 + jg * 8); dst.kq[2] = *(const f32x4*)(_p + 72 + jg * 8); dst.kq[3] = *(const f32x4*)(_p + 76 + jg * 8); \
        dst.b[0] = *(const f32x4*)(_p + 192); dst.b[1] = *(const f32x4*)(_p + 196); dst.e[0] = *(const f32x4*)(_p + 256); dst.e[1] = *(const f32x4*)(_p + 260); \
        const float2 _s2 = *(const float2*)(_p + 320 - jg * 8); dst.br = _s2.x; dst.kr = _s2.y; dst.v = vv[(st) * 32]; } while (0)
#define SC_BODY(cu, st) do { \
        f32x2_t d2 = {0.f, 0.f};                           \
        d2 += (f32x2_t){sA[0], sA[0]} * (f32x2_t){cu.kq[0][0], cu.kq[0][1]}; d2 += (f32x2_t){sA[1], sA[1]} * (f32x2_t){cu.kq[0][2], cu.kq[0][3]}; \
        d2 += (f32x2_t){sA[2], sA[2]} * (f32x2_t){cu.kq[1][0], cu.kq[1][1]}; d2 += (f32x2_t){sA[3], sA[3]} * (f32x2_t){cu.kq[1][2], cu.kq[1][3]}; \
        d2 += (f32x2_t){sB[0], sB[0]} * (f32x2_t){cu.kq[2][0], cu.kq[2][1]}; d2 += (f32x2_t){sB[1], sB[1]} * (f32x2_t){cu.kq[2][2], cu.kq[2][3]}; \
        d2 += (f32x2_t){sB[2], sB[2]} * (f32x2_t){cu.kq[3][0], cu.kq[3][1]}; d2 += (f32x2_t){sB[3], sB[3]} * (f32x2_t){cu.kq[3][2], cu.kq[3][3]}; \
        float sk = d2[0], z = d2[1]; \
        sk += dppf<0xB1>(sk); z += dppf<0xB1>(z); \
        sk += dppf<0x4E>(sk); z += dppf<0x4E>(z); \
        sk += dppf<0x141>(sk); z += dppf<0x141>(z); \
        sA = sA * cu.w[0] + (cu.e[0] * cu.v - cu.b[0] * sk); \
        sB = sB * cu.w[1] + (cu.e[1] * cu.v - cu.b[1] * sk); \
        const float _y = z - sk * cu.br + cu.v * cu.kr; \
        yq[(st) >> 3] = (jg == ((st) & 7)) ? _y : yq[(st) >> 3]; } while (0)
    __syncthreads();
    SC_LOAD(0);
    SC_WRITE(smem);
    __syncthreads();
    f32x4 sA = {0.f, 0.f, 0.f, 0.f}, sB = {0.f, 0.f, 0.f, 0.f};
    constexpr int NCH = TB / SC_CH;
    for (int ch = 0; ch < NCH; ++ch) {
        const char* cur = smem + (ch & 1) * SC_BUF;
        float* ybuf = ybuf0 + (ch & 1) * SC_CH * 32;
        if (ch + 1 < NCH) SC_LOAD(ch + 1);
        if (wave >= 4) {
            { const int c2 = (ch + (item % 3)) % NCH, pos = c2 % 3;
              if (pos != 0) cvt_expert_tile(a, ws, l, (item * 4 + (wave - 4)) + 1024 * (c2 / 3), pos - 1, lane); }
        } else {
            const float* vec = (const float*)cur + jg * 8;
            const float* vv = (const float*)cur + SC_CH * SC_STEP + rloc;
            float yq[4] = {0.f, 0.f, 0.f, 0.f};
            ScanStep c0, c1, c2;
            SC_FETCH(c0, 0);
            SC_FETCH(c1, 1);
#pragma unroll
            for (int st = 0; st < SC_CH; st += 3) {
                if (st + 2 < SC_CH) SC_FETCH(c2, st + 2);
                SC_BODY(c0, st);
                if (st + 1 < SC_CH) {
                    if (st + 3 < SC_CH) SC_FETCH(c0, st + 3);
                    SC_BODY(c1, st + 1);
                }
                if (st + 2 < SC_CH) {
                    if (st + 4 < SC_CH) SC_FETCH(c1, st + 4);
                    SC_BODY(c2, st + 2);
                }
            }
#pragma unroll
            for (int o = 0; o < 4; ++o) ybuf[(o * 8 + jg) * 32 + rloc] = yq[o];
        }
        if (ch + 1 < NCH) SC_WRITE(smem + ((ch + 1) & 1) * SC_BUF);
        __syncthreads();
        const int tok = scan_tok(d, ch * SC_CH + ss);
        const float2 yy = *(const float2*)(ybuf + ss * 32 + sj * 2);
        if (l == 0 || tok < SEQ) *(float2*)(Y + (rb + tok) * 512) = yy;
    }
#undef SC_LOAD
#undef SC_WRITE
#undef SC_FETCH
#undef SC_BODY
}

constexpr int KROW = 272;
constexpr int VROW = 144;
__device__ __forceinline__ void attn_item(const Args& a, int l, int item, char* smem, int tid) {
    unsigned char* ws = wsp(a);
    const int wave = tid >> 6, lane = tid & 63, g = lane >> 4, c = lane & 15;
    int b, head, r0, kt0;
    if (item < 512) { b = item >> 6; head = (item >> 4) & 3; r0 = b * TB + (item & 15) * 128; kt0 = 0; }
    else { const int j = item - 512; b = j >> 3; head = (j >> 1) & 3; r0 = b * TB + SEQ + (j & 1) * 128; kt0 = 32; }
    const bfu* Q = (const bfu*)(ws + WS_Q);
    const bfu* Kp = (const bfu*)(ws + WS_K) + (size_t)b * TB * 512 + head * 128;
    const bfu* Vp = (const bfu*)(ws + WS_VT) + (size_t)(b * 4 + head) * 128 * TB;
    char* Ks = smem;
    char* Vs = smem + 64 * KROW;
    const int qrow = r0 + wave * 16 + c;
    bf16x8 q1[2], q2[2];
#pragma unroll
    for (int ks = 0; ks < 2; ++ks) {
        q1[ks] = *(const bf16x8*)(Q + (size_t)qrow * 512 + head * 128 + ks * 32 + g * 8);
        q2[ks] = *(const bf16x8*)(Q + (size_t)qrow * 512 + head * 128 + 64 + ks * 32 + g * 8);
    }
    float m1 = -1e30f, m2 = -1e30f, l1 = 0.f, l2 = 0.f;
    f32x4 o1[8], o2[8];
#pragma unroll
    for (int mt = 0; mt < 8; ++mt) { o1[mt] = (f32x4){0.f, 0.f, 0.f, 0.f}; o2[mt] = (f32x4){0.f, 0.f, 0.f, 0.f}; }
    for (int kt = kt0; kt < 36; ++kt) {
        __syncthreads();
#pragma unroll
        for (int i = 0; i < 2; ++i) {
            const int key = (tid >> 4) + 32 * i, ch = tid & 15;
            *(uint4*)(Ks + key * KROW + ch * 16) = *(const uint4*)(Kp + (size_t)(kt * 64 + key) * 512 + ch * 8);
            const int dim = (tid >> 3) + 64 * i, cv = tid & 7;
            *(uint4*)(Vs + dim * VROW + cv * 16) = *(const uint4*)(Vp + (size_t)dim * TB + kt * 64 + cv * 8);
        }
        __syncthreads();
        f32x4 s1[4], s2[4];
#pragma unroll
        for (int kq = 0; kq < 4; ++kq) {
            s1[kq] = (f32x4){0.f, 0.f, 0.f, 0.f}; s2[kq] = (f32x4){0.f, 0.f, 0.f, 0.f};
#pragma unroll
            for (int ks = 0; ks < 2; ++ks) {
                const bf16x8 a1 = *(const bf16x8*)(Ks + (kq * 16 + c) * KROW + ks * 64 + g * 16);
                const bf16x8 a2 = *(const bf16x8*)(Ks + (kq * 16 + c) * KROW + 128 + ks * 64 + g * 16);
                s1[kq] = __builtin_amdgcn_mfma_f32_16x16x32_bf16(a1, q1[ks], s1[kq], 0, 0, 0);
                s2[kq] = __builtin_amdgcn_mfma_f32_16x16x32_bf16(a2, q2[ks], s2[kq], 0, 0, 0);
            }
        }
        float mx1 = s1[0][0], mx2 = s2[0][0];
#pragma unroll
        for (int kq = 0; kq < 4; ++kq)
#pragma unroll
            for (int r = 0; r < 4; ++r) { mx1 = fmaxf(mx1, s1[kq][r]); mx2 = fmaxf(mx2, s2[kq][r]); }
        mx1 = fmaxf(mx1, shx_(mx1, 16)); mx1 = fmaxf(mx1, shx_(mx1, 32));
        mx2 = fmaxf(mx2, shx_(mx2, 16)); mx2 = fmaxf(mx2, shx_(mx2, 32));
        const float mn1 = fmaxf(m1, mx1), mn2 = fmaxf(m2, mx2);
        const float al1 = exp2f(m1 - mn1), al2 = exp2f(m2 - mn2);
        m1 = mn1; m2 = mn2;
        float ps1 = 0.f, ps2 = 0.f;
        bf16x8 pb1[2], pb2[2];
#pragma unroll
        for (int kk = 0; kk < 2; ++kk) {
            float p[8], q[8];
#pragma unroll
            for (int e = 0; e < 4; ++e) {
                p[e] = exp2f(s1[2 * kk][e] - mn1); p[4 + e] = exp2f(s1[2 * kk + 1][e] - mn1);
                q[e] = exp2f(s2[2 * kk][e] - mn2); q[4 + e] = exp2f(s2[2 * kk + 1][e] - mn2);
            }
#pragma unroll
            for (int e = 0; e < 8; ++e) { ps1 += p[e]; ps2 += q[e]; pb1[kk][e] = (short)f2bf(p[e]); pb2[kk][e] = (short)f2bf(q[e]); }
        }
        l1 = l1 * al1 + ps1; l2 = l2 * al2 + ps2;
#pragma unroll
        for (int mt = 0; mt < 8; ++mt) {
            o1[mt] *= al1; o2[mt] *= al2;
#pragma unroll
            for (int kk = 0; kk < 2; ++kk) {
                const uint2 v0 = *(const uint2*)(Vs + (mt * 16 + c) * VROW + (kk * 32 + g * 4) * 2);
                const uint2 v1 = *(const uint2*)(Vs + (mt * 16 + c) * VROW + (kk * 32 + 16 + g * 4) * 2);
                union { uint4 u; bf16x8 v; } av; av.u = make_uint4(v0.x, v0.y, v1.x, v1.y);
                o1[mt] = __builtin_amdgcn_mfma_f32_16x16x32_bf16(av.v, pb1[kk], o1[mt], 0, 0, 0);
                o2[mt] = __builtin_amdgcn_mfma_f32_16x16x32_bf16(av.v, pb2[kk], o2[mt], 0, 0, 0);
            }
        }
    }
    l1 += shx_(l1, 16); l1 += shx_(l1, 32);
    l2 += shx_(l2, 16); l2 += shx_(l2, 32);
    const float lam = ((const float*)(ws + WS_TAB))[2048 + l];
    const float lam_init = (l == 0) ? 0.2f : (0.8f - 0.6f * 0.7408182206817179f);
    const float i1 = 1.0f / l1, i2 = lam / l2;
    float ss = 0.f;
#pragma unroll
    for (int mt = 0; mt < 8; ++mt)
#pragma unroll
        for (int r = 0; r < 4; ++r) { const float v = o1[mt][r] * i1 - o2[mt][r] * i2; o1[mt][r] = v; ss += v * v; }
    ss += shx_(ss, 16); ss += shx_(ss, 32);
    const float rs = rsqrtf(ss * (1.0f / 128.0f) + 1e-5f) * (1.0f - lam_init);
    bfu* ODA = (bfu*)(ws + WS_ODA);
    const float* sg = a.in[10] + l * 128;
#pragma unroll
    for (int mt = 0; mt < 8; ++mt) {
        const int dim = mt * 16 + g * 4;
        const float4 gg = *(const float4*)(sg + dim);
        uint2 p; p.x = pack2(o1[mt][0] * rs * gg.x, o1[mt][1] * rs * gg.y); p.y = pack2(o1[mt][2] * rs * gg.z, o1[mt][3] * rs * gg.w);
        *(uint2*)(ODA + (size_t)qrow * 512 + head * 128 + dim) = p;
    }
}

struct SlabAddr { const float* src; bfu* dst; int lds; };
__device__ __forceinline__ void slab_addr(const Args& a, unsigned char* ws, int l, int sid, int tid, SlabAddr& A) {
    const int e = sid / 768, r = sid % 768;
    const int n = tid & 63, kq = tid >> 6;
    if (r < 512) {
        const int tk = r >> 5, tn = r & 31, nd = tn * 64 + n;
        const int ns = ((nd >> 7) & 1) * 1024 + (nd >> 8) * 128 + (nd & 127);
        A.lds = 2048; A.src = a.in[29] + (size_t)(l * 32 + e) * 1024 * 2048 + (size_t)(tk * 64 + kq * 8) * 2048 + ns;
        A.dst = (bfu*)(ws + WS_W1T) + (size_t)(l * 32 + e) * 2048 * 1024 + (size_t)nd * 1024 + tk * 64 + kq * 8;
    } else {
        const int r2 = r - 512, tk = r2 >> 4, tn = r2 & 15, nd = tn * 64 + n;
        A.lds = 1024; A.src = a.in[31] + (size_t)(l * 32 + e) * 1024 * 1024 + (size_t)(tk * 64 + kq * 8) * 1024 + nd;
        A.dst = (bfu*)(ws + WS_W2ET) + (size_t)(l * 32 + e) * 1024 * 1024 + (size_t)nd * 1024 + tk * 64 + kq * 8;
    }
}

constexpr int AT_BUF = 64 * KROW + 128 * VROW;
__device__ __forceinline__ void attn_item2(const Args& a, int l, int item, char* smem, int tid) {
    unsigned char* ws = wsp(a);
    const int wave = tid >> 6, lane = tid & 63, g = lane >> 4, c = lane & 15;
    int b, head, r0, kt0;
    if (item < 512) { b = item >> 6; head = (item >> 4) & 3; r0 = b * TB + (item & 15) * 128; kt0 = 0; }
    else { const int j = item - 512; b = j >> 3; head = (j >> 1) & 3; r0 = b * TB + SEQ + (j & 1) * 128; kt0 = 32; }
    const bfu* Q = (const bfu*)(ws + WS_Q);
    const char* Kb = (const char*)(ws + WS_K) + ((size_t)b * TB * 512 + head * 128) * 2;
    const char* Vb = (const char*)(ws + WS_VT) + (size_t)(b * 4 + head) * 128 * TB * 2;
    const unsigned klo = (unsigned)((tid >> 4) * 512 + (tid & 15) * 8) * 2u, vlo = (unsigned)((tid >> 3) * TB + (tid & 7) * 8) * 2u;
    const bool piggy = (item < 512);
    const int pe = item >> 4, pi16 = item & 15;
    const char* ps1 = (const char*)(a.in[29] + ((size_t)(l * 32 + pe) * 1024 + pi16 * 64) * 2048);
    const char* ps2 = (const char*)(a.in[31] + ((size_t)(l * 32 + pe) * 1024 + (pi16 >> 2) * 64) * 1024 + (pi16 & 3) * 256);
    char* pd1 = (char*)((bfu*)(ws + WS_W1T) + (size_t)(l * 32 + pe) * 2048 * 1024 + pi16 * 64);
    char* pd2 = (char*)((bfu*)(ws + WS_W2ET) + (size_t)(l * 32 + pe) * 1024 * 1024 + (size_t)((pi16 & 3) * 256) * 1024 + (pi16 >> 2) * 64);
    const unsigned pls1 = (unsigned)((tid >> 6) * 8 * 2048 + (tid & 63)) * 4u, pls2 = (unsigned)((tid >> 6) * 8 * 1024 + (tid & 63)) * 4u;
    const unsigned pld = (unsigned)((tid & 63) * 1024 + (tid >> 6) * 8) * 2u;
    const int kw = (tid >> 4) * KROW + (tid & 15) * 16;
    const int vw = 64 * KROW + (tid >> 3) * VROW + (tid & 7) * 16;
    const int qrow = r0 + wave * 16 + c;
    bf16x8 q1[2], q2[2];
#pragma unroll
    for (int ks = 0; ks < 2; ++ks) {
        q1[ks] = *(const bf16x8*)(Q + (size_t)qrow * 512 + head * 128 + ks * 32 + g * 8);
        q2[ks] = *(const bf16x8*)(Q + (size_t)qrow * 512 + head * 128 + 64 + ks * 32 + g * 8);
    }
    bf16x8 ones;
#pragma unroll
    for (int e = 0; e < 8; ++e) ones[e] = (short)0x3F80;
    float m1 = 0.f, m2 = 0.f;
    f32x4 o1[8], o2[8], ls1 = {0.f, 0.f, 0.f, 0.f}, ls2 = {0.f, 0.f, 0.f, 0.f};
#pragma unroll
    for (int mt = 0; mt < 8; ++mt) { o1[mt] = (f32x4){0.f, 0.f, 0.f, 0.f}; o2[mt] = (f32x4){0.f, 0.f, 0.f, 0.f}; }
    u32x4_t rk0, rk1, rv0, rv1;
#define AT_LOAD(kt) do { GAS const char* kb_ = (GAS const char*)(Kb + (size_t)(kt) * 65536); GAS const char* kb2_ = kb_ + 32768; GAS const char* vb_ = (GAS const char*)(Vb + (kt) * 128); GAS const char* vb2_ = vb_ + 64 * TB * 2; \
        unsigned ko_ = klo, vo_ = vlo; asm volatile("" : "+v"(ko_), "+v"(vo_), "+s"(kb_), "+s"(kb2_), "+s"(vb_), "+s"(vb2_)); \
        rk0 = *(GAS const u32x4_t*)(kb_ + ko_); rk1 = *(GAS const u32x4_t*)(kb2_ + ko_); rv0 = *(GAS const u32x4_t*)(vb_ + vo_); rv1 = *(GAS const u32x4_t*)(vb2_ + vo_); } while (0)
#define AT_WRITE(bufp) do { *(u32x4_t*)((bufp) + kw) = rk0; *(u32x4_t*)((bufp) + kw + 32 * KROW) = rk1; *(u32x4_t*)((bufp) + vw) = rv0; *(u32x4_t*)((bufp) + vw + 64 * VROW) = rv1; } while (0)
    __syncthreads();
    AT_LOAD(kt0);
    AT_WRITE(smem);
    AT_LOAD(kt0 + 1);
    AT_WRITE(smem + AT_BUF);
    __syncthreads();
    const bool lag = (wave >= 4);
    if (lag) __builtin_amdgcn_s_barrier();
    int bi = 0;
    for (int kt = kt0; kt < 36; ++kt) {
        const char* Ks = smem + bi * AT_BUF;
        const char* Vs = Ks + 64 * KROW;
        if (kt + 2 < 36) AT_LOAD(kt + 2);
        float sv[8];
        if (piggy) {
            const bool pw1 = (kt < 32);
            const char* su = pw1 ? ps1 + ((((kt >> 1) & 1) * 1024 + (kt >> 2) * 128 + (kt & 1) * 64) * 4) : ps2 + (kt - 32) * 256;
            const int ldsb = pw1 ? 8192 : 4096;
            unsigned so_ = pw1 ? pls1 : pls2; asm volatile("" : "+v"(so_));
#pragma unroll
            for (int i = 0; i < 8; ++i) { GAS const char* bi = (GAS const char*)(su + (size_t)(i * ldsb)); asm volatile("" : "+s"(bi)); sv[i] = *(GAS const float*)(bi + so_); }
        }
        f32x4 s1[4], s2[4];
        {
            const char* kp = Ks + c * KROW + g * 16;
            bf16x8 ka[4], kb[4];
#pragma unroll
            for (int f = 0; f < 4; ++f) ka[f] = *(const bf16x8*)(kp + (f & 1) * 128 + (f >> 1) * 64);
#pragma unroll
            for (int kq = 0; kq < 4; ++kq) {
                if (kq < 3) {
#pragma unroll
                    for (int f = 0; f < 4; ++f) kb[f] = *(const bf16x8*)(kp + (kq + 1) * 16 * KROW + (f & 1) * 128 + (f >> 1) * 64);
                }
                __builtin_amdgcn_sched_barrier(0);
                s1[kq] = (f32x4){-m1, -m1, -m1, -m1}; s2[kq] = (f32x4){-m2, -m2, -m2, -m2};
                __builtin_amdgcn_s_setprio(1);
                s1[kq] = __builtin_amdgcn_mfma_f32_16x16x32_bf16(ka[0], q1[0], s1[kq], 0, 0, 0);
                s2[kq] = __builtin_amdgcn_mfma_f32_16x16x32_bf16(ka[1], q2[0], s2[kq], 0, 0, 0);
                s1[kq] = __builtin_amdgcn_mfma_f32_16x16x32_bf16(ka[2], q1[1], s1[kq], 0, 0, 0);
                s2[kq] = __builtin_amdgcn_mfma_f32_16x16x32_bf16(ka[3], q2[1], s2[kq], 0, 0, 0);
                __builtin_amdgcn_s_setprio(0);
                __builtin_amdgcn_sched_barrier(0);
#pragma unroll
                for (int f = 0; f < 4; ++f) ka[f] = kb[f];
            }
        }
        float mx1 = fmax3_(s1[0][0], s1[0][1], s1[0][2]), mx2 = fmax3_(s2[0][0], s2[0][1], s2[0][2]);
        mx1 = fmax3_(mx1, s1[0][3], s1[1][0]); mx2 = fmax3_(mx2, s2[0][3], s2[1][0]);
        mx1 = fmax3_(mx1, s1[1][1], s1[1][2]); mx2 = fmax3_(mx2, s2[1][1], s2[1][2]);
        mx1 = fmax3_(mx1, s1[1][3], s1[2][0]); mx2 = fmax3_(mx2, s2[1][3], s2[2][0]);
        mx1 = fmax3_(mx1, s1[2][1], s1[2][2]); mx2 = fmax3_(mx2, s2[2][1], s2[2][2]);
        mx1 = fmax3_(mx1, s1[2][3], s1[3][0]); mx2 = fmax3_(mx2, s2[2][3], s2[3][0]);
        mx1 = fmax3_(mx1, s1[3][1], s1[3][2]); mx2 = fmax3_(mx2, s2[3][1], s2[3][2]);
        mx1 = fmax3_(mx1, s1[3][3], mx1); mx2 = fmax3_(mx2, s2[3][3], mx2);
        const bool first = (kt == kt0);
        if (first || __any((mx1 > 8.0f) || (mx2 > 8.0f))) {
            asm volatile("; attn rescale" ::: "memory");
            mx1 = fmaxf(mx1, shx_(mx1, 16)); mx1 = fmaxf(mx1, shx_(mx1, 32));
            mx2 = fmaxf(mx2, shx_(mx2, 16)); mx2 = fmaxf(mx2, shx_(mx2, 32));
            const float d1 = first ? mx1 : fmaxf(mx1, 0.f), d2 = first ? mx2 : fmaxf(mx2, 0.f);
            const float al1 = first ? 1.0f : ex2_(-d1), al2 = first ? 1.0f : ex2_(-d2);
            m1 += d1; m2 += d2;
            ls1 *= al1; ls2 *= al2;
#pragma unroll
            for (int mt = 0; mt < 8; ++mt) { o1[mt] *= al1; o2[mt] *= al2; }
#pragma unroll
            for (int kq = 0; kq < 4; ++kq) { s1[kq] -= d1; s2[kq] -= d2; }
        }
        bf16x8 pb1[2], pb2[2];
#pragma unroll
        for (int kk = 0; kk < 2; ++kk) {
            union { unsigned u[4]; bf16x8 v; } t1, t2;
            t1.u[0] = pack2(ex2_(s1[2 * kk][0]), ex2_(s1[2 * kk][1])); t1.u[1] = pack2(ex2_(s1[2 * kk][2]), ex2_(s1[2 * kk][3]));
            t1.u[2] = pack2(ex2_(s1[2 * kk + 1][0]), ex2_(s1[2 * kk + 1][1])); t1.u[3] = pack2(ex2_(s1[2 * kk + 1][2]), ex2_(s1[2 * kk + 1][3]));
            t2.u[0] = pack2(ex2_(s2[2 * kk][0]), ex2_(s2[2 * kk][1])); t2.u[1] = pack2(ex2_(s2[2 * kk][2]), ex2_(s2[2 * kk][3]));
            t2.u[2] = pack2(ex2_(s2[2 * kk + 1][0]), ex2_(s2[2 * kk + 1][1])); t2.u[3] = pack2(ex2_(s2[2 * kk + 1][2]), ex2_(s2[2 * kk + 1][3]));
            pb1[kk] = t1.v; pb2[kk] = t2.v;
        }
        asm volatile("" ::: "memory"); __builtin_amdgcn_s_barrier(); asm volatile("" ::: "memory");
#pragma unroll
        for (int kk = 0; kk < 2; ++kk) {
            ls1 = __builtin_amdgcn_mfma_f32_16x16x32_bf16(ones, pb1[kk], ls1, 0, 0, 0);
            ls2 = __builtin_amdgcn_mfma_f32_16x16x32_bf16(ones, pb2[kk], ls2, 0, 0, 0);
        }
        {
            const char* vp = Vs + c * VROW + g * 8;
            uint2 va[4], vb[4];
#pragma unroll
            for (int f = 0; f < 4; ++f) va[f] = *(const uint2*)(vp + (f >> 1) * 64 + (f & 1) * 32);
#pragma unroll
            for (int mt = 0; mt < 8; ++mt) {
                if (mt < 7) {
#pragma unroll
                    for (int f = 0; f < 4; ++f) vb[f] = *(const uint2*)(vp + (mt + 1) * 16 * VROW + (f >> 1) * 64 + (f & 1) * 32);
                }
                __builtin_amdgcn_sched_barrier(0);
                union { uint4 u; bf16x8 v; } av0, av1;
                av0.u = make_uint4(va[0].x, va[0].y, va[1].x, va[1].y);
                av1.u = make_uint4(va[2].x, va[2].y, va[3].x, va[3].y);
                __builtin_amdgcn_s_setprio(1);
                o1[mt] = __builtin_amdgcn_mfma_f32_16x16x32_bf16(av0.v, pb1[0], o1[mt], 0, 0, 0);
                o2[mt] = __builtin_amdgcn_mfma_f32_16x16x32_bf16(av0.v, pb2[0], o2[mt], 0, 0, 0);
                o1[mt] = __builtin_amdgcn_mfma_f32_16x16x32_bf16(av1.v, pb1[1], o1[mt], 0, 0, 0);
                o2[mt] = __builtin_amdgcn_mfma_f32_16x16x32_bf16(av1.v, pb2[1], o2[mt], 0, 0, 0);
                __builtin_amdgcn_s_setprio(0);
                __builtin_amdgcn_sched_barrier(0);
#pragma unroll
                for (int f = 0; f < 4; ++f) va[f] = vb[f];
            }
        }
        if (piggy) {
            const u32x4_t p = {pack2(sv[0], sv[1]), pack2(sv[2], sv[3]), pack2(sv[4], sv[5]), pack2(sv[6], sv[7])};
            GAS char* du = (GAS char*)((kt < 32) ? pd1 + (size_t)kt * 131072 : pd2 + (size_t)(kt - 32) * 131072);
            unsigned do_ = pld; asm volatile("" : "+v"(do_), "+s"(du));
            *(GAS u32x4_t*)(du + do_) = p;
        }
        if (kt + 2 < 36) { const int bw = (bi == 0) ? 2 : bi - 1; AT_WRITE(smem + bw * AT_BUF); }
        asm volatile("s_waitcnt lgkmcnt(0)" ::: "memory"); __builtin_amdgcn_s_barrier(); asm volatile("" ::: "memory");
        bi = (bi == 2) ? 0 : bi + 1;
    }
    if (!lag) __builtin_amdgcn_s_barrier();
#undef AT_LOAD
#undef AT_WRITE
    const float lam = ((const float*)(ws + WS_TAB))[2048 + l];
    const float lam_init = (l == 0) ? 0.2f : (0.8f - 0.6f * 0.7408182206817179f);
    const float i1 = 1.0f / ls1[0], i2 = lam / ls2[0];
    float ss = 0.f;
#pragma unroll
    for (int mt = 0; mt < 8; ++mt)
#pragma unroll
        for (int r = 0; r < 4; ++r) { const float v = o1[mt][r] * i1 - o2[mt][r] * i2; o1[mt][r] = v; ss += v * v; }
    ss += shx_(ss, 16); ss += shx_(ss, 32);
    const float rs = rsqrtf(ss * (1.0f / 128.0f) + 1e-5f) * (1.0f - lam_init);
    bfu* ODA = (bfu*)(ws + WS_ODA);
    const float* sg = a.in[10] + l * 128;
#pragma unroll
    for (int mt = 0; mt < 8; ++mt) {
        const int dim = mt * 16 + g * 4;
        const float4 gg = *(const float4*)(sg + dim);
        uint2 p; p.x = pack2(o1[mt][0] * rs * gg.x, o1[mt][1] * rs * gg.y); p.y = pack2(o1[mt][2] * rs * gg.z, o1[mt][3] * rs * gg.w);
        *(uint2*)(ODA + (size_t)qrow * 512 + head * 128 + dim) = p;
    }
}

constexpr int CK = 16, NCK = TB / CK, NCHUNK = 128 * NCK;
constexpr size_t WS_CEB  = WS_H2HI;
constexpr size_t WS_CW1  = WS_YB;
constexpr size_t WS_CRH  = WS_CW1 + (size_t)NCHUNK * 1024 * 2;
constexpr size_t WS_CUV  = WS_CRH + (size_t)NCHUNK * 1024 * 2;
constexpr size_t WS_CV   = WS_CUV + (size_t)NCHUNK * 1024 * 2;
constexpr size_t WS_CG   = WS_ACT;
constexpr size_t WS_CPC  = WS_ACT + (size_t)NCHUNK * 512 * 2;
__device__ __forceinline__ int kperm(int jp) { return (jp & 32) + 8 * ((jp >> 2) & 3) + 4 * ((jp >> 4) & 1) + (jp & 3); }
__device__ __forceinline__ bf16x8 neg8(bf16x8 v) { union { bf16x8 v; uint4 u; } t; t.v = v; t.u.x ^= 0x80008000u; t.u.y ^= 0x80008000u; t.u.z ^= 0x80008000u; t.u.w ^= 0x80008000u; return t.v; }
__device__ __forceinline__ bf16x8 zero8() { bf16x8 z; for (int e = 0; e < 8; ++e) z[e] = 0; return z; }
__device__ __forceinline__ bf16x8 ldpad8(const char* p, int g) {
    union { bf16x8 v; uint4 u; } t; t.v = *(const bf16x8*)(p + (g & 1) * 16);
    const unsigned m = (g < 2) ? 0xFFFFFFFFu : 0u; t.u.x &= m; t.u.y &= m; t.u.z &= m; t.u.w &= m; return t.v; }

__device__ __forceinline__ void chunk_pre(const Args& a, unsigned char* ws, int l, int cid, char* L, int lane) {
    const int g = lane >> 4, c = lane & 15;
    const int seq = cid / NCK, ck = cid - seq * NCK;
    const int d = seq & 1, h = (seq >> 1) & 7, b = seq >> 4;
    const bfu* WD = (const bfu*)(ws + WS_WDEC) + (size_t)d * NT * 512;
    const bfu* AV = (const bfu*)(ws + WS_BV) + (size_t)d * NT * 512;
    const bfu* RK = (const bfu*)(ws + WS_RK);
    const bfu* RR = (const bfu*)(ws + WS_RR);
    const bfu* RV = (const bfu*)(ws + WS_RV);
    float KH[4][4], BH[4][4], EH[4][4], RH[4][4], BT[4][4], ET[4][4], VV[4][4], PC[4];
    {
        float kq[4][4], av[4][4], ww[4][4], rr[4][4], ssq[4] = {0.f, 0.f, 0.f, 0.f};
        {
            const size_t ro = ((size_t)b * TB + scan_tok(d, ck * CK + (lane >> 2))) * 512 + h * 64 + (lane & 3) * 16;
            const uint4 w0 = *(const uint4*)(WD + ro), w1_ = *(const uint4*)(WD + ro + 8), k0 = *(const uint4*)(RK + ro), k1 = *(const uint4*)(RK + ro + 8);
            const uint4 a0 = *(const uint4*)(AV + ro), a1 = *(const uint4*)(AV + ro + 8), r0_ = *(const uint4*)(RR + ro), r1_ = *(const uint4*)(RR + ro + 8);
            const uint4 v0 = *(const uint4*)(RV + ro), v1 = *(const uint4*)(RV + ro + 8);
            char* sp = L + (lane >> 2) * 128 + (lane & 3) * 32;
            *(uint4*)(sp) = w0; *(uint4*)(sp + 16) = w1_; *(uint4*)(sp + 2048) = k0; *(uint4*)(sp + 2064) = k1;
            *(uint4*)(sp + 4096) = a0; *(uint4*)(sp + 4112) = a1; *(uint4*)(sp + 6144) = r0_; *(uint4*)(sp + 6160) = r1_;
            *(uint4*)(sp + 8192) = v0; *(uint4*)(sp + 8208) = v1;
            asm volatile("s_waitcnt lgkmcnt(0)" ::: "memory");
#pragma unroll
            for (int r = 0; r < 4; ++r)
#pragma unroll
                for (int nt = 0; nt < 4; ++nt) {
                    const char* ep = L + (4 * g + r) * 128 + (16 * nt + c) * 2;
                    ww[nt][r] = bf2f(*(const bfu*)(ep)); kq[nt][r] = bf2f(*(const bfu*)(ep + 2048)); av[nt][r] = bf2f(*(const bfu*)(ep + 4096));
                    rr[nt][r] = bf2f(*(const bfu*)(ep + 6144)); VV[nt][r] = bf2f(*(const bfu*)(ep + 8192));
                }
            asm volatile("s_waitcnt lgkmcnt(0)" ::: "memory");
        }
#pragma unroll
        for (int nt = 0; nt < 4; ++nt) {
            const float kkw = a.in[20][l * 512 + h * 64 + 16 * nt + c], kaw = a.in[21][l * 512 + h * 64 + 16 * nt + c];
#pragma unroll
            for (int r = 0; r < 4; ++r) {
                const float k = kq[nt][r];
                EH[nt][r] = k * (1.0f + (av[nt][r] - 1.0f) * kaw);
                kq[nt][r] = k * kkw;
                ssq[r] += kq[nt][r] * kq[nt][r];
            }
        }
#pragma unroll
        for (int r = 0; r < 4; ++r) ssq[r] = rsqrtf(fmaxf(red16(ssq[r]), 1e-24f));
#pragma unroll
        for (int nt = 0; nt < 4; ++nt) {
            float cp[4];
            cp[0] = ww[nt][0]; cp[1] = cp[0] * ww[nt][1]; cp[2] = cp[1] * ww[nt][2]; cp[3] = cp[2] * ww[nt][3];
            const float t0 = shf_(cp[3], c), t1 = shf_(cp[3], c + 16), t2 = shf_(cp[3], c + 32), t3 = shf_(cp[3], c + 48);
            const float pre = ((g > 0) ? t0 : 1.0f) * ((g > 1) ? t1 : 1.0f) * ((g > 2) ? t2 : 1.0f);
            const float pc = (t0 * t1) * (t2 * t3);
            PC[nt] = pc;
#pragma unroll
            for (int r = 0; r < 4; ++r) {
                const float P = pre * cp[r], Pm = (r == 0) ? pre : pre * cp[r - 1];
                const float iP = __builtin_amdgcn_rcpf(P);
                const float kkn = kq[nt][r] * ssq[r], bb = kkn * av[nt][r], ke = EH[nt][r];
                KH[nt][r] = kkn * Pm; BH[nt][r] = bb * iP; EH[nt][r] = ke * iP; RH[nt][r] = rr[nt][r] * P;
                BT[nt][r] = bb * (pc * iP); ET[nt][r] = ke * (pc * iP);
            }
        }
    }
    char* R0 = L; char* R1 = L + 8192;
#pragma unroll
    for (int nt = 0; nt < 4; ++nt) {
#pragma unroll
        for (int r = 0; r < 4; ++r) {
            const int o = (4 * g + r) * 128 + (16 * nt + c) * 2;
            *(bfu*)(R0 + o) = f2bf(KH[nt][r]); *(bfu*)(R0 + 2048 + o) = f2bf(RH[nt][r]);
            *(bfu*)(R0 + 4096 + o) = f2bf(BH[nt][r]); *(bfu*)(R0 + 6144 + o) = f2bf(EH[nt][r]);
        }
        const int ot = (16 * nt + c) * 32 + 8 * g;
        uint2 p;
        p.x = pack2(KH[nt][0], KH[nt][1]); p.y = pack2(KH[nt][2], KH[nt][3]); *(uint2*)(R1 + ot) = p;
        p.x = pack2(VV[nt][0], VV[nt][1]); p.y = pack2(VV[nt][2], VV[nt][3]); *(uint2*)(R1 + 2048 + ot) = p;
        p.x = pack2(BT[nt][0], BT[nt][1]); p.y = pack2(BT[nt][2], BT[nt][3]); *(uint2*)(R1 + 4096 + ot) = p;
        p.x = pack2(ET[nt][0], ET[nt][1]); p.y = pack2(ET[nt][2], ET[nt][3]); *(uint2*)(R1 + 6144 + ot) = p;
    }
    const f32x4 z4 = {0.f, 0.f, 0.f, 0.f};
#define RM_(X, ks) (*(const bf16x8*)(R0 + (X) + c * 128 + (ks) * 64 + g * 16))
#define TR_(base, tile) ldpad8((base) + (16 * (tile) + c) * 32, g)
#define MM_(off) ldpad8(R0 + (off) + c * 32, g)
    f32x4 Am = z4, Bmm = z4, Grb = z4, Grk = z4;
#pragma unroll
    for (int ks = 0; ks < 2; ++ks) {
        const bf16x8 kh = RM_(0, ks), rh = RM_(2048, ks), bh = RM_(4096, ks), eh = RM_(6144, ks);
        Am = __builtin_amdgcn_mfma_f32_16x16x32_bf16(kh, bh, Am, 0, 0, 0);
        Bmm = __builtin_amdgcn_mfma_f32_16x16x32_bf16(kh, eh, Bmm, 0, 0, 0);
        Grb = __builtin_amdgcn_mfma_f32_16x16x32_bf16(rh, bh, Grb, 0, 0, 0);
        Grk = __builtin_amdgcn_mfma_f32_16x16x32_bf16(rh, eh, Grk, 0, 0, 0);
    }
#pragma unroll
    for (int r = 0; r < 4; ++r) {
        const int t = 4 * g + r;
        if (c >= t) { Am[r] = 0.f; Bmm[r] = 0.f; }
        if (c > t) { Grb[r] = 0.f; Grk[r] = 0.f; }
    }
    asm volatile("s_waitcnt lgkmcnt(0)" ::: "memory");
    float* Af = (float*)(R0 + 2048);
#pragma unroll
    for (int r = 0; r < 4; ++r) Af[(4 * g + r) * 16 + c] = Am[r];
    asm volatile("s_waitcnt lgkmcnt(0)" ::: "memory");
    float Tc[16];
#pragma unroll
    for (int t = 0; t < 16; ++t) {
        float acc = (t == c) ? 1.0f : 0.0f, acc2 = 0.0f;
#pragma unroll
        for (int s_ = 0; s_ < t; ++s_) { if (s_ & 1) acc2 -= Af[t * 16 + s_] * Tc[s_]; else acc -= Af[t * 16 + s_] * Tc[s_]; }
        Tc[t] = acc + acc2;
    }
    asm volatile("s_waitcnt lgkmcnt(0)" ::: "memory");
#pragma unroll
    for (int t = 0; t < 16; ++t) *(bfu*)(R0 + t * 32 + c * 2) = f2bf(Tc[t]);
#pragma unroll
    for (int r = 0; r < 4; ++r) {
        const int o = (4 * g + r) * 32 + c * 2;
        *(bfu*)(R0 + 512 + o) = f2bf(Bmm[r]); *(bfu*)(R0 + 1024 + o) = f2bf(Grb[r]); *(bfu*)(R0 + 1536 + o) = f2bf(Grk[r]);
    }
    asm volatile("s_waitcnt lgkmcnt(0)" ::: "memory");
    const bf16x8 mT = MM_(0), mBm = MM_(512), mGrb = MM_(1024), mGrk = MM_(1536);
    const bf16x8 mNGrb = neg8(mGrb);
    char* W1T = R0 + 2048; char* UvT = R0 + 4096; char* BmVT = R0 + 6144;
#pragma unroll
    for (int nt = 0; nt < 4; ++nt) {
        const f32x4 x = __builtin_amdgcn_mfma_f32_16x16x32_bf16(mBm, TR_(R1 + 2048, nt), z4, 0, 0, 0);
        *(uint2*)(BmVT + (16 * nt + c) * 32 + 8 * g) = pack4(x);
        const f32x4 w1 = __builtin_amdgcn_mfma_f32_16x16x32_bf16(mT, TR_(R1, nt), z4, 0, 0, 0);
        {
            const int pos = kperm(16 * nt + c);
            const int fo = ((pos >> 5) * 512 + ((pos >> 3) & 3) * 128 + (pos & 7)) * 2;
#pragma unroll
            for (int r = 0; r < 4; ++r) { *(bfu*)(W1T + fo + (4 * g + r) * 16) = f2bf(w1[r]); *(bfu*)(UvT + fo + (4 * g + r) * 16) = f2bf(RH[nt][r]); }
        }
    }
    asm volatile("s_waitcnt lgkmcnt(0)" ::: "memory");
    {
        bfu* W1P = (bfu*)(ws + WS_CW1) + (size_t)cid * 1024 + lane * 8;
        bfu* RHP = (bfu*)(ws + WS_CRH) + (size_t)cid * 1024 + lane * 8;
        *(uint4*)(W1P) = *(const uint4*)(W1T + lane * 16); *(uint4*)(W1P + 512) = *(const uint4*)(W1T + 1024 + lane * 16);
        *(uint4*)(RHP) = *(const uint4*)(UvT + lane * 16); *(uint4*)(RHP + 512) = *(const uint4*)(UvT + 1024 + lane * 16);
    }
#pragma unroll
    for (int nt = 0; nt < 4; ++nt) {
        const f32x4 uv = __builtin_amdgcn_mfma_f32_16x16x32_bf16(mT, TR_(BmVT, nt), z4, 0, 0, 0);
        *(uint2*)((bfu*)(ws + WS_CUV) + (size_t)cid * 1024 + nt * 256 + lane * 4) = pack4(uv);
        uint2 pv; pv.x = pack2(VV[nt][0], VV[nt][1]); pv.y = pack2(VV[nt][2], VV[nt][3]);
        *(uint2*)((bfu*)(ws + WS_CV) + (size_t)cid * 1024 + nt * 256 + lane * 4) = pv;
        uint4 eb; eb.x = pack2(ET[nt][0], ET[nt][1]); eb.y = pack2(ET[nt][2], ET[nt][3]); eb.z = pack2(BT[nt][0], BT[nt][1]); eb.w = pack2(BT[nt][2], BT[nt][3]);
        *(uint4*)((bfu*)(ws + WS_CEB) + (size_t)cid * 2048 + nt * 512 + lane * 8) = eb;
        if (g == 0) ((bfu*)(ws + WS_CPC))[(size_t)cid * 64 + (c >> 2) * 16 + nt * 4 + (c & 3)] = f2bf(PC[nt]);
    }
    {
        const uint2 gk = *(const uint2*)(R0 + 1536 + c * 32 + 8 * g), gb = *(const uint2*)(R0 + 1024 + c * 32 + 8 * g);
        *(uint4*)((bfu*)(ws + WS_CG) + (size_t)cid * 512 + lane * 8) = make_uint4(gk.x, gk.y, gb.x, gb.y);
    }
    asm volatile("s_waitcnt lgkmcnt(0)" ::: "memory");
#undef RM_
#undef TR_
#undef MM_
}

constexpr int CS_W1 = 0, CS_RH = 2048, CS_EB = 4096, CS_G = 8192, CS_UV = 9216, CS_V = 11264, CS_PC = 13312, CS_SLOT = 13568, CS_D = 8;
__device__ __forceinline__ void chain_dma(unsigned char* ws, LAS unsigned char* slot, size_t cid, int w4, int lane) {
#pragma unroll
    for (int q = 0; q < 4; ++q) {
        const int p = w4 + 4 * q;
        const char* src; int dst; bool on = true;
        if (p < 2) { src = (const char*)(ws + WS_CW1) + cid * 2048 + p * 1024; dst = CS_W1 + p * 1024; }
        else if (p < 4) { src = (const char*)(ws + WS_CRH) + cid * 2048 + (p - 2) * 1024; dst = CS_RH + (p - 2) * 1024; }
        else if (p < 8) { src = (const char*)(ws + WS_CEB) + cid * 4096 + (p - 4) * 1024; dst = CS_EB + (p - 4) * 1024; }
        else if (p < 9) { src = (const char*)(ws + WS_CG) + cid * 1024; dst = CS_G; }
        else if (p < 11) { src = (const char*)(ws + WS_CUV) + cid * 2048 + (p - 9) * 1024; dst = CS_UV + (p - 9) * 1024; }
        else if (p < 13) { src = (const char*)(ws + WS_CV) + cid * 2048 + (p - 11) * 1024; dst = CS_V + (p - 11) * 1024; }
        else if (p < 14) { src = (const char*)(ws + WS_CPC) + cid * 128; dst = CS_PC; on = (lane < 8); }
        else continue;
        if (on) __builtin_amdgcn_global_load_lds((const unsigned*)(src + lane * 16), (LAS unsigned*)(slot + dst), 16, 0, 0);
    }
}
__device__ __forceinline__ void chunk_chain_blk(const Args& a, unsigned char* ws, int l, int seq, char* smem, int tid) {
    const int wave = tid >> 6, lane = tid & 63, g = lane >> 4, c = lane & 15;
    const int d = seq & 1, h = (seq >> 1) & 7, b = seq >> 4;
    const int nt = wave & 3;
    const int wvu = __builtin_amdgcn_readfirstlane(wave);
    const int w4u = wvu & 3;
    LAS unsigned char* ring = (LAS unsigned char*)smem;
    const size_t cbase = (size_t)seq * NCK;
    float* Y = (float*)(ws + WS_Y) + (size_t)d * NT * 512 + h * 64 + 16 * nt + c;
    f32x4 Z[4];
#pragma unroll
    for (int mt = 0; mt < 4; ++mt) Z[mt] = (f32x4){0.f, 0.f, 0.f, 0.f};
    __syncthreads();
    if (wvu >= 4) {
        for (int k = 0; k < CS_D - 1; ++k) chain_dma(ws, ring + k * CS_SLOT, cbase + k, w4u, lane);
        asm volatile("s_waitcnt vmcnt(18)" ::: "memory");
    }
    __builtin_amdgcn_s_barrier();
    for (int ck = 0; ck < NCK; ++ck) {
        if (wvu >= 4) {
            if (ck + CS_D - 1 < NCK) chain_dma(ws, ring + ((ck + CS_D - 1) % CS_D) * CS_SLOT, cbase + ck + CS_D - 1, w4u, lane);
            if (ck + CS_D - 1 < NCK) asm volatile("s_waitcnt vmcnt(18)" ::: "memory"); else asm volatile("s_waitcnt vmcnt(0)" ::: "memory");
        } else {
            const LAS unsigned char* sl = ring + (ck % CS_D) * CS_SLOT;
            bf16x8 zb[2];
#pragma unroll
            for (int s_ = 0; s_ < 2; ++s_) {
                union { unsigned u[4]; bf16x8 v; } t;
                t.u[0] = pack2(Z[2 * s_][0], Z[2 * s_][1]); t.u[1] = pack2(Z[2 * s_][2], Z[2 * s_][3]);
                t.u[2] = pack2(Z[2 * s_ + 1][0], Z[2 * s_ + 1][1]); t.u[3] = pack2(Z[2 * s_ + 1][2], Z[2 * s_ + 1][3]);
                zb[s_] = t.v;
            }
            const u32x2_t uvq = *(const LAS u32x2_t*)(sl + CS_UV + nt * 512 + lane * 8);
            const u32x2_t vvq = *(const LAS u32x2_t*)(sl + CS_V + nt * 512 + lane * 8);
            f32x4 u = {-bflo(uvq.x), -bfhi(uvq.x), -bflo(uvq.y), -bfhi(uvq.y)};
            u = __builtin_amdgcn_mfma_f32_16x16x32_bf16(neg8(*(const LAS bf16x8*)(sl + CS_W1 + lane * 16)), zb[0], u, 0, 0, 0);
            u = __builtin_amdgcn_mfma_f32_16x16x32_bf16(neg8(*(const LAS bf16x8*)(sl + CS_W1 + 1024 + lane * 16)), zb[1], u, 0, 0, 0);
            f32x4 y = {0.f, 0.f, 0.f, 0.f};
            y = __builtin_amdgcn_mfma_f32_16x16x32_bf16(*(const LAS bf16x8*)(sl + CS_RH + lane * 16), zb[0], y, 0, 0, 0);
            y = __builtin_amdgcn_mfma_f32_16x16x32_bf16(*(const LAS bf16x8*)(sl + CS_RH + 1024 + lane * 16), zb[1], y, 0, 0, 0);
            union { unsigned q[4]; bf16x8 v; } b2; b2.q[0] = vvq.x; b2.q[1] = vvq.y; b2.q[2] = pack2(u[0], u[1]); b2.q[3] = pack2(u[2], u[3]);
            y = __builtin_amdgcn_mfma_f32_16x16x32_bf16(*(const LAS bf16x8*)(sl + CS_G + lane * 16), b2.v, y, 0, 0, 0);
            const u32x4_t pq0 = *(const LAS u32x4_t*)(sl + CS_PC + g * 32), pq1 = *(const LAS u32x4_t*)(sl + CS_PC + g * 32 + 16);
#pragma unroll
            for (int mt = 0; mt < 4; ++mt) {
                const u32x4_t pq = (mt < 2) ? pq0 : pq1;
                const unsigned p01 = (mt & 1) ? pq.z : pq.x, p23 = (mt & 1) ? pq.w : pq.y;
                const f32x4 zi = {Z[mt][0] * bflo(p01), Z[mt][1] * bfhi(p01), Z[mt][2] * bflo(p23), Z[mt][3] * bfhi(p23)};
                Z[mt] = __builtin_amdgcn_mfma_f32_16x16x32_bf16(*(const LAS bf16x8*)(sl + CS_EB + mt * 1024 + lane * 16), b2.v, zi, 0, 0, 0);
            }
            if ((l == 0) || (ck >= CTX / CK)) {
#pragma unroll
                for (int r = 0; r < 4; ++r) Y[((size_t)b * TB + scan_tok(d, ck * CK + 4 * g + r)) * 512] = y[r];
            }
            asm volatile("s_waitcnt lgkmcnt(0)" ::: "memory");
        }
        __builtin_amdgcn_s_barrier();
    }
    asm volatile("s_waitcnt vmcnt(0)" ::: "memory");
    __syncthreads();
}

__device__ __forceinline__ void phase_chunkpre(const Args& a, int l, char* smem, int tid, int bid, int nb) {
    unsigned char* ws = wsp(a);
    const int wave = tid >> 6, lane = tid & 63;
    char* L = smem + wave * 16384;
    for (int cid = bid * NW + wave; cid < NCHUNK; cid += nb * NW) chunk_pre(a, ws, l, cid, L, lane);
}
__device__ __forceinline__ void phase_mix(const Args& a, int l, char* smem, int tid, int bid, int nb) {
    unsigned char* ws = wsp(a);
    const int wave = tid >> 6, lane = tid & 63;
    for (int seq = bid; seq < 128; seq += nb) chunk_chain_blk(a, ws, l, seq, smem, tid);
    if (bid >= 128 || nb <= 128) {
        const int nconv = (nb > 128) ? (nb - 128) * NW : nb * NW;
        const int me = (nb > 128) ? ((bid - 128) * NW + wave) : (bid * NW + wave);
        for (int j = me; j < 6144; j += nconv) {
            const int t = (j / 192) * 768 + 512 + 64 + (j % 192);
            cvt_expert_tile(a, ws, l, t, 0, lane); cvt_expert_tile(a, ws, l, t, 1, lane);
        }
    }
    const int n_attn = (l == 0) ? 576 : 512;
    int* qctr = (int*)(ws + CNT_OFF + 1024) + l * 64;
    int* qsl = (int*)(smem + LDS_MAIN + 448);
    for (;;) {
        __syncthreads();
        if (tid == 0) *qsl = atomicAdd(qctr, 1);
        __syncthreads();
        const int it = __builtin_amdgcn_readfirstlane(*qsl);
        if (it >= n_attn) break;
        attn_item2(a, l, it, smem, tid);
    }
}

__device__ __forceinline__ void phase_post(const Args& a, int l, int tid, int bid, int nb) {
    unsigned char* ws = wsp(a);
    const int wave = tid >> 6, lane = tid & 63;
    const float* Y0 = (const float*)(ws + WS_Y);
    const float* Y1 = Y0 + (size_t)NT * 512;
    const bfu* RR = (const bfu*)(ws + WS_RR);
    const bfu* RV = (const bfu*)(ws + WS_RV);
    const bfu* RKp = (const bfu*)(ws + WS_RK);
    const bfu* AV0 = (const bfu*)(ws + WS_BV);
    const bfu* AV1 = AV0 + (size_t)NT * 512;
    const float* kap = a.in[21] + l * 512;
    const bfu* GG = (const bfu*)(ws + WS_GG);
    bfu* ORW = (bfu*)(ws + WS_ODA) + (size_t)2 * NT * 512;
    const float* lg = a.in[23] + l * 512;
    const float* lb = a.in[24] + l * 512;
    const float* rk = a.in[22] + l * 512;
    for (int row = bid * NW + wave; row < NT; row += nb * NW) {
        const int t = row % TB;
        if (l == 1 && t >= SEQ) continue;
        const size_t o = (size_t)row * 512 + lane * 8;
        float y[8];
        {
            const float4 a0 = *(const float4*)(Y0 + o), a1 = *(const float4*)(Y0 + o + 4);
            const float4 b0 = *(const float4*)(Y1 + o), b1 = *(const float4*)(Y1 + o + 4);
            y[0] = a0.x + b0.x; y[1] = a0.y + b0.y; y[2] = a0.z + b0.z; y[3] = a0.w + b0.w;
            y[4] = a1.x + b1.x; y[5] = a1.y + b1.y; y[6] = a1.z + b1.z; y[7] = a1.w + b1.w;
        }
        float s = 0.f;
#pragma unroll
        for (int e = 0; e < 8; ++e) s += y[e];
        s += shx_(s, 1); s += shx_(s, 2); s += shx_(s, 4);
        const float mu = s * (1.0f / 64.0f);
        float vs = 0.f;
#pragma unroll
        for (int e = 0; e < 8; ++e) { const float dlt = y[e] - mu; vs += dlt * dlt; }
        vs += shx_(vs, 1); vs += shx_(vs, 2); vs += shx_(vs, 4);
        const float rstd = rsqrtf(vs * (1.0f / 64.0f) + 64e-5f);
        const uint4 pr = *(const uint4*)(RR + o), pv = *(const uint4*)(RV + o), pk0 = *(const uint4*)(AV0 + o), pk1 = *(const uint4*)(AV1 + o), pg = *(const uint4*)(GG + o), pkk = *(const uint4*)(RKp + o);
        const float r8[8] = {bflo(pr.x), bfhi(pr.x), bflo(pr.y), bfhi(pr.y), bflo(pr.z), bfhi(pr.z), bflo(pr.w), bfhi(pr.w)};
        const float v8[8] = {bflo(pv.x), bfhi(pv.x), bflo(pv.y), bfhi(pv.y), bflo(pv.z), bfhi(pv.z), bflo(pv.w), bfhi(pv.w)};
        const float as8[8] = {bflo(pk0.x) + bflo(pk1.x), bfhi(pk0.x) + bfhi(pk1.x), bflo(pk0.y) + bflo(pk1.y), bfhi(pk0.y) + bfhi(pk1.y),
                              bflo(pk0.z) + bflo(pk1.z), bfhi(pk0.z) + bfhi(pk1.z), bflo(pk0.w) + bflo(pk1.w), bfhi(pk0.w) + bfhi(pk1.w)};
        const float kr8[8] = {bflo(pkk.x), bfhi(pkk.x), bflo(pkk.y), bfhi(pkk.y), bflo(pkk.z), bfhi(pkk.z), bflo(pkk.w), bfhi(pkk.w)};
        float k8[8];
#pragma unroll
        for (int e = 0; e < 8; ++e) k8[e] = kr8[e] * (2.0f + (as8[e] - 2.0f) * kap[lane * 8 + e]);
        const float g8[8] = {bflo(pg.x), bfhi(pg.x), bflo(pg.y), bfhi(pg.y), bflo(pg.z), bfhi(pg.z), bflo(pg.w), bfhi(pg.w)};
        float ds = 0.f;
#pragma unroll
        for (int e = 0; e < 8; ++e) ds += r8[e] * k8[e] * rk[lane * 8 + e];
        ds += shx_(ds, 1); ds += shx_(ds, 2); ds += shx_(ds, 4);
        float ov[8];
#pragma unroll
        for (int e = 0; e < 8; ++e) ov[e] = ((y[e] - mu) * rstd * lg[lane * 8 + e] + lb[lane * 8 + e] + ds * v8[e]) * g8[e];
        uint4 po; po.x = pack2(ov[0], ov[1]); po.y = pack2(ov[2], ov[3]); po.z = pack2(ov[4], ov[5]); po.w = pack2(ov[6], ov[7]);
        *(uint4*)(ORW + o) = po;
    }
}

__device__ __forceinline__ void phase_merge(const Args& a, int l, char* smem, int tid, int bid, int nb) {
    unsigned char* ws = wsp(a);
    const int wave = tid >> 6, lane = tid & 63, wm = wave >> 1, wn = wave & 1, g = lane >> 4, c = lane & 15;
    const bfu* GL = (const bfu*)(ws + WS_GL);
    bfu* MB = (bfu*)(ws + WS_MB);
    for (int it = bid; it < 72 * 16; it += nb) {
        const int mt = it >> 4, nt = it & 15;
        if (l == 1 && (mt % 9) == 8) continue;
        const int m0 = mt * 256, n0 = nt * 64;
        int arow[4]; ident_rows(arow, m0, tid);
        const int rowbase = m0 + wm * 64, colbase = n0 + wn * 32;
        f32x4 tot[4][2]; zero_acc<2>(tot);
        for (int n = 0; n < 3; ++n) {
            f32x4 acc[4][2]; zero_acc<2>(acc);
            gemm_loop<2>(acc, (const bfu*)(ws + WS_ODA) + (size_t)n * NT * 512, 512, arow,
                         (const bfu*)(ws + WS_WBT) + (size_t)(l * 3 + n) * 1024 * 512, 512, n0, 512, smem, tid);
#pragma unroll
            for (int mi = 0; mi < 4; ++mi)
#pragma unroll
                for (int ni = 0; ni < 2; ++ni)
#pragma unroll
                    for (int r = 0; r < 4; ++r) {
                        const int row = rowbase + mi * 16 + g * 4 + r;
                        const float gate = bf2f(GL[(size_t)row * 3072 + n * 1024 + colbase + ni * 16 + c]);
                        tot[mi][ni][r] += gate * acc[mi][ni][r];
                    }
        }
#pragma unroll
        for (int mi = 0; mi < 4; ++mi)
#pragma unroll
            for (int ni = 0; ni < 2; ++ni)
#pragma unroll
                for (int r = 0; r < 4; ++r) {
                    const int row = rowbase + mi * 16 + g * 4 + r;
                    MB[(size_t)row * 1024 + colbase + ni * 16 + c] = f2bf(tot[mi][ni][r]);
                }
    }
}

__device__ __forceinline__ void phase_wout(const Args& a, int l, char* smem, int tid, int bid, int nb) {
    unsigned char* ws = wsp(a);
    const int wave = tid >> 6, lane = tid & 63, wm = wave >> 1, wn = wave & 1, g = lane >> 4, c = lane & 15;
    float* xres = (float*)(ws + WS_XRES);
    const float* mod = (const float*)(ws + WS_MOD);
    for (int it = bid; it < 72 * 8; it += nb) {
        const int mt = it >> 3, nt = it & 7;
        if (l == 1 && (mt % 9) == 8) continue;
        const int m0 = mt * 256, n0 = nt * 128;
        int arow[4]; ident_rows(arow, m0, tid);
        f32x4 acc[4][4]; zero_acc<4>(acc);
        gemm_loop<4>(acc, (const bfu*)(ws + WS_MB), 1024, arow, (const bfu*)(ws + WS_WOT) + (size_t)l * 1024 * 1024, 1024, n0, 1024, smem, tid);
        const int rowbase = m0 + wm * 64, colbase = n0 + wn * 64;
        const int b = m0 / TB, m = ((m0 % TB) < SEQ) ? b : 8;
        const float* ga = mod + (size_t)(l * 9 + m) * 6144 + 2 * 1024;
#pragma unroll
        for (int ni = 0; ni < 4; ++ni) {
            const int col = colbase + ni * 16 + c;
            const float gac = ga[col];
#pragma unroll
            for (int mi = 0; mi < 4; ++mi)
#pragma unroll
                for (int r = 0; r < 4; ++r) {
                    const int row = rowbase + mi * 16 + g * 4 + r;
                    xres[(size_t)row * 1024 + col] += gac * acc[mi][ni][r];
                }
        }
    }
}

__device__ __forceinline__ void phase_topk(const Args& a, int l, char* smem, int tid, int bid, int nb) {
    unsigned char* ws = wsp(a);
    const float* LG = (const float*)(ws + WS_LOG);
    int* cnt = (int*)(ws + CNT_OFF) + l * 32;
    int* TOKL = (int*)(ws + WS_TOKL);
    float* GATE = (float*)(ws + WS_GATE);
    int* lcnt = (int*)smem;
    int* lbase = lcnt + 32;
    for (int blk = bid; blk < NT / NTHREADS; blk += nb) {
        const int row = blk * NTHREADS + tid;
        const int t = row % TB;
        const bool active = !(l == 1 && t >= SEQ);
        __syncthreads();
        if (tid < 32) lcnt[tid] = 0;
        __syncthreads();
        int ei[4] = {0, 0, 0, 0}; float ev[4] = {0.f, 0.f, 0.f, 0.f}; int lr[4] = {0, 0, 0, 0};
        if (active) {
            float v[32];
#pragma unroll
            for (int q = 0; q < 8; ++q) {
                const float4 x4 = *(const float4*)(LG + (size_t)row * 32 + q * 4);
                v[q * 4] = x4.x; v[q * 4 + 1] = x4.y; v[q * 4 + 2] = x4.z; v[q * 4 + 3] = x4.w;
            }
#pragma unroll
            for (int k = 0; k < 4; ++k) {
                float best = -3.0e38f; int bi = 0;
#pragma unroll
                for (int e = 0; e < 32; ++e) { const bool tk = v[e] > best; best = tk ? v[e] : best; bi = tk ? e : bi; }
                ei[k] = bi; ev[k] = best;
#pragma unroll
                for (int e = 0; e < 32; ++e) v[e] = (e == bi) ? -3.0e38f : v[e];
            }
            const float e1 = __expf(ev[1] - ev[0]), e2 = __expf(ev[2] - ev[0]), e3 = __expf(ev[3] - ev[0]);
            const float inv = 1.0f / (1.0f + e1 + e2 + e3);
            ev[0] = inv; ev[1] = e1 * inv; ev[2] = e2 * inv; ev[3] = e3 * inv;
#pragma unroll
            for (int k = 0; k < 4; ++k) lr[k] = atomicAdd(&lcnt[ei[k]], 1);
        }
        __syncthreads();
        if (tid < 32) lbase[tid] = (lcnt[tid] > 0) ? atomicAdd(&cnt[tid], lcnt[tid]) : 0;
        __syncthreads();
        if (active) {
#pragma unroll
            for (int k = 0; k < 4; ++k) {
                const int pos = lbase[ei[k]] + lr[k];
                const int id = row * 4 + k;
                TOKL[(size_t)ei[k] * NT + pos] = id;
                ((float*)(ws + WS_GATEL))[(size_t)ei[k] * NT + pos] = ev[k];
            }
        }
    }
}

__device__ __forceinline__ void expert_prefix(const Args& a, int l, int* sm, int tid) {
    const int* cnt = (const int*)(wsp(a) + CNT_OFF) + l * 32;
    __syncthreads();
    if (tid == 0) {
        int tp = 0, rp = 0;
        for (int e = 0; e < 32; ++e) {
            const int cn = cnt[e];
            sm[e] = cn; sm[32 + e] = tp; sm[65 + e] = rp;
            tp += (cn + 255) >> 8; rp += cn;
        }
        sm[64] = tp; sm[97] = rp;
    }
    __syncthreads();
}

__device__ __forceinline__ void phase_gemm1(const Args& a, int l, char* smem, int tid, int bid, int nb) {
    unsigned char* ws = wsp(a);
    int* pre = (int*)(smem + LDS_MAIN);
    expert_prefix(a, l, pre, tid);
    const int wave = tid >> 6, lane = tid & 63, wm = wave >> 1, wn = wave & 1, g = lane >> 4, c = lane & 15;
    const int ntiles = pre[64] * 16;
    const int* TOKL = (const int*)(ws + WS_TOKL);
    const bfu* HI = (const bfu*)(ws + WS_H2HI);
    bfu* ACT = (bfu*)(ws + WS_ACT);
    for (int it = bid; it < ntiles; it += nb) {
        const int tix = it >> 4, nt = it & 15;
        int e = 0;
        while (pre[32 + e + 1] <= tix) ++e;
        const int mt = tix - pre[32 + e];
        const int cn = pre[e], rs = pre[65 + e];
        const int* tl = TOKL + (size_t)e * NT;
        int arow[4];
#pragma unroll
        for (int i = 0; i < 4; ++i) {
            int ri = mt * 256 + (tid >> 3) + 64 * i;
            ri = (ri < cn) ? ri : 0;
            arow[i] = tl[ri] >> 2;
        }
        f32x4 acc[4][4]; zero_acc<4>(acc);
        gemm_loop<4>(acc, HI, 1024, arow, (const bfu*)(ws + WS_W1T) + (size_t)(l * 32 + e) * 2048 * 1024, 1024, nt * 128, 1024, smem, tid);
        const float* b1 = a.in[30] + (size_t)(l * 32 + e) * 2048;
#pragma unroll
        for (int p = 0; p < 2; ++p) {
            const int acol = nt * 64 + wn * 32 + p * 16 + c;
            const float bg = b1[acol], bl = b1[1024 + acol];
#pragma unroll
            for (int mi = 0; mi < 4; ++mi)
#pragma unroll
                for (int r = 0; r < 4; ++r) {
                    const int grow = mt * 256 + wm * 64 + mi * 16 + g * 4 + r;
                    if (grow < cn) {
                        const float glu = fminf(acc[mi][2 * p][r] + bg, 7.0f);
                        const float lin = fminf(fmaxf(acc[mi][2 * p + 1][r] + bl, -7.0f), 7.0f);
                        ACT[(size_t)(rs + grow) * 1024 + acol] = f2bf(glu * sigmoidf_(1.702f * glu) * (lin + 1.0f));
                    }
                }
        }
    }
}

__device__ __forceinline__ void phase_gemm2(const Args& a, int l, char* smem, int tid, int bid, int nb) {
    unsigned char* ws = wsp(a);
    int* pre = (int*)(smem + LDS_MAIN);
    expert_prefix(a, l, pre, tid);
    const int wave = tid >> 6, lane = tid & 63, wm = wave >> 1, wn = wave & 1, g = lane >> 4, c = lane & 15;
    const int ntiles = pre[64] * 8;
    const int* TOKL = (const int*)(ws + WS_TOKL);
    const float* GATE = (const float*)(ws + WS_GATE);
    const bfu* ACT = (const bfu*)(ws + WS_ACT);
    bfu* YB = (bfu*)(ws + WS_YB);
    for (int it = bid; it < ntiles; it += nb) {
        const int tix = it >> 3, nt = it & 7;
        int e = 0;
        while (pre[32 + e + 1] <= tix) ++e;
        const int mt = tix - pre[32 + e];
        const int cn = pre[e], rs = pre[65 + e];
        const int* tl = TOKL + (size_t)e * NT;
        int arow[4];
#pragma unroll
        for (int i = 0; i < 4; ++i) {
            int ri = mt * 256 + (tid >> 3) + 64 * i;
            ri = (ri < cn) ? ri : (cn - 1);
            arow[i] = rs + ri;
        }
        f32x4 acc[4][4]; zero_acc<4>(acc);
        gemm_loop<4>(acc, ACT, 1024, arow, (const bfu*)(ws + WS_W2ET) + (size_t)(l * 32 + e) * 1024 * 1024, 1024, nt * 128, 1024, smem, tid);
        const float* b2 = a.in[32] + (size_t)(l * 32 + e) * 1024;
#pragma unroll
        for (int mi = 0; mi < 4; ++mi)
#pragma unroll
            for (int r = 0; r < 4; ++r) {
                const int grow = mt * 256 + wm * 64 + mi * 16 + g * 4 + r;
                if (grow < cn) {
                    const int id = tl[grow];
                    const float gate = GATE[id];
#pragma unroll
                    for (int ni = 0; ni < 4; ++ni) {
                        const int col = nt * 128 + wn * 64 + ni * 16 + c;
                        YB[(size_t)id * 1024 + col] = f2bf((acc[mi][ni][r] + b2[col]) * gate);
                    }
                }
            }
    }
}

struct EpiWout {
    static constexpr bool PERM = true;
    unsigned char* ws; int l;
    __device__ __forceinline__ void operator()(const f32x4 (&acc)[2][2][4][2], const g8::Unit& u, int wr, int wc, int fr, int fq) const {
        bfu* xres = (bfu*)(ws + WS_XRES);
        const int rbase = u.pm * 256;
        const int b = rbase / TB, mm = ((rbase % TB) < SEQ) ? b : 8;
        const float* ga = (const float*)(ws + WS_MOD) + (size_t)(l * 9 + mm) * 6144 + 2 * 1024;
        const int col0 = u.pn * 256 + 32 * wc + 8 * fq;
        f32x4 gv[2][2];
#pragma unroll
        for (int bj = 0; bj < 2; ++bj)
#pragma unroll
            for (int n = 0; n < 2; ++n) gv[bj][n] = *(const f32x4*)(ga + col0 + bj * 128 + n * 4);
#pragma unroll
        for (int ai = 0; ai < 2; ++ai)
#pragma unroll
            for (int m = 0; m < 4; ++m) {
                bfu* rp = xres + (size_t)(rbase + ai * 128 + wr * 64 + m * 16 + fr) * 1024 + col0;
#pragma unroll
                for (int bj = 0; bj < 2; ++bj) {
                    const uint4 xp = *(const uint4*)(rp + bj * 128);
                    f32x4 x0 = {bflo(xp.x), bfhi(xp.x), bflo(xp.y), bfhi(xp.y)}, x1 = {bflo(xp.z), bfhi(xp.z), bflo(xp.w), bfhi(xp.w)};
                    x0 += gv[bj][0] * acc[ai][bj][m][0]; x1 += gv[bj][1] * acc[ai][bj][m][1];
                    const uint2 lo = pack4(x0), hi = pack4(x1);
                    *(uint4*)(rp + bj * 128) = make_uint4(lo.x, lo.y, hi.x, hi.y);
                }
            }
    }
};
__device__ __forceinline__ void phase_wout8(const Args& a, int l, char* smem, int tid, int bid, int nb) {
    SchedDense S;
    S.A = (const char*)(wsp(a) + WS_GL); S.B = (const char*)(wsp(a) + WS_WOT) + (size_t)l * 1024 * 3072 * 2;
    S.lda = 3072; S.ldb = 3072; S.nM = 64; S.nN = 4; S.G = nb; S.c = bid; S.skip9 = 1;
    EpiWout E; E.ws = wsp(a); E.l = l;
    g8::gemm8((LAS unsigned char*)smem, S, E, 1024, tid);
    if (l == 0) {
        unsigned char* ws = wsp(a);
        const int wave = tid >> 6, lane = tid & 63, wm = wave >> 1, wn = wave & 1, g = lane >> 4, c = lane & 15;
        bfu* xres = (bfu*)(ws + WS_XRES);
        const float* ga = (const float*)(ws + WS_MOD) + (size_t)(l * 9 + 8) * 6144 + 2 * 1024;
        __syncthreads();
        for (int it = bid; it < 128; it += nb) {
            const int mt = (it >> 4) * 9 + 8, nt = it & 15;
            const int m0 = mt * 256, n0 = nt * 64;
            int arow[4]; ident_rows(arow, m0, tid);
            f32x4 acc[4][2]; zero_acc<2>(acc);
            gemm_loop<2>(acc, (const bfu*)(ws + WS_MB), 1024, arow, (const bfu*)(ws + WS_WOT) + (size_t)l * 1024 * 3072, 3072, n0, 1024, smem, tid);
            const int rowbase = m0 + wm * 64, colbase = n0 + wn * 32;
#pragma unroll
            for (int ni = 0; ni < 2; ++ni) {
                const int col = colbase + ni * 16 + c;
                const float gac = ga[col];
#pragma unroll
                for (int mi = 0; mi < 4; ++mi)
#pragma unroll
                    for (int r = 0; r < 4; ++r) {
                        const int row = rowbase + mi * 16 + g * 4 + r;
                        xres[(size_t)row * 1024 + col] = f2bf(bf2f(xres[(size_t)row * 1024 + col]) + gac * acc[mi][ni][r]);
                    }
            }
        }
    }
}

struct SchedMerge {
    static constexpr bool GATHER = false;
    unsigned char* ws; int l, lda, ldb, nM, G, c, skip9;
    __device__ __forceinline__ bool next(int i, g8::Unit& u) const {
        const int j = i / 3, n = g8::uni(i - 3 * j);
        int pm, pn; if (!g8::static_tile(j, G, c, nM, 4, pm, pn)) return false;
        if (skip9) pm += pm >> 3;
        pm = g8::uni(pm); pn = g8::uni(pn);
        u.pm = pm; u.pn = pn; u.e = n; u.cn = 0;
        u.A = (const char*)(ws + WS_ODA) + ((size_t)n * NT * 512 + (size_t)pm * 256 * 512) * 2;
        u.B = (const char*)(ws + WS_WBT) + ((size_t)(l * 3 + n) * 1024 * 512 + (size_t)pn * 256 * 512) * 2;
        return true;
    }
    __device__ __forceinline__ void rows(const g8::Unit&, int, int&) const {}
};
struct EpiMerge {
    static constexpr bool PERM = true;
    unsigned char* ws;
    __device__ __forceinline__ void operator()(const f32x4 (&acc)[2][2][4][2], const g8::Unit& u, int wr, int wc, int fr, int fq) const {
        bfu* GL = (bfu*)(ws + WS_GL);
        const int col0 = u.pn * 256 + 32 * wc + 8 * fq;
        const int go = u.e * 1024;
        const bool first = (u.e == 0);
#pragma unroll
        for (int ai = 0; ai < 2; ++ai)
#pragma unroll
            for (int m = 0; m < 4; ++m) {
                bfu* rp = GL + (size_t)(u.pm * 256 + ai * 128 + wr * 64 + m * 16 + fr) * 3072 + col0;
#pragma unroll
                for (int bj = 0; bj < 2; ++bj) {
                    const uint4 gp = *(const uint4*)(rp + go + bj * 128);
                    uint4 zp = make_uint4(0u, 0u, 0u, 0u);
                    if (!first) zp = *(const uint4*)(rp + bj * 128);
                    f32x4 v0 = acc[ai][bj][m][0], v1 = acc[ai][bj][m][1];
                    v0[0] = v0[0] * bflo(gp.x) + bflo(zp.x); v0[1] = v0[1] * bfhi(gp.x) + bfhi(zp.x); v0[2] = v0[2] * bflo(gp.y) + bflo(zp.y); v0[3] = v0[3] * bfhi(gp.y) + bfhi(zp.y);
                    v1[0] = v1[0] * bflo(gp.z) + bflo(zp.z); v1[1] = v1[1] * bfhi(gp.z) + bfhi(zp.z); v1[2] = v1[2] * bflo(gp.w) + bflo(zp.w); v1[3] = v1[3] * bfhi(gp.w) + bfhi(zp.w);
                    const uint2 lo = pack4(v0), hi = pack4(v1);
                    *(uint4*)(rp + bj * 128) = make_uint4(lo.x, lo.y, hi.x, hi.y);
                }
            }
    }
};
__device__ __forceinline__ void phase_merge8(const Args& a, int l, char* smem, int tid, int bid, int nb) {
    SchedMerge S; S.ws = wsp(a); S.l = l; S.lda = 512; S.ldb = 512; S.nM = 64; S.G = nb; S.c = bid; S.skip9 = 1;
    EpiMerge E; E.ws = wsp(a);
    g8::gemm8((LAS unsigned char*)smem, S, E, 512, tid);
    if (l == 0) {
        unsigned char* ws = wsp(a);
        const int wave = tid >> 6, lane = tid & 63, wm = wave >> 1, wn = wave & 1, g = lane >> 4, c = lane & 15;
        const bfu* GL = (const bfu*)(ws + WS_GL);
        bfu* MB = (bfu*)(ws + WS_MB);
        __syncthreads();
        for (int it = bid; it < 128; it += nb) {
            const int mt = (it >> 4) * 9 + 8, nt = it & 15;
            const int m0 = mt * 256, n0 = nt * 64;
            int arow[4]; ident_rows(arow, m0, tid);
            const int rowbase = m0 + wm * 64, colbase = n0 + wn * 32;
            f32x4 tot[4][2]; zero_acc<2>(tot);
            for (int n = 0; n < 3; ++n) {
                f32x4 acc[4][2]; zero_acc<2>(acc);
                gemm_loop<2>(acc, (const bfu*)(ws + WS_ODA) + (size_t)n * NT * 512, 512, arow,
                             (const bfu*)(ws + WS_WBT) + (size_t)(l * 3 + n) * 1024 * 512, 512, n0, 512, smem, tid);
#pragma unroll
                for (int mi = 0; mi < 4; ++mi)
#pragma unroll
                    for (int ni = 0; ni < 2; ++ni)
#pragma unroll
                        for (int r = 0; r < 4; ++r) {
                            const int row = rowbase + mi * 16 + g * 4 + r;
                            const float gate = bf2f(GL[(size_t)row * 3072 + n * 1024 + colbase + ni * 16 + c]);
                            tot[mi][ni][r] += gate * acc[mi][ni][r];
                        }
            }
#pragma unroll
            for (int mi = 0; mi < 4; ++mi)
#pragma unroll
                for (int ni = 0; ni < 2; ++ni)
#pragma unroll
                    for (int r = 0; r < 4; ++r) {
                        const int row = rowbase + mi * 16 + g * 4 + r;
                        MB[(size_t)row * 1024 + colbase + ni * 16 + c] = f2bf(tot[mi][ni][r]);
                    }
        }
    }
}

constexpr int N2_RPW = 9;
#ifndef N2_SWAP16
#define N2_SWAP16 1
#endif
__device__ __forceinline__ float rowmax16(float x) {
    x = fmaxf(x, dppf<0xB1>(x)); x = fmaxf(x, dppf<0x4E>(x)); x = fmaxf(x, dppf<0x124>(x)); x = fmaxf(x, dppf<0x128>(x));
    return x;
}
__device__ __forceinline__ void phase_n2rt(const Args& a, int l, char* smem, int tid, int bid, int nb) {
    unsigned char* ws = wsp(a);
    const int wave = tid >> 6, lane = tid & 63;
    float* RT = (float*)smem;
    int* lcnt = (int*)(smem + LDS_MAIN);
    int* lbase = lcnt + 32;
    int* rec_e = (int*)(smem + LDS_MAIN + 512);
    int* rec_r = rec_e + NW * N2_RPW * 4;
    float* rec_g = (float*)(rec_r + NW * N2_RPW * 4);
    const bfu* xres = (const bfu*)(ws + WS_XRES);
    bfu* H = (bfu*)(ws + WS_H);
    const float* mod = (const float*)(ws + WS_MOD);
    int* cnt = (int*)(ws + CNT_OFF) + l * 32;
    int* TOKL = (int*)(ws + WS_TOKL);
    float* GATEL = (float*)(ws + WS_GATEL);
    __syncthreads();
    {
        const float* Rs = a.in[27] + (size_t)l * 1024 * 32;
        for (int idx = tid; idx < 8192; idx += NTHREADS) {
            const int k = idx & 1023, e4 = idx >> 10;
            const float4 r = *(const float4*)(Rs + (size_t)k * 32 + e4 * 4);
            RT[(e4 * 4 + 0) * 1024 + k] = r.x; RT[(e4 * 4 + 1) * 1024 + k] = r.y; RT[(e4 * 4 + 2) * 1024 + k] = r.z; RT[(e4 * 4 + 3) * 1024 + k] = r.w;
        }
    }
    const float bias = a.in[28][l * 32 + (lane >> 1)];
    const int stride = nb * NW;
    const bool b5 = (lane & 32) != 0, b4 = (lane & 16) != 0, b3 = (lane & 8) != 0, b2 = (lane & 4) != 0, b1 = (lane & 2) != 0;
    for (int r0 = bid * NW + wave; r0 - wave - bid * NW < NT; r0 += N2_RPW * stride) {
        __syncthreads();
        if (tid < 32) lcnt[tid] = 0;
        __syncthreads();
        uint2 vn[4];
        if (r0 < NT) {
#pragma unroll
            for (int i = 0; i < 4; ++i) vn[i] = *(const uint2*)(xres + (size_t)r0 * 1024 + i * 256 + lane * 4);
        }
        for (int kk = 0; kk < N2_RPW; ++kk) {
            const int row = r0 + kk * stride;
            if (row >= NT) { if (lane < 4) rec_e[(wave * N2_RPW + kk) * 4 + lane] = -1; continue; }
            const int b = row / TB, t = row % TB;
            float v[16];
#pragma unroll
            for (int i = 0; i < 4; ++i) { v[i * 4 + 0] = bflo(vn[i].x); v[i * 4 + 1] = bfhi(vn[i].x); v[i * 4 + 2] = bflo(vn[i].y); v[i * 4 + 3] = bfhi(vn[i].y); }
            if (kk + 1 < N2_RPW && row + stride < NT) {
#pragma unroll
                for (int i = 0; i < 4; ++i) vn[i] = *(const uint2*)(xres + (size_t)(row + stride) * 1024 + i * 256 + lane * 4);
            }
            if (l == 1 && t >= SEQ) { if (lane < 4) rec_e[(wave * N2_RPW + kk) * 4 + lane] = -1; continue; }
            const int m = (t < SEQ) ? b : 8;
            const float* md = mod + (size_t)(l * 9 + m) * 6144;
            float y[16];
            norm_mod(v, y, a.in[7] + l * 1024, md + 3 * 1024, md + 4 * 1024, lane);
            store_h_row(H + (size_t)row * 1024, y, lane);
            f32x2_t acc2[32];
#pragma unroll
            for (int e = 0; e < 32; ++e) acc2[e] = (f32x2_t){0.f, 0.f};
            {
                const float* rp = RT + lane * 4;
                f32x4 ra[6], rb[6];
#define N2_LD(dst, bt) do { _Pragma("unroll") for (int q = 0; q < 6; ++q) { const int pe = (bt) * 6 + q; if (pe < 128) dst[q] = *(const f32x4*)(rp + (pe & 31) * 1024 + (pe >> 5) * 256); } } while (0)
#define N2_FM(src, bt) do { _Pragma("unroll") for (int q = 0; q < 6; ++q) { const int pe = (bt) * 6 + q; if (pe < 128) { const int e = pe & 31, i_ = pe >> 5; \
                    const f32x2_t y01 = {y[i_ * 4 + 0], y[i_ * 4 + 1]}, y23 = {y[i_ * 4 + 2], y[i_ * 4 + 3]}; const f32x2_t r01 = {src[q][0], src[q][1]}, r23 = {src[q][2], src[q][3]}; \
                    acc2[e] = y01 * r01 + acc2[e]; acc2[e] = y23 * r23 + acc2[e]; } } } while (0)
                N2_LD(ra, 0);
#pragma unroll
                for (int bt = 0; bt < 22; bt += 2) {
                    N2_LD(rb, bt + 1);
                    __builtin_amdgcn_sched_barrier(0);
                    N2_FM(ra, bt);
                    __builtin_amdgcn_sched_barrier(0);
                    if (bt + 2 < 22) N2_LD(ra, bt + 2);
                    __builtin_amdgcn_sched_barrier(0);
                    N2_FM(rb, bt + 1);
                    __builtin_amdgcn_sched_barrier(0);
                }
#undef N2_LD
#undef N2_FM
            }
            float acc[32];
#pragma unroll
            for (int e = 0; e < 32; ++e) acc[e] = acc2[e][0] + acc2[e][1];
            float S[16], U[8], T4[4], W2[2];
#pragma unroll
            for (int j = 0; j < 16; ++j) {
                const auto r = __builtin_amdgcn_permlane32_swap(__float_as_uint(acc[j]), __float_as_uint(acc[16 + j]), false, false);
                S[j] = __uint_as_float(r[0]) + __uint_as_float(r[1]);
            }
#pragma unroll
            for (int j = 0; j < 8; ++j) {
#if N2_SWAP16
                const auto r = __builtin_amdgcn_permlane16_swap(__float_as_uint(S[j]), __float_as_uint(S[8 + j]), false, false);
                U[j] = __uint_as_float(r[0]) + __uint_as_float(r[1]);
#else
                const float keep = b4 ? S[8 + j] : S[j], send = b4 ? S[j] : S[8 + j];
                U[j] = keep + shx_(send, 16);
#endif
            }
#pragma unroll
            for (int j = 0; j < 4; ++j) { const float keep = b3 ? U[4 + j] : U[j], send = b3 ? U[j] : U[4 + j]; T4[j] = keep + dppf<0x128>(send); }
#pragma unroll
            for (int j = 0; j < 2; ++j) { const float keep = b2 ? T4[2 + j] : T4[j], send = b2 ? T4[j] : T4[2 + j]; W2[j] = keep + shx_(send, 4); }
            float X;
            { const float keep = b1 ? W2[1] : W2[0], send = b1 ? W2[0] : W2[1]; X = keep + dppf<0x4E>(send); }
            X += dppf<0xB1>(X);
            float lg = X + bias;
            int ei[4]; float ev[4];
#pragma unroll
            for (int k = 0; k < 4; ++k) {
                const float rm = rowmax16(lg);
                const float m0 = __int_as_float(__builtin_amdgcn_readlane(__float_as_int(rm), 0)), m1 = __int_as_float(__builtin_amdgcn_readlane(__float_as_int(rm), 16));
                const float m2 = __int_as_float(__builtin_amdgcn_readlane(__float_as_int(rm), 32)), m3 = __int_as_float(__builtin_amdgcn_readlane(__float_as_int(rm), 48));
                const float mx = fmaxf(fmaxf(m0, m1), fmaxf(m2, m3));
                const unsigned long long bm = __ballot(lg == mx);
                const int e = (__ffsll((long long)bm) - 1) >> 1;
                ei[k] = e; ev[k] = mx;
                lg = ((lane >> 1) == e) ? -3.0e38f : lg;
            }
            const float e1 = __expf(ev[1] - ev[0]), e2 = __expf(ev[2] - ev[0]), e3 = __expf(ev[3] - ev[0]);
            const float inv = 1.0f / (1.0f + e1 + e2 + e3);
            if (lane < 4) {
                const int es = (lane == 0) ? ei[0] : (lane == 1) ? ei[1] : (lane == 2) ? ei[2] : ei[3];
                const float gs = ((lane == 0) ? 1.0f : (lane == 1) ? e1 : (lane == 2) ? e2 : e3) * inv;
                const int lr = atomicAdd(&lcnt[es], 1);
                const int ro = (wave * N2_RPW + kk) * 4 + lane;
                rec_e[ro] = es; rec_r[ro] = lr; rec_g[ro] = gs;
            }
        }
        __syncthreads();
        if (tid < 32) lbase[tid] = (lcnt[tid] > 0) ? atomicAdd(&cnt[tid], lcnt[tid]) : 0;
        __syncthreads();
        if (lane < N2_RPW * 4) {
            const int kk = lane >> 2, k = lane & 3;
            const int ro = (wave * N2_RPW + kk) * 4 + k;
            const int e = rec_e[ro];
            if (e >= 0) {
                const int row = r0 + kk * stride;
                const int pos = lbase[e] + rec_r[ro];
                TOKL[(size_t)e * NT + pos] = row * 4 + k;
                GATEL[(size_t)e * NT + pos] = rec_g[ro];
            }
        }
    }
}

struct SchedG1 {
    static constexpr bool GATHER = true;
    unsigned char* ws; const int* pre; int l, lda, ldb, G, c; mutable int hint;
    __device__ __forceinline__ bool next(int i, g8::Unit& u) const {
        const int total = pre[64] * 8;
        const long L0 = (long)i * G + c; if (L0 >= total) return false;
        int L = (int)L0; { const int q = total / 8, r = total % 8, xcd = L % 8, off = L / 8; L = (xcd < r ? xcd * (q + 1) : r * (q + 1) + (xcd - r) * q) + off; }
        const int tix = g8::uni(L >> 3), pn = g8::uni(L & 7);
        int e = (pre[32 + hint] <= tix) ? hint : 0; while (pre[32 + e + 1] <= tix) ++e;
        e = g8::uni(e); hint = e;
        u.e = e; u.cn = g8::uni(pre[e]); u.pm = g8::uni(tix - pre[32 + e]); u.pn = pn;
        u.A = (const char*)(ws + WS_H);
        u.B = (const char*)(ws + WS_W1T) + ((size_t)(l * 32 + e) * 2048 + (size_t)pn * 256) * 1024 * 2;
        return true;
    }
    __device__ __forceinline__ void rows(const g8::Unit& u, int r, int& idx) const {
        int ri = u.pm * 256 + r; ri = (ri < u.cn) ? ri : 0;
        idx = ((const int*)(ws + WS_TOKL))[(size_t)u.e * NT + ri] >> 2;
    }
};
struct EpiG1 {
    static constexpr bool PERM = true;
    unsigned char* ws; const int* pre; const float* b1l;
    __device__ __forceinline__ void operator()(const f32x4 (&acc)[2][2][4][2], const g8::Unit& u, int wr, int wc, int fr, int fq) const {
        bfu* ACT = (bfu*)(ws + WS_ACT);
        const float* b1 = b1l + (size_t)u.e * 2048;
        const size_t rbase = (size_t)(pre[32 + u.e] + u.pm) * 256 + wr * 64 + fr;
        const int ac0 = u.pn * 128 + 32 * wc + 8 * fq;
        f32x4 bg[2], bl[2];
#pragma unroll
        for (int n = 0; n < 2; ++n) { bg[n] = *(const f32x4*)(b1 + ac0 + 4 * n); bl[n] = *(const f32x4*)(b1 + 1024 + ac0 + 4 * n); }
#pragma unroll
        for (int ai = 0; ai < 2; ++ai)
#pragma unroll
            for (int m = 0; m < 4; ++m) {
                uint2 pk[2];
#pragma unroll
                for (int n = 0; n < 2; ++n) {
                    f32x4 o;
#pragma unroll
                    for (int j = 0; j < 4; ++j) {
                        const float glu = fminf(acc[ai][0][m][n][j] + bg[n][j], 7.0f);
                        const float lin = fminf(fmaxf(acc[ai][1][m][n][j] + bl[n][j], -7.0f), 7.0f);
                        o[j] = glu * sigmoidf_(1.702f * glu) * (lin + 1.0f);
                    }
                    pk[n] = pack4(o);
                }
                *(uint4*)(ACT + (rbase + ai * 128 + m * 16) * 1024 + ac0) = make_uint4(pk[0].x, pk[0].y, pk[1].x, pk[1].y);
            }
    }
};
struct SchedG2 {
    static constexpr bool GATHER = false;
    unsigned char* ws; const int* pre; int l, lda, ldb, G, c; mutable int hint;
    __device__ __forceinline__ bool next(int i, g8::Unit& u) const {
        const int total = pre[64] * 4;
        const long L0 = (long)i * G + c; if (L0 >= total) return false;
        int L = (int)L0; { const int q = total / 8, r = total % 8, xcd = L % 8, off = L / 8; L = (xcd < r ? xcd * (q + 1) : r * (q + 1) + (xcd - r) * q) + off; }
        const int tix = g8::uni(L >> 2), pn = g8::uni(L & 3);
        int e = (pre[32 + hint] <= tix) ? hint : 0; while (pre[32 + e + 1] <= tix) ++e;
        e = g8::uni(e); hint = e;
        u.e = e; u.cn = g8::uni(pre[e]); u.pm = g8::uni(tix - pre[32 + e]); u.pn = pn;
        u.A = (const char*)(ws + WS_ACT) + (size_t)tix * 256 * 1024 * 2;
        u.B = (const char*)(ws + WS_W2ET) + ((size_t)(l * 32 + e) * 1024 + (size_t)pn * 256) * 1024 * 2;
        return true;
    }
    __device__ __forceinline__ void rows(const g8::Unit&, int, int&) const {}
};
struct EpiG2 {
    static constexpr bool PERM = true;
    unsigned char* ws; const float* b2l;
    __device__ __forceinline__ void operator()(const f32x4 (&acc)[2][2][4][2], const g8::Unit& u, int wr, int wc, int fr, int fq) const {
        bfu* YB = (bfu*)(ws + WS_YB);
        const int* tl = (const int*)(ws + WS_TOKL) + (size_t)u.e * NT;
        const float* gl = (const float*)(ws + WS_GATEL) + (size_t)u.e * NT;
        const float* b2 = b2l + (size_t)u.e * 1024;
        const int col0 = u.pn * 256 + 32 * wc + 8 * fq;
        f32x4 bv[2][2];
#pragma unroll
        for (int bj = 0; bj < 2; ++bj)
#pragma unroll
            for (int n = 0; n < 2; ++n) bv[bj][n] = *(const f32x4*)(b2 + col0 + bj * 128 + n * 4);
        int ids[2][4]; float gts[2][4];
#pragma unroll
        for (int ai = 0; ai < 2; ++ai)
#pragma unroll
            for (int m = 0; m < 4; ++m) {
                int ri = u.pm * 256 + ai * 128 + wr * 64 + m * 16 + fr; ri = (ri < u.cn) ? ri : 0;
                ids[ai][m] = tl[ri]; gts[ai][m] = gl[ri];
            }
#pragma unroll
        for (int ai = 0; ai < 2; ++ai)
#pragma unroll
            for (int m = 0; m < 4; ++m) {
                const int ri = u.pm * 256 + ai * 128 + wr * 64 + m * 16 + fr;
                if (ri < u.cn) {
                    const float gate = gts[ai][m];
                    bfu* rp = YB + (size_t)ids[ai][m] * 1024 + col0;
#pragma unroll
                    for (int bj = 0; bj < 2; ++bj) {
                        const uint2 lo = pack4((acc[ai][bj][m][0] + bv[bj][0]) * gate), hi = pack4((acc[ai][bj][m][1] + bv[bj][1]) * gate);
                        *(uint4*)(rp + bj * 128) = make_uint4(lo.x, lo.y, hi.x, hi.y);
                    }
                }
            }
    }
};
__device__ __forceinline__ void expert_prefix8(const Args& a, int l, int* sm, int tid) {
    const int* cnt = (const int*)(wsp(a) + CNT_OFF) + l * 32;
    __syncthreads();
    if (tid == 0) {
        int tp = 0;
        for (int e = 0; e < 32; ++e) { const int cn = cnt[e]; sm[e] = cn; sm[32 + e] = tp; tp += (cn + 255) >> 8; }
        sm[64] = tp;
    }
    __syncthreads();
}
__device__ __forceinline__ void phase_gemm1_8(const Args& a, int l, char* smem, int tid, int bid, int nb) {
    int* pre = (int*)(smem + LDS_MAIN);
    expert_prefix8(a, l, pre, tid);
    SchedG1 S; S.ws = wsp(a); S.pre = pre; S.l = l; S.lda = 1024; S.ldb = 1024; S.G = nb; S.c = bid; S.hint = 0;
    EpiG1 E; E.ws = wsp(a); E.pre = pre; E.b1l = a.in[30] + (size_t)l * 32 * 2048;
    g8::gemm8((LAS unsigned char*)smem, S, E, 1024, tid);
}
__device__ __forceinline__ void phase_gemm2_8(const Args& a, int l, char* smem, int tid, int bid, int nb) {
    int* pre = (int*)(smem + LDS_MAIN);
    expert_prefix8(a, l, pre, tid);
    SchedG2 S; S.ws = wsp(a); S.pre = pre; S.l = l; S.lda = 1024; S.ldb = 1024; S.G = nb; S.c = bid; S.hint = 0;
    EpiG2 E; E.ws = wsp(a); E.b2l = a.in[32] + (size_t)l * 32 * 1024;
    g8::gemm8((LAS unsigned char*)smem, S, E, 1024, tid);
}

struct EpiS2 {
    static constexpr bool PERM = true;
    unsigned char* ws; const float* w0; const float* a0;
    __device__ __forceinline__ void operator()(const f32x4 (&acc)[2][2][4][2], const g8::Unit& u, int wr, int wc, int fr, int fq) const {
        const int kind = u.pn >> 1;
        const int col0 = (u.pn & 1) * 256 + 32 * wc + 8 * fq;
        bfu* dst; const float* bias = nullptr;
        if (kind < 2) { dst = (bfu*)(ws + WS_WDEC) + (size_t)kind * NT * 512; bias = w0 + kind * 512; }
        else if (kind < 4) { dst = (bfu*)(ws + WS_BV) + (size_t)(kind - 2) * NT * 512; bias = a0 + (kind - 2) * 512; }
        else dst = (bfu*)(ws + WS_GG);
        f32x4 bv[2][2];
#pragma unroll
        for (int bj = 0; bj < 2; ++bj)
#pragma unroll
            for (int n = 0; n < 2; ++n) bv[bj][n] = bias ? *(const f32x4*)(bias + col0 + bj * 128 + n * 4) : (f32x4){0.f, 0.f, 0.f, 0.f};
#pragma unroll
        for (int ai = 0; ai < 2; ++ai)
#pragma unroll
            for (int m = 0; m < 4; ++m) {
                bfu* d = dst + (size_t)(u.pm * 256 + ai * 128 + wr * 64 + m * 16 + fr) * 512 + col0;
#pragma unroll
                for (int bj = 0; bj < 2; ++bj) {
                    uint2 pk[2];
#pragma unroll
                    for (int n = 0; n < 2; ++n) {
                        f32x4 v = acc[ai][bj][m][n] + bv[bj][n];
                        if (kind < 2) { v[0] = ex2_(-0.87503925f * sigmoidf_(v[0])); v[1] = ex2_(-0.87503925f * sigmoidf_(v[1])); v[2] = ex2_(-0.87503925f * sigmoidf_(v[2])); v[3] = ex2_(-0.87503925f * sigmoidf_(v[3])); }
                        else if (kind < 4) { v[0] = sigmoidf_(v[0]); v[1] = sigmoidf_(v[1]); v[2] = sigmoidf_(v[2]); v[3] = sigmoidf_(v[3]); }
                        pk[n] = pack4(v);
                    }
                    *(uint4*)(d + bj * 128) = make_uint4(pk[0].x, pk[0].y, pk[1].x, pk[1].y);
                }
            }
    }
};
__device__ __forceinline__ void phase_stage2_8(const Args& a, int l, char* smem, int tid, int bid, int nb) {
    unsigned char* ws = wsp(a);
    {
        SchedDense S;
        S.A = (const char*)(ws + WS_LORA); S.B = (const char*)(ws + WS_S2T) + (size_t)l * 2560 * 512 * 2;
        S.lda = 512; S.ldb = 512; S.nM = 72; S.nN = 10; S.G = nb; S.c = bid; S.skip9 = 0;
        EpiS2 E; E.ws = ws; E.w0 = a.in[12] + l * 1024; E.a0 = a.in[15] + l * 1024;
        g8::gemm8((LAS unsigned char*)smem, S, E, 512, tid);
    }
    {
        const bfu* SB = (const bfu*)(ws + WS_SB);
        const bfu* SG = SB + (size_t)NT * 512;
        const bfu* SX = SG + (size_t)NT * 512;
        bfu* OSC = (bfu*)(ws + WS_ODA) + (size_t)NT * 512;
        const float* cw = a.in[11] + l * 3 * 512;
        for (int i = bid * NTHREADS + tid; i < NT * 64; i += nb * NTHREADS) {
            const int row = i >> 6, c8 = (i & 63) * 8;
            const int t = row % TB;
            if (l == 1 && t >= SEQ) continue;
            const bool hasp = (t != 0 && t != SEQ);
            const bool hasn = (t != SEQ - 1 && t != TB - 1);
            float u[3][8];
#pragma unroll
            for (int j = 0; j < 3; ++j) {
                const bool ok = (j == 1) || (j == 0 ? hasp : hasn);
                if (ok) {
                    const size_t o = (size_t)(row + j - 1) * 512 + c8;
                    const uint4 pg = *(const uint4*)(SG + o), px = *(const uint4*)(SX + o);
                    u[j][0] = bflo(pg.x) * bflo(px.x); u[j][1] = bfhi(pg.x) * bfhi(px.x);
                    u[j][2] = bflo(pg.y) * bflo(px.y); u[j][3] = bfhi(pg.y) * bfhi(px.y);
                    u[j][4] = bflo(pg.z) * bflo(px.z); u[j][5] = bfhi(pg.z) * bfhi(px.z);
                    u[j][6] = bflo(pg.w) * bflo(px.w); u[j][7] = bfhi(pg.w) * bfhi(px.w);
                } else {
#pragma unroll
                    for (int e = 0; e < 8; ++e) u[j][e] = 0.f;
                }
            }
            const uint4 pb = *(const uint4*)(SB + (size_t)row * 512 + c8);
            float sbv[8] = {bflo(pb.x), bfhi(pb.x), bflo(pb.y), bfhi(pb.y), bflo(pb.z), bfhi(pb.z), bflo(pb.w), bfhi(pb.w)};
            float o[8];
#pragma unroll
            for (int e = 0; e < 8; ++e)
                o[e] = sbv[e] * (cw[c8 + e] * u[0][e] + cw[512 + c8 + e] * u[1][e] + cw[1024 + c8 + e] * u[2][e]);
            uint4 po; po.x = pack2(o[0], o[1]); po.y = pack2(o[2], o[3]); po.z = pack2(o[4], o[5]); po.w = pack2(o[6], o[7]);
            *(uint4*)(OSC + (size_t)row * 512 + c8) = po;
        }
    }
}

struct EpiRouter {
    static constexpr bool PERM = true;
    unsigned char* ws; const float* bias;
    __device__ __forceinline__ void operator()(const f32x4 (&acc)[2][2][4][2], const g8::Unit& u, int wr, int wc, int fr, int fq) const {
        if (wc != 0) return;
        float* LG = (float*)(ws + WS_LOG);
#pragma unroll
        for (int n = 0; n < 2; ++n) {
            const f32x4 bv = *(const f32x4*)(bias + 8 * fq + 4 * n);
#pragma unroll
            for (int ai = 0; ai < 2; ++ai)
#pragma unroll
                for (int m = 0; m < 4; ++m) {
                    const size_t row = (size_t)(u.pm * 256 + ai * 128 + wr * 64 + m * 16 + fr);
                    *(f32x4*)(LG + row * 32 + 8 * fq + 4 * n) = acc[ai][0][m][n] + acc[ai][1][m][n] + bv;
                }
        }
    }
};
__device__ __forceinline__ void phase_router8(const Args& a, int l, char* smem, int tid, int bid, int nb) {
    SchedDense S;
    S.A = (const char*)(wsp(a) + WS_H2HI); S.B = (const char*)(wsp(a) + WS_RT) + (size_t)l * 256 * 2048 * 2;
    S.lda = 2048; S.ldb = 2048; S.nM = (l == 0) ? 72 : 64; S.nN = 1; S.G = nb; S.c = bid; S.skip9 = (l == 1);
    EpiRouter E; E.ws = wsp(a); E.bias = a.in[28] + l * 32;
    g8::gemm8((LAS unsigned char*)smem, S, E, 2048, tid);
}

constexpr int N_PHASES = 2 + 11 * NL;

__global__ void __launch_bounds__(NTHREADS, 2) fwd(Args a0) {
    extern __shared__ __attribute__((aligned(16))) char dyn_smem[];
    char* smem = dyn_smem + 16;
    const int tid = threadIdx.x, bid0 = blockIdx.x, nb0 = gridDim.x;
    const int wave_s = __builtin_amdgcn_readfirstlane(tid >> 6);
    const bool multi = (a0.ph_hi - a0.ph_lo) > 1;
    XcdBarrier bar;
    bar.bar = (unsigned*)(a0.ws + WS_CTL); bar.x = 0; bar.st = (volatile LAS unsigned*)dyn_smem;
    if (multi) {
        if (tid == 0) *(uint4*)dyn_smem = make_uint4(0u, 0u, 0u, 0u);
        __syncthreads();
        bar = xcd_barrier_post((unsigned*)(a0.ws + WS_CTL), (volatile LAS unsigned*)dyn_smem);
    }
#ifndef REP_MASK
#define REP_MASK 0u
#define REP_N 1
#endif
#ifndef PHASE_MASK
#define PHASE_MASK 0xFFFFFFFFu
#endif
#define RUN_PHASE(KIND, ID, CALL) do { if constexpr (((PHASE_MASK) >> (KIND)) & 1u) { const int _id = (ID); if (_id >= a0.ph_lo && _id < a0.ph_hi) { \
    for (int _r = 0; _r < ((((REP_MASK) >> (KIND)) & 1u) ? REP_N : 1); ++_r) { int tid = (wave_s << 6) | lane_id_(), bid = bid0, nb = nb0; const Args& a = a0; asm volatile("" : "+v"(tid), "+s"(bid), "+s"(nb)); CALL; } if (_id + 1 < a0.ph_hi) xcd_barrier(bar, wave_s); } } } while (0)
    RUN_PHASE(0, 0, phase_prep(a, smem, tid, bid, nb));
    RUN_PHASE(1, 1, phase_norm1_l0(a, tid, bid, nb));
    for (int l = 0; l < NL; ++l) {
        const int base = 2 + 11 * l;
        RUN_PHASE(2, base + 0, phase_gemm_in8(a, l, smem, tid, bid, nb));
        RUN_PHASE(3, base + 1, phase_stage2_8(a, l, smem, tid, bid, nb));
        RUN_PHASE(14, base + 2, phase_chunkpre(a, l, smem, tid, bid, nb));
        RUN_PHASE(4, base + 3, phase_mix(a, l, smem, tid, bid, nb));
        RUN_PHASE(5, base + 4, phase_post(a, l, tid, bid, nb));
        RUN_PHASE(6, base + 5, phase_merge8(a, l, smem, tid, bid, nb));
        RUN_PHASE(7, base + 6, phase_wout8(a, l, smem, tid, bid, nb));
        RUN_PHASE(8, base + 7, phase_n2rt(a, l, smem, tid, bid, nb));
        RUN_PHASE(11, base + 8, phase_gemm1_8(a, l, smem, tid, bid, nb));
        RUN_PHASE(12, base + 9, phase_gemm2_8(a, l, smem, tid, bid, nb));
        RUN_PHASE(13, base + 10, phase_combine(a, l, tid, bid, nb));
    }
}

extern "C" void kernel_launch(void* const* d_in, const int* in_sizes, int n_in,
                              void* d_out, int out_size, void* d_ws, size_t ws_size,
                              hipStream_t stream) {
    static int grid = 0;
    if (grid == 0) {
        if (n_in != 34 || ws_size < WS_END) { fprintf(stderr, "kernel_launch: bad inputs (n_in %d, ws %zu < %zu)\n", n_in, ws_size, (size_t)WS_END); grid = -1; return; }
        int dev = 0, cus = 0, per_cu = 0;
        hipGetDevice(&dev);
        hipDeviceGetAttribute(&cus, hipDeviceAttributeMultiprocessorCount, dev);
        if (hipFuncSetAttribute((const void*)fwd, hipFuncAttributeMaxDynamicSharedMemorySize, LDS_BYTES) != hipSuccess) { fprintf(stderr, "hipFuncSetAttribute failed\n"); grid = -1; return; }
        hipOccupancyMaxActiveBlocksPerMultiprocessor(&per_cu, (const void*)fwd, NTHREADS, LDS_BYTES);
        (void)hipGetLastError();
        if (per_cu < 1) per_cu = 1;
        grid = cus;
    }
    if (grid < 0) return;
    hipMemsetAsync((char*)d_ws + WS_CTL, 0, CTL_BYTES, stream);
    hipMemsetAsync((char*)d_ws + WS_S2T, 0, (size_t)2 * 2560 * 512 * 2, stream);
    Args a{};
    for (int i = 0; i < 34; ++i) a.in[i] = (const float*)d_in[i];
    a.out = (float*)d_out; a.ws = (unsigned char*)d_ws;
#if N_LAUNCH_MODE == 1
    a.ph_lo = 0; a.ph_hi = N_PHASES;
    hipLaunchKernelGGL(fwd, dim3(grid), dim3(NTHREADS), LDS_BYTES, stream, a);
#else
    for (int p = 0; p < N_PHASES; ++p) {
        a.ph_lo = p; a.ph_hi = p + 1;
        hipLaunchKernelGGL(fwd, dim3(grid), dim3(NTHREADS), LDS_BYTES, stream, a);
    }
#endif
}
```

```cpp
#include <hip/hip_runtime.h>
#include <stdint.h>
#include <stdio.h>

typedef unsigned short bfu;
using bf16x8 = __attribute__((ext_vector_type(8))) short;
using f32x4  = __attribute__((ext_vector_type(4))) float;

constexpr int NB = 8, SEQ = 2048, CTX = 256, TB = 2304, NT = NB * TB, DM = 1024, NL = 2;
constexpr int NEXP = 32;
constexpr int NTHREADS = 512;
constexpr int NW = NTHREADS / 64;
constexpr int LDS_MAIN = 131072;
constexpr int LDS_EXTRA = 4096;
constexpr int LDS_BYTES = LDS_MAIN + LDS_EXTRA + 16;

#ifndef N_LAUNCH_MODE
#define N_LAUNCH_MODE 1
#endif

constexpr size_t al(size_t x) { return (x + 255) & ~(size_t)255; }
constexpr size_t WS_CTL    = 0;
constexpr size_t CTL_BYTES = 32768;
constexpr size_t CNT_OFF   = 16384;
constexpr size_t WS_MOD    = WS_CTL + CTL_BYTES;
constexpr size_t WS_TAB    = al(WS_MOD + (size_t)2 * 9 * 6144 * 4);
constexpr size_t WS_WINT   = al(WS_TAB + 2 * 64 * 16 * 4 + 64);
constexpr size_t WS_S2T    = al(WS_WINT + (size_t)2 * 8192 * 1024 * 2);
constexpr size_t WS_WBT    = al(WS_S2T + (size_t)2 * 2560 * 512 * 2);
constexpr size_t WS_WOT    = al(WS_WBT + (size_t)2 * 3 * 1024 * 512 * 2);
constexpr size_t WS_RT     = al(WS_WOT + (size_t)2 * 1024 * 3072 * 2);
constexpr size_t WS_W1T    = al(WS_RT + (size_t)2 * 256 * 2048 * 2);
constexpr size_t WS_W2ET   = al(WS_W1T + (size_t)2 * 32 * 2048 * 1024 * 2);
constexpr size_t WS_XRES   = al(WS_W2ET + (size_t)2 * 32 * 1024 * 1024 * 2);
constexpr size_t WS_H      = al(WS_XRES + (size_t)NT * 1024 * 4);
constexpr size_t SZ512     = (size_t)NT * 512 * 2;
constexpr size_t WS_Q      = al(WS_H + (size_t)NT * 1024 * 2);
constexpr size_t WS_K      = al(WS_Q + SZ512);
constexpr size_t WS_VT     = al(WS_K + SZ512);
constexpr size_t WS_SB     = al(WS_VT + SZ512);
constexpr size_t WS_RR     = al(WS_SB + 3 * SZ512);
constexpr size_t WS_RK     = al(WS_RR + SZ512);
constexpr size_t WS_RV     = al(WS_RK + SZ512);
constexpr size_t WS_KKB    = al(WS_RV + SZ512);
constexpr size_t WS_GL     = al(WS_KKB + SZ512);
constexpr size_t WS_LORA   = al(WS_GL + (size_t)NT * 3072 * 2);
constexpr size_t WS_WDEC   = al(WS_LORA + SZ512);
constexpr size_t WS_BV     = al(WS_WDEC + 2 * SZ512);
constexpr size_t WS_KE     = al(WS_BV + 2 * SZ512);
constexpr size_t WS_GG     = al(WS_KE + 2 * SZ512);
constexpr size_t WS_Y      = al(WS_GG + SZ512);
constexpr size_t WS_ODA    = al(WS_Y + (size_t)2 * NT * 512 * 4);
constexpr size_t WS_MB     = al(WS_ODA + 3 * SZ512);
constexpr size_t WS_H2HI   = al(WS_MB + (size_t)NT * 1024 * 2);
constexpr size_t WS_H2LO   = al(WS_H2HI + (size_t)NT * 1024 * 2);
constexpr size_t WS_LOG    = al(WS_H2LO + (size_t)NT * 1024 * 2);
constexpr size_t WS_TOKL   = al(WS_LOG + (size_t)NT * 32 * 4);
constexpr size_t WS_GATE   = al(WS_TOKL + (size_t)32 * NT * 4);
constexpr size_t WS_GATEL  = al(WS_GATE + (size_t)NT * 4 * 4);
constexpr size_t WS_ACT    = al(WS_GATEL + (size_t)32 * NT * 4);
constexpr size_t WS_YB     = al(WS_ACT + (size_t)(NT * 4 + 8192) * 1024 * 2);
constexpr size_t WS_END    = al(WS_YB + (size_t)NT * 4 * 1024 * 2);

struct Args {
    const float* in[34];
    float* out;
    unsigned char* ws;
    int ph_lo, ph_hi;
};
#define GAS __attribute__((address_space(1)))
__device__ __forceinline__ unsigned char* wsp(const Args& a) {
    GAS unsigned char* p = (GAS unsigned char*)a.ws; asm volatile("" : "+s"(p)); return (unsigned char*)p; }


typedef __bf16 bf16x2_t __attribute__((ext_vector_type(2)));
typedef float f32x2_t __attribute__((ext_vector_type(2)));
typedef unsigned u32x2_t __attribute__((ext_vector_type(2)));
typedef unsigned u32x4_t __attribute__((ext_vector_type(4)));
__device__ __forceinline__ bfu f2bf(float f) { return __builtin_bit_cast(bfu, (__bf16)f); }
__device__ __forceinline__ float bf2f(bfu b) { return __uint_as_float(((unsigned)b) << 16); }
__device__ __forceinline__ unsigned pack2(float a, float b) { f32x2_t v = {a, b}; return __builtin_bit_cast(unsigned, __builtin_convertvector(v, bf16x2_t)); }
__device__ __forceinline__ float bflo(unsigned u) { return __uint_as_float(u << 16); }
__device__ __forceinline__ float bfhi(unsigned u) { return __uint_as_float(u & 0xFFFF0000u); }
__device__ __forceinline__ float sigmoidf_(float x) { return __builtin_amdgcn_rcpf(1.0f + __builtin_amdgcn_exp2f(-1.4426950408889634f * x)); }
__device__ __forceinline__ float tanhf_(float x) { const float e = __builtin_amdgcn_exp2f(2.8853900817779268f * x); return 1.0f - 2.0f * __builtin_amdgcn_rcpf(e + 1.0f); }
__device__ __forceinline__ int lane_id_() { int l; asm volatile("v_mbcnt_lo_u32_b32 %0, -1, 0\n\tv_mbcnt_hi_u32_b32 %0, -1, %0" : "=v"(l)); return l; }
__device__ __forceinline__ float shx_(float v, int m) { return __int_as_float(__builtin_amdgcn_ds_bpermute((lane_id_() ^ m) << 2, __float_as_int(v))); }
__device__ __forceinline__ float shf_(float v, int src) { return __int_as_float(__builtin_amdgcn_ds_bpermute(src << 2, __float_as_int(v))); }
__device__ __forceinline__ float wave_sum_shfl(float v) {
#pragma unroll
    for (int o = 32; o >= 1; o >>= 1) v += shx_(v, o);
    return v;
}
__device__ __forceinline__ float fmax3_(float a, float b, float c) { float r; asm("v_max3_f32 %0, %1, %2, %3" : "=v"(r) : "v"(a), "v"(b), "v"(c)); return r; }
__device__ __forceinline__ float ex2_(float x) { return __builtin_amdgcn_exp2f(x); }
template <int CTRL>
__device__ __forceinline__ float dppf(float x) {
    return __int_as_float(__builtin_amdgcn_update_dpp(0, __float_as_int(x), CTRL, 0xF, 0xF, true));
}
__device__ __forceinline__ float red16(float x) {
    x += dppf<0xB1>(x);
    x += dppf<0x4E>(x);
    x += dppf<0x124>(x);
    x += dppf<0x128>(x);
    return x;
}
__device__ __forceinline__ float wave_sum(float v) {
    v = red16(v);
    const float s0 = __int_as_float(__builtin_amdgcn_readlane(__float_as_int(v), 0)), s1 = __int_as_float(__builtin_amdgcn_readlane(__float_as_int(v), 16));
    const float s2 = __int_as_float(__builtin_amdgcn_readlane(__float_as_int(v), 32)), s3 = __int_as_float(__builtin_amdgcn_readlane(__float_as_int(v), 48));
    return (s0 + s1) + (s2 + s3);
}

#define XB_TMO      128
#define XB_XCNT(j)  (256  + 64 * (j))
#define XB_XSUB(j)  (1280 + 64 * (j))
#define XB_XGEN(j)  (2304 + 64 * (j))
#define XB_TOP      3328
#define XB_TOPGEN   3392
#define XCD_BAR_WORDS 3456
#define XB_SPIN_CAP (1u << 22)
#define LAS __attribute__((address_space(3)))

__device__ __forceinline__ unsigned xb_ld(unsigned* p)              { return __hip_atomic_load(p, __ATOMIC_RELAXED, __HIP_MEMORY_SCOPE_AGENT); }
__device__ __forceinline__ unsigned xb_add(unsigned* p, unsigned v) { return __hip_atomic_fetch_add(p, v, __ATOMIC_RELAXED, __HIP_MEMORY_SCOPE_AGENT); }
__device__ __forceinline__ unsigned xb_xcc_id() { return (unsigned)__builtin_amdgcn_s_getreg((3 << 11) | 20) & 0xFu; }
#define XB_SPIN(cond, bar) do { unsigned _sp = 0; while (cond) { __builtin_amdgcn_s_sleep(1); \
    if ((++_sp & 255u) == 0u) { if (xb_ld(&(bar)[XB_TMO])) break; if (_sp > XB_SPIN_CAP) { atomicAdd(&(bar)[XB_TMO], 1u); break; } } } } while (0)

struct XcdBarrier { unsigned* bar; unsigned x; volatile LAS unsigned* st; };

__device__ __forceinline__ XcdBarrier xcd_barrier_post(unsigned* bar, volatile LAS unsigned* st) {
    XcdBarrier b; b.bar = bar; b.x = xb_xcc_id(); b.st = st;
    if (threadIdx.x == 0) (void)xb_add(&bar[XB_XCNT(b.x)], 1u);
    return b;
}
__device__ __forceinline__ void xcd_barrier_complete(unsigned* bar, unsigned x, unsigned& nloc, unsigned& nx) {
    const unsigned G = gridDim.x * gridDim.y * gridDim.z;
    unsigned sum, cnt, mine, sp = 0u;
    for (;;) {
        sum = 0u; cnt = 0u; mine = 0u;
#pragma unroll
        for (unsigned j = 0; j < 16; ++j) { const unsigned c = xb_ld(&bar[XB_XCNT(j)]); sum += c; cnt += (c > 0u) ? 1u : 0u; mine = (j == x) ? c : mine; }
        if (sum == G) break;
        __builtin_amdgcn_s_sleep(1);
        if ((++sp & 255u) == 0u) { if (xb_ld(&bar[XB_TMO])) break; if (sp > XB_SPIN_CAP) { atomicAdd(&bar[XB_TMO], 1u); break; } }
    }
    nloc = mine > 0u ? mine : 1u; nx = cnt > 0u ? cnt : 1u;
}
__device__ __forceinline__ void xcd_barrier(const XcdBarrier& b, int wave_s) {
    asm volatile("s_waitcnt vmcnt(0)" ::: "memory");
    __syncthreads();
    if (wave_s == 0 && lane_id_() == 0) {
        unsigned* bar = b.bar;
        __builtin_amdgcn_s_waitcnt(0);
        unsigned nloc = b.st[0], nx = b.st[1];
        if (nloc == 0u) { xcd_barrier_complete(bar, b.x, nloc, nx); b.st[0] = nloc; b.st[1] = nx; }
        const unsigned old = xb_add(&bar[XB_XSUB(b.x)], 1u);
        const unsigned gen = old / nloc;
        if (old + 1u == (gen + 1u) * nloc) {
            __builtin_amdgcn_fence(__ATOMIC_RELEASE, "agent");
            asm volatile("s_waitcnt vmcnt(0)" ::: "memory");
            const unsigned og = xb_add(&bar[XB_TOP], 1u);
            const unsigned tg = og / nx;
            if (og + 1u == (tg + 1u) * nx) xb_add(&bar[XB_TOPGEN], 1u);
            else XB_SPIN(xb_ld(&bar[XB_TOPGEN]) == tg, bar);
            __builtin_amdgcn_fence(__ATOMIC_ACQUIRE, "agent");
            xb_add(&bar[XB_XGEN(b.x)], 1u);
            asm volatile("s_waitcnt vmcnt(0)" ::: "memory");
        } else {
            XB_SPIN(xb_ld(&bar[XB_XGEN(b.x)]) == gen, bar);
            __builtin_amdgcn_fence(__ATOMIC_ACQUIRE, "agent");
            asm volatile("s_waitcnt vmcnt(0)" ::: "memory");
        }
    }
    __syncthreads();
}

constexpr int LROW = 144;
constexpr int LTILE = 256 * LROW;
constexpr int LTILEB = 128 * LROW;

template <int NI>
__device__ __forceinline__ void gemm_loop(f32x4 (&acc)[4][NI], const bfu* __restrict__ A, int lda, const int (&arow)[4],
                                          const bfu* __restrict__ Bt, int ldb, int n0, int K, char* smem, int tid) {
    const int kc = tid & 7, tr = tid >> 3;
    const int wave = tid >> 6, lane = tid & 63, wm = wave >> 1, wn = wave & 1, g = lane >> 4, c = lane & 15;
    const bfu* pa0 = A + (size_t)arow[0] * lda + kc * 8;
    const bfu* pa1 = A + (size_t)arow[1] * lda + kc * 8;
    const bfu* pa2 = A + (size_t)arow[2] * lda + kc * 8;
    const bfu* pa3 = A + (size_t)arow[3] * lda + kc * 8;
    const bfu* pb0 = Bt + (size_t)(n0 + tr) * ldb + kc * 8;
    const bfu* pb1 = Bt + (size_t)(n0 + tr + ((NI == 4) ? 64 : 0)) * ldb + kc * 8;
    const int wofs = tr * LROW + kc * 16;
    const int aofs = (wm * 64 + c) * LROW + g * 16;
    const int bofs = (wn * (16 * NI) + c) * LROW + g * 16;
    const int nk = K >> 6;
    uint4 ra0 = *(const uint4*)pa0, ra1 = *(const uint4*)pa1, ra2 = *(const uint4*)pa2, ra3 = *(const uint4*)pa3;
    uint4 rb0 = *(const uint4*)pb0, rb1 = *(const uint4*)pb1;
    *(uint4*)(smem + wofs) = ra0; *(uint4*)(smem + wofs + 64 * LROW) = ra1; *(uint4*)(smem + wofs + 128 * LROW) = ra2; *(uint4*)(smem + wofs + 192 * LROW) = ra3;
    *(uint4*)(smem + 2 * LTILE + wofs) = rb0;
    if (NI == 4) *(uint4*)(smem + 2 * LTILE + wofs + 64 * LROW) = rb1;
    __syncthreads();
    for (int kt = 0; kt < nk; ++kt) {
        const int cur = kt & 1;
        const bool more = (kt + 1 < nk);
        if (more) {
            const size_t ko = (size_t)(kt + 1) * 64;
            ra0 = *(const uint4*)(pa0 + ko); ra1 = *(const uint4*)(pa1 + ko); ra2 = *(const uint4*)(pa2 + ko); ra3 = *(const uint4*)(pa3 + ko);
            rb0 = *(const uint4*)(pb0 + ko); rb1 = *(const uint4*)(pb1 + ko);
        }
        const char* As = smem + cur * LTILE;
        const char* Bs = smem + 2 * LTILE + cur * LTILEB;
#pragma unroll
        for (int ks = 0; ks < 2; ++ks) {
            bf16x8 af[4], bq[NI];
#pragma unroll
            for (int mi = 0; mi < 4; ++mi) af[mi] = *(const bf16x8*)(As + aofs + mi * 16 * LROW + ks * 64);
#pragma unroll
            for (int ni = 0; ni < NI; ++ni) bq[ni] = *(const bf16x8*)(Bs + bofs + ni * 16 * LROW + ks * 64);
#pragma unroll
            for (int mi = 0; mi < 4; ++mi)
#pragma unroll
                for (int ni = 0; ni < NI; ++ni)
                    acc[mi][ni] = __builtin_amdgcn_mfma_f32_16x16x32_bf16(af[mi], bq[ni], acc[mi][ni], 0, 0, 0);
        }
        if (more) {
            char* Aw = smem + (cur ^ 1) * LTILE;
            char* Bw = smem + 2 * LTILE + (cur ^ 1) * LTILEB;
            *(uint4*)(Aw + wofs) = ra0; *(uint4*)(Aw + wofs + 64 * LROW) = ra1; *(uint4*)(Aw + wofs + 128 * LROW) = ra2; *(uint4*)(Aw + wofs + 192 * LROW) = ra3;
            *(uint4*)(Bw + wofs) = rb0;
            if (NI == 4) *(uint4*)(Bw + wofs + 64 * LROW) = rb1;
        }
        __syncthreads();
    }
}
template <int NI>
__device__ __forceinline__ void zero_acc(f32x4 (&acc)[4][NI]) {
#pragma unroll
    for (int mi = 0; mi < 4; ++mi)
#pragma unroll
        for (int ni = 0; ni < NI; ++ni) acc[mi][ni] = (f32x4){0.f, 0.f, 0.f, 0.f};
}
__device__ __forceinline__ void ident_rows(int (&arow)[4], int m0, int tid) {
#pragma unroll
    for (int i = 0; i < 4; ++i) arow[i] = m0 + (tid >> 3) + 64 * i;
}

namespace g8 {
constexpr int BM = 256, BK = 64, HALF = 128, HTB = HALF * BK * 2, STAGE_BYTES = 8 * HTB, NXCD = 8, WGM = 8;
__device__ __forceinline__ int lds_byte(int r, int c) { const int st = (r >> 4) * 2 + (c >> 5), rr = r & 15, cc = c & 31, ob = rr * 64 + cc * 2; return st * 1024 + (ob ^ (((ob >> 9) & 1) << 5)); }
__device__ __forceinline__ void stage_rc(int b, int& R, int& C) { const int st = b / 1024, sb = b % 1024, swz = sb ^ (((sb >> 9) & 1) << 5); R = (st >> 1) * 16 + swz / 64; C = (st & 1) * 32 + (swz % 64) / 2; }
__device__ __forceinline__ int perm32(int rho) { const int n = rho >> 4, i = rho & 15; return 8 * (i >> 2) + 4 * n + (i & 3); }

struct Unit { const char* A; const char* B; int pm, pn, e, cn; };
__device__ __forceinline__ int uni(int v) { return __builtin_amdgcn_readfirstlane(v); }

__device__ __forceinline__ bool static_tile(int i, int G, int c, int nM, int nN, int& pm, int& pn) {
    const int nwg = nM * nN;
    const long L = (long)i * G + c; if (L >= nwg) return false;
    int wgid = (int)L; { const int q = nwg / NXCD, r = nwg % NXCD, xcd = wgid % NXCD, off = wgid / NXCD; wgid = (xcd < r ? xcd * (q + 1) : r * (q + 1) + (xcd - r) * q) + off; }
    const int nig = WGM * nN, gid = wgid / nig, fm = gid * WGM, gsz = (nM - fm) < WGM ? (nM - fm) : WGM;
    pm = fm + ((wgid % nig) % gsz); pn = (wgid % nig) / gsz; return true;
}

template <class Epi, class Sched>
__device__ __forceinline__ void gemm8(LAS unsigned char* lds, const Sched& S, const Epi& E, int K, int tid) {
    const int wid = __builtin_amdgcn_readfirstlane(tid >> 6), lane = tid & 63, wr = wid >> 2, wc = wid & 3, fr = lane & 15, fq = lane >> 4;
    const int nt = K / BK;
    unsigned voffB[2];
#pragma unroll
    for (int i = 0; i < 2; ++i) { int R_, C_; stage_rc(tid * 16 + i * 8192, R_, C_); const int Rb = Epi::PERM ? ((R_ & ~31) + perm32(R_ & 31)) : R_;
        voffB[i] = (unsigned)(Rb * S.ldb + C_) * 2u; }
    const size_t kstep = (size_t)(BK * 2);
    const size_t hstepB = (size_t)HALF * S.ldb * 2;
    const unsigned ldsw = (unsigned)wid * 1024u;
    const int aoff = lds_byte(wr * 64 + fr, fq * 8), boff = lds_byte(wc * 32 + fr, fq * 8);
#define G8_SA(b, h) (((b) * 2 + (h)) * HTB)
#define G8_SB(b, h) ((4 + (b) * 2 + (h)) * HTB)
#define G8_STAGEB(bufoff, gbase) do { _Pragma("unroll") for (int _i = 0; _i < 2; ++_i) { unsigned _o = voffB[_i]; asm volatile("" : "+v"(_o)); \
        __builtin_amdgcn_global_load_lds((const unsigned*)((const char*)(gbase) + _o), (LAS unsigned*)(lds + (bufoff) + ldsw + _i * 8192), 16, 0, 0); } } while (0)
#define G8_STAGEA(bufoff, gbase, VA, h) do { _Pragma("unroll") for (int _i = 0; _i < 2; ++_i) { unsigned _o = (VA)[h][_i]; asm volatile("" : "+v"(_o)); \
        __builtin_amdgcn_global_load_lds((const unsigned*)((const char*)(gbase) + _o), (LAS unsigned*)(lds + (bufoff) + ldsw + _i * 8192), 16, 0, 0); } } while (0)
#define G8_LDA(dst, b, h) do { _Pragma("unroll") for (int m = 0; m < 4; ++m) _Pragma("unroll") for (int k = 0; k < 2; ++k) dst[m][k] = *(const LAS bf16x8*)(lds + G8_SA(b, h) + aoff + m * 2048 + k * 1024); } while (0)
#define G8_LDB(dst, b, h) do { _Pragma("unroll") for (int n = 0; n < 2; ++n) _Pragma("unroll") for (int k = 0; k < 2; ++k) dst[n][k] = *(const LAS bf16x8*)(lds + G8_SB(b, h) + boff + n * 2048 + k * 1024); } while (0)
#define G8_MMA(ai, bj, At, Bt) do { __builtin_amdgcn_s_setprio(1); _Pragma("unroll") for (int m = 0; m < 4; ++m) _Pragma("unroll") for (int n = 0; n < 2; ++n) _Pragma("unroll") for (int k = 0; k < 2; ++k) \
        acc[ai][bj][m][n] = __builtin_amdgcn_mfma_f32_16x16x32_bf16(Bt[n][k], At[m][k], acc[ai][bj][m][n], 0, 0, 0); __builtin_amdgcn_s_setprio(0); } while (0)
#define G8_WAIT_V(n) asm volatile("s_waitcnt vmcnt(" #n ")" ::: "memory")
#define G8_WAIT_L(n) asm volatile("s_waitcnt lgkmcnt(" #n ")" ::: "memory")
#define G8_BAR __builtin_amdgcn_s_barrier()
#define G8_SCHED __builtin_amdgcn_sched_barrier(0)
#define G8_VOFF(VA, U) do { _Pragma("unroll") for (int _i = 0; _i < 2; ++_i) { int _R, _C; stage_rc(tid * 16 + _i * 8192, _R, _C); _Pragma("unroll") for (int _h = 0; _h < 2; ++_h) { \
        int _row = _R + _h * HALF; if (Sched::GATHER) S.rows(U, _row, _row); VA[_h][_i] = (unsigned)(_row * S.lda + _C) * 2u; } } } while (0)
    Unit cur, nxt; int ui = 0;
    if (!S.next(0, cur)) return;
    f32x4 acc[2][2][4][2];
#pragma unroll
    for (int a = 0; a < 2; ++a)
#pragma unroll
        for (int b = 0; b < 2; ++b)
#pragma unroll
            for (int m = 0; m < 4; ++m)
#pragma unroll
                for (int n = 0; n < 2; ++n) acc[a][b][m][n] = (f32x4){0.f, 0.f, 0.f, 0.f};
    bf16x8 At[4][2], B0[2][2], B1[2][2];
    unsigned cva[2][2], nva[2][2]; int nidx[2][2];
    G8_VOFF(cva, cur);
    const char* cA = cur.A; const char* cB = cur.B;
    G8_STAGEB(G8_SB(0, 0), cB); G8_STAGEA(G8_SA(0, 0), cA, cva, 0); G8_STAGEB(G8_SB(0, 1), cB + hstepB); G8_STAGEA(G8_SA(0, 1), cA, cva, 1);
    if (wr == 1) G8_BAR;
    G8_WAIT_V(4); G8_BAR;
    G8_STAGEB(G8_SB(1, 0), cB + kstep); G8_STAGEA(G8_SA(1, 0), cA + kstep, cva, 0); G8_STAGEB(G8_SB(1, 1), cB + hstepB + kstep);
    G8_WAIT_V(6); G8_BAR;
    for (;;) {
        const bool has_next = S.next(ui + 1, nxt);
        const char* nA = has_next ? nxt.A : cA; const char* nB = has_next ? nxt.B : cB;
        if constexpr (Sched::GATHER) {
            if (has_next) {
#pragma unroll
                for (int _i = 0; _i < 2; ++_i) { int _R, _C; stage_rc(tid * 16 + _i * 8192, _R, _C);
#pragma unroll
                    for (int _h = 0; _h < 2; ++_h) { int _row = _R + _h * HALF; S.rows(nxt, _row, _row); nidx[_h][_i] = _row; } }
            }
        }
        for (int t = 0; t < nt; t += 2) {
            const bool last = (t == nt - 2);
            const char* a1 = cA + (size_t)(t + 1) * kstep;
            const char* a2 = last ? nA : cA + (size_t)(t + 2) * kstep; const char* b2 = last ? nB : cB + (size_t)(t + 2) * kstep;
            const char* a3 = a2 + kstep; const char* b3 = b2 + kstep;
            if constexpr (Sched::GATHER) {
                if (last && has_next) {
#pragma unroll
                    for (int _i = 0; _i < 2; ++_i) { int _R, _C; stage_rc(tid * 16 + _i * 8192, _R, _C);
#pragma unroll
                        for (int _h = 0; _h < 2; ++_h) nva[_h][_i] = (unsigned)(nidx[_h][_i] * S.lda + _C) * 2u; }
                }
            }
            const bool use_n = Sched::GATHER && last && has_next;
            G8_LDB(B0, 0, 0); G8_SCHED; G8_LDA(At, 0, 0); G8_STAGEA(G8_SA(1, 1), a1, cva, 1);
            G8_WAIT_L(8); G8_BAR; G8_WAIT_L(0); G8_MMA(0, 0, At, B0); G8_BAR; G8_SCHED;
            G8_LDB(B1, 0, 1); G8_STAGEB(G8_SB(0, 0), b2);
            G8_BAR; G8_WAIT_L(0); G8_MMA(0, 1, At, B1); G8_BAR;
            G8_LDA(At, 0, 1); if (use_n) { G8_STAGEA(G8_SA(0, 0), a2, nva, 0); } else { G8_STAGEA(G8_SA(0, 0), a2, cva, 0); }
            G8_BAR; G8_WAIT_L(0); G8_MMA(1, 0, At, B0); G8_BAR; G8_SCHED;
            G8_STAGEB(G8_SB(0, 1), b2 + hstepB);
            G8_WAIT_V(6); G8_BAR; G8_MMA(1, 1, At, B1); G8_BAR;
            G8_LDB(B0, 1, 0); G8_SCHED; G8_LDA(At, 1, 0); if (use_n) { G8_STAGEA(G8_SA(0, 1), a2, nva, 1); } else { G8_STAGEA(G8_SA(0, 1), a2, cva, 1); }
            G8_WAIT_L(8); G8_BAR; G8_WAIT_L(0); G8_MMA(0, 0, At, B0); G8_BAR; G8_SCHED;
            G8_LDB(B1, 1, 1); G8_STAGEB(G8_SB(1, 0), b3);
            G8_BAR; G8_WAIT_L(0); G8_MMA(0, 1, At, B1); G8_BAR;
            G8_LDA(At, 1, 1); if (use_n) { G8_STAGEA(G8_SA(1, 0), a3, nva, 0); } else { G8_STAGEA(G8_SA(1, 0), a3, cva, 0); }
            G8_BAR; G8_WAIT_L(0); G8_MMA(1, 0, At, B0); G8_BAR; G8_SCHED;
            G8_STAGEB(G8_SB(1, 1), b3 + hstepB);
            G8_WAIT_V(6); G8_BAR; G8_MMA(1, 1, At, B1); G8_BAR;
        }
        E(acc, cur, wr, wc, fr, fq);
        if (!has_next) break;
#pragma unroll
        for (int a = 0; a < 2; ++a)
#pragma unroll
            for (int b = 0; b < 2; ++b)
#pragma unroll
                for (int m = 0; m < 4; ++m)
#pragma unroll
                    for (int n = 0; n < 2; ++n) acc[a][b][m][n] = (f32x4){0.f, 0.f, 0.f, 0.f};
        cur = nxt; cA = nA; cB = nB; ++ui;
        if constexpr (Sched::GATHER) {
#pragma unroll
            for (int _h = 0; _h < 2; ++_h) { cva[_h][0] = nva[_h][0]; cva[_h][1] = nva[_h][1]; }
        }
    }
    G8_WAIT_V(0);
    if (wr == 0) G8_BAR;
    G8_BAR;
#undef G8_SA
#undef G8_SB
#undef G8_STAGEA
#undef G8_STAGEB
#undef G8_LDA
#undef G8_LDB
#undef G8_MMA
#undef G8_WAIT_V
#undef G8_WAIT_L
#undef G8_BAR
#undef G8_SCHED
#undef G8_VOFF
}
}

struct TJob { const float* src; bfu* dst; bfu* dst2; int K, N, lds, ldd, Kd, Nd, mode; };

__device__ __forceinline__ void tr_tile(const TJob& jb, int tk, int tn, char* smem, int tid) {
    float* tile = (float*)smem;
    const int k0 = tk * 64, n0 = tn * 64;
    __syncthreads();
#pragma unroll
    for (int i = 0; i < 8; ++i) {
        const int kk = (tid >> 6) + 8 * i, nn = tid & 63;
        const int k = k0 + kk, n = n0 + nn;
        int ns = n;
        if (jb.mode == 1) { const int G = n >> 5, hh = (n >> 4) & 1, ii = n & 15; ns = hh * 1024 + G * 16 + ii; }
        float v = 0.f;
        if (k < jb.K && n < jb.N) v = jb.src[(size_t)k * jb.lds + ns];
        tile[kk * 65 + nn] = v;
    }
    __syncthreads();
#pragma unroll
    for (int i = 0; i < 8; ++i) {
        const int nn = (tid >> 6) + 8 * i, kk = tid & 63;
        const float v = tile[kk * 65 + nn];
        const size_t o = (size_t)(n0 + nn) * jb.ldd + k0 + kk;
        const bfu hi = f2bf(v);
        if (jb.mode == 2) { if (n0 + nn < jb.N) { jb.dst[o] = hi; jb.dst[o + 1024] = hi; jb.dst2[o] = f2bf(v - bf2f(hi)); } }
        else jb.dst[o] = hi;
    }
}

__device__ __forceinline__ void tr_tile256(const float* __restrict__ src, int lds, bfu* __restrict__ dst, int ldd, int mode, int tk, int tn, char* smem, int tid) {
    float* tile = (float*)smem;
    const int k0 = tk * 64, n0 = tn * 256;
    __syncthreads();
    float4 v[8];
#pragma unroll
    for (int i = 0; i < 8; ++i) {
        const int kk = (tid >> 6) + 8 * i, c4 = (tid & 63) * 4;
        int ns = n0 + c4;
        if (mode == 1) { const int n = n0 + c4; ns = ((n >> 4) & 1) * 1024 + (n >> 5) * 16 + (n & 15); }
        v[i] = *(const float4*)(src + (size_t)(k0 + kk) * lds + ns);
    }
#pragma unroll
    for (int i = 0; i < 8; ++i) {
        const int kk = (tid >> 6) + 8 * i, c4 = (tid & 63) * 4;
        float* t = tile + kk * 257 + c4;
        t[0] = v[i].x; t[1] = v[i].y; t[2] = v[i].z; t[3] = v[i].w;
    }
    __syncthreads();
#pragma unroll
    for (int i = 0; i < 4; ++i) {
        const int nn = (tid >> 3) + 64 * i, k8 = (tid & 7) * 8;
        const float* t = tile + k8 * 257 + nn;
        uint4 p;
        p.x = pack2(t[0], t[257]); p.y = pack2(t[2 * 257], t[3 * 257]); p.z = pack2(t[4 * 257], t[5 * 257]); p.w = pack2(t[6 * 257], t[7 * 257]);
        *(uint4*)(dst + (size_t)(n0 + nn) * ldd + k0 + k8) = p;
    }
}

__device__ __forceinline__ void misc_job(const Args& a, int j, TJob& jb) {
    const int l = j / 16, q = j % 16;
    unsigned char* ws = wsp(a);
    jb.dst2 = nullptr; jb.mode = 0;
    bfu* wint = (bfu*)(ws + WS_WINT) + (size_t)l * 8192 * 1024;
    if (q == 0) { jb.src = a.in[8] + (size_t)l * 1024 * 7680; jb.K = 1024; jb.N = 7680; jb.lds = 7680; jb.dst = wint; jb.ldd = 1024; jb.Kd = 1024; jb.Nd = 7680; }
    else if (q <= 2) { const int d = q - 1; jb.src = a.in[13] + (size_t)(l * 2 + d) * 1024 * 64; jb.K = 1024; jb.N = 64; jb.lds = 64; jb.dst = wint + (size_t)(7680 + 64 * d) * 1024; jb.ldd = 1024; jb.Kd = 1024; jb.Nd = 64; }
    else if (q <= 4) { const int d = q - 3; jb.src = a.in[16] + (size_t)(l * 2 + d) * 1024 * 64; jb.K = 1024; jb.N = 64; jb.lds = 64; jb.dst = wint + (size_t)(7808 + 64 * d) * 1024; jb.ldd = 1024; jb.Kd = 1024; jb.Nd = 64; }
    else if (q == 5) { jb.src = a.in[18] + (size_t)l * 1024 * 160; jb.K = 1024; jb.N = 160; jb.lds = 160; jb.dst = wint + (size_t)7936 * 1024; jb.ldd = 1024; jb.Kd = 1024; jb.Nd = 256; }
    else if (q <= 7) { const int d = q - 6; jb.src = a.in[14] + (size_t)(l * 2 + d) * 64 * 512; jb.K = 64; jb.N = 512; jb.lds = 512; jb.dst = (bfu*)(ws + WS_S2T) + (size_t)l * 2560 * 512 + (size_t)(512 * d) * 512 + 64 * d; jb.ldd = 512; jb.Kd = 64; jb.Nd = 512; }
    else if (q <= 9) { const int d = q - 8; jb.src = a.in[17] + (size_t)(l * 2 + d) * 64 * 512; jb.K = 64; jb.N = 512; jb.lds = 512; jb.dst = (bfu*)(ws + WS_S2T) + (size_t)l * 2560 * 512 + (size_t)(1024 + 512 * d) * 512 + 128 + 64 * d; jb.ldd = 512; jb.Kd = 64; jb.Nd = 512; }
    else if (q == 10) { jb.src = a.in[19] + (size_t)l * 160 * 512; jb.K = 160; jb.N = 512; jb.lds = 512; jb.dst = (bfu*)(ws + WS_S2T) + (size_t)l * 2560 * 512 + (size_t)2048 * 512 + 256; jb.ldd = 512; jb.Kd = 192; jb.Nd = 512; }
    else if (q <= 13) { const int n = q - 11; jb.src = a.in[25] + (size_t)(l * 3 + n) * 512 * 1024; jb.K = 512; jb.N = 1024; jb.lds = 1024; jb.dst = (bfu*)(ws + WS_WBT) + (size_t)(l * 3 + n) * 1024 * 512; jb.ldd = 512; jb.Kd = 512; jb.Nd = 1024; }
    else if (q == 14) { jb.src = a.in[26] + (size_t)l * 1024 * 1024; jb.K = 1024; jb.N = 1024; jb.lds = 1024; jb.dst = (bfu*)(ws + WS_WOT) + (size_t)l * 1024 * 1024; jb.ldd = 1024; jb.Kd = 1024; jb.Nd = 1024; }
    else { jb.src = a.in[27] + (size_t)l * 1024 * 32; jb.K = 1024; jb.N = 32; jb.lds = 32; jb.dst = (bfu*)(ws + WS_RT) + (size_t)l * 256 * 2048; jb.dst2 = jb.dst + (size_t)128 * 2048; jb.ldd = 2048; jb.Kd = 1024; jb.Nd = 64; jb.mode = 2; }
}

__device__ __forceinline__ void phase_prep(const Args& a, char* smem, int tid, int bid, int nb) {
    unsigned char* ws = wsp(a);
    for (int it = bid + 12288; it < 12288 + 1280; it += nb) {
        if (it < 12288) {
            const int le = it / 192, r = it % 192;
            if (r < 128) tr_tile256(a.in[29] + (size_t)le * 1024 * 2048, 2048, (bfu*)(ws + WS_W1T) + (size_t)le * 2048 * 1024, 1024, 1, r >> 3, r & 7, smem, tid);
            else { const int r2 = r - 128; tr_tile256(a.in[31] + (size_t)le * 1024 * 1024, 1024, (bfu*)(ws + WS_W2ET) + (size_t)le * 1024 * 1024, 1024, 0, r2 >> 2, r2 & 3, smem, tid); }
        } else {
            const int j = it - 12288, l = j / 640, r = j % 640;
            if (r < 480) tr_tile256(a.in[8] + (size_t)l * 1024 * 7680, 7680, (bfu*)(ws + WS_WINT) + (size_t)l * 8192 * 1024, 1024, 0, r / 30, r % 30, smem, tid);
            else if (r < 576) { const int r2 = r - 480, n = r2 >> 5, q = r2 & 31; tr_tile256(a.in[25] + (size_t)(l * 3 + n) * 512 * 1024, 1024, (bfu*)(ws + WS_WBT) + (size_t)(l * 3 + n) * 1024 * 512, 512, 0, q >> 2, q & 3, smem, tid); }
            else { const int r2 = r - 576;
                for (int cpy = 0; cpy < 1; ++cpy) tr_tile256(a.in[26] + (size_t)l * 1024 * 1024, 1024, (bfu*)(ws + WS_WOT) + (size_t)l * 1024 * 3072 + cpy * 1024, 3072, 0, r2 >> 2, r2 & 3, smem, tid); }
        }
    }
    {
        int base = 0;
        for (int j = 0; j < 32; ++j) {
            TJob jb; misc_job(a, j, jb);
            const int q_ = j % 16;
            const bool fastdone = (q_ == 0) || (q_ >= 11 && q_ <= 15);
            const int tks = jb.Kd >> 6, tns = jb.Nd >> 6, nt = fastdone ? 0 : tks * tns;
            int first = ((bid - base) % nb + nb) % nb;
            for (int t = first; t < nt; t += nb) tr_tile(jb, t / tns, t % tns, smem, tid);
            base = (base + nt) % nb;
        }
    }
    __syncthreads();
    for (int it = bid; it < 192; it += nb) {
        const int l = it / 96, jb0 = (it % 96) * 64;
        float* sl = (float*)smem;
        float* red = (float*)(smem + 36864);
        __syncthreads();
        for (int i = tid; i < 9 * 1024; i += NTHREADS) {
            const int m = i >> 10, k = i & 1023;
            const float v = (m < 8) ? a.in[1][m * 1024 + k] : a.in[3][k];
            sl[i] = v / (1.0f + __expf(-v));
        }
        __syncthreads();
        const int kq = tid >> 4, jv = tid & 15;
        float acc[9][4];
#pragma unroll
        for (int m = 0; m < 9; ++m) { acc[m][0] = 0.f; acc[m][1] = 0.f; acc[m][2] = 0.f; acc[m][3] = 0.f; }
        const float* wm = a.in[4] + (size_t)l * 1024 * 6144 + jb0 + jv * 4;
#pragma unroll 4
        for (int kk = 0; kk < 32; ++kk) {
            const int k = kq * 32 + kk;
            const float4 w = *(const float4*)(wm + (size_t)k * 6144);
#pragma unroll
            for (int m = 0; m < 9; ++m) {
                const float s = sl[m * 1024 + k];
                acc[m][0] += s * w.x; acc[m][1] += s * w.y; acc[m][2] += s * w.z; acc[m][3] += s * w.w;
            }
        }
#pragma unroll
        for (int m = 0; m < 9; ++m)
#pragma unroll
            for (int e = 0; e < 4; ++e) red[(kq * 9 + m) * 64 + jv * 4 + e] = acc[m][e];
        __syncthreads();
        for (int i = tid; i < 9 * 64; i += NTHREADS) {
            const int m = i >> 6, jj = i & 63;
            float s = 0.f;
#pragma unroll
            for (int q = 0; q < 32; ++q) s += red[(q * 9 + m) * 64 + jj];
            ((float*)(ws + WS_MOD))[(size_t)(l * 9 + m) * 6144 + jb0 + jj] = s + a.in[5][l * 6144 + jb0 + jj];
        }
    }
    if (bid == 0) {
        float* tab = (float*)(ws + WS_TAB);
        for (int i = tid; i < 1024; i += NTHREADS) {
            const int pos = i >> 4, j = i & 15;
            const float inv = exp2f(-(float)j * (13.287712379549449f / 16.0f));
            const double ang = (double)((float)pos * inv);
            double rev = ang * 0.15915494309189535;
            rev -= floor(rev);
            tab[i] = __builtin_amdgcn_cosf((float)rev);
            tab[1024 + i] = __builtin_amdgcn_sinf((float)rev);
        }
        if (tid < 2) {
            const float* lv = a.in[9] + tid * 256;
            float s1 = 0.f, s2 = 0.f;
            for (int i = 0; i < 64; ++i) { s1 += lv[i] * lv[64 + i]; s2 += lv[128 + i] * lv[192 + i]; }
            const float lam_init = (tid == 0) ? 0.2f : (0.8f - 0.6f * 0.7408182206817179f);
            tab[2048 + tid] = __expf(s1) - __expf(s2) + lam_init;
        }
    }
}

__device__ __forceinline__ void store_h_row(bfu* dst, const float (&y)[16], int lane) {
#pragma unroll
    for (int i = 0; i < 4; ++i) {
        uint2 p; p.x = pack2(y[i * 4 + 0], y[i * 4 + 1]); p.y = pack2(y[i * 4 + 2], y[i * 4 + 3]);
        *(uint2*)(dst + i * 256 + lane * 4) = p;
    }
}
__device__ __forceinline__ void norm_mod(const float (&v)[16], float (&y)[16], const float* g, const float* shift, const float* scale, int lane) {
    float ss = 0.f;
#pragma unroll
    for (int i = 0; i < 16; ++i) ss += v[i] * v[i];
    ss = wave_sum(ss);
    const float rs = rsqrtf(ss * (1.0f / 1024.0f) + 1e-6f);
#pragma unroll
    for (int i = 0; i < 4; ++i) {
        const int col = i * 256 + lane * 4;
        const float4 gg = *(const float4*)(g + col);
        const float4 sh = *(const float4*)(shift + col);
        const float4 sc = *(const float4*)(scale + col);
        y[i * 4 + 0] = v[i * 4 + 0] * rs * gg.x * (1.0f + sc.x) + sh.x;
        y[i * 4 + 1] = v[i * 4 + 1] * rs * gg.y * (1.0f + sc.y) + sh.y;
        y[i * 4 + 2] = v[i * 4 + 2] * rs * gg.z * (1.0f + sc.z) + sh.z;
        y[i * 4 + 3] = v[i * 4 + 3] * rs * gg.w * (1.0f + sc.w) + sh.w;
    }
}

__device__ __forceinline__ void phase_norm1_l0(const Args& a, int tid, int bid, int nb) {
    const int wave = tid >> 6, lane = tid & 63;
    bfu* xres = (bfu*)(wsp(a) + WS_XRES);
    bfu* H = (bfu*)(wsp(a) + WS_H);
    const float* mod = (const float*)(wsp(a) + WS_MOD);
    for (int row = bid * NW + wave; row < NT; row += nb * NW) {
        const int b = row / TB, t = row % TB;
        const float* src = (t < SEQ) ? (a.in[0] + ((size_t)b * SEQ + t) * 1024) : (a.in[2] + ((size_t)b * CTX + (t - SEQ)) * 1024);
        const int m = (t < SEQ) ? b : 8;
        float v[16], y[16];
#pragma unroll
        for (int i = 0; i < 4; ++i) {
            const float4 x4 = *(const float4*)(src + i * 256 + lane * 4);
            v[i * 4 + 0] = x4.x; v[i * 4 + 1] = x4.y; v[i * 4 + 2] = x4.z; v[i * 4 + 3] = x4.w;
            { uint2 p; p.x = pack2(x4.x, x4.y); p.y = pack2(x4.z, x4.w); *(uint2*)(xres + (size_t)row * 1024 + i * 256 + lane * 4) = p; }
        }
        const float* md = mod + (size_t)(0 * 9 + m) * 6144;
        norm_mod(v, y, a.in[6], md + 0, md + 1024, lane);
        store_h_row(H + (size_t)row * 1024, y, lane);
    }
}

__device__ __forceinline__ void phase_norm2(const Args& a, int l, int tid, int bid, int nb) {
    const int wave = tid >> 6, lane = tid & 63;
    const float* xres = (const float*)(wsp(a) + WS_XRES);
    bfu* HI = (bfu*)(wsp(a) + WS_H2HI);
    bfu* LO = (bfu*)(wsp(a) + WS_H2LO);
    const float* mod = (const float*)(wsp(a) + WS_MOD);
    for (int row = bid * NW + wave; row < NT; row += nb * NW) {
        const int b = row / TB, t = row % TB;
        if (l == 1 && t >= SEQ) continue;
        const int m = (t < SEQ) ? b : 8;
        float v[16], y[16], lo[16];
#pragma unroll
        for (int i = 0; i < 4; ++i) {
            const float4 x4 = *(const float4*)(xres + (size_t)row * 1024 + i * 256 + lane * 4);
            v[i * 4 + 0] = x4.x; v[i * 4 + 1] = x4.y; v[i * 4 + 2] = x4.z; v[i * 4 + 3] = x4.w;
        }
        const float* md = mod + (size_t)(l * 9 + m) * 6144;
        norm_mod(v, y, a.in[7] + l * 1024, md + 3 * 1024, md + 4 * 1024, lane);
#pragma unroll
        for (int i = 0; i < 16; ++i) lo[i] = y[i] - bf2f(f2bf(y[i]));
        store_h_row(HI + (size_t)row * 2048, y, lane);
        store_h_row(HI + (size_t)row * 2048 + 1024, lo, lane);
        store_h_row((bfu*)(wsp(a) + WS_H) + (size_t)row * 1024, y, lane);
    }
}

__device__ __forceinline__ void phase_combine(const Args& a, int l, int tid, int bid, int nb) {
    const int wave = tid >> 6, lane = tid & 63;
    bfu* xres = (bfu*)(wsp(a) + WS_XRES);
    const bfu* YB = (const bfu*)(wsp(a) + WS_YB);
    bfu* H = (bfu*)(wsp(a) + WS_H);
    const float* mod = (const float*)(wsp(a) + WS_MOD);
    for (int row = bid * NW + wave; row < NT; row += nb * NW) {
        const int b = row / TB, t = row % TB;
        if (l == 1 && t >= SEQ) continue;
        const int m = (t < SEQ) ? b : 8;
        const float* md = mod + (size_t)(l * 9 + m) * 6144;
        float v[16], y[16];
#pragma unroll
        for (int i = 0; i < 4; ++i) {
            const int col = i * 256 + lane * 4;
            const uint2 xp = *(const uint2*)(xres + (size_t)row * 1024 + col);
            const float4 x4 = make_float4(bflo(xp.x), bfhi(xp.x), bflo(xp.y), bfhi(xp.y));
            float f0 = 0.f, f1 = 0.f, f2 = 0.f, f3 = 0.f;
#pragma unroll
            for (int k = 0; k < 4; ++k) {
                const uint2 p = *(const uint2*)(YB + ((size_t)row * 4 + k) * 1024 + col);
                f0 += bflo(p.x); f1 += bfhi(p.x); f2 += bflo(p.y); f3 += bfhi(p.y);
            }
            const float4 gf = *(const float4*)(md + 5 * 1024 + col);
            v[i * 4 + 0] = x4.x + gf.x * f0; v[i * 4 + 1] = x4.y + gf.y * f1;
            v[i * 4 + 2] = x4.z + gf.z * f2; v[i * 4 + 3] = x4.w + gf.w * f3;
        }
        if (l == 0) {
#pragma unroll
            for (int i = 0; i < 4; ++i)
                { uint2 p; p.x = pack2(v[i * 4], v[i * 4 + 1]); p.y = pack2(v[i * 4 + 2], v[i * 4 + 3]); *(uint2*)(xres + (size_t)row * 1024 + i * 256 + lane * 4) = p; }
            const float* md1 = mod + (size_t)(1 * 9 + m) * 6144;
            norm_mod(v, y, a.in[6] + 1024, md1 + 0, md1 + 1024, lane);
            store_h_row(H + (size_t)row * 1024, y, lane);
        } else {
            float ss = 0.f;
#pragma unroll
            for (int i = 0; i < 16; ++i) ss += v[i] * v[i];
            ss = wave_sum(ss);
            const float rs = rsqrtf(ss * (1.0f / 1024.0f) + 1e-6f);
            float* o = a.out + ((size_t)b * SEQ + t) * 1024;
#pragma unroll
            for (int i = 0; i < 4; ++i) {
                const int col = i * 256 + lane * 4;
                const float4 gg = *(const float4*)(a.in[33] + col);
                *(float4*)(o + col) = make_float4(v[i * 4] * rs * gg.x, v[i * 4 + 1] * rs * gg.y, v[i * 4 + 2] * rs * gg.z, v[i * 4 + 3] * rs * gg.w);
            }
        }
    }
}

__device__ __forceinline__ void phase_gemm_in(const Args& a, int l, char* smem, int tid, int bid, int nb) {
    unsigned char* ws = wsp(a);
    const bfu* H = (const bfu*)(ws + WS_H);
    const bfu* W = (const bfu*)(ws + WS_WINT) + (size_t)l * 8192 * 1024;
    const float* tab = (const float*)(ws + WS_TAB);
    const int wave = tid >> 6, lane = tid & 63, wm = wave >> 1, wn = wave & 1, g = lane >> 4, c = lane & 15;
    for (int it = bid; it < 72 * 64; it += nb) {
        const int mt = it >> 6, nt = it & 63;
        const int m0 = mt * 256, n0 = nt * 128;
        int arow[4]; ident_rows(arow, m0, tid);
        f32x4 acc[4][4]; zero_acc<4>(acc);
        gemm_loop<4>(acc, H, 1024, arow, W, 1024, n0, 1024, smem, tid);
        const int colbase = n0 + wn * 64;
        const int rowbase = m0 + wm * 64;
        if (nt < 8) {
            bfu* dst = (bfu*)(ws + (nt < 4 ? WS_Q : WS_K));
            const int cc = colbase & 511;
            const float qs = (nt < 4) ? 0.18033688011112042f : 1.0f;
#pragma unroll
            for (int mi = 0; mi < 4; ++mi)
#pragma unroll
                for (int r = 0; r < 4; ++r) {
                    const int row = rowbase + mi * 16 + g * 4 + r;
                    const int t = row % TB;
                    float x0 = acc[mi][0][r], x1 = acc[mi][1][r], x2 = acc[mi][2][r], x3 = acc[mi][3][r];
                    if (t < SEQ) {
                        const int pr = t >> 6, pc = t & 63;
                        const float cr = tab[pr * 16 + c], sr = tab[1024 + pr * 16 + c];
                        const float c2 = tab[pc * 16 + c], s2 = tab[1024 + pc * 16 + c];
                        const float y0 = x0 * cr - x1 * sr, y1 = x0 * sr + x1 * cr;
                        const float y2 = x2 * c2 - x3 * s2, y3 = x2 * s2 + x3 * c2;
                        x0 = y0; x1 = y1; x2 = y2; x3 = y3;
                    }
                    bfu* d = dst + (size_t)row * 512 + cc + c;
                    d[0] = f2bf(x0 * qs); d[16] = f2bf(x1 * qs); d[32] = f2bf(x2 * qs); d[48] = f2bf(x3 * qs);
                }
        } else if (nt < 12) {
            bfu* VT = (bfu*)(ws + WS_VT);
            const int b = m0 / TB;
            const int tb0 = (m0 % TB) + wm * 64;
#pragma unroll
            for (int ni = 0; ni < 4; ++ni) {
                const int cc = colbase - 1024 + ni * 16 + c;
                const int head = cc >> 7, dim = cc & 127;
                bfu* d = VT + ((size_t)(b * 4 + head) * 128 + dim) * TB;
#pragma unroll
                for (int mi = 0; mi < 4; ++mi) {
                    uint2 p; p.x = pack2(acc[mi][ni][0], acc[mi][ni][1]); p.y = pack2(acc[mi][ni][2], acc[mi][ni][3]);
                    *(uint2*)(d + tb0 + mi * 16 + g * 4) = p;
                }
            }
        } else if (nt < 36) {
            bfu* dst; int cc;
            if (nt < 24) { const int q = colbase - 1536; dst = (bfu*)(ws + WS_SB) + (size_t)(q >> 9) * NT * 512; cc = q & 511; }
            else if (nt < 28) { dst = (bfu*)(ws + WS_RR); cc = colbase - 3072; }
            else if (nt < 32) { dst = (bfu*)(ws + WS_RK); cc = colbase - 3584; }
            else { dst = (bfu*)(ws + WS_RV); cc = colbase - 4096; }
#pragma unroll
            for (int mi = 0; mi < 4; ++mi)
#pragma unroll
                for (int ni = 0; ni < 4; ++ni)
#pragma unroll
                    for (int r = 0; r < 4; ++r) {
                        const int row = rowbase + mi * 16 + g * 4 + r;
                        dst[(size_t)row * 512 + cc + ni * 16 + c] = f2bf(acc[mi][ni][r]);
                    }
            if (nt >= 28 && nt < 32) {
                bfu* KKB = (bfu*)(ws + WS_KKB);
                const float* kkw = a.in[20] + l * 512 + cc;
                float w4[4];
#pragma unroll
                for (int ni = 0; ni < 4; ++ni) w4[ni] = kkw[ni * 16 + c];
#pragma unroll
                for (int mi = 0; mi < 4; ++mi)
#pragma unroll
                    for (int r = 0; r < 4; ++r) {
                        float s = 0.f;
#pragma unroll
                        for (int ni = 0; ni < 4; ++ni) { const float q = acc[mi][ni][r] * w4[ni]; s += q * q; }
                        s = red16(s);
                        const float inv = rsqrtf(fmaxf(s, 1e-24f));
                        const int row = rowbase + mi * 16 + g * 4 + r;
#pragma unroll
                        for (int ni = 0; ni < 4; ++ni)
                            KKB[(size_t)row * 512 + cc + ni * 16 + c] = f2bf(acc[mi][ni][r] * w4[ni] * inv);
                    }
            }
        } else if (nt < 60) {
            bfu* GL = (bfu*)(ws + WS_GL);
            const int cc = colbase - 4608;
#pragma unroll
            for (int mi = 0; mi < 4; ++mi)
#pragma unroll
                for (int ni = 0; ni < 4; ++ni)
#pragma unroll
                    for (int r = 0; r < 4; ++r) {
                        const int row = rowbase + mi * 16 + g * 4 + r;
                        GL[(size_t)row * 3072 + cc + ni * 16 + c] = f2bf(sigmoidf_(acc[mi][ni][r]));
                    }
        } else {
            bfu* LO = (bfu*)(ws + WS_LORA);
            const int cc = colbase - 7680;
#pragma unroll
            for (int mi = 0; mi < 4; ++mi)
#pragma unroll
                for (int ni = 0; ni < 4; ++ni)
#pragma unroll
                    for (int r = 0; r < 4; ++r) {
                        const int row = rowbase + mi * 16 + g * 4 + r;
                        float v = acc[mi][ni][r];
                        if (nt == 60) v = tanhf_(v); else if (nt >= 62) v = sigmoidf_(v);
                        LO[(size_t)row * 512 + cc + ni * 16 + c] = f2bf(v);
                    }
        }
    }
}

struct SchedDense {
    static constexpr bool GATHER = false;
    const char* A; const char* B; int lda, ldb, nM, nN, G, c, skip9;
    __device__ __forceinline__ bool next(int i, g8::Unit& u) const {
        int pm, pn; if (!g8::static_tile(i, G, c, nM, nN, pm, pn)) return false;
        if (skip9) pm += pm >> 3;
        pm = g8::uni(pm); pn = g8::uni(pn);
        u.pm = pm; u.pn = pn; u.e = 0; u.cn = 0;
        u.A = A + (size_t)pm * 256 * lda * 2; u.B = B + (size_t)pn * 256 * ldb * 2; return true;
    }
    __device__ __forceinline__ void rows(const g8::Unit&, int, int&) const {}
};
__device__ __forceinline__ uint2 pack4(const f32x4& v) { uint2 p; p.x = pack2(v[0], v[1]); p.y = pack2(v[2], v[3]); return p; }

struct EpiIn {
    static constexpr bool PERM = true;
    unsigned char* ws; int l;
    __device__ __forceinline__ void operator()(const f32x4 (&acc)[2][2][4][2], const g8::Unit& u, int wr, int wc, int fr, int fq) const {
        const int pn = u.pn;
        const int row0 = u.pm * 256 + wr * 64 + fr;
        const int colw = 32 * wc + 8 * fq;
        if (pn < 4) {
            bfu* dst = (bfu*)(ws + (pn < 2 ? WS_Q : WS_K)) + (pn & 1) * 256 + colw;
            const float* tab = (const float*)(ws + WS_TAB);
            const float qs = (pn < 2) ? 0.18033688011112042f : 1.0f;
            const bool colrot = (wc & 1) != 0;
            const bool latent = ((u.pm % 9) != 8);
            const float sgn = (fq < 2) ? -1.0f : 1.0f;
            const int fo = 8 * (fq & 1);
#pragma unroll
            for (int ai = 0; ai < 2; ++ai)
#pragma unroll
                for (int m = 0; m < 4; ++m) {
                    const int row = row0 + ai * 128 + m * 16;
                    const int t = row % TB;
                    const int pos = colrot ? (t & 63) : ((t >> 6) & 31);
                    f32x4 cs[2], sn[2];
#pragma unroll
                    for (int n = 0; n < 2; ++n) { cs[n] = *(const f32x4*)(tab + pos * 16 + fo + 4 * n); sn[n] = *(const f32x4*)(tab + 1024 + pos * 16 + fo + 4 * n); }
#pragma unroll
                    for (int bj = 0; bj < 2; ++bj) {
                        uint2 pk[2];
#pragma unroll
                        for (int n = 0; n < 2; ++n) {
                            f32x4 x = acc[ai][bj][m][n];
                            if (latent) {
                                f32x4 p;
                                p[0] = shx_(x[0], 32); p[1] = shx_(x[1], 32); p[2] = shx_(x[2], 32); p[3] = shx_(x[3], 32);
                                x = x * cs[n] + (p * sn[n]) * sgn;
                            }
                            pk[n] = pack4(x * qs);
                        }
                        *(uint4*)(dst + (size_t)row * 512 + bj * 128) = make_uint4(pk[0].x, pk[0].y, pk[1].x, pk[1].y);
                    }
                }
        } else if (pn < 6) {
            bfu* VT = (bfu*)(ws + WS_VT);
            const int rbase = u.pm * 256;
            const int b = rbase / TB, t0 = (rbase % TB) + wr * 64 + fr;
#pragma unroll
            for (int bj = 0; bj < 2; ++bj)
#pragma unroll
                for (int n = 0; n < 2; ++n) {
                    const int cc = (pn - 4) * 256 + bj * 128 + colw + n * 4;
                    const int head = cc >> 7, dim = cc & 127;
                    bfu* d = VT + ((size_t)(b * 4 + head) * 128 + dim) * TB + t0;
#pragma unroll
                    for (int ai = 0; ai < 2; ++ai)
#pragma unroll
                        for (int m = 0; m < 4; ++m)
#pragma unroll
                            for (int j = 0; j < 4; ++j) d[(size_t)j * TB + ai * 128 + m * 16] = f2bf(acc[ai][bj][m][n][j]);
                }
        } else {
            bfu* dst; int ld, kind;
            if (pn < 18) { dst = (bfu*)(ws + WS_SB) + (size_t)((pn - 6) >> 1) * NT * 512 + ((pn - 6) & 1) * 256; ld = 512; kind = 0; }
            else if (pn < 30) { dst = (bfu*)(ws + WS_GL) + (pn - 18) * 256; ld = 3072; kind = 1; }
            else { dst = (bfu*)(ws + WS_LORA) + (pn - 30) * 256; ld = 512; kind = (pn == 31) ? 1 : 2; }
            dst += colw;
#pragma unroll
            for (int ai = 0; ai < 2; ++ai)
#pragma unroll
                for (int m = 0; m < 4; ++m) {
                    bfu* d = dst + (size_t)(row0 + ai * 128 + m * 16) * ld;
#pragma unroll
                    for (int bj = 0; bj < 2; ++bj) {
                        uint2 pk[2];
#pragma unroll
                        for (int n = 0; n < 2; ++n) {
                            f32x4 v = acc[ai][bj][m][n];
                            if (kind == 1) { v[0] = sigmoidf_(v[0]); v[1] = sigmoidf_(v[1]); v[2] = sigmoidf_(v[2]); v[3] = sigmoidf_(v[3]); }
                            else if (kind == 2 && bj == 0) { v[0] = tanhf_(v[0]); v[1] = tanhf_(v[1]); v[2] = tanhf_(v[2]); v[3] = tanhf_(v[3]); }
                            pk[n] = pack4(v);
                        }
                        *(uint4*)(d + bj * 128) = make_uint4(pk[0].x, pk[0].y, pk[1].x, pk[1].y);
                    }
                }
        }
    }
};

__device__ __forceinline__ void phase_gemm_in8(const Args& a, int l, char* smem, int tid, int bid, int nb) {
    SchedDense S;
    S.A = (const char*)(wsp(a) + WS_H); S.B = (const char*)(wsp(a) + WS_WINT) + (size_t)l * 8192 * 1024 * 2;
    S.lda = 1024; S.ldb = 1024; S.nM = 72; S.nN = 32; S.G = nb; S.c = bid; S.skip9 = 0;
    EpiIn E; E.ws = wsp(a); E.l = l;
    g8::gemm8(( LAS unsigned char*)smem, S, E, 1024, tid);
}

__device__ __forceinline__ int scan_tok(int d, int idx) {
    if (d == 0) return (idx < CTX) ? (SEQ + idx) : (idx - CTX);
    return (idx < CTX) ? (TB - 1 - idx) : (SEQ - 1 - (idx - CTX));
}
struct StepRaw { uint2 w, kk, b, ke, r; unsigned v; };

__device__ __forceinline__ void scan_item(const Args& a, int l, int item, int tid) {
    unsigned char* ws = wsp(a);
    const int wave = tid >> 6, lane = tid & 63;
    const int sub = item & 1, d = (item >> 1) & 1, h = (item >> 2) & 7, b = item >> 5;
    const int rg = sub * 8 + wave;
    const int i = rg * 4 + (lane >> 4), jg = lane & 15;
    const bfu* WD = (const bfu*)(ws + WS_WDEC) + (size_t)d * NT * 512 + h * 64 + jg * 4;
    const bfu* KK = (const bfu*)(ws + WS_KKB) + h * 64 + jg * 4;
    const bfu* BV = (const bfu*)(ws + WS_BV) + (size_t)d * NT * 512 + h * 64 + jg * 4;
    const bfu* KE = (const bfu*)(ws + WS_KE) + (size_t)d * NT * 512 + h * 64 + jg * 4;
    const bfu* RR = (const bfu*)(ws + WS_RR) + h * 64 + jg * 4;
    const bfu* RV = (const bfu*)(ws + WS_RV) + h * 64 + i;
    float* Y = (float*)(ws + WS_Y) + (size_t)d * NT * 512 + h * 64 + i;
    const size_t rb = (size_t)b * TB;
    float s0 = 0.f, s1 = 0.f, s2 = 0.f, s3 = 0.f;
    constexpr int U = 4;
    StepRaw nx[U];
#pragma unroll
    for (int u = 0; u < U; ++u) {
        const size_t o = (rb + scan_tok(d, u)) * 512;
        nx[u].w = *(const uint2*)(WD + o); nx[u].kk = *(const uint2*)(KK + o); nx[u].b = *(const uint2*)(BV + o);
        nx[u].ke = *(const uint2*)(KE + o); nx[u].r = *(const uint2*)(RR + o); nx[u].v = RV[o];
    }
    for (int base = 0; base < TB; base += U) {
        StepRaw cu[U];
#pragma unroll
        for (int u = 0; u < U; ++u) cu[u] = nx[u];
        if (base + U < TB) {
#pragma unroll
            for (int u = 0; u < U; ++u) {
                const size_t o = (rb + scan_tok(d, base + U + u)) * 512;
                nx[u].w = *(const uint2*)(WD + o); nx[u].kk = *(const uint2*)(KK + o); nx[u].b = *(const uint2*)(BV + o);
                nx[u].ke = *(const uint2*)(KE + o); nx[u].r = *(const uint2*)(RR + o); nx[u].v = RV[o];
            }
        }
#pragma unroll
        for (int u = 0; u < U; ++u) {
            const float k0 = bflo(cu[u].kk.x), k1 = bfhi(cu[u].kk.x), k2 = bflo(cu[u].kk.y), k3 = bfhi(cu[u].kk.y);
            float sk = s0 * k0 + s1 * k1 + s2 * k2 + s3 * k3;
            sk = red16(sk);
            const float v = bf2f((bfu)cu[u].v);
            s0 = s0 * bflo(cu[u].w.x) + (v * bflo(cu[u].ke.x) - sk * (k0 * bflo(cu[u].b.x)));
            s1 = s1 * bfhi(cu[u].w.x) + (v * bfhi(cu[u].ke.x) - sk * (k1 * bfhi(cu[u].b.x)));
            s2 = s2 * bflo(cu[u].w.y) + (v * bflo(cu[u].ke.y) - sk * (k2 * bflo(cu[u].b.y)));
            s3 = s3 * bfhi(cu[u].w.y) + (v * bfhi(cu[u].ke.y) - sk * (k3 * bfhi(cu[u].b.y)));
            float y = s0 * bflo(cu[u].r.x) + s1 * bfhi(cu[u].r.x) + s2 * bflo(cu[u].r.y) + s3 * bfhi(cu[u].r.y);
            y = red16(y);
            const int tt = scan_tok(d, base + u);
            if (jg == 0 && (l == 0 || tt < SEQ)) Y[(rb + tt) * 512] = y;
        }
    }
}

__device__ __forceinline__ void cvt_expert_tile(const Args& a, unsigned char* ws, int l, int t, int sub, int lane) {
    const int e = t / 768, r = t % 768;
    const float* src; bfu* dst; int lds, tk, tn; bool w1;
    if (r < 512) { w1 = true; src = a.in[29] + (size_t)(l * 32 + e) * 1024 * 2048; lds = 2048; dst = (bfu*)(ws + WS_W1T) + (size_t)(l * 32 + e) * 2048 * 1024; tk = r >> 5; tn = r & 31; }
    else { const int r2 = r - 512; w1 = false; src = a.in[31] + (size_t)(l * 32 + e) * 1024 * 1024; lds = 1024; dst = (bfu*)(ws + WS_W2ET) + (size_t)(l * 32 + e) * 1024 * 1024; tk = r2 >> 4; tn = r2 & 15; }
    const int kq = lane >> 4, n4 = lane & 15;
    const int nd = tn * 64 + n4 * 4;
    const int ns = w1 ? (((nd >> 7) & 1) * 1024 + (nd >> 8) * 128 + (nd & 127)) : nd;
    const float* sp = src + (size_t)(tk * 64 + sub * 32 + kq * 8) * lds + ns;
    float4 v[8];
#pragma unroll
    for (int i = 0; i < 8; ++i) v[i] = *(const float4*)(sp + (size_t)i * lds);
    bfu* dp = dst + (size_t)nd * 1024 + tk * 64 + sub * 32 + kq * 8;
#pragma unroll
    for (int c = 0; c < 4; ++c) {
        uint4 p0;
#define CV_(i) (c == 0 ? v[i].x : c == 1 ? v[i].y : c == 2 ? v[i].z : v[i].w)
        p0.x = pack2(CV_(0), CV_(1)); p0.y = pack2(CV_(2), CV_(3)); p0.z = pack2(CV_(4), CV_(5)); p0.w = pack2(CV_(6), CV_(7));
#undef CV_
        *(uint4*)(dp + (size_t)c * 1024) = p0;
    }
}

constexpr int SC_CH = 32;
constexpr int SC_STEP = 5 * 64 + 4;
constexpr int SC_BUF = SC_CH * (SC_STEP + 32) * 4;
struct ScanStep { f32x4 w[2], kq[4], b[2], e[2]; float br, kr, v; };
__device__ __forceinline__ void scan_item2(const Args& a, int l, int item, char* smem, int tid) {
    unsigned char* ws = wsp(a);
    const int wave = tid >> 6, lane = tid & 63;
    const int half = item & 1, d = (item >> 1) & 1, h = (item >> 2) & 7, b = item >> 5;
    const int rloc = (wave & 3) * 8 + (lane >> 3), jg = lane & 7;
    const int ss = tid >> 4, sj = tid & 15;
    const bfu* WD = (const bfu*)(ws + WS_WDEC) + (size_t)d * NT * 512 + h * 64 + sj * 4;
    const bfu* AV = (const bfu*)(ws + WS_BV) + (size_t)d * NT * 512 + h * 64 + sj * 4;
    const bfu* RK = (const bfu*)(ws + WS_RK) + h * 64 + sj * 4;
    const bfu* RR = (const bfu*)(ws + WS_RR) + h * 64 + sj * 4;
    const bfu* RV = (const bfu*)(ws + WS_RV) + h * 64 + half * 32 + sj * 2;
    float* Y = (float*)(ws + WS_Y) + (size_t)d * NT * 512 + h * 64 + half * 32 + sj * 2;
    const f32x4 kkw = *(const f32x4*)(a.in[20] + l * 512 + h * 64 + sj * 4);
    const f32x4 kaw = *(const f32x4*)(a.in[21] + l * 512 + h * 64 + sj * 4);
    const size_t rb = (size_t)b * TB;
    float* ybuf0 = (float*)(smem + 2 * SC_BUF);
    uint2 rw, rk, ra, rr; unsigned rv;
#define SC_LOAD(chunk) do { const size_t _o = (rb + scan_tok(d, (chunk) * SC_CH + ss)) * 512; \
        rw = *(const uint2*)(WD + _o); rk = *(const uint2*)(RK + _o); ra = *(const uint2*)(AV + _o); rr = *(const uint2*)(RR + _o); rv = *(const unsigned*)(RV + _o); } while (0)
#define SC_WRITE(bufp) do { float* _b = (float*)(bufp) + ss * SC_STEP + sj * 4; \
        const f32x4 _k = {bflo(rk.x), bfhi(rk.x), bflo(rk.y), bfhi(rk.y)}; const f32x4 _a = {bflo(ra.x), bfhi(ra.x), bflo(ra.y), bfhi(ra.y)}; \
        const f32x4 _w = {bflo(rw.x), bfhi(rw.x), bflo(rw.y), bfhi(rw.y)}; const f32x4 _r = {bflo(rr.x), bfhi(rr.x), bflo(rr.y), bfhi(rr.y)}; \
        f32x4 _q = _k * kkw; float _s = _q[0] * _q[0] + _q[1] * _q[1] + _q[2] * _q[2] + _q[3] * _q[3]; _s = red16(_s); \
        _q *= rsqrtf(fmaxf(_s, 1e-24f)); \
        const f32x4 _bb = _q * _a; const f32x4 _ke = _k * (1.0f + (_a - 1.0f) * kaw); \
        float _br = _bb[0] * _r[0] + _bb[1] * _r[1] + _bb[2] * _r[2] + _bb[3] * _r[3]; _br = red16(_br); \
        float _kr = _ke[0] * _r[0] + _ke[1] * _r[1] + _ke[2] * _r[2] + _ke[3] * _r[3]; _kr = red16(_kr); \
        const f32x4 _wr = _w * _r; float* _kq = (float*)(bufp) + ss * SC_STEP + 64 + sj * 8; \
        *(f32x4*)(_b) = _w; *(f32x4*)(_kq) = (f32x4){_q[0], _wr[0], _q[1], _wr[1]}; *(f32x4*)(_kq + 4) = (f32x4){_q[2], _wr[2], _q[3], _wr[3]}; \
        *(f32x4*)(_b + 192) = _bb; *(f32x4*)(_b + 256) = _ke; \
        if (sj == 0) { float* _sc = (float*)(bufp) + ss * SC_STEP + 320; _sc[0] = _br; _sc[1] = _kr; } \
        float* _v = (float*)(bufp) + SC_CH * SC_STEP + ss * 32 + sj * 2; _v[0] = bflo(rv); _v[1] = bfhi(rv); } while (0)
#define SC_FETCH(dst, st) do { const float* _p = vec + (st) * SC_STEP; \
        dst.w[0] = *(const f32x4*)(_p); dst.w[1] = *(const f32x4*)(_p + 4); \
        dst.kq[0] = *(const f32x4*)(_p + 64 + jg * 8); dst.kq[1] = *(const f32x4*)(_p + 68 + jg * 8); dst.kq[2] = *(const f32x4*)(_p + 72 + jg * 8); dst.kq[3] = *(const f32x4*)(_p + 76 + jg * 8); \
        dst.b[0] = *(const f32x4*)(_p + 192); dst.b[1] = *(const f32x4*)(_p + 196); dst.e[0] = *(const f32x4*)(_p + 256); dst.e[1] = *(const f32x4*)(_p + 260); \
        const float2 _s2 = *(const float2*)(_p + 320 - jg * 8); dst.br = _s2.x; dst.kr = _s2.y; dst.v = vv[(st) * 32]; } while (0)
#define SC_BODY(cu, st) do { \
        f32x2_t d2 = {0.f, 0.f};                           \
        d2 += (f32x2_t){sA[0], sA[0]} * (f32x2_t){cu.kq[0][0], cu.kq[0][1]}; d2 += (f32x2_t){sA[1], sA[1]} * (f32x2_t){cu.kq[0][2], cu.kq[0][3]}; \
        d2 += (f32x2_t){sA[2], sA[2]} * (f32x2_t){cu.kq[1][0], cu.kq[1][1]}; d2 += (f32x2_t){sA[3], sA[3]} * (f32x2_t){cu.kq[1][2], cu.kq[1][3]}; \
        d2 += (f32x2_t){sB[0], sB[0]} * (f32x2_t){cu.kq[2][0], cu.kq[2][1]}; d2 += (f32x2_t){sB[1], sB[1]} * (f32x2_t){cu.kq[2][2], cu.kq[2][3]}; \
        d2 += (f32x2_t){sB[2], sB[2]} * (f32x2_t){cu.kq[3][0], cu.kq[3][1]}; d2 += (f32x2_t){sB[3], sB[3]} * (f32x2_t){cu.kq[3][2], cu.kq[3][3]}; \
        float sk = d2[0], z = d2[1]; \
        sk += dppf<0xB1>(sk); z += dppf<0xB1>(z); \
        sk += dppf<0x4E>(sk); z += dppf<0x4E>(z); \
        sk += dppf<0x141>(sk); z += dppf<0x141>(z); \
        sA = sA * cu.w[0] + (cu.e[0] * cu.v - cu.b[0] * sk); \
        sB = sB * cu.w[1] + (cu.e[1] * cu.v - cu.b[1] * sk); \
        const float _y = z - sk * cu.br + cu.v * cu.kr; \
        yq[(st) >> 3] = (jg == ((st) & 7)) ? _y : yq[(st) >> 3]; } while (0)
    __syncthreads();
    SC_LOAD(0);
    SC_WRITE(smem);
    __syncthreads();
    f32x4 sA = {0.f, 0.f, 0.f, 0.f}, sB = {0.f, 0.f, 0.f, 0.f};
    constexpr int NCH = TB / SC_CH;
    for (int ch = 0; ch < NCH; ++ch) {
        const char* cur = smem + (ch & 1) * SC_BUF;
        float* ybuf = ybuf0 + (ch & 1) * SC_CH * 32;
        if (ch + 1 < NCH) SC_LOAD(ch + 1);
        if (wave >= 4) {
            { const int c2 = (ch + (item % 3)) % NCH, pos = c2 % 3;
              if (pos != 0) cvt_expert_tile(a, ws, l, (item * 4 + (wave - 4)) + 1024 * (c2 / 3), pos - 1, lane); }
        } else {
            const float* vec = (const float*)cur + jg * 8;
            const float* vv = (const float*)cur + SC_CH * SC_STEP + rloc;
            float yq[4] = {0.f, 0.f, 0.f, 0.f};
            ScanStep c0, c1, c2;
            SC_FETCH(c0, 0);
            SC_FETCH(c1, 1);
#pragma unroll
            for (int st = 0; st < SC_CH; st += 3) {
                if (st + 2 < SC_CH) SC_FETCH(c2, st + 2);
                SC_BODY(c0, st);
                if (st + 1 < SC_CH) {
                    if (st + 3 < SC_CH) SC_FETCH(c0, st + 3);
                    SC_BODY(c1, st + 1);
                }
                if (st + 2 < SC_CH) {
                    if (st + 4 < SC_CH) SC_FETCH(c1, st + 4);
                    SC_BODY(c2, st + 2);
                }
            }
#pragma unroll
            for (int o = 0; o < 4; ++o) ybuf[(o * 8 + jg) * 32 + rloc] = yq[o];
        }
        if (ch + 1 < NCH) SC_WRITE(smem + ((ch + 1) & 1) * SC_BUF);
        __syncthreads();
        const int tok = scan_tok(d, ch * SC_CH + ss);
        const float2 yy = *(const float2*)(ybuf + ss * 32 + sj * 2);
        if (l == 0 || tok < SEQ) *(float2*)(Y + (rb + tok) * 512) = yy;
    }
#undef SC_LOAD
#undef SC_WRITE
#undef SC_FETCH
#undef SC_BODY
}

constexpr int KROW = 272;
constexpr int VROW = 144;
__device__ __forceinline__ void attn_item(const Args& a, int l, int item, char* smem, int tid) {
    unsigned char* ws = wsp(a);
    const int wave = tid >> 6, lane = tid & 63, g = lane >> 4, c = lane & 15;
    int b, head, r0, kt0;
    if (item < 512) { b = item >> 6; head = (item >> 4) & 3; r0 = b * TB + (item & 15) * 128; kt0 = 0; }
    else { const int j = item - 512; b = j >> 3; head = (j >> 1) & 3; r0 = b * TB + SEQ + (j & 1) * 128; kt0 = 32; }
    const bfu* Q = (const bfu*)(ws + WS_Q);
    const bfu* Kp = (const bfu*)(ws + WS_K) + (size_t)b * TB * 512 + head * 128;
    const bfu* Vp = (const bfu*)(ws + WS_VT) + (size_t)(b * 4 + head) * 128 * TB;
    char* Ks = smem;
    char* Vs = smem + 64 * KROW;
    const int qrow = r0 + wave * 16 + c;
    bf16x8 q1[2], q2[2];
#pragma unroll
    for (int ks = 0; ks < 2; ++ks) {
        q1[ks] = *(const bf16x8*)(Q + (size_t)qrow * 512 + head * 128 + ks * 32 + g * 8);
        q2[ks] = *(const bf16x8*)(Q + (size_t)qrow * 512 + head * 128 + 64 + ks * 32 + g * 8);
    }
    float m1 = -1e30f, m2 = -1e30f, l1 = 0.f, l2 = 0.f;
    f32x4 o1[8], o2[8];
#pragma unroll
    for (int mt = 0; mt < 8; ++mt) { o1[mt] = (f32x4){0.f, 0.f, 0.f, 0.f}; o2[mt] = (f32x4){0.f, 0.f, 0.f, 0.f}; }
    for (int kt = kt0; kt < 36; ++kt) {
        __syncthreads();
#pragma unroll
        for (int i = 0; i < 2; ++i) {
            const int key = (tid >> 4) + 32 * i, ch = tid & 15;
            *(uint4*)(Ks + key * KROW + ch * 16) = *(const uint4*)(Kp + (size_t)(kt * 64 + key) * 512 + ch * 8);
            const int dim = (tid >> 3) + 64 * i, cv = tid & 7;
            *(uint4*)(Vs + dim * VROW + cv * 16) = *(const uint4*)(Vp + (size_t)dim * TB + kt * 64 + cv * 8);
        }
        __syncthreads();
        f32x4 s1[4], s2[4];
#pragma unroll
        for (int kq = 0; kq < 4; ++kq) {
            s1[kq] = (f32x4){0.f, 0.f, 0.f, 0.f}; s2[kq] = (f32x4){0.f, 0.f, 0.f, 0.f};
#pragma unroll
            for (int ks = 0; ks < 2; ++ks) {
                const bf16x8 a1 = *(const bf16x8*)(Ks + (kq * 16 + c) * KROW + ks * 64 + g * 16);
                const bf16x8 a2 = *(const bf16x8*)(Ks + (kq * 16 + c) * KROW + 128 + ks * 64 + g * 16);
                s1[kq] = __builtin_amdgcn_mfma_f32_16x16x32_bf16(a1, q1[ks], s1[kq], 0, 0, 0);
                s2[kq] = __builtin_amdgcn_mfma_f32_16x16x32_bf16(a2, q2[ks], s2[kq], 0, 0, 0);
            }
        }
        float mx1 = s1[0][0], mx2 = s2[0][0];
#pragma unroll
        for (int kq = 0; kq < 4; ++kq)
#pragma unroll
            for (int r = 0; r < 4; ++r) { mx1 = fmaxf(mx1, s1[kq][r]); mx2 = fmaxf(mx2, s2[kq][r]); }
        mx1 = fmaxf(mx1, shx_(mx1, 16)); mx1 = fmaxf(mx1, shx_(mx1, 32));
        mx2 = fmaxf(mx2, shx_(mx2, 16)); mx2 = fmaxf(mx2, shx_(mx2, 32));
        const float mn1 = fmaxf(m1, mx1), mn2 = fmaxf(m2, mx2);
        const float al1 = exp2f(m1 - mn1), al2 = exp2f(m2 - mn2);
        m1 = mn1; m2 = mn2;
        float ps1 = 0.f, ps2 = 0.f;
        bf16x8 pb1[2], pb2[2];
#pragma unroll
        for (int kk = 0; kk < 2; ++kk) {
            float p[8], q[8];
#pragma unroll
            for (int e = 0; e < 4; ++e) {
                p[e] = exp2f(s1[2 * kk][e] - mn1); p[4 + e] = exp2f(s1[2 * kk + 1][e] - mn1);
                q[e] = exp2f(s2[2 * kk][e] - mn2); q[4 + e] = exp2f(s2[2 * kk + 1][e] - mn2);
            }
#pragma unroll
            for (int e = 0; e < 8; ++e) { ps1 += p[e]; ps2 += q[e]; pb1[kk][e] = (short)f2bf(p[e]); pb2[kk][e] = (short)f2bf(q[e]); }
        }
        l1 = l1 * al1 + ps1; l2 = l2 * al2 + ps2;
#pragma unroll
        for (int mt = 0; mt < 8; ++mt) {
            o1[mt] *= al1; o2[mt] *= al2;
#pragma unroll
            for (int kk = 0; kk < 2; ++kk) {
                const uint2 v0 = *(const uint2*)(Vs + (mt * 16 + c) * VROW + (kk * 32 + g * 4) * 2);
                const uint2 v1 = *(const uint2*)(Vs + (mt * 16 + c) * VROW + (kk * 32 + 16 + g * 4) * 2);
                union { uint4 u; bf16x8 v; } av; av.u = make_uint4(v0.x, v0.y, v1.x, v1.y);
                o1[mt] = __builtin_amdgcn_mfma_f32_16x16x32_bf16(av.v, pb1[kk], o1[mt], 0, 0, 0);
                o2[mt] = __builtin_amdgcn_mfma_f32_16x16x32_bf16(av.v, pb2[kk], o2[mt], 0, 0, 0);
            }
        }
    }
    l1 += shx_(l1, 16); l1 += shx_(l1, 32);
    l2 += shx_(l2, 16); l2 += shx_(l2, 32);
    const float lam = ((const float*)(ws + WS_TAB))[2048 + l];
    const float lam_init = (l == 0) ? 0.2f : (0.8f - 0.6f * 0.7408182206817179f);
    const float i1 = 1.0f / l1, i2 = lam / l2;
    float ss = 0.f;
#pragma unroll
    for (int mt = 0; mt < 8; ++mt)
#pragma unroll
        for (int r = 0; r < 4; ++r) { const float v = o1[mt][r] * i1 - o2[mt][r] * i2; o1[mt][r] = v; ss += v * v; }
    ss += shx_(ss, 16); ss += shx_(ss, 32);
    const float rs = rsqrtf(ss * (1.0f / 128.0f) + 1e-5f) * (1.0f - lam_init);
    bfu* ODA = (bfu*)(ws + WS_ODA);
    const float* sg = a.in[10] + l * 128;
#pragma unroll
    for (int mt = 0; mt < 8; ++mt) {
        const int dim = mt * 16 + g * 4;
        const float4 gg = *(const float4*)(sg + dim);
        uint2 p; p.x = pack2(o1[mt][0] * rs * gg.x, o1[mt][1] * rs * gg.y); p.y = pack2(o1[mt][2] * rs * gg.z, o1[mt][3] * rs * gg.w);
        *(uint2*)(ODA + (size_t)qrow * 512 + head * 128 + dim) = p;
    }
}

struct SlabAddr { const float* src; bfu* dst; int lds; };
__device__ __forceinline__ void slab_addr(const Args& a, unsigned char* ws, int l, int sid, int tid, SlabAddr& A) {
    const int e = sid / 768, r = sid % 768;
    const int n = tid & 63, kq = tid >> 6;
    if (r < 512) {
        const int tk = r >> 5, tn = r & 31, nd = tn * 64 + n;
        const int ns = ((nd >> 7) & 1) * 1024 + (nd >> 8) * 128 + (nd & 127);
        A.lds = 2048; A.src = a.in[29] + (size_t)(l * 32 + e) * 1024 * 2048 + (size_t)(tk * 64 + kq * 8) * 2048 + ns;
        A.dst = (bfu*)(ws + WS_W1T) + (size_t)(l * 32 + e) * 2048 * 1024 + (size_t)nd * 1024 + tk * 64 + kq * 8;
    } else {
        const int r2 = r - 512, tk = r2 >> 4, tn = r2 & 15, nd = tn * 64 + n;
        A.lds = 1024; A.src = a.in[31] + (size_t)(l * 32 + e) * 1024 * 1024 + (size_t)(tk * 64 + kq * 8) * 1024 + nd;
        A.dst = (bfu*)(ws + WS_W2ET) + (size_t)(l * 32 + e) * 1024 * 1024 + (size_t)nd * 1024 + tk * 64 + kq * 8;
    }
}

constexpr int AT_BUF = 64 * KROW + 128 * VROW;
__device__ __forceinline__ void attn_item2(const Args& a, int l, int item, char* smem, int tid) {
    unsigned char* ws = wsp(a);
    const int wave = tid >> 6, lane = tid & 63, g = lane >> 4, c = lane & 15;
    int b, head, r0, kt0;
    if (item < 512) { b = item >> 6; head = (item >> 4) & 3; r0 = b * TB + (item & 15) * 128; kt0 = 0; }
    else { const int j = item - 512; b = j >> 3; head = (j >> 1) & 3; r0 = b * TB + SEQ + (j & 1) * 128; kt0 = 32; }
    const bfu* Q = (const bfu*)(ws + WS_Q);
    const char* Kb = (const char*)(ws + WS_K) + ((size_t)b * TB * 512 + head * 128) * 2;
    const char* Vb = (const char*)(ws + WS_VT) + (size_t)(b * 4 + head) * 128 * TB * 2;
    const unsigned klo = (unsigned)((tid >> 4) * 512 + (tid & 15) * 8) * 2u, vlo = (unsigned)((tid >> 3) * TB + (tid & 7) * 8) * 2u;
    const bool piggy = (item < 512);
    const int pe = item >> 4, pi16 = item & 15;
    const char* ps1 = (const char*)(a.in[29] + ((size_t)(l * 32 + pe) * 1024 + pi16 * 64) * 2048);
    const char* ps2 = (const char*)(a.in[31] + ((size_t)(l * 32 + pe) * 1024 + (pi16 >> 2) * 64) * 1024 + (pi16 & 3) * 256);
    char* pd1 = (char*)((bfu*)(ws + WS_W1T) + (size_t)(l * 32 + pe) * 2048 * 1024 + pi16 * 64);
    char* pd2 = (char*)((bfu*)(ws + WS_W2ET) + (size_t)(l * 32 + pe) * 1024 * 1024 + (size_t)((pi16 & 3) * 256) * 1024 + (pi16 >> 2) * 64);
    const unsigned pls1 = (unsigned)((tid >> 6) * 8 * 2048 + (tid & 63)) * 4u, pls2 = (unsigned)((tid >> 6) * 8 * 1024 + (tid & 63)) * 4u;
    const unsigned pld = (unsigned)((tid & 63) * 1024 + (tid >> 6) * 8) * 2u;
    const int kw = (tid >> 4) * KROW + (tid & 15) * 16;
    const int vw = 64 * KROW + (tid >> 3) * VROW + (tid & 7) * 16;
    const int qrow = r0 + wave * 16 + c;
    bf16x8 q1[2], q2[2];
#pragma unroll
    for (int ks = 0; ks < 2; ++ks) {
        q1[ks] = *(const bf16x8*)(Q + (size_t)qrow * 512 + head * 128 + ks * 32 + g * 8);
        q2[ks] = *(const bf16x8*)(Q + (size_t)qrow * 512 + head * 128 + 64 + ks * 32 + g * 8);
    }
    bf16x8 ones;
#pragma unroll
    for (int e = 0; e < 8; ++e) ones[e] = (short)0x3F80;
    float m1 = 0.f, m2 = 0.f;
    f32x4 o1[8], o2[8], ls1 = {0.f, 0.f, 0.f, 0.f}, ls2 = {0.f, 0.f, 0.f, 0.f};
#pragma unroll
    for (int mt = 0; mt < 8; ++mt) { o1[mt] = (f32x4){0.f, 0.f, 0.f, 0.f}; o2[mt] = (f32x4){0.f, 0.f, 0.f, 0.f}; }
    u32x4_t rk0, rk1, rv0, rv1;
#define AT_LOAD(kt) do { GAS const char* kb_ = (GAS const char*)(Kb + (size_t)(kt) * 65536); GAS const char* kb2_ = kb_ + 32768; GAS const char* vb_ = (GAS const char*)(Vb + (kt) * 128); GAS const char* vb2_ = vb_ + 64 * TB * 2; \
        unsigned ko_ = klo, vo_ = vlo; asm volatile("" : "+v"(ko_), "+v"(vo_), "+s"(kb_), "+s"(kb2_), "+s"(vb_), "+s"(vb2_)); \
        rk0 = *(GAS const u32x4_t*)(kb_ + ko_); rk1 = *(GAS const u32x4_t*)(kb2_ + ko_); rv0 = *(GAS const u32x4_t*)(vb_ + vo_); rv1 = *(GAS const u32x4_t*)(vb2_ + vo_); } while (0)
#define AT_WRITE(bufp) do { *(u32x4_t*)((bufp) + kw) = rk0; *(u32x4_t*)((bufp) + kw + 32 * KROW) = rk1; *(u32x4_t*)((bufp) + vw) = rv0; *(u32x4_t*)((bufp) + vw + 64 * VROW) = rv1; } while (0)
    __syncthreads();
    AT_LOAD(kt0);
    AT_WRITE(smem);
    AT_LOAD(kt0 + 1);
    AT_WRITE(smem + AT_BUF);
    __syncthreads();
    const bool lag = (wave >= 4);
    if (lag) __builtin_amdgcn_s_barrier();
    int bi = 0;
    for (int kt = kt0; kt < 36; ++kt) {
        const char* Ks = smem + bi * AT_BUF;
        const char* Vs = Ks + 64 * KROW;
        if (kt + 2 < 36) AT_LOAD(kt + 2);
        float sv[8];
        if (piggy) {
            const bool pw1 = (kt < 32);
            const char* su = pw1 ? ps1 + ((((kt >> 1) & 1) * 1024 + (kt >> 2) * 128 + (kt & 1) * 64) * 4) : ps2 + (kt - 32) * 256;
            const int ldsb = pw1 ? 8192 : 4096;
            unsigned so_ = pw1 ? pls1 : pls2; asm volatile("" : "+v"(so_));
#pragma unroll
            for (int i = 0; i < 8; ++i) { GAS const char* bi = (GAS const char*)(su + (size_t)(i * ldsb)); asm volatile("" : "+s"(bi)); sv[i] = *(GAS const float*)(bi + so_); }
        }
        f32x4 s1[4], s2[4];
        {
            const char* kp = Ks + c * KROW + g * 16;
            bf16x8 ka[4], kb[4];
#pragma unroll
            for (int f = 0; f < 4; ++f) ka[f] = *(const bf16x8*)(kp + (f & 1) * 128 + (f >> 1) * 64);
#pragma unroll
            for (int kq = 0; kq < 4; ++kq) {
                if (kq < 3) {
#pragma unroll
                    for (int f = 0; f < 4; ++f) kb[f] = *(const bf16x8*)(kp + (kq + 1) * 16 * KROW + (f & 1) * 128 + (f >> 1) * 64);
                }
                __builtin_amdgcn_sched_barrier(0);
                s1[kq] = (f32x4){-m1, -m1, -m1, -m1}; s2[kq] = (f32x4){-m2, -m2, -m2, -m2};
                __builtin_amdgcn_s_setprio(1);
                s1[kq] = __builtin_amdgcn_mfma_f32_16x16x32_bf16(ka[0], q1[0], s1[kq], 0, 0, 0);
                s2[kq] = __builtin_amdgcn_mfma_f32_16x16x32_bf16(ka[1], q2[0], s2[kq], 0, 0, 0);
                s1[kq] = __builtin_amdgcn_mfma_f32_16x16x32_bf16(ka[2], q1[1], s1[kq], 0, 0, 0);
                s2[kq] = __builtin_amdgcn_mfma_f32_16x16x32_bf16(ka[3], q2[1], s2[kq], 0, 0, 0);
                __builtin_amdgcn_s_setprio(0);
                __builtin_amdgcn_sched_barrier(0);
#pragma unroll
                for (int f = 0; f < 4; ++f) ka[f] = kb[f];
            }
        }
        float mx1 = fmax3_(s1[0][0], s1[0][1], s1[0][2]), mx2 = fmax3_(s2[0][0], s2[0][1], s2[0][2]);
        mx1 = fmax3_(mx1, s1[0][3], s1[1][0]); mx2 = fmax3_(mx2, s2[0][3], s2[1][0]);
        mx1 = fmax3_(mx1, s1[1][1], s1[1][2]); mx2 = fmax3_(mx2, s2[1][1], s2[1][2]);
        mx1 = fmax3_(mx1, s1[1][3], s1[2][0]); mx2 = fmax3_(mx2, s2[1][3], s2[2][0]);
        mx1 = fmax3_(mx1, s1[2][1], s1[2][2]); mx2 = fmax3_(mx2, s2[2][1], s2[2][2]);
        mx1 = fmax3_(mx1, s1[2][3], s1[3][0]); mx2 = fmax3_(mx2, s2[2][3], s2[3][0]);
        mx1 = fmax3_(mx1, s1[3][1], s1[3][2]); mx2 = fmax3_(mx2, s2[3][1], s2[3][2]);
        mx1 = fmax3_(mx1, s1[3][3], mx1); mx2 = fmax3_(mx2, s2[3][3], mx2);
        const bool first = (kt == kt0);
        if (first || __any((mx1 > 8.0f) || (mx2 > 8.0f))) {
            asm volatile("; attn rescale" ::: "memory");
            mx1 = fmaxf(mx1, shx_(mx1, 16)); mx1 = fmaxf(mx1, shx_(mx1, 32));
            mx2 = fmaxf(mx2, shx_(mx2, 16)); mx2 = fmaxf(mx2, shx_(mx2, 32));
            const float d1 = first ? mx1 : fmaxf(mx1, 0.f), d2 = first ? mx2 : fmaxf(mx2, 0.f);
            const float al1 = first ? 1.0f : ex2_(-d1), al2 = first ? 1.0f : ex2_(-d2);
            m1 += d1; m2 += d2;
            ls1 *= al1; ls2 *= al2;
#pragma unroll
            for (int mt = 0; mt < 8; ++mt) { o1[mt] *= al1; o2[mt] *= al2; }
#pragma unroll
            for (int kq = 0; kq < 4; ++kq) { s1[kq] -= d1; s2[kq] -= d2; }
        }
        bf16x8 pb1[2], pb2[2];
#pragma unroll
        for (int kk = 0; kk < 2; ++kk) {
            union { unsigned u[4]; bf16x8 v; } t1, t2;
            t1.u[0] = pack2(ex2_(s1[2 * kk][0]), ex2_(s1[2 * kk][1])); t1.u[1] = pack2(ex2_(s1[2 * kk][2]), ex2_(s1[2 * kk][3]));
            t1.u[2] = pack2(ex2_(s1[2 * kk + 1][0]), ex2_(s1[2 * kk + 1][1])); t1.u[3] = pack2(ex2_(s1[2 * kk + 1][2]), ex2_(s1[2 * kk + 1][3]));
            t2.u[0] = pack2(ex2_(s2[2 * kk][0]), ex2_(s2[2 * kk][1])); t2.u[1] = pack2(ex2_(s2[2 * kk][2]), ex2_(s2[2 * kk][3]));
            t2.u[2] = pack2(ex2_(s2[2 * kk + 1][0]), ex2_(s2[2 * kk + 1][1])); t2.u[3] = pack2(ex2_(s2[2 * kk + 1][2]), ex2_(s2[2 * kk + 1][3]));
            pb1[kk] = t1.v; pb2[kk] = t2.v;
        }
        asm volatile("" ::: "memory"); __builtin_amdgcn_s_barrier(); asm volatile("" ::: "memory");
#pragma unroll
        for (int kk = 0; kk < 2; ++kk) {
            ls1 = __builtin_amdgcn_mfma_f32_16x16x32_bf16(ones, pb1[kk], ls1, 0, 0, 0);
            ls2 = __builtin_amdgcn_mfma_f32_16x16x32_bf16(ones, pb2[kk], ls2, 0, 0, 0);
        }
        {
            const char* vp = Vs + c * VROW + g * 8;
            uint2 va[4], vb[4];
#pragma unroll
            for (int f = 0; f < 4; ++f) va[f] = *(const uint2*)(vp + (f >> 1) * 64 + (f & 1) * 32);
#pragma unroll
            for (int mt = 0; mt < 8; ++mt) {
                if (mt < 7) {
#pragma unroll
                    for (int f = 0; f < 4; ++f) vb[f] = *(const uint2*)(vp + (mt + 1) * 16 * VROW + (f >> 1) * 64 + (f & 1) * 32);
                }
                __builtin_amdgcn_sched_barrier(0);
                union { uint4 u; bf16x8 v; } av0, av1;
                av0.u = make_uint4(va[0].x, va[0].y, va[1].x, va[1].y);
                av1.u = make_uint4(va[2].x, va[2].y, va[3].x, va[3].y);
                __builtin_amdgcn_s_setprio(1);
                o1[mt] = __builtin_amdgcn_mfma_f32_16x16x32_bf16(av0.v, pb1[0], o1[mt], 0, 0, 0);
                o2[mt] = __builtin_amdgcn_mfma_f32_16x16x32_bf16(av0.v, pb2[0], o2[mt], 0, 0, 0);
                o1[mt] = __builtin_amdgcn_mfma_f32_16x16x32_bf16(av1.v, pb1[1], o1[mt], 0, 0, 0);
                o2[mt] = __builtin_amdgcn_mfma_f32_16x16x32_bf16(av1.v, pb2[1], o2[mt], 0, 0, 0);
                __builtin_amdgcn_s_setprio(0);
                __builtin_amdgcn_sched_barrier(0);
#pragma unroll
                for (int f = 0; f < 4; ++f) va[f] = vb[f];
            }
        }
        if (piggy) {
            const u32x4_t p = {pack2(sv[0], sv[1]), pack2(sv[2], sv[3]), pack2(sv[4], sv[5]), pack2(sv[6], sv[7])};
            GAS char* du = (GAS char*)((kt < 32) ? pd1 + (size_t)kt * 131072 : pd2 + (size_t)(kt - 32) * 131072);
            unsigned do_ = pld; asm volatile("" : "+v"(do_), "+s"(du));
            *(GAS u32x4_t*)(du + do_) = p;
        }
        if (kt + 2 < 36) { const int bw = (bi == 0) ? 2 : bi - 1; AT_WRITE(smem + bw * AT_BUF); }
        asm volatile("s_waitcnt lgkmcnt(0)" ::: "memory"); __builtin_amdgcn_s_barrier(); asm volatile("" ::: "memory");
        bi = (bi == 2) ? 0 : bi + 1;
    }
    if (!lag) __builtin_amdgcn_s_barrier();
#undef AT_LOAD
#undef AT_WRITE
    const float lam = ((const float*)(ws + WS_TAB))[2048 + l];
    const float lam_init = (l == 0) ? 0.2f : (0.8f - 0.6f * 0.7408182206817179f);
    const float i1 = 1.0f / ls1[0], i2 = lam / ls2[0];
    float ss = 0.f;
#pragma unroll
    for (int mt = 0; mt < 8; ++mt)
#pragma unroll
        for (int r = 0; r < 4; ++r) { const float v = o1[mt][r] * i1 - o2[mt][r] * i2; o1[mt][r] = v; ss += v * v; }
    ss += shx_(ss, 16); ss += shx_(ss, 32);
    const float rs = rsqrtf(ss * (1.0f / 128.0f) + 1e-5f) * (1.0f - lam_init);
    bfu* ODA = (bfu*)(ws + WS_ODA);
    const float* sg = a.in[10] + l * 128;
#pragma unroll
    for (int mt = 0; mt < 8; ++mt) {
        const int dim = mt * 16 + g * 4;
        const float4 gg = *(const float4*)(sg + dim);
        uint2 p; p.x = pack2(o1[mt][0] * rs * gg.x, o1[mt][1] * rs * gg.y); p.y = pack2(o1[mt][2] * rs * gg.z, o1[mt][3] * rs * gg.w);
        *(uint2*)(ODA + (size_t)qrow * 512 + head * 128 + dim) = p;
    }
}

constexpr int CK = 16, NCK = TB / CK, NCHUNK = 128 * NCK;
constexpr size_t WS_CEB  = WS_H2HI;
constexpr size_t WS_CW1  = WS_YB;
constexpr size_t WS_CRH  = WS_CW1 + (size_t)NCHUNK * 1024 * 2;
constexpr size_t WS_CUV  = WS_CRH + (size_t)NCHUNK * 1024 * 2;
constexpr size_t WS_CV   = WS_CUV + (size_t)NCHUNK * 1024 * 2;
constexpr size_t WS_CG   = WS_ACT;
constexpr size_t WS_CPC  = WS_ACT + (size_t)NCHUNK * 512 * 2;
__device__ __forceinline__ int kperm(int jp) { return (jp & 32) + 8 * ((jp >> 2) & 3) + 4 * ((jp >> 4) & 1) + (jp & 3); }
__device__ __forceinline__ bf16x8 neg8(bf16x8 v) { union { bf16x8 v; uint4 u; } t; t.v = v; t.u.x ^= 0x80008000u; t.u.y ^= 0x80008000u; t.u.z ^= 0x80008000u; t.u.w ^= 0x80008000u; return t.v; }
__device__ __forceinline__ bf16x8 zero8() { bf16x8 z; for (int e = 0; e < 8; ++e) z[e] = 0; return z; }
__device__ __forceinline__ bf16x8 ldpad8(const char* p, int g) {
    union { bf16x8 v; uint4 u; } t; t.v = *(const bf16x8*)(p + (g & 1) * 16);
    const unsigned m = (g < 2) ? 0xFFFFFFFFu : 0u; t.u.x &= m; t.u.y &= m; t.u.z &= m; t.u.w &= m; return t.v; }

__device__ __forceinline__ void chunk_pre(const Args& a, unsigned char* ws, int l, int cid, char* L, int lane) {
    const int g = lane >> 4, c = lane & 15;
    const int seq = cid / NCK, ck = cid - seq * NCK;
    const int d = seq & 1, h = (seq >> 1) & 7, b = seq >> 4;
    const bfu* WD = (const bfu*)(ws + WS_WDEC) + (size_t)d * NT * 512;
    const bfu* AV = (const bfu*)(ws + WS_BV) + (size_t)d * NT * 512;
    const bfu* RK = (const bfu*)(ws + WS_RK);
    const bfu* RR = (const bfu*)(ws + WS_RR);
    const bfu* RV = (const bfu*)(ws + WS_RV);
    float KH[4][4], BH[4][4], EH[4][4], RH[4][4], BT[4][4], ET[4][4], VV[4][4], PC[4];
    {
        float kq[4][4], av[4][4], ww[4][4], rr[4][4], ssq[4] = {0.f, 0.f, 0.f, 0.f};
        {
            const size_t ro = ((size_t)b * TB + scan_tok(d, ck * CK + (lane >> 2))) * 512 + h * 64 + (lane & 3) * 16;
            const uint4 w0 = *(const uint4*)(WD + ro), w1_ = *(const uint4*)(WD + ro + 8), k0 = *(const uint4*)(RK + ro), k1 = *(const uint4*)(RK + ro + 8);
            const uint4 a0 = *(const uint4*)(AV + ro), a1 = *(const uint4*)(AV + ro + 8), r0_ = *(const uint4*)(RR + ro), r1_ = *(const uint4*)(RR + ro + 8);
            const uint4 v0 = *(const uint4*)(RV + ro), v1 = *(const uint4*)(RV + ro + 8);
            char* sp = L + (lane >> 2) * 128 + (lane & 3) * 32;
            *(uint4*)(sp) = w0; *(uint4*)(sp + 16) = w1_; *(uint4*)(sp + 2048) = k0; *(uint4*)(sp + 2064) = k1;
            *(uint4*)(sp + 4096) = a0; *(uint4*)(sp + 4112) = a1; *(uint4*)(sp + 6144) = r0_; *(uint4*)(sp + 6160) = r1_;
            *(uint4*)(sp + 8192) = v0; *(uint4*)(sp + 8208) = v1;
            asm volatile("s_waitcnt lgkmcnt(0)" ::: "memory");
#pragma unroll
            for (int r = 0; r < 4; ++r)
#pragma unroll
                for (int nt = 0; nt < 4; ++nt) {
                    const char* ep = L + (4 * g + r) * 128 + (16 * nt + c) * 2;
                    ww[nt][r] = bf2f(*(const bfu*)(ep)); kq[nt][r] = bf2f(*(const bfu*)(ep + 2048)); av[nt][r] = bf2f(*(const bfu*)(ep + 4096));
                    rr[nt][r] = bf2f(*(const bfu*)(ep + 6144)); VV[nt][r] = bf2f(*(const bfu*)(ep + 8192));
                }
            asm volatile("s_waitcnt lgkmcnt(0)" ::: "memory");
        }
#pragma unroll
        for (int nt = 0; nt < 4; ++nt) {
            const float kkw = a.in[20][l * 512 + h * 64 + 16 * nt + c], kaw = a.in[21][l * 512 + h * 64 + 16 * nt + c];
#pragma unroll
            for (int r = 0; r < 4; ++r) {
                const float k = kq[nt][r];
                EH[nt][r] = k * (1.0f + (av[nt][r] - 1.0f) * kaw);
                kq[nt][r] = k * kkw;
                ssq[r] += kq[nt][r] * kq[nt][r];
            }
        }
#pragma unroll
        for (int r = 0; r < 4; ++r) ssq[r] = rsqrtf(fmaxf(red16(ssq[r]), 1e-24f));
#pragma unroll
        for (int nt = 0; nt < 4; ++nt) {
            float cp[4];
            cp[0] = ww[nt][0]; cp[1] = cp[0] * ww[nt][1]; cp[2] = cp[1] * ww[nt][2]; cp[3] = cp[2] * ww[nt][3];
            const float t0 = shf_(cp[3], c), t1 = shf_(cp[3], c + 16), t2 = shf_(cp[3], c + 32), t3 = shf_(cp[3], c + 48);
            const float pre = ((g > 0) ? t0 : 1.0f) * ((g > 1) ? t1 : 1.0f) * ((g > 2) ? t2 : 1.0f);
            const float pc = (t0 * t1) * (t2 * t3);
            PC[nt] = pc;
#pragma unroll
            for (int r = 0; r < 4; ++r) {
                const float P = pre * cp[r], Pm = (r == 0) ? pre : pre * cp[r - 1];
                const float iP = __builtin_amdgcn_rcpf(P);
                const float kkn = kq[nt][r] * ssq[r], bb = kkn * av[nt][r], ke = EH[nt][r];
                KH[nt][r] = kkn * Pm; BH[nt][r] = bb * iP; EH[nt][r] = ke * iP; RH[nt][r] = rr[nt][r] * P;
                BT[nt][r] = bb * (pc * iP); ET[nt][r] = ke * (pc * iP);
            }
        }
    }
    char* R0 = L; char* R1 = L + 8192;
#pragma unroll
    for (int nt = 0; nt < 4; ++nt) {
#pragma unroll
        for (int r = 0; r < 4; ++r) {
            const int o = (4 * g + r) * 128 + (16 * nt + c) * 2;
            *(bfu*)(R0 + o) = f2bf(KH[nt][r]); *(bfu*)(R0 + 2048 + o) = f2bf(RH[nt][r]);
            *(bfu*)(R0 + 4096 + o) = f2bf(BH[nt][r]); *(bfu*)(R0 + 6144 + o) = f2bf(EH[nt][r]);
        }
        const int ot = (16 * nt + c) * 32 + 8 * g;
        uint2 p;
        p.x = pack2(KH[nt][0], KH[nt][1]); p.y = pack2(KH[nt][2], KH[nt][3]); *(uint2*)(R1 + ot) = p;
        p.x = pack2(VV[nt][0], VV[nt][1]); p.y = pack2(VV[nt][2], VV[nt][3]); *(uint2*)(R1 + 2048 + ot) = p;
        p.x = pack2(BT[nt][0], BT[nt][1]); p.y = pack2(BT[nt][2], BT[nt][3]); *(uint2*)(R1 + 4096 + ot) = p;
        p.x = pack2(ET[nt][0], ET[nt][1]); p.y = pack2(ET[nt][2], ET[nt][3]); *(uint2*)(R1 + 6144 + ot) = p;
    }
    const f32x4 z4 = {0.f, 0.f, 0.f, 0.f};
#define RM_(X, ks) (*(const bf16x8*)(R0 + (X) + c * 128 + (ks) * 64 + g * 16))
#define TR_(base, tile) ldpad8((base) + (16 * (tile) + c) * 32, g)
#define MM_(off) ldpad8(R0 + (off) + c * 32, g)
    f32x4 Am = z4, Bmm = z4, Grb = z4, Grk = z4;
#pragma unroll
    for (int ks = 0; ks < 2; ++ks) {
        const bf16x8 kh = RM_(0, ks), rh = RM_(2048, ks), bh = RM_(4096, ks), eh = RM_(6144, ks);
        Am = __builtin_amdgcn_mfma_f32_16x16x32_bf16(kh, bh, Am, 0, 0, 0);
        Bmm = __builtin_amdgcn_mfma_f32_16x16x32_bf16(kh, eh, Bmm, 0, 0, 0);
        Grb = __builtin_amdgcn_mfma_f32_16x16x32_bf16(rh, bh, Grb, 0, 0, 0);
        Grk = __builtin_amdgcn_mfma_f32_16x16x32_bf16(rh, eh, Grk, 0, 0, 0);
    }
#pragma unroll
    for (int r = 0; r < 4; ++r) {
        const int t = 4 * g + r;
        if (c >= t) { Am[r] = 0.f; Bmm[r] = 0.f; }
        if (c > t) { Grb[r] = 0.f; Grk[r] = 0.f; }
    }
    asm volatile("s_waitcnt lgkmcnt(0)" ::: "memory");
    float* Af = (float*)(R0 + 2048);
#pragma unroll
    for (int r = 0; r < 4; ++r) Af[(4 * g + r) * 16 + c] = Am[r];
    asm volatile("s_waitcnt lgkmcnt(0)" ::: "memory");
    float Tc[16];
#pragma unroll
    for (int t = 0; t < 16; ++t) {
        float acc = (t == c) ? 1.0f : 0.0f, acc2 = 0.0f;
#pragma unroll
        for (int s_ = 0; s_ < t; ++s_) { if (s_ & 1) acc2 -= Af[t * 16 + s_] * Tc[s_]; else acc -= Af[t * 16 + s_] * Tc[s_]; }
        Tc[t] = acc + acc2;
    }
    asm volatile("s_waitcnt lgkmcnt(0)" ::: "memory");
#pragma unroll
    for (int t = 0; t < 16; ++t) *(bfu*)(R0 + t * 32 + c * 2) = f2bf(Tc[t]);
#pragma unroll
    for (int r = 0; r < 4; ++r) {
        const int o = (4 * g + r) * 32 + c * 2;
        *(bfu*)(R0 + 512 + o) = f2bf(Bmm[r]); *(bfu*)(R0 + 1024 + o) = f2bf(Grb[r]); *(bfu*)(R0 + 1536 + o) = f2bf(Grk[r]);
    }
    asm volatile("s_waitcnt lgkmcnt(0)" ::: "memory");
    const bf16x8 mT = MM_(0), mBm = MM_(512), mGrb = MM_(1024), mGrk = MM_(1536);
    const bf16x8 mNGrb = neg8(mGrb);
    char* W1T = R0 + 2048; char* UvT = R0 + 4096; char* BmVT = R0 + 6144;
#pragma unroll
    for (int nt = 0; nt < 4; ++nt) {
        const f32x4 x = __builtin_amdgcn_mfma_f32_16x16x32_bf16(mBm, TR_(R1 + 2048, nt), z4, 0, 0, 0);
        *(uint2*)(BmVT + (16 * nt + c) * 32 + 8 * g) = pack4(x);
        const f32x4 w1 = __builtin_amdgcn_mfma_f32_16x16x32_bf16(mT, TR_(R1, nt), z4, 0, 0, 0);
        {
            const int pos = kperm(16 * nt + c);
            const int fo = ((pos >> 5) * 512 + ((pos >> 3) & 3) * 128 + (pos & 7)) * 2;
#pragma unroll
            for (int r = 0; r < 4; ++r) { *(bfu*)(W1T + fo + (4 * g + r) * 16) = f2bf(w1[r]); *(bfu*)(UvT + fo + (4 * g + r) * 16) = f2bf(RH[nt][r]); }
        }
    }
    asm volatile("s_waitcnt lgkmcnt(0)" ::: "memory");
    {
        bfu* W1P = (bfu*)(ws + WS_CW1) + (size_t)cid * 1024 + lane * 8;
        bfu* RHP = (bfu*)(ws + WS_CRH) + (size_t)cid * 1024 + lane * 8;
        *(uint4*)(W1P) = *(const uint4*)(W1T + lane * 16); *(uint4*)(W1P + 512) = *(const uint4*)(W1T + 1024 + lane * 16);
        *(uint4*)(RHP) = *(const uint4*)(UvT + lane * 16); *(uint4*)(RHP + 512) = *(const uint4*)(UvT + 1024 + lane * 16);
    }
#pragma unroll
    for (int nt = 0; nt < 4; ++nt) {
        const f32x4 uv = __builtin_amdgcn_mfma_f32_16x16x32_bf16(mT, TR_(BmVT, nt), z4, 0, 0, 0);
        *(uint2*)((bfu*)(ws + WS_CUV) + (size_t)cid * 1024 + nt * 256 + lane * 4) = pack4(uv);
        uint2 pv; pv.x = pack2(VV[nt][0], VV[nt][1]); pv.y = pack2(VV[nt][2], VV[nt][3]);
        *(uint2*)((bfu*)(ws + WS_CV) + (size_t)cid * 1024 + nt * 256 + lane * 4) = pv;
        uint4 eb; eb.x = pack2(ET[nt][0], ET[nt][1]); eb.y = pack2(ET[nt][2], ET[nt][3]); eb.z = pack2(BT[nt][0], BT[nt][1]); eb.w = pack2(BT[nt][2], BT[nt][3]);
        *(uint4*)((bfu*)(ws + WS_CEB) + (size_t)cid * 2048 + nt * 512 + lane * 8) = eb;
        if (g == 0) ((bfu*)(ws + WS_CPC))[(size_t)cid * 64 + (c >> 2) * 16 + nt * 4 + (c & 3)] = f2bf(PC[nt]);
    }
    {
        const uint2 gk = *(const uint2*)(R0 + 1536 + c * 32 + 8 * g), gb = *(const uint2*)(R0 + 1024 + c * 32 + 8 * g);
        *(uint4*)((bfu*)(ws + WS_CG) + (size_t)cid * 512 + lane * 8) = make_uint4(gk.x, gk.y, gb.x, gb.y);
    }
    asm volatile("s_waitcnt lgkmcnt(0)" ::: "memory");
#undef RM_
#undef TR_
#undef MM_
}

constexpr int CS_W1 = 0, CS_RH = 2048, CS_EB = 4096, CS_G = 8192, CS_UV = 9216, CS_V = 11264, CS_PC = 13312, CS_SLOT = 13568, CS_D = 8;
__device__ __forceinline__ void chain_dma(unsigned char* ws, LAS unsigned char* slot, size_t cid, int w4, int lane) {
#pragma unroll
    for (int q = 0; q < 4; ++q) {
        const int p = w4 + 4 * q;
        const char* src; int dst; bool on = true;
        if (p < 2) { src = (const char*)(ws + WS_CW1) + cid * 2048 + p * 1024; dst = CS_W1 + p * 1024; }
        else if (p < 4) { src = (const char*)(ws + WS_CRH) + cid * 2048 + (p - 2) * 1024; dst = CS_RH + (p - 2) * 1024; }
        else if (p < 8) { src = (const char*)(ws + WS_CEB) + cid * 4096 + (p - 4) * 1024; dst = CS_EB + (p - 4) * 1024; }
        else if (p < 9) { src = (const char*)(ws + WS_CG) + cid * 1024; dst = CS_G; }
        else if (p < 11) { src = (const char*)(ws + WS_CUV) + cid * 2048 + (p - 9) * 1024; dst = CS_UV + (p - 9) * 1024; }
        else if (p < 13) { src = (const char*)(ws + WS_CV) + cid * 2048 + (p - 11) * 1024; dst = CS_V + (p - 11) * 1024; }
        else if (p < 14) { src = (const char*)(ws + WS_CPC) + cid * 128; dst = CS_PC; on = (lane < 8); }
        else continue;
        if (on) __builtin_amdgcn_global_load_lds((const unsigned*)(src + lane * 16), (LAS unsigned*)(slot + dst), 16, 0, 0);
    }
}
__device__ __forceinline__ void chunk_chain_blk(const Args& a, unsigned char* ws, int l, int seq, char* smem, int tid) {
    const int wave = tid >> 6, lane = tid & 63, g = lane >> 4, c = lane & 15;
    const int d = seq & 1, h = (seq >> 1) & 7, b = seq >> 4;
    const int nt = wave & 3;
    const int wvu = __builtin_amdgcn_readfirstlane(wave);
    const int w4u = wvu & 3;
    LAS unsigned char* ring = (LAS unsigned char*)smem;
    const size_t cbase = (size_t)seq * NCK;
    bfu* Y = (bfu*)(ws + WS_Y) + (size_t)d * NT * 512 + h * 64 + 16 * nt + c;
    f32x4 Z[4];
#pragma unroll
    for (int mt = 0; mt < 4; ++mt) Z[mt] = (f32x4){0.f, 0.f, 0.f, 0.f};
    __syncthreads();
    if (wvu >= 4) {
        for (int k = 0; k < CS_D - 1; ++k) chain_dma(ws, ring + k * CS_SLOT, cbase + k, w4u, lane);
        asm volatile("s_waitcnt vmcnt(18)" ::: "memory");
    }
    __builtin_amdgcn_s_barrier();
    for (int ck = 0; ck < NCK; ++ck) {
        if (wvu >= 4) {
            if (ck + CS_D - 1 < NCK) chain_dma(ws, ring + ((ck + CS_D - 1) % CS_D) * CS_SLOT, cbase + ck + CS_D - 1, w4u, lane);
            if (ck + CS_D - 1 < NCK) asm volatile("s_waitcnt vmcnt(18)" ::: "memory"); else asm volatile("s_waitcnt vmcnt(0)" ::: "memory");
        } else {
            const LAS unsigned char* sl = ring + (ck % CS_D) * CS_SLOT;
            bf16x8 zb[2];
#pragma unroll
            for (int s_ = 0; s_ < 2; ++s_) {
                union { unsigned u[4]; bf16x8 v; } t;
                t.u[0] = pack2(Z[2 * s_][0], Z[2 * s_][1]); t.u[1] = pack2(Z[2 * s_][2], Z[2 * s_][3]);
                t.u[2] = pack2(Z[2 * s_ + 1][0], Z[2 * s_ + 1][1]); t.u[3] = pack2(Z[2 * s_ + 1][2], Z[2 * s_ + 1][3]);
                zb[s_] = t.v;
            }
            const u32x2_t uvq = *(const LAS u32x2_t*)(sl + CS_UV + nt * 512 + lane * 8);
            const u32x2_t vvq = *(const LAS u32x2_t*)(sl + CS_V + nt * 512 + lane * 8);
            f32x4 u = {-bflo(uvq.x), -bfhi(uvq.x), -bflo(uvq.y), -bfhi(uvq.y)};
            u = __builtin_amdgcn_mfma_f32_16x16x32_bf16(neg8(*(const LAS bf16x8*)(sl + CS_W1 + lane * 16)), zb[0], u, 0, 0, 0);
            u = __builtin_amdgcn_mfma_f32_16x16x32_bf16(neg8(*(const LAS bf16x8*)(sl + CS_W1 + 1024 + lane * 16)), zb[1], u, 0, 0, 0);
            f32x4 y = {0.f, 0.f, 0.f, 0.f};
            y = __builtin_amdgcn_mfma_f32_16x16x32_bf16(*(const LAS bf16x8*)(sl + CS_RH + lane * 16), zb[0], y, 0, 0, 0);
            y = __builtin_amdgcn_mfma_f32_16x16x32_bf16(*(const LAS bf16x8*)(sl + CS_RH + 1024 + lane * 16), zb[1], y, 0, 0, 0);
            union { unsigned q[4]; bf16x8 v; } b2; b2.q[0] = vvq.x; b2.q[1] = vvq.y; b2.q[2] = pack2(u[0], u[1]); b2.q[3] = pack2(u[2], u[3]);
            y = __builtin_amdgcn_mfma_f32_16x16x32_bf16(*(const LAS bf16x8*)(sl + CS_G + lane * 16), b2.v, y, 0, 0, 0);
            const u32x4_t pq0 = *(const LAS u32x4_t*)(sl + CS_PC + g * 32), pq1 = *(const LAS u32x4_t*)(sl + CS_PC + g * 32 + 16);
#pragma unroll
            for (int mt = 0; mt < 4; ++mt) {
                const u32x4_t pq = (mt < 2) ? pq0 : pq1;
                const unsigned p01 = (mt & 1) ? pq.z : pq.x, p23 = (mt & 1) ? pq.w : pq.y;
                const f32x4 zi = {Z[mt][0] * bflo(p01), Z[mt][1] * bfhi(p01), Z[mt][2] * bflo(p23), Z[mt][3] * bfhi(p23)};
                Z[mt] = __builtin_amdgcn_mfma_f32_16x16x32_bf16(*(const LAS bf16x8*)(sl + CS_EB + mt * 1024 + lane * 16), b2.v, zi, 0, 0, 0);
            }
            if ((l == 0) || (ck >= CTX / CK)) {
#pragma unroll
                for (int r = 0; r < 4; ++r) Y[((size_t)b * TB + scan_tok(d, ck * CK + 4 * g + r)) * 512] = f2bf(y[r]);
            }
            asm volatile("s_waitcnt lgkmcnt(0)" ::: "memory");
        }
        __builtin_amdgcn_s_barrier();
    }
    asm volatile("s_waitcnt vmcnt(0)" ::: "memory");
    __syncthreads();
}

__device__ __forceinline__ void phase_chunkpre(const Args& a, int l, char* smem, int tid, int bid, int nb) {
    unsigned char* ws = wsp(a);
    const int wave = tid >> 6, lane = tid & 63;
    char* L = smem + wave * 16384;
    for (int cid = bid * NW + wave; cid < NCHUNK; cid += nb * NW) chunk_pre(a, ws, l, cid, L, lane);
}
__device__ __forceinline__ void phase_mix(const Args& a, int l, char* smem, int tid, int bid, int nb) {
    unsigned char* ws = wsp(a);
    const int wave = tid >> 6, lane = tid & 63;
    for (int seq = bid; seq < 128; seq += nb) chunk_chain_blk(a, ws, l, seq, smem, tid);
    if (bid >= 128 || nb <= 128) {
        const int nconv = (nb > 128) ? (nb - 128) * NW : nb * NW;
        const int me = (nb > 128) ? ((bid - 128) * NW + wave) : (bid * NW + wave);
        for (int j = me; j < 6144; j += nconv) {
            const int t = (j / 192) * 768 + 512 + 64 + (j % 192);
            cvt_expert_tile(a, ws, l, t, 0, lane); cvt_expert_tile(a, ws, l, t, 1, lane);
        }
    }
    const int n_attn = (l == 0) ? 576 : 512;
    int* qctr = (int*)(ws + CNT_OFF + 1024) + l * 64;
    int* qsl = (int*)(smem + LDS_MAIN + 448);
    for (;;) {
        __syncthreads();
        if (tid == 0) *qsl = atomicAdd(qctr, 1);
        __syncthreads();
        const int it = __builtin_amdgcn_readfirstlane(*qsl);
        if (it >= n_attn) break;
        attn_item2(a, l, it, smem, tid);
    }
}

__device__ __forceinline__ void phase_post(const Args& a, int l, int tid, int bid, int nb) {
    unsigned char* ws = wsp(a);
    const int wave = tid >> 6, lane = tid & 63;
    const bfu* Y0 = (const bfu*)(ws + WS_Y);
    const bfu* Y1 = Y0 + (size_t)NT * 512;
    const bfu* RR = (const bfu*)(ws + WS_RR);
    const bfu* RV = (const bfu*)(ws + WS_RV);
    const bfu* RKp = (const bfu*)(ws + WS_RK);
    const bfu* AV0 = (const bfu*)(ws + WS_BV);
    const bfu* AV1 = AV0 + (size_t)NT * 512;
    const float* kap = a.in[21] + l * 512;
    const bfu* GG = (const bfu*)(ws + WS_GG);
    bfu* ORW = (bfu*)(ws + WS_ODA) + (size_t)2 * NT * 512;
    const float* lg = a.in[23] + l * 512;
    const float* lb = a.in[24] + l * 512;
    const float* rk = a.in[22] + l * 512;
    for (int row = bid * NW + wave; row < NT; row += nb * NW) {
        const int t = row % TB;
        if (l == 1 && t >= SEQ) continue;
        const size_t o = (size_t)row * 512 + lane * 8;
        float y[8];
        {
            const uint4 a0 = *(const uint4*)(Y0 + o), b0 = *(const uint4*)(Y1 + o);
            y[0] = bflo(a0.x) + bflo(b0.x); y[1] = bfhi(a0.x) + bfhi(b0.x); y[2] = bflo(a0.y) + bflo(b0.y); y[3] = bfhi(a0.y) + bfhi(b0.y);
            y[4] = bflo(a0.z) + bflo(b0.z); y[5] = bfhi(a0.z) + bfhi(b0.z); y[6] = bflo(a0.w) + bflo(b0.w); y[7] = bfhi(a0.w) + bfhi(b0.w);
        }
        float s = 0.f;
#pragma unroll
        for (int e = 0; e < 8; ++e) s += y[e];
        s += shx_(s, 1); s += shx_(s, 2); s += shx_(s, 4);
        const float mu = s * (1.0f / 64.0f);
        float vs = 0.f;
#pragma unroll
        for (int e = 0; e < 8; ++e) { const float dlt = y[e] - mu; vs += dlt * dlt; }
        vs += shx_(vs, 1); vs += shx_(vs, 2); vs += shx_(vs, 4);
        const float rstd = rsqrtf(vs * (1.0f / 64.0f) + 64e-5f);
        const uint4 pr = *(const uint4*)(RR + o), pv = *(const uint4*)(RV + o), pk0 = *(const uint4*)(AV0 + o), pk1 = *(const uint4*)(AV1 + o), pg = *(const uint4*)(GG + o), pkk = *(const uint4*)(RKp + o);
        const float r8[8] = {bflo(pr.x), bfhi(pr.x), bflo(pr.y), bfhi(pr.y), bflo(pr.z), bfhi(pr.z), bflo(pr.w), bfhi(pr.w)};
        const float v8[8] = {bflo(pv.x), bfhi(pv.x), bflo(pv.y), bfhi(pv.y), bflo(pv.z), bfhi(pv.z), bflo(pv.w), bfhi(pv.w)};
        const float as8[8] = {bflo(pk0.x) + bflo(pk1.x), bfhi(pk0.x) + bfhi(pk1.x), bflo(pk0.y) + bflo(pk1.y), bfhi(pk0.y) + bfhi(pk1.y),
                              bflo(pk0.z) + bflo(pk1.z), bfhi(pk0.z) + bfhi(pk1.z), bflo(pk0.w) + bflo(pk1.w), bfhi(pk0.w) + bfhi(pk1.w)};
        const float kr8[8] = {bflo(pkk.x), bfhi(pkk.x), bflo(pkk.y), bfhi(pkk.y), bflo(pkk.z), bfhi(pkk.z), bflo(pkk.w), bfhi(pkk.w)};
        float k8[8];
#pragma unroll
        for (int e = 0; e < 8; ++e) k8[e] = kr8[e] * (2.0f + (as8[e] - 2.0f) * kap[lane * 8 + e]);
        const float g8[8] = {bflo(pg.x), bfhi(pg.x), bflo(pg.y), bfhi(pg.y), bflo(pg.z), bfhi(pg.z), bflo(pg.w), bfhi(pg.w)};
        float ds = 0.f;
#pragma unroll
        for (int e = 0; e < 8; ++e) ds += r8[e] * k8[e] * rk[lane * 8 + e];
        ds += shx_(ds, 1); ds += shx_(ds, 2); ds += shx_(ds, 4);
        float ov[8];
#pragma unroll
        for (int e = 0; e < 8; ++e) ov[e] = ((y[e] - mu) * rstd * lg[lane * 8 + e] + lb[lane * 8 + e] + ds * v8[e]) * g8[e];
        uint4 po; po.x = pack2(ov[0], ov[1]); po.y = pack2(ov[2], ov[3]); po.z = pack2(ov[4], ov[5]); po.w = pack2(ov[6], ov[7]);
        *(uint4*)(ORW + o) = po;
    }
}

__device__ __forceinline__ void phase_merge(const Args& a, int l, char* smem, int tid, int bid, int nb) {
    unsigned char* ws = wsp(a);
    const int wave = tid >> 6, lane = tid & 63, wm = wave >> 1, wn = wave & 1, g = lane >> 4, c = lane & 15;
    const bfu* GL = (const bfu*)(ws + WS_GL);
    bfu* MB = (bfu*)(ws + WS_MB);
    for (int it = bid; it < 72 * 16; it += nb) {
        const int mt = it >> 4, nt = it & 15;
        if (l == 1 && (mt % 9) == 8) continue;
        const int m0 = mt * 256, n0 = nt * 64;
        int arow[4]; ident_rows(arow, m0, tid);
        const int rowbase = m0 + wm * 64, colbase = n0 + wn * 32;
        f32x4 tot[4][2]; zero_acc<2>(tot);
        for (int n = 0; n < 3; ++n) {
            f32x4 acc[4][2]; zero_acc<2>(acc);
            gemm_loop<2>(acc, (const bfu*)(ws + WS_ODA) + (size_t)n * NT * 512, 512, arow,
                         (const bfu*)(ws + WS_WBT) + (size_t)(l * 3 + n) * 1024 * 512, 512, n0, 512, smem, tid);
#pragma unroll
            for (int mi = 0; mi < 4; ++mi)
#pragma unroll
                for (int ni = 0; ni < 2; ++ni)
#pragma unroll
                    for (int r = 0; r < 4; ++r) {
                        const int row = rowbase + mi * 16 + g * 4 + r;
                        const float gate = bf2f(GL[(size_t)row * 3072 + n * 1024 + colbase + ni * 16 + c]);
                        tot[mi][ni][r] += gate * acc[mi][ni][r];
                    }
        }
#pragma unroll
        for (int mi = 0; mi < 4; ++mi)
#pragma unroll
            for (int ni = 0; ni < 2; ++ni)
#pragma unroll
                for (int r = 0; r < 4; ++r) {
                    const int row = rowbase + mi * 16 + g * 4 + r;
                    MB[(size_t)row * 1024 + colbase + ni * 16 + c] = f2bf(tot[mi][ni][r]);
                }
    }
}

__device__ __forceinline__ void phase_wout(const Args& a, int l, char* smem, int tid, int bid, int nb) {
    unsigned char* ws = wsp(a);
    const int wave = tid >> 6, lane = tid & 63, wm = wave >> 1, wn = wave & 1, g = lane >> 4, c = lane & 15;
    float* xres = (float*)(ws + WS_XRES);
    const float* mod = (const float*)(ws + WS_MOD);
    for (int it = bid; it < 72 * 8; it += nb) {
        const int mt = it >> 3, nt = it & 7;
        if (l == 1 && (mt % 9) == 8) continue;
        const int m0 = mt * 256, n0 = nt * 128;
        int arow[4]; ident_rows(arow, m0, tid);
        f32x4 acc[4][4]; zero_acc<4>(acc);
        gemm_loop<4>(acc, (const bfu*)(ws + WS_MB), 1024, arow, (const bfu*)(ws + WS_WOT) + (size_t)l * 1024 * 1024, 1024, n0, 1024, smem, tid);
        const int rowbase = m0 + wm * 64, colbase = n0 + wn * 64;
        const int b = m0 / TB, m = ((m0 % TB) < SEQ) ? b : 8;
        const float* ga = mod + (size_t)(l * 9 + m) * 6144 + 2 * 1024;
#pragma unroll
        for (int ni = 0; ni < 4; ++ni) {
            const int col = colbase + ni * 16 + c;
            const float gac = ga[col];
#pragma unroll
            for (int mi = 0; mi < 4; ++mi)
#pragma unroll
                for (int r = 0; r < 4; ++r) {
                    const int row = rowbase + mi * 16 + g * 4 + r;
                    xres[(size_t)row * 1024 + col] += gac * acc[mi][ni][r];
                }
        }
    }
}

__device__ __forceinline__ void phase_topk(const Args& a, int l, char* smem, int tid, int bid, int nb) {
    unsigned char* ws = wsp(a);
    const float* LG = (const float*)(ws + WS_LOG);
    int* cnt = (int*)(ws + CNT_OFF) + l * 32;
    int* TOKL = (int*)(ws + WS_TOKL);
    float* GATE = (float*)(ws + WS_GATE);
    int* lcnt = (int*)smem;
    int* lbase = lcnt + 32;
    for (int blk = bid; blk < NT / NTHREADS; blk += nb) {
        const int row = blk * NTHREADS + tid;
        const int t = row % TB;
        const bool active = !(l == 1 && t >= SEQ);
        __syncthreads();
        if (tid < 32) lcnt[tid] = 0;
        __syncthreads();
        int ei[4] = {0, 0, 0, 0}; float ev[4] = {0.f, 0.f, 0.f, 0.f}; int lr[4] = {0, 0, 0, 0};
        if (active) {
            float v[32];
#pragma unroll
            for (int q = 0; q < 8; ++q) {
                const float4 x4 = *(const float4*)(LG + (size_t)row * 32 + q * 4);
                v[q * 4] = x4.x; v[q * 4 + 1] = x4.y; v[q * 4 + 2] = x4.z; v[q * 4 + 3] = x4.w;
            }
#pragma unroll
            for (int k = 0; k < 4; ++k) {
                float best = -3.0e38f; int bi = 0;
#pragma unroll
                for (int e = 0; e < 32; ++e) { const bool tk = v[e] > best; best = tk ? v[e] : best; bi = tk ? e : bi; }
                ei[k] = bi; ev[k] = best;
#pragma unroll
                for (int e = 0; e < 32; ++e) v[e] = (e == bi) ? -3.0e38f : v[e];
            }
            const float e1 = __expf(ev[1] - ev[0]), e2 = __expf(ev[2] - ev[0]), e3 = __expf(ev[3] - ev[0]);
            const float inv = 1.0f / (1.0f + e1 + e2 + e3);
            ev[0] = inv; ev[1] = e1 * inv; ev[2] = e2 * inv; ev[3] = e3 * inv;
#pragma unroll
            for (int k = 0; k < 4; ++k) lr[k] = atomicAdd(&lcnt[ei[k]], 1);
        }
        __syncthreads();
        if (tid < 32) lbase[tid] = (lcnt[tid] > 0) ? atomicAdd(&cnt[tid], lcnt[tid]) : 0;
        __syncthreads();
        if (active) {
#pragma unroll
            for (int k = 0; k < 4; ++k) {
                const int pos = lbase[ei[k]] + lr[k];
                const int id = row * 4 + k;
                TOKL[(size_t)ei[k] * NT + pos] = id;
                ((float*)(ws + WS_GATEL))[(size_t)ei[k] * NT + pos] = ev[k];
            }
        }
    }
}

__device__ __forceinline__ void expert_prefix(const Args& a, int l, int* sm, int tid) {
    const int* cnt = (const int*)(wsp(a) + CNT_OFF) + l * 32;
    __syncthreads();
    if (tid == 0) {
        int tp = 0, rp = 0;
        for (int e = 0; e < 32; ++e) {
            const int cn = cnt[e];
            sm[e] = cn; sm[32 + e] = tp; sm[65 + e] = rp;
            tp += (cn + 255) >> 8; rp += cn;
        }
        sm[64] = tp; sm[97] = rp;
    }
    __syncthreads();
}

__device__ __forceinline__ void phase_gemm1(const Args& a, int l, char* smem, int tid, int bid, int nb) {
    unsigned char* ws = wsp(a);
    int* pre = (int*)(smem + LDS_MAIN);
    expert_prefix(a, l, pre, tid);
    const int wave = tid >> 6, lane = tid & 63, wm = wave >> 1, wn = wave & 1, g = lane >> 4, c = lane & 15;
    const int ntiles = pre[64] * 16;
    const int* TOKL = (const int*)(ws + WS_TOKL);
    const bfu* HI = (const bfu*)(ws + WS_H2HI);
    bfu* ACT = (bfu*)(ws + WS_ACT);
    for (int it = bid; it < ntiles; it += nb) {
        const int tix = it >> 4, nt = it & 15;
        int e = 0;
        while (pre[32 + e + 1] <= tix) ++e;
        const int mt = tix - pre[32 + e];
        const int cn = pre[e], rs = pre[65 + e];
        const int* tl = TOKL + (size_t)e * NT;
        int arow[4];
#pragma unroll
        for (int i = 0; i < 4; ++i) {
            int ri = mt * 256 + (tid >> 3) + 64 * i;
            ri = (ri < cn) ? ri : 0;
            arow[i] = tl[ri] >> 2;
        }
        f32x4 acc[4][4]; zero_acc<4>(acc);
        gemm_loop<4>(acc, HI, 1024, arow, (const bfu*)(ws + WS_W1T) + (size_t)(l * 32 + e) * 2048 * 1024, 1024, nt * 128, 1024, smem, tid);
        const float* b1 = a.in[30] + (size_t)(l * 32 + e) * 2048;
#pragma unroll
        for (int p = 0; p < 2; ++p) {
            const int acol = nt * 64 + wn * 32 + p * 16 + c;
            const float bg = b1[acol], bl = b1[1024 + acol];
#pragma unroll
            for (int mi = 0; mi < 4; ++mi)
#pragma unroll
                for (int r = 0; r < 4; ++r) {
                    const int grow = mt * 256 + wm * 64 + mi * 16 + g * 4 + r;
                    if (grow < cn) {
                        const float glu = fminf(acc[mi][2 * p][r] + bg, 7.0f);
                        const float lin = fminf(fmaxf(acc[mi][2 * p + 1][r] + bl, -7.0f), 7.0f);
                        ACT[(size_t)(rs + grow) * 1024 + acol] = f2bf(glu * sigmoidf_(1.702f * glu) * (lin + 1.0f));
                    }
                }
        }
    }
}

__device__ __forceinline__ void phase_gemm2(const Args& a, int l, char* smem, int tid, int bid, int nb) {
    unsigned char* ws = wsp(a);
    int* pre = (int*)(smem + LDS_MAIN);
    expert_prefix(a, l, pre, tid);
    const int wave = tid >> 6, lane = tid & 63, wm = wave >> 1, wn = wave & 1, g = lane >> 4, c = lane & 15;
    const int ntiles = pre[64] * 8;
    const int* TOKL = (const int*)(ws + WS_TOKL);
    const float* GATE = (const float*)(ws + WS_GATE);
    const bfu* ACT = (const bfu*)(ws + WS_ACT);
    bfu* YB = (bfu*)(ws + WS_YB);
    for (int it = bid; it < ntiles; it += nb) {
        const int tix = it >> 3, nt = it & 7;
        int e = 0;
        while (pre[32 + e + 1] <= tix) ++e;
        const int mt = tix - pre[32 + e];
        const int cn = pre[e], rs = pre[65 + e];
        const int* tl = TOKL + (size_t)e * NT;
        int arow[4];
#pragma unroll
        for (int i = 0; i < 4; ++i) {
            int ri = mt * 256 + (tid >> 3) + 64 * i;
            ri = (ri < cn) ? ri : (cn - 1);
            arow[i] = rs + ri;
        }
        f32x4 acc[4][4]; zero_acc<4>(acc);
        gemm_loop<4>(acc, ACT, 1024, arow, (const bfu*)(ws + WS_W2ET) + (size_t)(l * 32 + e) * 1024 * 1024, 1024, nt * 128, 1024, smem, tid);
        const float* b2 = a.in[32] + (size_t)(l * 32 + e) * 1024;
#pragma unroll
        for (int mi = 0; mi < 4; ++mi)
#pragma unroll
            for (int r = 0; r < 4; ++r) {
                const int grow = mt * 256 + wm * 64 + mi * 16 + g * 4 + r;
                if (grow < cn) {
                    const int id = tl[grow];
                    const float gate = GATE[id];
#pragma unroll
                    for (int ni = 0; ni < 4; ++ni) {
                        const int col = nt * 128 + wn * 64 + ni * 16 + c;
                        YB[(size_t)id * 1024 + col] = f2bf((acc[mi][ni][r] + b2[col]) * gate);
                    }
                }
            }
    }
}

struct EpiWout {
    static constexpr bool PERM = true;
    unsigned char* ws; int l;
    __device__ __forceinline__ void operator()(const f32x4 (&acc)[2][2][4][2], const g8::Unit& u, int wr, int wc, int fr, int fq) const {
        bfu* xres = (bfu*)(ws + WS_XRES);
        const int rbase = u.pm * 256;
        const int b = rbase / TB, mm = ((rbase % TB) < SEQ) ? b : 8;
        const float* ga = (const float*)(ws + WS_MOD) + (size_t)(l * 9 + mm) * 6144 + 2 * 1024;
        const int col0 = u.pn * 256 + 32 * wc + 8 * fq;
        f32x4 gv[2][2];
#pragma unroll
        for (int bj = 0; bj < 2; ++bj)
#pragma unroll
            for (int n = 0; n < 2; ++n) gv[bj][n] = *(const f32x4*)(ga + col0 + bj * 128 + n * 4);
#pragma unroll
        for (int ai = 0; ai < 2; ++ai)
#pragma unroll
            for (int m = 0; m < 4; ++m) {
                bfu* rp = xres + (size_t)(rbase + ai * 128 + wr * 64 + m * 16 + fr) * 1024 + col0;
#pragma unroll
                for (int bj = 0; bj < 2; ++bj) {
                    const uint4 xp = *(const uint4*)(rp + bj * 128);
                    f32x4 x0 = {bflo(xp.x), bfhi(xp.x), bflo(xp.y), bfhi(xp.y)}, x1 = {bflo(xp.z), bfhi(xp.z), bflo(xp.w), bfhi(xp.w)};
                    x0 += gv[bj][0] * acc[ai][bj][m][0]; x1 += gv[bj][1] * acc[ai][bj][m][1];
                    const uint2 lo = pack4(x0), hi = pack4(x1);
                    *(uint4*)(rp + bj * 128) = make_uint4(lo.x, lo.y, hi.x, hi.y);
                }
            }
    }
};
__device__ __forceinline__ void phase_wout8(const Args& a, int l, char* smem, int tid, int bid, int nb) {
    SchedDense S;
    S.A = (const char*)(wsp(a) + WS_GL); S.B = (const char*)(wsp(a) + WS_WOT) + (size_t)l * 1024 * 3072 * 2;
    S.lda = 3072; S.ldb = 3072; S.nM = 64; S.nN = 4; S.G = nb; S.c = bid; S.skip9 = 1;
    EpiWout E; E.ws = wsp(a); E.l = l;
    g8::gemm8((LAS unsigned char*)smem, S, E, 1024, tid);
    if (l == 0) {
        unsigned char* ws = wsp(a);
        const int wave = tid >> 6, lane = tid & 63, wm = wave >> 1, wn = wave & 1, g = lane >> 4, c = lane & 15;
        bfu* xres = (bfu*)(ws + WS_XRES);
        const float* ga = (const float*)(ws + WS_MOD) + (size_t)(l * 9 + 8) * 6144 + 2 * 1024;
        __syncthreads();
        for (int it = bid; it < 128; it += nb) {
            const int mt = (it >> 4) * 9 + 8, nt = it & 15;
            const int m0 = mt * 256, n0 = nt * 64;
            int arow[4]; ident_rows(arow, m0, tid);
            f32x4 acc[4][2]; zero_acc<2>(acc);
            gemm_loop<2>(acc, (const bfu*)(ws + WS_MB), 1024, arow, (const bfu*)(ws + WS_WOT) + (size_t)l * 1024 * 3072, 3072, n0, 1024, smem, tid);
            const int rowbase = m0 + wm * 64, colbase = n0 + wn * 32;
#pragma unroll
            for (int ni = 0; ni < 2; ++ni) {
                const int col = colbase + ni * 16 + c;
                const float gac = ga[col];
#pragma unroll
                for (int mi = 0; mi < 4; ++mi)
#pragma unroll
                    for (int r = 0; r < 4; ++r) {
                        const int row = rowbase + mi * 16 + g * 4 + r;
                        xres[(size_t)row * 1024 + col] = f2bf(bf2f(xres[(size_t)row * 1024 + col]) + gac * acc[mi][ni][r]);
                    }
            }
        }
    }
}

struct SchedMerge {
    static constexpr bool GATHER = false;
    unsigned char* ws; int l, lda, ldb, nM, G, c, skip9;
    __device__ __forceinline__ bool next(int i, g8::Unit& u) const {
        const int j = i / 3, n = g8::uni(i - 3 * j);
        int pm, pn; if (!g8::static_tile(j, G, c, nM, 4, pm, pn)) return false;
        if (skip9) pm += pm >> 3;
        pm = g8::uni(pm); pn = g8::uni(pn);
        u.pm = pm; u.pn = pn; u.e = n; u.cn = 0;
        u.A = (const char*)(ws + WS_ODA) + ((size_t)n * NT * 512 + (size_t)pm * 256 * 512) * 2;
        u.B = (const char*)(ws + WS_WBT) + ((size_t)(l * 3 + n) * 1024 * 512 + (size_t)pn * 256 * 512) * 2;
        return true;
    }
    __device__ __forceinline__ void rows(const g8::Unit&, int, int&) const {}
};
struct EpiMerge {
    static constexpr bool PERM = true;
    unsigned char* ws;
    __device__ __forceinline__ void operator()(const f32x4 (&acc)[2][2][4][2], const g8::Unit& u, int wr, int wc, int fr, int fq) const {
        bfu* GL = (bfu*)(ws + WS_GL);
        const int col0 = u.pn * 256 + 32 * wc + 8 * fq;
        const int go = u.e * 1024;
        const bool first = (u.e == 0);
#pragma unroll
        for (int ai = 0; ai < 2; ++ai)
#pragma unroll
            for (int m = 0; m < 4; ++m) {
                bfu* rp = GL + (size_t)(u.pm * 256 + ai * 128 + wr * 64 + m * 16 + fr) * 3072 + col0;
#pragma unroll
                for (int bj = 0; bj < 2; ++bj) {
                    const uint4 gp = *(const uint4*)(rp + go + bj * 128);
                    uint4 zp = make_uint4(0u, 0u, 0u, 0u);
                    if (!first) zp = *(const uint4*)(rp + bj * 128);
                    f32x4 v0 = acc[ai][bj][m][0], v1 = acc[ai][bj][m][1];
                    v0[0] = v0[0] * bflo(gp.x) + bflo(zp.x); v0[1] = v0[1] * bfhi(gp.x) + bfhi(zp.x); v0[2] = v0[2] * bflo(gp.y) + bflo(zp.y); v0[3] = v0[3] * bfhi(gp.y) + bfhi(zp.y);
                    v1[0] = v1[0] * bflo(gp.z) + bflo(zp.z); v1[1] = v1[1] * bfhi(gp.z) + bfhi(zp.z); v1[2] = v1[2] * bflo(gp.w) + bflo(zp.w); v1[3] = v1[3] * bfhi(gp.w) + bfhi(zp.w);
                    const uint2 lo = pack4(v0), hi = pack4(v1);
                    *(uint4*)(rp + bj * 128) = make_uint4(lo.x, lo.y, hi.x, hi.y);
                }
            }
    }
};
__device__ __forceinline__ void phase_merge8(const Args& a, int l, char* smem, int tid, int bid, int nb) {
    SchedMerge S; S.ws = wsp(a); S.l = l; S.lda = 512; S.ldb = 512; S.nM = 64; S.G = nb; S.c = bid; S.skip9 = 1;
    EpiMerge E; E.ws = wsp(a);
    g8::gemm8((LAS unsigned char*)smem, S, E, 512, tid);
    if (l == 0) {
        unsigned char* ws = wsp(a);
        const int wave = tid >> 6, lane = tid & 63, wm = wave >> 1, wn = wave & 1, g = lane >> 4, c = lane & 15;
        const bfu* GL = (const bfu*)(ws + WS_GL);
        bfu* MB = (bfu*)(ws + WS_MB);
        __syncthreads();
        for (int it = bid; it < 128; it += nb) {
            const int mt = (it >> 4) * 9 + 8, nt = it & 15;
            const int m0 = mt * 256, n0 = nt * 64;
            int arow[4]; ident_rows(arow, m0, tid);
            const int rowbase = m0 + wm * 64, colbase = n0 + wn * 32;
            f32x4 tot[4][2]; zero_acc<2>(tot);
            for (int n = 0; n < 3; ++n) {
                f32x4 acc[4][2]; zero_acc<2>(acc);
                gemm_loop<2>(acc, (const bfu*)(ws + WS_ODA) + (size_t)n * NT * 512, 512, arow,
                             (const bfu*)(ws + WS_WBT) + (size_t)(l * 3 + n) * 1024 * 512, 512, n0, 512, smem, tid);
#pragma unroll
                for (int mi = 0; mi < 4; ++mi)
#pragma unroll
                    for (int ni = 0; ni < 2; ++ni)
#pragma unroll
                        for (int r = 0; r < 4; ++r) {
                            const int row = rowbase + mi * 16 + g * 4 + r;
                            const float gate = bf2f(GL[(size_t)row * 3072 + n * 1024 + colbase + ni * 16 + c]);
                            tot[mi][ni][r] += gate * acc[mi][ni][r];
                        }
            }
#pragma unroll
            for (int mi = 0; mi < 4; ++mi)
#pragma unroll
                for (int ni = 0; ni < 2; ++ni)
#pragma unroll
                    for (int r = 0; r < 4; ++r) {
                        const int row = rowbase + mi * 16 + g * 4 + r;
                        MB[(size_t)row * 1024 + colbase + ni * 16 + c] = f2bf(tot[mi][ni][r]);
                    }
        }
    }
}

constexpr int N2_RPW = 9;
#ifndef N2_SWAP16
#define N2_SWAP16 1
#endif
__device__ __forceinline__ float rowmax16(float x) {
    x = fmaxf(x, dppf<0xB1>(x)); x = fmaxf(x, dppf<0x4E>(x)); x = fmaxf(x, dppf<0x124>(x)); x = fmaxf(x, dppf<0x128>(x));
    return x;
}
__device__ __forceinline__ void phase_n2rt(const Args& a, int l, char* smem, int tid, int bid, int nb) {
    unsigned char* ws = wsp(a);
    const int wave = tid >> 6, lane = tid & 63;
    float* RT = (float*)smem;
    int* lcnt = (int*)(smem + LDS_MAIN);
    int* lbase = lcnt + 32;
    int* rec_e = (int*)(smem + LDS_MAIN + 512);
    int* rec_r = rec_e + NW * N2_RPW * 4;
    float* rec_g = (float*)(rec_r + NW * N2_RPW * 4);
    const bfu* xres = (const bfu*)(ws + WS_XRES);
    bfu* H = (bfu*)(ws + WS_H);
    const float* mod = (const float*)(ws + WS_MOD);
    int* cnt = (int*)(ws + CNT_OFF) + l * 32;
    int* TOKL = (int*)(ws + WS_TOKL);
    float* GATEL = (float*)(ws + WS_GATEL);
    __syncthreads();
    {
        const float* Rs = a.in[27] + (size_t)l * 1024 * 32;
        for (int idx = tid; idx < 8192; idx += NTHREADS) {
            const int k = idx & 1023, e4 = idx >> 10;
            const float4 r = *(const float4*)(Rs + (size_t)k * 32 + e4 * 4);
            RT[(e4 * 4 + 0) * 1024 + k] = r.x; RT[(e4 * 4 + 1) * 1024 + k] = r.y; RT[(e4 * 4 + 2) * 1024 + k] = r.z; RT[(e4 * 4 + 3) * 1024 + k] = r.w;
        }
    }
    const float bias = a.in[28][l * 32 + (lane >> 1)];
    const int stride = nb * NW;
    const bool b5 = (lane & 32) != 0, b4 = (lane & 16) != 0, b3 = (lane & 8) != 0, b2 = (lane & 4) != 0, b1 = (lane & 2) != 0;
    for (int r0 = bid * NW + wave; r0 - wave - bid * NW < NT; r0 += N2_RPW * stride) {
        __syncthreads();
        if (tid < 32) lcnt[tid] = 0;
        __syncthreads();
        uint2 vn[4];
        if (r0 < NT) {
#pragma unroll
            for (int i = 0; i < 4; ++i) vn[i] = *(const uint2*)(xres + (size_t)r0 * 1024 + i * 256 + lane * 4);
        }
        for (int kk = 0; kk < N2_RPW; ++kk) {
            const int row = r0 + kk * stride;
            if (row >= NT) { if (lane < 4) rec_e[(wave * N2_RPW + kk) * 4 + lane] = -1; continue; }
            const int b = row / TB, t = row % TB;
            float v[16];
#pragma unroll
            for (int i = 0; i < 4; ++i) { v[i * 4 + 0] = bflo(vn[i].x); v[i * 4 + 1] = bfhi(vn[i].x); v[i * 4 + 2] = bflo(vn[i].y); v[i * 4 + 3] = bfhi(vn[i].y); }
            if (kk + 1 < N2_RPW && row + stride < NT) {
#pragma unroll
                for (int i = 0; i < 4; ++i) vn[i] = *(const uint2*)(xres + (size_t)(row + stride) * 1024 + i * 256 + lane * 4);
            }
            if (l == 1 && t >= SEQ) { if (lane < 4) rec_e[(wave * N2_RPW + kk) * 4 + lane] = -1; continue; }
            const int m = (t < SEQ) ? b : 8;
            const float* md = mod + (size_t)(l * 9 + m) * 6144;
            float y[16];
            norm_mod(v, y, a.in[7] + l * 1024, md + 3 * 1024, md + 4 * 1024, lane);
            store_h_row(H + (size_t)row * 1024, y, lane);
            f32x2_t acc2[32];
#pragma unroll
            for (int e = 0; e < 32; ++e) acc2[e] = (f32x2_t){0.f, 0.f};
            {
                const float* rp = RT + lane * 4;
                f32x4 ra[6], rb[6];
#define N2_LD(dst, bt) do { _Pragma("unroll") for (int q = 0; q < 6; ++q) { const int pe = (bt) * 6 + q; if (pe < 128) dst[q] = *(const f32x4*)(rp + (pe & 31) * 1024 + (pe >> 5) * 256); } } while (0)
#define N2_FM(src, bt) do { _Pragma("unroll") for (int q = 0; q < 6; ++q) { const int pe = (bt) * 6 + q; if (pe < 128) { const int e = pe & 31, i_ = pe >> 5; \
                    const f32x2_t y01 = {y[i_ * 4 + 0], y[i_ * 4 + 1]}, y23 = {y[i_ * 4 + 2], y[i_ * 4 + 3]}; const f32x2_t r01 = {src[q][0], src[q][1]}, r23 = {src[q][2], src[q][3]}; \
                    acc2[e] = y01 * r01 + acc2[e]; acc2[e] = y23 * r23 + acc2[e]; } } } while (0)
                N2_LD(ra, 0);
#pragma unroll
                for (int bt = 0; bt < 22; bt += 2) {
                    N2_LD(rb, bt + 1);
                    __builtin_amdgcn_sched_barrier(0);
                    N2_FM(ra, bt);
                    __builtin_amdgcn_sched_barrier(0);
                    if (bt + 2 < 22) N2_LD(ra, bt + 2);
                    __builtin_amdgcn_sched_barrier(0);
                    N2_FM(rb, bt + 1);
                    __builtin_amdgcn_sched_barrier(0);
                }
#undef N2_LD
#undef N2_FM
            }
            float acc[32];
#pragma unroll
            for (int e = 0; e < 32; ++e) acc[e] = acc2[e][0] + acc2[e][1];
            float S[16], U[8], T4[4], W2[2];
#pragma unroll
            for (int j = 0; j < 16; ++j) {
                const auto r = __builtin_amdgcn_permlane32_swap(__float_as_uint(acc[j]), __float_as_uint(acc[16 + j]), false, false);
                S[j] = __uint_as_float(r[0]) + __uint_as_float(r[1]);
            }
#pragma unroll
            for (int j = 0; j < 8; ++j) {
#if N2_SWAP16
                const auto r = __builtin_amdgcn_permlane16_swap(__float_as_uint(S[j]), __float_as_uint(S[8 + j]), false, false);
                U[j] = __uint_as_float(r[0]) + __uint_as_float(r[1]);
#else
                const float keep = b4 ? S[8 + j] : S[j], send = b4 ? S[j] : S[8 + j];
                U[j] = keep + shx_(send, 16);
#endif
            }
#pragma unroll
            for (int j = 0; j < 4; ++j) { const float keep = b3 ? U[4 + j] : U[j], send = b3 ? U[j] : U[4 + j]; T4[j] = keep + dppf<0x128>(send); }
#pragma unroll
            for (int j = 0; j < 2; ++j) { const float keep = b2 ? T4[2 + j] : T4[j], send = b2 ? T4[j] : T4[2 + j]; W2[j] = keep + shx_(send, 4); }
            float X;
            { const float keep = b1 ? W2[1] : W2[0], send = b1 ? W2[0] : W2[1]; X = keep + dppf<0x4E>(send); }
            X += dppf<0xB1>(X);
            float lg = X + bias;
            int ei[4]; float ev[4];
#pragma unroll
            for (int k = 0; k < 4; ++k) {
                const float rm = rowmax16(lg);
                const float m0 = __int_as_float(__builtin_amdgcn_readlane(__float_as_int(rm), 0)), m1 = __int_as_float(__builtin_amdgcn_readlane(__float_as_int(rm), 16));
                const float m2 = __int_as_float(__builtin_amdgcn_readlane(__float_as_int(rm), 32)), m3 = __int_as_float(__builtin_amdgcn_readlane(__float_as_int(rm), 48));
                const float mx = fmaxf(fmaxf(m0, m1), fmaxf(m2, m3));
                const unsigned long long bm = __ballot(lg == mx);
                const int e = (__ffsll((long long)bm) - 1) >> 1;
                ei[k] = e; ev[k] = mx;
                lg = ((lane >> 1) == e) ? -3.0e38f : lg;
            }
            const float e1 = __expf(ev[1] - ev[0]), e2 = __expf(ev[2] - ev[0]), e3 = __expf(ev[3] - ev[0]);
            const float inv = 1.0f / (1.0f + e1 + e2 + e3);
            if (lane < 4) {
                const int es = (lane == 0) ? ei[0] : (lane == 1) ? ei[1] : (lane == 2) ? ei[2] : ei[3];
                const float gs = ((lane == 0) ? 1.0f : (lane == 1) ? e1 : (lane == 2) ? e2 : e3) * inv;
                const int lr = atomicAdd(&lcnt[es], 1);
                const int ro = (wave * N2_RPW + kk) * 4 + lane;
                rec_e[ro] = es; rec_r[ro] = lr; rec_g[ro] = gs;
            }
        }
        __syncthreads();
        if (tid < 32) lbase[tid] = (lcnt[tid] > 0) ? atomicAdd(&cnt[tid], lcnt[tid]) : 0;
        __syncthreads();
        if (lane < N2_RPW * 4) {
            const int kk = lane >> 2, k = lane & 3;
            const int ro = (wave * N2_RPW + kk) * 4 + k;
            const int e = rec_e[ro];
            if (e >= 0) {
                const int row = r0 + kk * stride;
                const int pos = lbase[e] + rec_r[ro];
                TOKL[(size_t)e * NT + pos] = row * 4 + k;
                GATEL[(size_t)e * NT + pos] = rec_g[ro];
            }
        }
    }
}

struct SchedG1 {
    static constexpr bool GATHER = true;
    unsigned char* ws; const int* pre; int l, lda, ldb, G, c; mutable int hint;
    __device__ __forceinline__ bool next(int i, g8::Unit& u) const {
        const int total = pre[64] * 8;
        const long L0 = (long)i * G + c; if (L0 >= total) return false;
        int L = (int)L0; { const int q = total / 8, r = total % 8, xcd = L % 8, off = L / 8; L = (xcd < r ? xcd * (q + 1) : r * (q + 1) + (xcd - r) * q) + off; }
        const int tix = g8::uni(L >> 3), pn = g8::uni(L & 7);
        int e = (pre[32 + hint] <= tix) ? hint : 0; while (pre[32 + e + 1] <= tix) ++e;
        e = g8::uni(e); hint = e;
        u.e = e; u.cn = g8::uni(pre[e]); u.pm = g8::uni(tix - pre[32 + e]); u.pn = pn;
        u.A = (const char*)(ws + WS_H);
        u.B = (const char*)(ws + WS_W1T) + ((size_t)(l * 32 + e) * 2048 + (size_t)pn * 256) * 1024 * 2;
        return true;
    }
    __device__ __forceinline__ void rows(const g8::Unit& u, int r, int& idx) const {
        int ri = u.pm * 256 + r; ri = (ri < u.cn) ? ri : 0;
        idx = ((const int*)(ws + WS_TOKL))[(size_t)u.e * NT + ri] >> 2;
    }
};
struct EpiG1 {
    static constexpr bool PERM = true;
    unsigned char* ws; const int* pre; const float* b1l;
    __device__ __forceinline__ void operator()(const f32x4 (&acc)[2][2][4][2], const g8::Unit& u, int wr, int wc, int fr, int fq) const {
        bfu* ACT = (bfu*)(ws + WS_ACT);
        const float* b1 = b1l + (size_t)u.e * 2048;
        const size_t rbase = (size_t)(pre[32 + u.e] + u.pm) * 256 + wr * 64 + fr;
        const int ac0 = u.pn * 128 + 32 * wc + 8 * fq;
        f32x4 bg[2], bl[2];
#pragma unroll
        for (int n = 0; n < 2; ++n) { bg[n] = *(const f32x4*)(b1 + ac0 + 4 * n); bl[n] = *(const f32x4*)(b1 + 1024 + ac0 + 4 * n); }
#pragma unroll
        for (int ai = 0; ai < 2; ++ai)
#pragma unroll
            for (int m = 0; m < 4; ++m) {
                uint2 pk[2];
#pragma unroll
                for (int n = 0; n < 2; ++n) {
                    f32x4 o;
#pragma unroll
                    for (int j = 0; j < 4; ++j) {
                        const float glu = fminf(acc[ai][0][m][n][j] + bg[n][j], 7.0f);
                        const float lin = fminf(fmaxf(acc[ai][1][m][n][j] + bl[n][j], -7.0f), 7.0f);
                        o[j] = glu * sigmoidf_(1.702f * glu) * (lin + 1.0f);
                    }
                    pk[n] = pack4(o);
                }
                *(uint4*)(ACT + (rbase + ai * 128 + m * 16) * 1024 + ac0) = make_uint4(pk[0].x, pk[0].y, pk[1].x, pk[1].y);
            }
    }
};
struct SchedG2 {
    static constexpr bool GATHER = false;
    unsigned char* ws; const int* pre; int l, lda, ldb, G, c; mutable int hint;
    __device__ __forceinline__ bool next(int i, g8::Unit& u) const {
        const int total = pre[64] * 4;
        const long L0 = (long)i * G + c; if (L0 >= total) return false;
        int L = (int)L0; { const int q = total / 8, r = total % 8, xcd = L % 8, off = L / 8; L = (xcd < r ? xcd * (q + 1) : r * (q + 1) + (xcd - r) * q) + off; }
        const int tix = g8::uni(L >> 2), pn = g8::uni(L & 3);
        int e = (pre[32 + hint] <= tix) ? hint : 0; while (pre[32 + e + 1] <= tix) ++e;
        e = g8::uni(e); hint = e;
        u.e = e; u.cn = g8::uni(pre[e]); u.pm = g8::uni(tix - pre[32 + e]); u.pn = pn;
        u.A = (const char*)(ws + WS_ACT) + (size_t)tix * 256 * 1024 * 2;
        u.B = (const char*)(ws + WS_W2ET) + ((size_t)(l * 32 + e) * 1024 + (size_t)pn * 256) * 1024 * 2;
        return true;
    }
    __device__ __forceinline__ void rows(const g8::Unit&, int, int&) const {}
};
struct EpiG2 {
    static constexpr bool PERM = true;
    unsigned char* ws; const float* b2l;
    __device__ __forceinline__ void operator()(const f32x4 (&acc)[2][2][4][2], const g8::Unit& u, int wr, int wc, int fr, int fq) const {
        bfu* YB = (bfu*)(ws + WS_YB);
        const int* tl = (const int*)(ws + WS_TOKL) + (size_t)u.e * NT;
        const float* gl = (const float*)(ws + WS_GATEL) + (size_t)u.e * NT;
        const float* b2 = b2l + (size_t)u.e * 1024;
        const int col0 = u.pn * 256 + 32 * wc + 8 * fq;
        f32x4 bv[2][2];
#pragma unroll
        for (int bj = 0; bj < 2; ++bj)
#pragma unroll
            for (int n = 0; n < 2; ++n) bv[bj][n] = *(const f32x4*)(b2 + col0 + bj * 128 + n * 4);
        int ids[2][4]; float gts[2][4];
#pragma unroll
        for (int ai = 0; ai < 2; ++ai)
#pragma unroll
            for (int m = 0; m < 4; ++m) {
                int ri = u.pm * 256 + ai * 128 + wr * 64 + m * 16 + fr; ri = (ri < u.cn) ? ri : 0;
                ids[ai][m] = tl[ri]; gts[ai][m] = gl[ri];
            }
#pragma unroll
        for (int ai = 0; ai < 2; ++ai)
#pragma unroll
            for (int m = 0; m < 4; ++m) {
                const int ri = u.pm * 256 + ai * 128 + wr * 64 + m * 16 + fr;
                if (ri < u.cn) {
                    const float gate = gts[ai][m];
                    bfu* rp = YB + (size_t)ids[ai][m] * 1024 + col0;
#pragma unroll
                    for (int bj = 0; bj < 2; ++bj) {
                        const uint2 lo = pack4((acc[ai][bj][m][0] + bv[bj][0]) * gate), hi = pack4((acc[ai][bj][m][1] + bv[bj][1]) * gate);
                        *(uint4*)(rp + bj * 128) = make_uint4(lo.x, lo.y, hi.x, hi.y);
                    }
                }
            }
    }
};
__device__ __forceinline__ void expert_prefix8(const Args& a, int l, int* sm, int tid) {
    const int* cnt = (const int*)(wsp(a) + CNT_OFF) + l * 32;
    __syncthreads();
    if (tid == 0) {
        int tp = 0;
        for (int e = 0; e < 32; ++e) { const int cn = cnt[e]; sm[e] = cn; sm[32 + e] = tp; tp += (cn + 255) >> 8; }
        sm[64] = tp;
    }
    __syncthreads();
}
__device__ __forceinline__ void phase_gemm1_8(const Args& a, int l, char* smem, int tid, int bid, int nb) {
    int* pre = (int*)(smem + LDS_MAIN);
    expert_prefix8(a, l, pre, tid);
    SchedG1 S; S.ws = wsp(a); S.pre = pre; S.l = l; S.lda = 1024; S.ldb = 1024; S.G = nb; S.c = bid; S.hint = 0;
    EpiG1 E; E.ws = wsp(a); E.pre = pre; E.b1l = a.in[30] + (size_t)l * 32 * 2048;
    g8::gemm8((LAS unsigned char*)smem, S, E, 1024, tid);
}
__device__ __forceinline__ void phase_gemm2_8(const Args& a, int l, char* smem, int tid, int bid, int nb) {
    int* pre = (int*)(smem + LDS_MAIN);
    expert_prefix8(a, l, pre, tid);
    SchedG2 S; S.ws = wsp(a); S.pre = pre; S.l = l; S.lda = 1024; S.ldb = 1024; S.G = nb; S.c = bid; S.hint = 0;
    EpiG2 E; E.ws = wsp(a); E.b2l = a.in[32] + (size_t)l * 32 * 1024;
    g8::gemm8((LAS unsigned char*)smem, S, E, 1024, tid);
}

struct EpiS2 {
    static constexpr bool PERM = true;
    unsigned char* ws; const float* w0; const float* a0;
    __device__ __forceinline__ void operator()(const f32x4 (&acc)[2][2][4][2], const g8::Unit& u, int wr, int wc, int fr, int fq) const {
        const int kind = u.pn >> 1;
        const int col0 = (u.pn & 1) * 256 + 32 * wc + 8 * fq;
        bfu* dst; const float* bias = nullptr;
        if (kind < 2) { dst = (bfu*)(ws + WS_WDEC) + (size_t)kind * NT * 512; bias = w0 + kind * 512; }
        else if (kind < 4) { dst = (bfu*)(ws + WS_BV) + (size_t)(kind - 2) * NT * 512; bias = a0 + (kind - 2) * 512; }
        else dst = (bfu*)(ws + WS_GG);
        f32x4 bv[2][2];
#pragma unroll
        for (int bj = 0; bj < 2; ++bj)
#pragma unroll
            for (int n = 0; n < 2; ++n) bv[bj][n] = bias ? *(const f32x4*)(bias + col0 + bj * 128 + n * 4) : (f32x4){0.f, 0.f, 0.f, 0.f};
#pragma unroll
        for (int ai = 0; ai < 2; ++ai)
#pragma unroll
            for (int m = 0; m < 4; ++m) {
                bfu* d = dst + (size_t)(u.pm * 256 + ai * 128 + wr * 64 + m * 16 + fr) * 512 + col0;
#pragma unroll
                for (int bj = 0; bj < 2; ++bj) {
                    uint2 pk[2];
#pragma unroll
                    for (int n = 0; n < 2; ++n) {
                        f32x4 v = acc[ai][bj][m][n] + bv[bj][n];
                        if (kind < 2) { v[0] = ex2_(-0.87503925f * sigmoidf_(v[0])); v[1] = ex2_(-0.87503925f * sigmoidf_(v[1])); v[2] = ex2_(-0.87503925f * sigmoidf_(v[2])); v[3] = ex2_(-0.87503925f * sigmoidf_(v[3])); }
                        else if (kind < 4) { v[0] = sigmoidf_(v[0]); v[1] = sigmoidf_(v[1]); v[2] = sigmoidf_(v[2]); v[3] = sigmoidf_(v[3]); }
                        pk[n] = pack4(v);
                    }
                    *(uint4*)(d + bj * 128) = make_uint4(pk[0].x, pk[0].y, pk[1].x, pk[1].y);
                }
            }
    }
};
__device__ __forceinline__ void phase_stage2_8(const Args& a, int l, char* smem, int tid, int bid, int nb) {
    unsigned char* ws = wsp(a);
    {
        SchedDense S;
        S.A = (const char*)(ws + WS_LORA); S.B = (const char*)(ws + WS_S2T) + (size_t)l * 2560 * 512 * 2;
        S.lda = 512; S.ldb = 512; S.nM = 72; S.nN = 10; S.G = nb; S.c = bid; S.skip9 = 0;
        EpiS2 E; E.ws = ws; E.w0 = a.in[12] + l * 1024; E.a0 = a.in[15] + l * 1024;
        g8::gemm8((LAS unsigned char*)smem, S, E, 512, tid);
    }
    {
        const bfu* SB = (const bfu*)(ws + WS_SB);
        const bfu* SG = SB + (size_t)NT * 512;
        const bfu* SX = SG + (size_t)NT * 512;
        bfu* OSC = (bfu*)(ws + WS_ODA) + (size_t)NT * 512;
        const float* cw = a.in[11] + l * 3 * 512;
        for (int i = bid * NTHREADS + tid; i < NT * 64; i += nb * NTHREADS) {
            const int row = i >> 6, c8 = (i & 63) * 8;
            const int t = row % TB;
            if (l == 1 && t >= SEQ) continue;
            const bool hasp = (t != 0 && t != SEQ);
            const bool hasn = (t != SEQ - 1 && t != TB - 1);
            float u[3][8];
#pragma unroll
            for (int j = 0; j < 3; ++j) {
                const bool ok = (j == 1) || (j == 0 ? hasp : hasn);
                if (ok) {
                    const size_t o = (size_t)(row + j - 1) * 512 + c8;
                    const uint4 pg = *(const uint4*)(SG + o), px = *(const uint4*)(SX + o);
                    u[j][0] = bflo(pg.x) * bflo(px.x); u[j][1] = bfhi(pg.x) * bfhi(px.x);
                    u[j][2] = bflo(pg.y) * bflo(px.y); u[j][3] = bfhi(pg.y) * bfhi(px.y);
                    u[j][4] = bflo(pg.z) * bflo(px.z); u[j][5] = bfhi(pg.z) * bfhi(px.z);
                    u[j][6] = bflo(pg.w) * bflo(px.w); u[j][7] = bfhi(pg.w) * bfhi(px.w);
                } else {
#pragma unroll
                    for (int e = 0; e < 8; ++e) u[j][e] = 0.f;
                }
            }
            const uint4 pb = *(const uint4*)(SB + (size_t)row * 512 + c8);
            float sbv[8] = {bflo(pb.x), bfhi(pb.x), bflo(pb.y), bfhi(pb.y), bflo(pb.z), bfhi(pb.z), bflo(pb.w), bfhi(pb.w)};
            float o[8];
#pragma unroll
            for (int e = 0; e < 8; ++e)
                o[e] = sbv[e] * (cw[c8 + e] * u[0][e] + cw[512 + c8 + e] * u[1][e] + cw[1024 + c8 + e] * u[2][e]);
            uint4 po; po.x = pack2(o[0], o[1]); po.y = pack2(o[2], o[3]); po.z = pack2(o[4], o[5]); po.w = pack2(o[6], o[7]);
            *(uint4*)(OSC + (size_t)row * 512 + c8) = po;
        }
    }
}

struct EpiRouter {
    static constexpr bool PERM = true;
    unsigned char* ws; const float* bias;
    __device__ __forceinline__ void operator()(const f32x4 (&acc)[2][2][4][2], const g8::Unit& u, int wr, int wc, int fr, int fq) const {
        if (wc != 0) return;
        float* LG = (float*)(ws + WS_LOG);
#pragma unroll
        for (int n = 0; n < 2; ++n) {
            const f32x4 bv = *(const f32x4*)(bias + 8 * fq + 4 * n);
#pragma unroll
            for (int ai = 0; ai < 2; ++ai)
#pragma unroll
                for (int m = 0; m < 4; ++m) {
                    const size_t row = (size_t)(u.pm * 256 + ai * 128 + wr * 64 + m * 16 + fr);
                    *(f32x4*)(LG + row * 32 + 8 * fq + 4 * n) = acc[ai][0][m][n] + acc[ai][1][m][n] + bv;
                }
        }
    }
};
__device__ __forceinline__ void phase_router8(const Args& a, int l, char* smem, int tid, int bid, int nb) {
    SchedDense S;
    S.A = (const char*)(wsp(a) + WS_H2HI); S.B = (const char*)(wsp(a) + WS_RT) + (size_t)l * 256 * 2048 * 2;
    S.lda = 2048; S.ldb = 2048; S.nM = (l == 0) ? 72 : 64; S.nN = 1; S.G = nb; S.c = bid; S.skip9 = (l == 1);
    EpiRouter E; E.ws = wsp(a); E.bias = a.in[28] + l * 32;
    g8::gemm8((LAS unsigned char*)smem, S, E, 2048, tid);
}

constexpr int N_PHASES = 2 + 11 * NL;

__global__ void __launch_bounds__(NTHREADS, 2) fwd(Args a0) {
    extern __shared__ __attribute__((aligned(16))) char dyn_smem[];
    char* smem = dyn_smem + 16;
    const int tid = threadIdx.x, bid0 = blockIdx.x, nb0 = gridDim.x;
    const int wave_s = __builtin_amdgcn_readfirstlane(tid >> 6);
    const bool multi = (a0.ph_hi - a0.ph_lo) > 1;
    XcdBarrier bar;
    bar.bar = (unsigned*)(a0.ws + WS_CTL); bar.x = 0; bar.st = (volatile LAS unsigned*)dyn_smem;
    if (multi) {
        if (tid == 0) *(uint4*)dyn_smem = make_uint4(0u, 0u, 0u, 0u);
        __syncthreads();
        bar = xcd_barrier_post((unsigned*)(a0.ws + WS_CTL), (volatile LAS unsigned*)dyn_smem);
    }
#ifndef REP_MASK
#define REP_MASK 0u
#define REP_N 1
#endif
#ifndef PHASE_MASK
#define PHASE_MASK 0xFFFFFFFFu
#endif
#define RUN_PHASE(KIND, ID, CALL) do { if constexpr (((PHASE_MASK) >> (KIND)) & 1u) { const int _id = (ID); if (_id >= a0.ph_lo && _id < a0.ph_hi) { \
    for (int _r = 0; _r < ((((REP_MASK) >> (KIND)) & 1u) ? REP_N : 1); ++_r) { int tid = (wave_s << 6) | lane_id_(), bid = bid0, nb = nb0; const Args& a = a0; asm volatile("" : "+v"(tid), "+s"(bid), "+s"(nb)); CALL; } if (_id + 1 < a0.ph_hi) xcd_barrier(bar, wave_s); } } } while (0)
    RUN_PHASE(0, 0, phase_prep(a, smem, tid, bid, nb));
    RUN_PHASE(1, 1, phase_norm1_l0(a, tid, bid, nb));
    for (int l = 0; l < NL; ++l) {
        const int base = 2 + 11 * l;
        RUN_PHASE(2, base + 0, phase_gemm_in8(a, l, smem, tid, bid, nb));
        RUN_PHASE(3, base + 1, phase_stage2_8(a, l, smem, tid, bid, nb));
        RUN_PHASE(14, base + 2, phase_chunkpre(a, l, smem, tid, bid, nb));
        RUN_PHASE(4, base + 3, phase_mix(a, l, smem, tid, bid, nb));
        RUN_PHASE(5, base + 4, phase_post(a, l, tid, bid, nb));
        RUN_PHASE(6, base + 5, phase_merge8(a, l, smem, tid, bid, nb));
        RUN_PHASE(7, base + 6, phase_wout8(a, l, smem, tid, bid, nb));
        RUN_PHASE(8, base + 7, phase_n2rt(a, l, smem, tid, bid, nb));
        RUN_PHASE(11, base + 8, phase_gemm1_8(a, l, smem, tid, bid, nb));
        RUN_PHASE(12, base + 9, phase_gemm2_8(a, l, smem, tid, bid, nb));
        RUN_PHASE(13, base + 10, phase_combine(a, l, tid, bid, nb));
    }
}

extern "C" void kernel_launch(void* const* d_in, const int* in_sizes, int n_in,
                              void* d_out, int out_size, void* d_ws, size_t ws_size,
                              hipStream_t stream) {
    static int grid = 0;
    if (grid == 0) {
        if (n_in != 34 || ws_size < WS_END) { fprintf(stderr, "kernel_launch: bad inputs (n_in %d, ws %zu < %zu)\n", n_in, ws_size, (size_t)WS_END); grid = -1; return; }
        int dev = 0, cus = 0, per_cu = 0;
        hipGetDevice(&dev);
        hipDeviceGetAttribute(&cus, hipDeviceAttributeMultiprocessorCount, dev);
        if (hipFuncSetAttribute((const void*)fwd, hipFuncAttributeMaxDynamicSharedMemorySize, LDS_BYTES) != hipSuccess) { fprintf(stderr, "hipFuncSetAttribute failed\n"); grid = -1; return; }
        hipOccupancyMaxActiveBlocksPerMultiprocessor(&per_cu, (const void*)fwd, NTHREADS, LDS_BYTES);
        (void)hipGetLastError();
        if (per_cu < 1) per_cu = 1;
        grid = cus;
    }
    if (grid < 0) return;
    hipMemsetAsync((char*)d_ws + WS_CTL, 0, CTL_BYTES, stream);
    hipMemsetAsync((char*)d_ws + WS_S2T, 0, (size_t)2 * 2560 * 512 * 2, stream);
    Args a{};
    for (int i = 0; i < 34; ++i) a.in[i] = (const float*)d_in[i];
    a.out = (float*)d_out; a.ws = (unsigned char*)d_ws;
#if N_LAUNCH_MODE == 1
    a.ph_lo = 0; a.ph_hi = N_PHASES;
    hipLaunchKernelGGL(fwd, dim3(grid), dim3(NTHREADS), LDS_BYTES, stream, a);
#else
    for (int p = 0; p < N_PHASES; ++p) {
        a.ph_lo = p; a.ph_hi = p + 1;
        hipLaunchKernelGGL(fwd, dim3(grid), dim3(NTHREADS), LDS_BYTES, stream, a);
    }
#endif
}
```

```cpp
#include <hip/hip_runtime.h>
#include <stdint.h>
#include <stdio.h>

typedef unsigned short bfu;
using bf16x8 = __attribute__((ext_vector_type(8))) short;
using f32x4  = __attribute__((ext_vector_type(4))) float;

constexpr int NB = 8, SEQ = 2048, CTX = 256, TB = 2304, NT = NB * TB, DM = 1024, NL = 2;
constexpr int NEXP = 32;
constexpr int NTHREADS = 512;
constexpr int NW = NTHREADS / 64;
constexpr int LDS_MAIN = 131072;
constexpr int LDS_EXTRA = 4096;
constexpr int LDS_BYTES = LDS_MAIN + LDS_EXTRA + 16;

#ifndef N_LAUNCH_MODE
#define N_LAUNCH_MODE 1
#endif

constexpr size_t al(size_t x) { return (x + 255) & ~(size_t)255; }
constexpr size_t WS_CTL    = 0;
constexpr size_t CTL_BYTES = 32768;
constexpr size_t CNT_OFF   = 16384;
constexpr size_t WS_MOD    = WS_CTL + CTL_BYTES;
constexpr size_t WS_TAB    = al(WS_MOD + (size_t)2 * 9 * 6144 * 4);
constexpr size_t WS_WINT   = al(WS_TAB + 2 * 64 * 16 * 4 + 64);
constexpr size_t WS_S2T    = al(WS_WINT + (size_t)2 * 8192 * 1024 * 2);
constexpr size_t WS_WBT    = al(WS_S2T + (size_t)2 * 2560 * 512 * 2);
constexpr size_t WS_WOT    = al(WS_WBT + (size_t)2 * 3 * 1024 * 512 * 2);
constexpr size_t WS_RT     = al(WS_WOT + (size_t)2 * 1024 * 3072 * 2);
constexpr size_t WS_W1T    = al(WS_RT + (size_t)2 * 256 * 2048 * 2);
constexpr size_t WS_W2ET   = al(WS_W1T + (size_t)2 * 32 * 2048 * 1024 * 2);
constexpr size_t WS_XRES   = al(WS_W2ET + (size_t)2 * 32 * 1024 * 1024 * 2);
constexpr size_t WS_H      = al(WS_XRES + (size_t)NT * 1024 * 4);
constexpr size_t SZ512     = (size_t)NT * 512 * 2;
constexpr size_t WS_Q      = al(WS_H + (size_t)NT * 1024 * 2);
constexpr size_t WS_K      = al(WS_Q + SZ512);
constexpr size_t WS_VT     = al(WS_K + SZ512);
constexpr size_t WS_SB     = al(WS_VT + SZ512);
constexpr size_t WS_RR     = al(WS_SB + 3 * SZ512);
constexpr size_t WS_RK     = al(WS_RR + SZ512);
constexpr size_t WS_RV     = al(WS_RK + SZ512);
constexpr size_t WS_KKB    = al(WS_RV + SZ512);
constexpr size_t WS_GL     = al(WS_KKB + SZ512);
constexpr size_t WS_LORA   = al(WS_GL + (size_t)NT * 3072 * 2);
constexpr size_t WS_WDEC   = al(WS_LORA + SZ512);
constexpr size_t WS_BV     = al(WS_WDEC + 2 * SZ512);
constexpr size_t WS_KE     = al(WS_BV + 2 * SZ512);
constexpr size_t WS_GG     = al(WS_KE + 2 * SZ512);
constexpr size_t WS_Y      = al(WS_GG + SZ512);
constexpr size_t WS_ODA    = al(WS_Y + (size_t)2 * NT * 512 * 4);
constexpr size_t WS_MB     = al(WS_ODA + 3 * SZ512);
constexpr size_t WS_H2HI   = al(WS_MB + (size_t)NT * 1024 * 2);
constexpr size_t WS_H2LO   = al(WS_H2HI + (size_t)NT * 1024 * 2);
constexpr size_t WS_LOG    = al(WS_H2LO + (size_t)NT * 1024 * 2);
constexpr size_t WS_TOKL   = al(WS_LOG + (size_t)NT * 32 * 4);
constexpr size_t WS_GATE   = al(WS_TOKL + (size_t)32 * NT * 4);
constexpr size_t WS_GATEL  = al(WS_GATE + (size_t)NT * 4 * 4);
constexpr size_t WS_ACT    = al(WS_GATEL + (size_t)32 * NT * 4);
constexpr size_t WS_YB     = al(WS_ACT + (size_t)(NT * 4 + 8192) * 1024 * 2);
constexpr size_t WS_END    = al(WS_YB + (size_t)NT * 4 * 1024 * 2);

struct Args {
    const float* in[34];
    float* out;
    unsigned char* ws;
    int ph_lo, ph_hi;
};
#define GAS __attribute__((address_space(1)))
__device__ __forceinline__ unsigned char* wsp(const Args& a) {
    GAS unsigned char* p = (GAS unsigned char*)a.ws; asm volatile("" : "+s"(p)); return (unsigned char*)p; }


typedef __bf16 bf16x2_t __attribute__((ext_vector_type(2)));
typedef float f32x2_t __attribute__((ext_vector_type(2)));
typedef unsigned u32x2_t __attribute__((ext_vector_type(2)));
typedef unsigned u32x4_t __attribute__((ext_vector_type(4)));
__device__ __forceinline__ bfu f2bf(float f) { return __builtin_bit_cast(bfu, (__bf16)f); }
__device__ __forceinline__ float bf2f(bfu b) { return __uint_as_float(((unsigned)b) << 16); }
__device__ __forceinline__ unsigned pack2(float a, float b) { f32x2_t v = {a, b}; return __builtin_bit_cast(unsigned, __builtin_convertvector(v, bf16x2_t)); }
__device__ __forceinline__ float bflo(unsigned u) { return __uint_as_float(u << 16); }
__device__ __forceinline__ float bfhi(unsigned u) { return __uint_as_float(u & 0xFFFF0000u); }
__device__ __forceinline__ float sigmoidf_(float x) { return __builtin_amdgcn_rcpf(1.0f + __builtin_amdgcn_exp2f(-1.4426950408889634f * x)); }
__device__ __forceinline__ float tanhf_(float x) { const float e = __builtin_amdgcn_exp2f(2.8853900817779268f * x); return 1.0f - 2.0f * __builtin_amdgcn_rcpf(e + 1.0f); }
__device__ __forceinline__ int lane_id_() { int l; asm volatile("v_mbcnt_lo_u32_b32 %0, -1, 0\n\tv_mbcnt_hi_u32_b32 %0, -1, %0" : "=v"(l)); return l; }
__device__ __forceinline__ float shx_(float v, int m) { return __int_as_float(__builtin_amdgcn_ds_bpermute((lane_id_() ^ m) << 2, __float_as_int(v))); }
__device__ __forceinline__ float shf_(float v, int src) { return __int_as_float(__builtin_amdgcn_ds_bpermute(src << 2, __float_as_int(v))); }
__device__ __forceinline__ float wave_sum_shfl(float v) {
#pragma unroll
    for (int o = 32; o >= 1; o >>= 1) v += shx_(v, o);
    return v;
}
__device__ __forceinline__ float fmax3_(float a, float b, float c) { float r; asm("v_max3_f32 %0, %1, %2, %3" : "=v"(r) : "v"(a), "v"(b), "v"(c)); return r; }
__device__ __forceinline__ float ex2_(float x) { return __builtin_amdgcn_exp2f(x); }
template <int CTRL>
__device__ __forceinline__ float dppf(float x) {
    return __int_as_float(__builtin_amdgcn_update_dpp(0, __float_as_int(x), CTRL, 0xF, 0xF, true));
}
__device__ __forceinline__ float red16(float x) {
    x += dppf<0xB1>(x);
    x += dppf<0x4E>(x);
    x += dppf<0x124>(x);
    x += dppf<0x128>(x);
    return x;
}
__device__ __forceinline__ float wave_sum(float v) {
    v = red16(v);
    const float s0 = __int_as_float(__builtin_amdgcn_readlane(__float_as_int(v), 0)), s1 = __int_as_float(__builtin_amdgcn_readlane(__float_as_int(v), 16));
    const float s2 = __int_as_float(__builtin_amdgcn_readlane(__float_as_int(v), 32)), s3 = __int_as_float(__builtin_amdgcn_readlane(__float_as_int(v), 48));
    return (s0 + s1) + (s2 + s3);
}

#define XB_TMO      128
#define XB_XCNT(j)  (256  + 64 * (j))
#define XB_XSUB(j)  (1280 + 64 * (j))
#define XB_XGEN(j)  (2304 + 64 * (j))
#define XB_TOP      3328
#define XB_TOPGEN   3392
#define XCD_BAR_WORDS 3456
#define XB_SPIN_CAP (1u << 22)
#define LAS __attribute__((address_space(3)))

__device__ __forceinline__ unsigned xb_ld(unsigned* p)              { return __hip_atomic_load(p, __ATOMIC_RELAXED, __HIP_MEMORY_SCOPE_AGENT); }
__device__ __forceinline__ unsigned xb_add(unsigned* p, unsigned v) { return __hip_atomic_fetch_add(p, v, __ATOMIC_RELAXED, __HIP_MEMORY_SCOPE_AGENT); }
__device__ __forceinline__ unsigned xb_xcc_id() { return (unsigned)__builtin_amdgcn_s_getreg((3 << 11) | 20) & 0xFu; }
#define XB_SPIN(cond, bar) do { unsigned _sp = 0; while (cond) { __builtin_amdgcn_s_sleep(1); \
    if ((++_sp & 255u) == 0u) { if (xb_ld(&(bar)[XB_TMO])) break; if (_sp > XB_SPIN_CAP) { atomicAdd(&(bar)[XB_TMO], 1u); break; } } } } while (0)

struct XcdBarrier { unsigned* bar; unsigned x; volatile LAS unsigned* st; };

__device__ __forceinline__ XcdBarrier xcd_barrier_post(unsigned* bar, volatile LAS unsigned* st) {
    XcdBarrier b; b.bar = bar; b.x = xb_xcc_id(); b.st = st;
    if (threadIdx.x == 0) (void)xb_add(&bar[XB_XCNT(b.x)], 1u);
    return b;
}
__device__ __forceinline__ void xcd_barrier_complete(unsigned* bar, unsigned x, unsigned& nloc, unsigned& nx) {
    const unsigned G = gridDim.x * gridDim.y * gridDim.z;
    unsigned sum, cnt, mine, sp = 0u;
    for (;;) {
        sum = 0u; cnt = 0u; mine = 0u;
#pragma unroll
        for (unsigned j = 0; j < 16; ++j) { const unsigned c = xb_ld(&bar[XB_XCNT(j)]); sum += c; cnt += (c > 0u) ? 1u : 0u; mine = (j == x) ? c : mine; }
        if (sum == G) break;
        __builtin_amdgcn_s_sleep(1);
        if ((++sp & 255u) == 0u) { if (xb_ld(&bar[XB_TMO])) break; if (sp > XB_SPIN_CAP) { atomicAdd(&bar[XB_TMO], 1u); break; } }
    }
    nloc = mine > 0u ? mine : 1u; nx = cnt > 0u ? cnt : 1u;
}
__device__ __forceinline__ void xcd_barrier(const XcdBarrier& b, int wave_s) {
    asm volatile("s_waitcnt vmcnt(0)" ::: "memory");
    __syncthreads();
    if (wave_s == 0 && lane_id_() == 0) {
        unsigned* bar = b.bar;
        __builtin_amdgcn_s_waitcnt(0);
        unsigned nloc = b.st[0], nx = b.st[1];
        if (nloc == 0u) { xcd_barrier_complete(bar, b.x, nloc, nx); b.st[0] = nloc; b.st[1] = nx; }
        const unsigned old = xb_add(&bar[XB_XSUB(b.x)], 1u);
        const unsigned gen = old / nloc;
        if (old + 1u == (gen + 1u) * nloc) {
            __builtin_amdgcn_fence(__ATOMIC_RELEASE, "agent");
            asm volatile("s_waitcnt vmcnt(0)" ::: "memory");
            const unsigned og = xb_add(&bar[XB_TOP], 1u);
            const unsigned tg = og / nx;
            if (og + 1u == (tg + 1u) * nx) xb_add(&bar[XB_TOPGEN], 1u);
            else XB_SPIN(xb_ld(&bar[XB_TOPGEN]) == tg, bar);
            __builtin_amdgcn_fence(__ATOMIC_ACQUIRE, "agent");
            xb_add(&bar[XB_XGEN(b.x)], 1u);
            asm volatile("s_waitcnt vmcnt(0)" ::: "memory");
        } else {
            XB_SPIN(xb_ld(&bar[XB_XGEN(b.x)]) == gen, bar);
            __builtin_amdgcn_fence(__ATOMIC_ACQUIRE, "agent");
            asm volatile("s_waitcnt vmcnt(0)" ::: "memory");
        }
    }
    __syncthreads();
}

constexpr int LROW = 144;
constexpr int LTILE = 256 * LROW;
constexpr int LTILEB = 128 * LROW;

template <int NI>
__device__ __forceinline__ void gemm_loop(f32x4 (&acc)[4][NI], const bfu* __restrict__ A, int lda, const int (&arow)[4],
                                          const bfu* __restrict__ Bt, int ldb, int n0, int K, char* smem, int tid) {
    const int kc = tid & 7, tr = tid >> 3;
    const int wave = tid >> 6, lane = tid & 63, wm = wave >> 1, wn = wave & 1, g = lane >> 4, c = lane & 15;
    const bfu* pa0 = A + (size_t)arow[0] * lda + kc * 8;
    const bfu* pa1 = A + (size_t)arow[1] * lda + kc * 8;
    const bfu* pa2 = A + (size_t)arow[2] * lda + kc * 8;
    const bfu* pa3 = A + (size_t)arow[3] * lda + kc * 8;
    const bfu* pb0 = Bt + (size_t)(n0 + tr) * ldb + kc * 8;
    const bfu* pb1 = Bt + (size_t)(n0 + tr + ((NI == 4) ? 64 : 0)) * ldb + kc * 8;
    const int wofs = tr * LROW + kc * 16;
    const int aofs = (wm * 64 + c) * LROW + g * 16;
    const int bofs = (wn * (16 * NI) + c) * LROW + g * 16;
    const int nk = K >> 6;
    uint4 Pa0, Pa1, Pa2, Pa3, Pb0, Pb1 = make_uint4(0u, 0u, 0u, 0u), Qa0, Qa1, Qa2, Qa3, Qb0, Qb1 = make_uint4(0u, 0u, 0u, 0u);
#define GL_LOAD(S, kt_) do { const size_t ko_ = (size_t)(kt_) * 64; S##a0 = *(const uint4*)(pa0 + ko_); S##a1 = *(const uint4*)(pa1 + ko_); S##a2 = *(const uint4*)(pa2 + ko_); \
        S##a3 = *(const uint4*)(pa3 + ko_); S##b0 = *(const uint4*)(pb0 + ko_); if (NI == 4) S##b1 = *(const uint4*)(pb1 + ko_); } while (0)
#define GL_WRITE(S, buf_) do { char* Aw_ = smem + (buf_) * LTILE; char* Bw_ = smem + 2 * LTILE + (buf_) * LTILEB; \
        *(uint4*)(Aw_ + wofs) = S##a0; *(uint4*)(Aw_ + wofs + 64 * LROW) = S##a1; *(uint4*)(Aw_ + wofs + 128 * LROW) = S##a2; *(uint4*)(Aw_ + wofs + 192 * LROW) = S##a3; \
        *(uint4*)(Bw_ + wofs) = S##b0; if (NI == 4) *(uint4*)(Bw_ + wofs + 64 * LROW) = S##b1; } while (0)
#define GL_COMPUTE(buf_) do { const char* As = smem + (buf_) * LTILE; const char* Bs = smem + 2 * LTILE + (buf_) * LTILEB; \
        _Pragma("unroll") for (int ks = 0; ks < 2; ++ks) { bf16x8 af[4], bq[NI]; \
            _Pragma("unroll") for (int mi = 0; mi < 4; ++mi) af[mi] = *(const bf16x8*)(As + aofs + mi * 16 * LROW + ks * 64); \
            _Pragma("unroll") for (int ni = 0; ni < NI; ++ni) bq[ni] = *(const bf16x8*)(Bs + bofs + ni * 16 * LROW + ks * 64); \
            _Pragma("unroll") for (int mi = 0; mi < 4; ++mi) _Pragma("unroll") for (int ni = 0; ni < NI; ++ni) \
                acc[mi][ni] = __builtin_amdgcn_mfma_f32_16x16x32_bf16(af[mi], bq[ni], acc[mi][ni], 0, 0, 0); } } while (0)
    GL_LOAD(Q, 0); GL_LOAD(P, 1);
    GL_WRITE(Q, 0);
    __syncthreads();
    for (int kt = 0; kt < nk; kt += 2) {
        if (kt + 2 < nk) GL_LOAD(Q, kt + 2);
        GL_COMPUTE(0);
        GL_WRITE(P, 1);
        __syncthreads();
        if (kt + 3 < nk) GL_LOAD(P, kt + 3);
        GL_COMPUTE(1);
        if (kt + 2 < nk) GL_WRITE(Q, 0);
        __syncthreads();
    }
#undef GL_LOAD
#undef GL_WRITE
#undef GL_COMPUTE
}
template <int NI>
__device__ __forceinline__ void zero_acc(f32x4 (&acc)[4][NI]) {
#pragma unroll
    for (int mi = 0; mi < 4; ++mi)
#pragma unroll
        for (int ni = 0; ni < NI; ++ni) acc[mi][ni] = (f32x4){0.f, 0.f, 0.f, 0.f};
}
__device__ __forceinline__ void ident_rows(int (&arow)[4], int m0, int tid) {
#pragma unroll
    for (int i = 0; i < 4; ++i) arow[i] = m0 + (tid >> 3) + 64 * i;
}

namespace g8 {
constexpr int BM = 256, BK = 64, HALF = 128, HTB = HALF * BK * 2, STAGE_BYTES = 8 * HTB, NXCD = 8, WGM = 8;
__device__ __forceinline__ int lds_byte(int r, int c) { const int st = (r >> 4) * 2 + (c >> 5), rr = r & 15, cc = c & 31, ob = rr * 64 + cc * 2; return st * 1024 + (ob ^ (((ob >> 9) & 1) << 5)); }
__device__ __forceinline__ void stage_rc(int b, int& R, int& C) { const int st = b / 1024, sb = b % 1024, swz = sb ^ (((sb >> 9) & 1) << 5); R = (st >> 1) * 16 + swz / 64; C = (st & 1) * 32 + (swz % 64) / 2; }
__device__ __forceinline__ int perm32(int rho) { const int n = rho >> 4, i = rho & 15; return 8 * (i >> 2) + 4 * n + (i & 3); }

struct Unit { const char* A; const char* B; int pm, pn, e, cn; };
__device__ __forceinline__ int uni(int v) { return __builtin_amdgcn_readfirstlane(v); }

__device__ __forceinline__ bool static_tile(int i, int G, int c, int nM, int nN, int& pm, int& pn) {
    const int nwg = nM * nN;
    const long L = (long)i * G + c; if (L >= nwg) return false;
    int wgid = (int)L; { const int q = nwg / NXCD, r = nwg % NXCD, xcd = wgid % NXCD, off = wgid / NXCD; wgid = (xcd < r ? xcd * (q + 1) : r * (q + 1) + (xcd - r) * q) + off; }
    const int nig = WGM * nN, gid = wgid / nig, fm = gid * WGM, gsz = (nM - fm) < WGM ? (nM - fm) : WGM;
    pm = fm + ((wgid % nig) % gsz); pn = (wgid % nig) / gsz; return true;
}

template <class Epi, class Sched>
__device__ __forceinline__ void gemm8(LAS unsigned char* lds, const Sched& S, const Epi& E, int K, int tid) {
    const int wid = __builtin_amdgcn_readfirstlane(tid >> 6), lane = tid & 63, wr = wid >> 2, wc = wid & 3, fr = lane & 15, fq = lane >> 4;
    const int nt = K / BK;
    unsigned voffB[2];
#pragma unroll
    for (int i = 0; i < 2; ++i) { int R_, C_; stage_rc(tid * 16 + i * 8192, R_, C_); const int Rb = Epi::PERM ? ((R_ & ~31) + perm32(R_ & 31)) : R_;
        voffB[i] = (unsigned)(Rb * S.ldb + C_) * 2u; }
    const size_t kstep = (size_t)(BK * 2);
    const size_t hstepB = (size_t)HALF * S.ldb * 2;
    const unsigned ldsw = (unsigned)wid * 1024u;
    const int aoff = lds_byte(wr * 64 + fr, fq * 8), boff = lds_byte(wc * 32 + fr, fq * 8);
#define G8_SA(b, h) (((b) * 2 + (h)) * HTB)
#define G8_SB(b, h) ((4 + (b) * 2 + (h)) * HTB)
#define G8_STAGEB(bufoff, gbase) do { _Pragma("unroll") for (int _i = 0; _i < 2; ++_i) { unsigned _o = voffB[_i]; asm volatile("" : "+v"(_o)); \
        __builtin_amdgcn_global_load_lds((const unsigned*)((const char*)(gbase) + _o), (LAS unsigned*)(lds + (bufoff) + ldsw + _i * 8192), 16, 0, 0); } } while (0)
#define G8_STAGEA(bufoff, gbase, VA, h) do { _Pragma("unroll") for (int _i = 0; _i < 2; ++_i) { unsigned _o = (VA)[h][_i]; asm volatile("" : "+v"(_o)); \
        __builtin_amdgcn_global_load_lds((const unsigned*)((const char*)(gbase) + _o), (LAS unsigned*)(lds + (bufoff) + ldsw + _i * 8192), 16, 0, 0); } } while (0)
#define G8_LDA(dst, b, h) do { _Pragma("unroll") for (int m = 0; m < 4; ++m) _Pragma("unroll") for (int k = 0; k < 2; ++k) dst[m][k] = *(const LAS bf16x8*)(lds + G8_SA(b, h) + aoff + m * 2048 + k * 1024); } while (0)
#define G8_LDB(dst, b, h) do { _Pragma("unroll") for (int n = 0; n < 2; ++n) _Pragma("unroll") for (int k = 0; k < 2; ++k) dst[n][k] = *(const LAS bf16x8*)(lds + G8_SB(b, h) + boff + n * 2048 + k * 1024); } while (0)
#define G8_MMA(ai, bj, At, Bt) do { __builtin_amdgcn_s_setprio(1); _Pragma("unroll") for (int m = 0; m < 4; ++m) _Pragma("unroll") for (int n = 0; n < 2; ++n) _Pragma("unroll") for (int k = 0; k < 2; ++k) \
        acc[ai][bj][m][n] = __builtin_amdgcn_mfma_f32_16x16x32_bf16(Bt[n][k], At[m][k], acc[ai][bj][m][n], 0, 0, 0); __builtin_amdgcn_s_setprio(0); } while (0)
#define G8_WAIT_V(n) asm volatile("s_waitcnt vmcnt(" #n ")" ::: "memory")
#define G8_WAIT_L(n) asm volatile("s_waitcnt lgkmcnt(" #n ")" ::: "memory")
#define G8_BAR __builtin_amdgcn_s_barrier()
#define G8_SCHED __builtin_amdgcn_sched_barrier(0)
#define G8_VOFF(VA, U) do { _Pragma("unroll") for (int _i = 0; _i < 2; ++_i) { int _R, _C; stage_rc(tid * 16 + _i * 8192, _R, _C); _Pragma("unroll") for (int _h = 0; _h < 2; ++_h) { \
        int _row = _R + _h * HALF; if (Sched::GATHER) S.rows(U, _row, _row); VA[_h][_i] = (unsigned)(_row * S.lda + _C) * 2u; } } } while (0)
    Unit cur, nxt; int ui = 0;
    if (!S.next(0, cur)) return;
    typename Epi::Pre pre;
    E.preload(cur, pre, wr, wc, fr, fq);
    f32x4 acc[2][2][4][2];
#pragma unroll
    for (int a = 0; a < 2; ++a)
#pragma unroll
        for (int b = 0; b < 2; ++b)
#pragma unroll
            for (int m = 0; m < 4; ++m)
#pragma unroll
                for (int n = 0; n < 2; ++n) acc[a][b][m][n] = (f32x4){0.f, 0.f, 0.f, 0.f};
    bf16x8 At[4][2], B0[2][2], B1[2][2];
    unsigned cva[2][2], nva[2][2]; int nidx[2][2];
    G8_VOFF(cva, cur);
    const char* cA = cur.A; const char* cB = cur.B;
    G8_STAGEB(G8_SB(0, 0), cB); G8_STAGEA(G8_SA(0, 0), cA, cva, 0); G8_STAGEB(G8_SB(0, 1), cB + hstepB); G8_STAGEA(G8_SA(0, 1), cA, cva, 1);
    G8_STAGEB(G8_SB(1, 0), cB + kstep); G8_STAGEA(G8_SA(1, 0), cA + kstep, cva, 0); G8_STAGEB(G8_SB(1, 1), cB + hstepB + kstep);
    if (wr == 1) G8_BAR;
    G8_WAIT_V(10); G8_BAR;
    G8_WAIT_V(6); G8_BAR;
    for (;;) {
        const bool has_next = S.next(ui + 1, nxt);
        const char* nA = has_next ? nxt.A : cA; const char* nB = has_next ? nxt.B : cB;
        if constexpr (Sched::GATHER) {
            if (has_next) {
#pragma unroll
                for (int _i = 0; _i < 2; ++_i) { int _R, _C; stage_rc(tid * 16 + _i * 8192, _R, _C);
#pragma unroll
                    for (int _h = 0; _h < 2; ++_h) { int _row = _R + _h * HALF; S.rows(nxt, _row, _row); nidx[_h][_i] = _row; } }
            }
        }
        const int ntu = Sched::UNITK ? uni(cur.cn) : nt;
        for (int t = 0; t < ntu; t += 2) {
            const bool last = (t == ntu - 2);
            const char* a1 = cA + (size_t)(t + 1) * kstep;
            const char* a2 = last ? nA : cA + (size_t)(t + 2) * kstep; const char* b2 = last ? nB : cB + (size_t)(t + 2) * kstep;
            const char* a3 = a2 + kstep; const char* b3 = b2 + kstep;
            if constexpr (Sched::GATHER) {
                if (last && has_next) {
#pragma unroll
                    for (int _i = 0; _i < 2; ++_i) { int _R, _C; stage_rc(tid * 16 + _i * 8192, _R, _C);
#pragma unroll
                        for (int _h = 0; _h < 2; ++_h) nva[_h][_i] = (unsigned)(nidx[_h][_i] * S.lda + _C) * 2u; }
                }
            }
            const bool use_n = Sched::GATHER && last && has_next;
            G8_LDB(B0, 0, 0); G8_SCHED; G8_LDA(At, 0, 0); G8_STAGEA(G8_SA(1, 1), a1, cva, 1);
            G8_WAIT_L(8); G8_BAR; G8_WAIT_L(0); G8_MMA(0, 0, At, B0); G8_BAR; G8_SCHED;
            G8_LDB(B1, 0, 1); G8_STAGEB(G8_SB(0, 0), b2);
            G8_BAR; G8_WAIT_L(0); G8_MMA(0, 1, At, B1); G8_BAR;
            G8_LDA(At, 0, 1); if (use_n) { G8_STAGEA(G8_SA(0, 0), a2, nva, 0); } else { G8_STAGEA(G8_SA(0, 0), a2, cva, 0); }
            G8_BAR; G8_WAIT_L(0); G8_MMA(1, 0, At, B0); G8_BAR; G8_SCHED;
            G8_STAGEB(G8_SB(0, 1), b2 + hstepB);
            G8_WAIT_V(6); G8_BAR; G8_MMA(1, 1, At, B1); G8_BAR;
            G8_LDB(B0, 1, 0); G8_SCHED; G8_LDA(At, 1, 0); if (use_n) { G8_STAGEA(G8_SA(0, 1), a2, nva, 1); } else { G8_STAGEA(G8_SA(0, 1), a2, cva, 1); }
            G8_WAIT_L(8); G8_BAR; G8_WAIT_L(0); G8_MMA(0, 0, At, B0); G8_BAR; G8_SCHED;
            G8_LDB(B1, 1, 1); G8_STAGEB(G8_SB(1, 0), b3);
            G8_BAR; G8_WAIT_L(0); G8_MMA(0, 1, At, B1); G8_BAR;
            G8_LDA(At, 1, 1); if (use_n) { G8_STAGEA(G8_SA(1, 0), a3, nva, 0); } else { G8_STAGEA(G8_SA(1, 0), a3, cva, 0); }
            G8_BAR; G8_WAIT_L(0); G8_MMA(1, 0, At, B0); G8_BAR; G8_SCHED;
            G8_STAGEB(G8_SB(1, 1), b3 + hstepB);
            G8_WAIT_V(6); G8_BAR; G8_MMA(1, 1, At, B1); G8_BAR;
        }
        E(acc, cur, pre, wr, wc, fr, fq);
        if (!has_next) break;
#pragma unroll
        for (int a = 0; a < 2; ++a)
#pragma unroll
            for (int b = 0; b < 2; ++b)
#pragma unroll
                for (int m = 0; m < 4; ++m)
#pragma unroll
                    for (int n = 0; n < 2; ++n) acc[a][b][m][n] = (f32x4){0.f, 0.f, 0.f, 0.f};
        cur = nxt; cA = nA; cB = nB; ++ui;
        E.preload(cur, pre, wr, wc, fr, fq);
        if constexpr (Sched::GATHER) {
#pragma unroll
            for (int _h = 0; _h < 2; ++_h) { cva[_h][0] = nva[_h][0]; cva[_h][1] = nva[_h][1]; }
        }
    }
    G8_WAIT_V(0);
    if (wr == 0) G8_BAR;
    G8_BAR;
#undef G8_SA
#undef G8_SB
#undef G8_STAGEA
#undef G8_STAGEB
#undef G8_LDA
#undef G8_LDB
#undef G8_MMA
#undef G8_WAIT_V
#undef G8_WAIT_L
#undef G8_BAR
#undef G8_SCHED
#undef G8_VOFF
}
}

struct TJob { const float* src; bfu* dst; bfu* dst2; int K, N, lds, ldd, Kd, Nd, mode; };

__device__ __forceinline__ void tr_tile(const TJob& jb, int tk, int tn, char* smem, int tid) {
    float* tile = (float*)smem;
    const int k0 = tk * 64, n0 = tn * 64;
    __syncthreads();
#pragma unroll
    for (int i = 0; i < 8; ++i) {
        const int kk = (tid >> 6) + 8 * i, nn = tid & 63;
        const int k = k0 + kk, n = n0 + nn;
        int ns = n;
        if (jb.mode == 1) { const int G = n >> 5, hh = (n >> 4) & 1, ii = n & 15; ns = hh * 1024 + G * 16 + ii; }
        float v = 0.f;
        if (k < jb.K && n < jb.N) v = jb.src[(size_t)k * jb.lds + ns];
        tile[kk * 65 + nn] = v;
    }
    __syncthreads();
#pragma unroll
    for (int i = 0; i < 8; ++i) {
        const int nn = (tid >> 6) + 8 * i, kk = tid & 63;
        const float v = tile[kk * 65 + nn];
        const size_t o = (size_t)(n0 + nn) * jb.ldd + k0 + kk;
        const bfu hi = f2bf(v);
        if (jb.mode == 2) { if (n0 + nn < jb.N) { jb.dst[o] = hi; jb.dst[o + 1024] = hi; jb.dst2[o] = f2bf(v - bf2f(hi)); } }
        else jb.dst[o] = hi;
    }
}

__device__ __forceinline__ void tr_tile256(const float* __restrict__ src, int lds, bfu* __restrict__ dst, int ldd, int mode, int tk, int tn, char* smem, int tid) {
    float* tile = (float*)smem;
    const int k0 = tk * 64, n0 = tn * 256;
    __syncthreads();
    float4 v[8];
#pragma unroll
    for (int i = 0; i < 8; ++i) {
        const int kk = (tid >> 6) + 8 * i, c4 = (tid & 63) * 4;
        int ns = n0 + c4;
        if (mode == 1) { const int n = n0 + c4; ns = ((n >> 4) & 1) * 1024 + (n >> 5) * 16 + (n & 15); }
        v[i] = *(const float4*)(src + (size_t)(k0 + kk) * lds + ns);
    }
#pragma unroll
    for (int i = 0; i < 8; ++i) {
        const int kk = (tid >> 6) + 8 * i, c4 = (tid & 63) * 4;
        float* t = tile + kk * 257 + c4;
        t[0] = v[i].x; t[1] = v[i].y; t[2] = v[i].z; t[3] = v[i].w;
    }
    __syncthreads();
#pragma unroll
    for (int i = 0; i < 4; ++i) {
        const int nn = (tid >> 3) + 64 * i, k8 = (tid & 7) * 8;
        const float* t = tile + k8 * 257 + nn;
        uint4 p;
        p.x = pack2(t[0], t[257]); p.y = pack2(t[2 * 257], t[3 * 257]); p.z = pack2(t[4 * 257], t[5 * 257]); p.w = pack2(t[6 * 257], t[7 * 257]);
        *(uint4*)(dst + (size_t)(n0 + nn) * ldd + k0 + k8) = p;
    }
}

__device__ __forceinline__ void tr_tile256_ld(const float* src, int lds, int tk, int tn, int tid, float4 (&v)[8]) {
    const int k0 = tk * 64, n0 = tn * 256;
#pragma unroll
    for (int i = 0; i < 8; ++i) {
        const int kk = (tid >> 6) + 8 * i, c4 = (tid & 63) * 4;
        v[i] = *(const float4*)(src + (size_t)(k0 + kk) * lds + n0 + c4);
    }
}
__device__ __forceinline__ void tr_tile256_fin(const float4 (&v)[8], bfu* dst, int ldd, int tk, int tn, char* smem, int tid) {
    float* tile = (float*)smem;
    const int k0 = tk * 64, n0 = tn * 256;
    __syncthreads();
#pragma unroll
    for (int i = 0; i < 8; ++i) {
        const int kk = (tid >> 6) + 8 * i, c4 = (tid & 63) * 4;
        float* t = tile + kk * 257 + c4;
        t[0] = v[i].x; t[1] = v[i].y; t[2] = v[i].z; t[3] = v[i].w;
    }
    __syncthreads();
#pragma unroll
    for (int i = 0; i < 4; ++i) {
        const int nn = (tid >> 3) + 64 * i, k8 = (tid & 7) * 8;
        const float* t = tile + k8 * 257 + nn;
        uint4 p;
        p.x = pack2(t[0], t[257]); p.y = pack2(t[2 * 257], t[3 * 257]); p.z = pack2(t[4 * 257], t[5 * 257]); p.w = pack2(t[6 * 257], t[7 * 257]);
        *(uint4*)(dst + (size_t)(n0 + nn) * ldd + k0 + k8) = p;
    }
}
struct BigTile { const float* src; bfu* dst; int lds, ldd, tk, tn; };
__device__ __forceinline__ void big_tile(const Args& a, unsigned char* ws, int j, BigTile& b) {
    const int l = j / 640, r = j % 640;
    if (r < 480) { b.src = a.in[8] + (size_t)l * 1024 * 7680; b.lds = 7680; b.dst = (bfu*)(ws + WS_WINT) + (size_t)l * 8192 * 1024; b.ldd = 1024; b.tk = r / 30; b.tn = r % 30; }
    else if (r < 576) { const int r2 = r - 480, n = r2 >> 5, q = r2 & 31; b.src = a.in[25] + (size_t)(l * 3 + n) * 512 * 1024; b.lds = 1024; b.dst = (bfu*)(ws + WS_WBT) + (size_t)(l * 3 + n) * 1024 * 512; b.ldd = 512; b.tk = q >> 2; b.tn = q & 3; }
    else { const int r2 = r - 576; b.src = a.in[26] + (size_t)l * 1024 * 1024; b.lds = 1024; b.dst = (bfu*)(ws + WS_WOT) + (size_t)l * 1024 * 3072; b.ldd = 3072; b.tk = r2 >> 2; b.tn = r2 & 3; }
}

__device__ __forceinline__ void misc_job(const Args& a, int j, TJob& jb) {
    const int l = j / 16, q = j % 16;
    unsigned char* ws = wsp(a);
    jb.dst2 = nullptr; jb.mode = 0;
    bfu* wint = (bfu*)(ws + WS_WINT) + (size_t)l * 8192 * 1024;
    if (q == 0) { jb.src = a.in[8] + (size_t)l * 1024 * 7680; jb.K = 1024; jb.N = 7680; jb.lds = 7680; jb.dst = wint; jb.ldd = 1024; jb.Kd = 1024; jb.Nd = 7680; }
    else if (q <= 2) { const int d = q - 1; jb.src = a.in[13] + (size_t)(l * 2 + d) * 1024 * 64; jb.K = 1024; jb.N = 64; jb.lds = 64; jb.dst = wint + (size_t)(7680 + 64 * d) * 1024; jb.ldd = 1024; jb.Kd = 1024; jb.Nd = 64; }
    else if (q <= 4) { const int d = q - 3; jb.src = a.in[16] + (size_t)(l * 2 + d) * 1024 * 64; jb.K = 1024; jb.N = 64; jb.lds = 64; jb.dst = wint + (size_t)(7808 + 64 * d) * 1024; jb.ldd = 1024; jb.Kd = 1024; jb.Nd = 64; }
    else if (q == 5) { jb.src = a.in[18] + (size_t)l * 1024 * 160; jb.K = 1024; jb.N = 160; jb.lds = 160; jb.dst = wint + (size_t)7936 * 1024; jb.ldd = 1024; jb.Kd = 1024; jb.Nd = 256; }
    else if (q <= 7) { const int d = q - 6; jb.src = a.in[14] + (size_t)(l * 2 + d) * 64 * 512; jb.K = 64; jb.N = 512; jb.lds = 512; jb.dst = (bfu*)(ws + WS_S2T) + (size_t)l * 2560 * 512 + (size_t)(512 * d) * 512 + 64 * d; jb.ldd = 512; jb.Kd = 64; jb.Nd = 512; }
    else if (q <= 9) { const int d = q - 8; jb.src = a.in[17] + (size_t)(l * 2 + d) * 64 * 512; jb.K = 64; jb.N = 512; jb.lds = 512; jb.dst = (bfu*)(ws + WS_S2T) + (size_t)l * 2560 * 512 + (size_t)(1024 + 512 * d) * 512 + 128 + 64 * d; jb.ldd = 512; jb.Kd = 64; jb.Nd = 512; }
    else if (q == 10) { jb.src = a.in[19] + (size_t)l * 160 * 512; jb.K = 160; jb.N = 512; jb.lds = 512; jb.dst = (bfu*)(ws + WS_S2T) + (size_t)l * 2560 * 512 + (size_t)2048 * 512 + 256; jb.ldd = 512; jb.Kd = 192; jb.Nd = 512; }
    else if (q <= 13) { const int n = q - 11; jb.src = a.in[25] + (size_t)(l * 3 + n) * 512 * 1024; jb.K = 512; jb.N = 1024; jb.lds = 1024; jb.dst = (bfu*)(ws + WS_WBT) + (size_t)(l * 3 + n) * 1024 * 512; jb.ldd = 512; jb.Kd = 512; jb.Nd = 1024; }
    else if (q == 14) { jb.src = a.in[26] + (size_t)l * 1024 * 1024; jb.K = 1024; jb.N = 1024; jb.lds = 1024; jb.dst = (bfu*)(ws + WS_WOT) + (size_t)l * 1024 * 1024; jb.ldd = 1024; jb.Kd = 1024; jb.Nd = 1024; }
    else { jb.src = a.in[27] + (size_t)l * 1024 * 32; jb.K = 1024; jb.N = 32; jb.lds = 32; jb.dst = (bfu*)(ws + WS_RT) + (size_t)l * 256 * 2048; jb.dst2 = jb.dst + (size_t)128 * 2048; jb.ldd = 2048; jb.Kd = 1024; jb.Nd = 64; jb.mode = 2; }
}

__device__ __forceinline__ void phase_prep(const Args& a, char* smem, int tid, int bid, int nb) {
    unsigned char* ws = wsp(a);
    {
        int j = bid;
        BigTile cur, nxt; float4 v[8];
        if (j < 1280) { big_tile(a, ws, j, cur); tr_tile256_ld(cur.src, cur.lds, cur.tk, cur.tn, tid, v); }
        for (; j < 1280; j += nb) {
            float4 cv[8];
#pragma unroll
            for (int i = 0; i < 8; ++i) cv[i] = v[i];
            nxt = cur;
            if (j + nb < 1280) { big_tile(a, ws, j + nb, nxt); tr_tile256_ld(nxt.src, nxt.lds, nxt.tk, nxt.tn, tid, v); }
            tr_tile256_fin(cv, cur.dst, cur.ldd, cur.tk, cur.tn, smem, tid);
            cur = nxt;
        }
    }
    for (int i = bid * NTHREADS + tid; i < 2 * 2560 * 64; i += nb * NTHREADS) {
        const int chunk = i & 63, row = (i >> 6) % 2560;
        const int blk = row >> 9;
        const int c0 = (blk < 4) ? blk * 8 : 32, c1 = (blk < 4) ? c0 + 8 : 56;
        if (chunk < c0 || chunk >= c1) *(uint4*)((bfu*)(ws + WS_S2T) + (size_t)(i >> 6) * 512 + chunk * 8) = make_uint4(0u, 0u, 0u, 0u);
    }
    {
        int base = 0;
        for (int j = 0; j < 32; ++j) {
            TJob jb; misc_job(a, j, jb);
            const int q_ = j % 16;
            const bool fastdone = (q_ == 0) || (q_ >= 11 && q_ <= 15);
            const int tks = jb.Kd >> 6, tns = jb.Nd >> 6, nt = fastdone ? 0 : tks * tns;
            int first = ((bid - base) % nb + nb) % nb;
            for (int t = first; t < nt; t += nb) tr_tile(jb, t / tns, t % tns, smem, tid);
            base = (base + nt) % nb;
        }
    }
    __syncthreads();
    for (int it = bid; it < 192; it += nb) {
        const int l = it / 96, jb0 = (it % 96) * 64;
        float* sl = (float*)smem;
        float* red = (float*)(smem + 36864);
        __syncthreads();
        for (int i = tid; i < 9 * 1024; i += NTHREADS) {
            const int m = i >> 10, k = i & 1023;
            const float v = (m < 8) ? a.in[1][m * 1024 + k] : a.in[3][k];
            sl[i] = v / (1.0f + __expf(-v));
        }
        __syncthreads();
        const int kq = tid >> 4, jv = tid & 15;
        float acc[9][4];
#pragma unroll
        for (int m = 0; m < 9; ++m) { acc[m][0] = 0.f; acc[m][1] = 0.f; acc[m][2] = 0.f; acc[m][3] = 0.f; }
        const float* wm = a.in[4] + (size_t)l * 1024 * 6144 + jb0 + jv * 4;
        float4 wv[32];
#pragma unroll
        for (int kk = 0; kk < 32; ++kk) wv[kk] = *(const float4*)(wm + (size_t)(kq * 32 + kk) * 6144);
#pragma unroll
        for (int kk = 0; kk < 32; ++kk) {
            const int k = kq * 32 + kk;
            const float4 w = wv[kk];
#pragma unroll
            for (int m = 0; m < 9; ++m) {
                const float s = sl[m * 1024 + k];
                acc[m][0] += s * w.x; acc[m][1] += s * w.y; acc[m][2] += s * w.z; acc[m][3] += s * w.w;
            }
        }
#pragma unroll
        for (int m = 0; m < 9; ++m)
#pragma unroll
            for (int e = 0; e < 4; ++e) red[(kq * 9 + m) * 64 + jv * 4 + e] = acc[m][e];
        __syncthreads();
        for (int i = tid; i < 9 * 64; i += NTHREADS) {
            const int m = i >> 6, jj = i & 63;
            float s = 0.f;
#pragma unroll
            for (int q = 0; q < 32; ++q) s += red[(q * 9 + m) * 64 + jj];
            ((float*)(ws + WS_MOD))[(size_t)(l * 9 + m) * 6144 + jb0 + jj] = s + a.in[5][l * 6144 + jb0 + jj];
        }
    }
    if (bid == 0) {
        float* tab = (float*)(ws + WS_TAB);
        for (int i = tid; i < 1024; i += NTHREADS) {
            const int pos = i >> 4, j = i & 15;
            const float inv = exp2f(-(float)j * (13.287712379549449f / 16.0f));
            const double ang = (double)((float)pos * inv);
            double rev = ang * 0.15915494309189535;
            rev -= floor(rev);
            tab[i] = __builtin_amdgcn_cosf((float)rev);
            tab[1024 + i] = __builtin_amdgcn_sinf((float)rev);
        }
        if (tid < 2) {
            const float* lv = a.in[9] + tid * 256;
            float s1 = 0.f, s2 = 0.f;
            for (int i = 0; i < 64; ++i) { s1 += lv[i] * lv[64 + i]; s2 += lv[128 + i] * lv[192 + i]; }
            const float lam_init = (tid == 0) ? 0.2f : (0.8f - 0.6f * 0.7408182206817179f);
            tab[2048 + tid] = __expf(s1) - __expf(s2) + lam_init;
        }
    }
}

__device__ __forceinline__ void store_h_row(bfu* dst, const float (&y)[16], int lane) {
#pragma unroll
    for (int i = 0; i < 4; ++i) {
        uint2 p; p.x = pack2(y[i * 4 + 0], y[i * 4 + 1]); p.y = pack2(y[i * 4 + 2], y[i * 4 + 3]);
        *(uint2*)(dst + i * 256 + lane * 4) = p;
    }
}
__device__ __forceinline__ void norm_mod(const float (&v)[16], float (&y)[16], const float* g, const float* shift, const float* scale, int lane) {
    float ss = 0.f;
#pragma unroll
    for (int i = 0; i < 16; ++i) ss += v[i] * v[i];
    ss = wave_sum(ss);
    const float rs = rsqrtf(ss * (1.0f / 1024.0f) + 1e-6f);
#pragma unroll
    for (int i = 0; i < 4; ++i) {
        const int col = i * 256 + lane * 4;
        const float4 gg = *(const float4*)(g + col);
        const float4 sh = *(const float4*)(shift + col);
        const float4 sc = *(const float4*)(scale + col);
        y[i * 4 + 0] = v[i * 4 + 0] * rs * gg.x * (1.0f + sc.x) + sh.x;
        y[i * 4 + 1] = v[i * 4 + 1] * rs * gg.y * (1.0f + sc.y) + sh.y;
        y[i * 4 + 2] = v[i * 4 + 2] * rs * gg.z * (1.0f + sc.z) + sh.z;
        y[i * 4 + 3] = v[i * 4 + 3] * rs * gg.w * (1.0f + sc.w) + sh.w;
    }
}

__device__ __forceinline__ void phase_norm1_l0(const Args& a, int tid, int bid, int nb) {
    const int wave = tid >> 6, lane = tid & 63;
    bfu* xres = (bfu*)(wsp(a) + WS_XRES);
    bfu* H = (bfu*)(wsp(a) + WS_H);
    const float* mod = (const float*)(wsp(a) + WS_MOD);
    const int stride = nb * NW;
    int row = bid * NW + wave;
    float4 nx[4];
#define N1_LOAD(r_) do { const int b_ = (r_) / TB, t_ = (r_) % TB; \
        const float* src_ = (t_ < SEQ) ? (a.in[0] + ((size_t)b_ * SEQ + t_) * 1024) : (a.in[2] + ((size_t)b_ * CTX + (t_ - SEQ)) * 1024); \
        _Pragma("unroll") for (int i = 0; i < 4; ++i) nx[i] = *(const float4*)(src_ + i * 256 + lane * 4); } while (0)
    if (row < NT) N1_LOAD(row);
    for (; row < NT; row += stride) {
        const int b = row / TB, t = row % TB;
        const int m = (t < SEQ) ? b : 8;
        float v[16], y[16];
#pragma unroll
        for (int i = 0; i < 4; ++i) { v[i * 4 + 0] = nx[i].x; v[i * 4 + 1] = nx[i].y; v[i * 4 + 2] = nx[i].z; v[i * 4 + 3] = nx[i].w; }
        if (row + stride < NT) N1_LOAD(row + stride);
        const float* md = mod + (size_t)(0 * 9 + m) * 6144;
        norm_mod(v, y, a.in[6], md + 0, md + 1024, lane);
#pragma unroll
        for (int i = 0; i < 4; ++i) {
            uint2 p; p.x = pack2(v[i * 4 + 0], v[i * 4 + 1]); p.y = pack2(v[i * 4 + 2], v[i * 4 + 3]);
            *(uint2*)(xres + (size_t)row * 1024 + i * 256 + lane * 4) = p;
        }
        store_h_row(H + (size_t)row * 1024, y, lane);
    }
#undef N1_LOAD
}

__device__ __forceinline__ void phase_norm2(const Args& a, int l, int tid, int bid, int nb) {
    const int wave = tid >> 6, lane = tid & 63;
    const float* xres = (const float*)(wsp(a) + WS_XRES);
    bfu* HI = (bfu*)(wsp(a) + WS_H2HI);
    bfu* LO = (bfu*)(wsp(a) + WS_H2LO);
    const float* mod = (const float*)(wsp(a) + WS_MOD);
    for (int row = bid * NW + wave; row < NT; row += nb * NW) {
        const int b = row / TB, t = row % TB;
        if (l == 1 && t >= SEQ) continue;
        const int m = (t < SEQ) ? b : 8;
        float v[16], y[16], lo[16];
#pragma unroll
        for (int i = 0; i < 4; ++i) {
            const float4 x4 = *(const float4*)(xres + (size_t)row * 1024 + i * 256 + lane * 4);
            v[i * 4 + 0] = x4.x; v[i * 4 + 1] = x4.y; v[i * 4 + 2] = x4.z; v[i * 4 + 3] = x4.w;
        }
        const float* md = mod + (size_t)(l * 9 + m) * 6144;
        norm_mod(v, y, a.in[7] + l * 1024, md + 3 * 1024, md + 4 * 1024, lane);
#pragma unroll
        for (int i = 0; i < 16; ++i) lo[i] = y[i] - bf2f(f2bf(y[i]));
        store_h_row(HI + (size_t)row * 2048, y, lane);
        store_h_row(HI + (size_t)row * 2048 + 1024, lo, lane);
        store_h_row((bfu*)(wsp(a) + WS_H) + (size_t)row * 1024, y, lane);
    }
}

__device__ __forceinline__ void phase_combine(const Args& a, int l, int tid, int bid, int nb) {
    const int wave = tid >> 6, lane = tid & 63;
    bfu* xres = (bfu*)(wsp(a) + WS_XRES);
    const bfu* YB = (const bfu*)(wsp(a) + WS_YB);
    bfu* H = (bfu*)(wsp(a) + WS_H);
    const float* mod = (const float*)(wsp(a) + WS_MOD);
    const int stride = nb * NW;
    int row = bid * NW + wave;
    uint2 nx[4], ny[4][4];
#define CB_LOAD(r_) do { _Pragma("unroll") for (int i = 0; i < 4; ++i) { const int col = i * 256 + lane * 4; nx[i] = *(const uint2*)(xres + (size_t)(r_) * 1024 + col); \
            _Pragma("unroll") for (int k = 0; k < 4; ++k) ny[i][k] = *(const uint2*)(YB + ((size_t)(r_) * 4 + k) * 1024 + col); } } while (0)
    if (row < NT) CB_LOAD(row);
    for (; row < NT; row += stride) {
        const int b = row / TB, t = row % TB;
        uint2 cx[4], cy[4][4];
#pragma unroll
        for (int i = 0; i < 4; ++i) { cx[i] = nx[i];
#pragma unroll
            for (int k = 0; k < 4; ++k) cy[i][k] = ny[i][k]; }
        if (row + stride < NT) CB_LOAD(row + stride);
        if (l == 1 && t >= SEQ) continue;
        const int m = (t < SEQ) ? b : 8;
        const float* md = mod + (size_t)(l * 9 + m) * 6144;
        float v[16], y[16];
#pragma unroll
        for (int i = 0; i < 4; ++i) {
            const int col = i * 256 + lane * 4;
            const uint2 xp = cx[i];
            const float4 x4 = make_float4(bflo(xp.x), bfhi(xp.x), bflo(xp.y), bfhi(xp.y));
            float f0 = 0.f, f1 = 0.f, f2 = 0.f, f3 = 0.f;
#pragma unroll
            for (int k = 0; k < 4; ++k) {
                const uint2 p = cy[i][k];
                f0 += bflo(p.x); f1 += bfhi(p.x); f2 += bflo(p.y); f3 += bfhi(p.y);
            }
            const float4 gf = *(const float4*)(md + 5 * 1024 + col);
            v[i * 4 + 0] = x4.x + gf.x * f0; v[i * 4 + 1] = x4.y + gf.y * f1;
            v[i * 4 + 2] = x4.z + gf.z * f2; v[i * 4 + 3] = x4.w + gf.w * f3;
        }
        if (l == 0) {
            const float* md1 = mod + (size_t)(1 * 9 + m) * 6144;
            norm_mod(v, y, a.in[6] + 1024, md1 + 0, md1 + 1024, lane);
#pragma unroll
            for (int i = 0; i < 4; ++i)
                { uint2 p; p.x = pack2(v[i * 4], v[i * 4 + 1]); p.y = pack2(v[i * 4 + 2], v[i * 4 + 3]); *(uint2*)(xres + (size_t)row * 1024 + i * 256 + lane * 4) = p; }
            store_h_row(H + (size_t)row * 1024, y, lane);
        } else {
            float ss = 0.f;
#pragma unroll
            for (int i = 0; i < 16; ++i) ss += v[i] * v[i];
            ss = wave_sum(ss);
            const float rs = rsqrtf(ss * (1.0f / 1024.0f) + 1e-6f);
            float* o = a.out + ((size_t)b * SEQ + t) * 1024;
            float4 gg[4];
#pragma unroll
            for (int i = 0; i < 4; ++i) gg[i] = *(const float4*)(a.in[33] + i * 256 + lane * 4);
#pragma unroll
            for (int i = 0; i < 4; ++i) {
                const int col = i * 256 + lane * 4;
                *(float4*)(o + col) = make_float4(v[i * 4] * rs * gg[i].x, v[i * 4 + 1] * rs * gg[i].y, v[i * 4 + 2] * rs * gg[i].z, v[i * 4 + 3] * rs * gg[i].w);
            }
        }
    }
#undef CB_LOAD
}

__device__ __forceinline__ void phase_gemm_in(const Args& a, int l, char* smem, int tid, int bid, int nb) {
    unsigned char* ws = wsp(a);
    const bfu* H = (const bfu*)(ws + WS_H);
    const bfu* W = (const bfu*)(ws + WS_WINT) + (size_t)l * 8192 * 1024;
    const float* tab = (const float*)(ws + WS_TAB);
    const int wave = tid >> 6, lane = tid & 63, wm = wave >> 1, wn = wave & 1, g = lane >> 4, c = lane & 15;
    for (int it = bid; it < 72 * 64; it += nb) {
        const int mt = it >> 6, nt = it & 63;
        const int m0 = mt * 256, n0 = nt * 128;
        int arow[4]; ident_rows(arow, m0, tid);
        f32x4 acc[4][4]; zero_acc<4>(acc);
        gemm_loop<4>(acc, H, 1024, arow, W, 1024, n0, 1024, smem, tid);
        const int colbase = n0 + wn * 64;
        const int rowbase = m0 + wm * 64;
        if (nt < 8) {
            bfu* dst = (bfu*)(ws + (nt < 4 ? WS_Q : WS_K));
            const int cc = colbase & 511;
            const float qs = (nt < 4) ? 0.18033688011112042f : 1.0f;
#pragma unroll
            for (int mi = 0; mi < 4; ++mi)
#pragma unroll
                for (int r = 0; r < 4; ++r) {
                    const int row = rowbase + mi * 16 + g * 4 + r;
                    const int t = row % TB;
                    float x0 = acc[mi][0][r], x1 = acc[mi][1][r], x2 = acc[mi][2][r], x3 = acc[mi][3][r];
                    if (t < SEQ) {
                        const int pr = t >> 6, pc = t & 63;
                        const float cr = tab[pr * 16 + c], sr = tab[1024 + pr * 16 + c];
                        const float c2 = tab[pc * 16 + c], s2 = tab[1024 + pc * 16 + c];
                        const float y0 = x0 * cr - x1 * sr, y1 = x0 * sr + x1 * cr;
                        const float y2 = x2 * c2 - x3 * s2, y3 = x2 * s2 + x3 * c2;
                        x0 = y0; x1 = y1; x2 = y2; x3 = y3;
                    }
                    bfu* d = dst + (size_t)row * 512 + cc + c;
                    d[0] = f2bf(x0 * qs); d[16] = f2bf(x1 * qs); d[32] = f2bf(x2 * qs); d[48] = f2bf(x3 * qs);
                }
        } else if (nt < 12) {
            bfu* VT = (bfu*)(ws + WS_VT);
            const int b = m0 / TB;
            const int tb0 = (m0 % TB) + wm * 64;
#pragma unroll
            for (int ni = 0; ni < 4; ++ni) {
                const int cc = colbase - 1024 + ni * 16 + c;
                const int head = cc >> 7, dim = cc & 127;
                bfu* d = VT + ((size_t)(b * 4 + head) * 128 + dim) * TB;
#pragma unroll
                for (int mi = 0; mi < 4; ++mi) {
                    uint2 p; p.x = pack2(acc[mi][ni][0], acc[mi][ni][1]); p.y = pack2(acc[mi][ni][2], acc[mi][ni][3]);
                    *(uint2*)(d + tb0 + mi * 16 + g * 4) = p;
                }
            }
        } else if (nt < 36) {
            bfu* dst; int cc;
            if (nt < 24) { const int q = colbase - 1536; dst = (bfu*)(ws + WS_SB) + (size_t)(q >> 9) * NT * 512; cc = q & 511; }
            else if (nt < 28) { dst = (bfu*)(ws + WS_RR); cc = colbase - 3072; }
            else if (nt < 32) { dst = (bfu*)(ws + WS_RK); cc = colbase - 3584; }
            else { dst = (bfu*)(ws + WS_RV); cc = colbase - 4096; }
#pragma unroll
            for (int mi = 0; mi < 4; ++mi)
#pragma unroll
                for (int ni = 0; ni < 4; ++ni)
#pragma unroll
                    for (int r = 0; r < 4; ++r) {
                        const int row = rowbase + mi * 16 + g * 4 + r;
                        dst[(size_t)row * 512 + cc + ni * 16 + c] = f2bf(acc[mi][ni][r]);
                    }
            if (nt >= 28 && nt < 32) {
                bfu* KKB = (bfu*)(ws + WS_KKB);
                const float* kkw = a.in[20] + l * 512 + cc;
                float w4[4];
#pragma unroll
                for (int ni = 0; ni < 4; ++ni) w4[ni] = kkw[ni * 16 + c];
#pragma unroll
                for (int mi = 0; mi < 4; ++mi)
#pragma unroll
                    for (int r = 0; r < 4; ++r) {
                        float s = 0.f;
#pragma unroll
                        for (int ni = 0; ni < 4; ++ni) { const float q = acc[mi][ni][r] * w4[ni]; s += q * q; }
                        s = red16(s);
                        const float inv = rsqrtf(fmaxf(s, 1e-24f));
                        const int row = rowbase + mi * 16 + g * 4 + r;
#pragma unroll
                        for (int ni = 0; ni < 4; ++ni)
                            KKB[(size_t)row * 512 + cc + ni * 16 + c] = f2bf(acc[mi][ni][r] * w4[ni] * inv);
                    }
            }
        } else if (nt < 60) {
            bfu* GL = (bfu*)(ws + WS_GL);
            const int cc = colbase - 4608;
#pragma unroll
            for (int mi = 0; mi < 4; ++mi)
#pragma unroll
                for (int ni = 0; ni < 4; ++ni)
#pragma unroll
                    for (int r = 0; r < 4; ++r) {
                        const int row = rowbase + mi * 16 + g * 4 + r;
                        GL[(size_t)row * 3072 + cc + ni * 16 + c] = f2bf(sigmoidf_(acc[mi][ni][r]));
                    }
        } else {
            bfu* LO = (bfu*)(ws + WS_LORA);
            const int cc = colbase - 7680;
#pragma unroll
            for (int mi = 0; mi < 4; ++mi)
#pragma unroll
                for (int ni = 0; ni < 4; ++ni)
#pragma unroll
                    for (int r = 0; r < 4; ++r) {
                        const int row = rowbase + mi * 16 + g * 4 + r;
                        float v = acc[mi][ni][r];
                        if (nt == 60) v = tanhf_(v); else if (nt >= 62) v = sigmoidf_(v);
                        LO[(size_t)row * 512 + cc + ni * 16 + c] = f2bf(v);
                    }
        }
    }
}

struct SchedDense {
    static constexpr bool GATHER = false; static constexpr bool UNITK = false;
    const char* A; const char* B; int lda, ldb, nM, nN, G, c, skip9; int kpn = 1 << 30, kofs = 0;
    __device__ __forceinline__ bool next(int i, g8::Unit& u) const {
        int pm, pn; if (!g8::static_tile(i, G, c, nM, nN, pm, pn)) return false;
        if (skip9) pm += pm >> 3;
        pm = g8::uni(pm); pn = g8::uni(pn);
        u.pm = pm; u.pn = pn; u.e = 0; u.cn = 0;
        const int ko = (pn >= kpn) ? kofs * 2 : 0;
        u.A = A + (size_t)pm * 256 * lda * 2 + ko; u.B = B + (size_t)pn * 256 * ldb * 2 + ko; return true;
    }
    __device__ __forceinline__ void rows(const g8::Unit&, int, int&) const {}
};
__device__ __forceinline__ uint2 pack4(const f32x4& v) { uint2 p; p.x = pack2(v[0], v[1]); p.y = pack2(v[2], v[3]); return p; }

struct EpiIn {
    static constexpr bool PERM = true;
    unsigned char* ws; int l;
    struct Pre {};
    __device__ __forceinline__ void preload(const g8::Unit&, Pre&, int, int, int, int) const {}
    template <bool CR>
    __device__ __forceinline__ void qk_rot(const f32x4 (&acc)[2][2][4][2], bfu* dst, const float* tab, int row0, float qs, bool latent, float sgn, int fo, int fq) const {
#pragma unroll
        for (int hh = 0; hh < 2; ++hh) {
            f32x4 cs[2][2], sn[2][2];
#pragma unroll
            for (int q = 0; q < (CR ? 2 : 1); ++q) {
                const int rw = row0 + (CR ? (2 * hh + q) * 16 : hh * 128);
                const int t = rw % TB;
                const int pos = CR ? (t & 63) : ((t >> 6) & 31);
#pragma unroll
                for (int n = 0; n < 2; ++n) { cs[q][n] = *(const f32x4*)(tab + pos * 16 + fo + 4 * n); sn[q][n] = *(const f32x4*)(tab + 1024 + pos * 16 + fo + 4 * n); }
            }
#pragma unroll
            for (int i = 0; i < 4; ++i) {
                const int q = CR ? (i >> 1) : 0;
                const int ai = CR ? (i & 1) : hh, m = CR ? (2 * hh + (i >> 1)) : i;
                const int row = row0 + ai * 128 + m * 16;
#pragma unroll
                for (int bj = 0; bj < 2; ++bj) {
                    uint2 pk[2];
#pragma unroll
                    for (int n = 0; n < 2; ++n) {
                        f32x4 x = acc[ai][bj][m][n];
                        if (latent) {
                            f32x4 p;
#pragma unroll
                            for (int j = 0; j < 4; ++j) {
                                const auto sw = __builtin_amdgcn_permlane32_swap(__float_as_uint(x[j]), __float_as_uint(x[j]), false, false);
                                p[j] = __uint_as_float((fq < 2) ? sw[1] : sw[0]);
                            }
                            x = x * cs[q][n] + (p * sn[q][n]) * sgn;
                        }
                        pk[n] = pack4(x * qs);
                    }
                    *(uint4*)(dst + (size_t)row * 512 + bj * 128) = make_uint4(pk[0].x, pk[0].y, pk[1].x, pk[1].y);
                }
            }
        }
    }
    __device__ __forceinline__ void operator()(const f32x4 (&acc)[2][2][4][2], const g8::Unit& u, const Pre& pre, int wr, int wc, int fr, int fq) const {
        const int pn = u.pn;
        const int row0 = u.pm * 256 + wr * 64 + fr;
        const int colw = 32 * wc + 8 * fq;
        if (pn < 4) {
            bfu* dst = (bfu*)(ws + (pn < 2 ? WS_Q : WS_K)) + (pn & 1) * 256 + colw;
            const float* tab = (const float*)(ws + WS_TAB);
            const float qs = (pn < 2) ? 0.18033688011112042f : 1.0f;
            const bool colrot = (wc & 1) != 0;
            const bool latent = ((u.pm % 9) != 8);
            const float sgn = (fq < 2) ? -1.0f : 1.0f;
            const int fo = 8 * (fq & 1);
            if (colrot) qk_rot<true>(acc, dst, tab, row0, qs, latent, sgn, fo, fq); else qk_rot<false>(acc, dst, tab, row0, qs, latent, sgn, fo, fq);
        } else if (pn < 6) {
            bfu* VT = (bfu*)(ws + WS_VT);
            const int rbase = u.pm * 256;
            const int b = rbase / TB, t0 = (rbase % TB) + wr * 64 + fr;
#pragma unroll
            for (int bj = 0; bj < 2; ++bj)
#pragma unroll
                for (int n = 0; n < 2; ++n) {
                    const int cc = (pn - 4) * 256 + bj * 128 + colw + n * 4;
                    const int head = cc >> 7, dim = cc & 127;
                    bfu* d = VT + ((size_t)(b * 4 + head) * 128 + dim) * TB + t0;
#pragma unroll
                    for (int ai = 0; ai < 2; ++ai)
#pragma unroll
                        for (int m = 0; m < 4; ++m)
#pragma unroll
                            for (int j = 0; j < 4; ++j) d[(size_t)j * TB + ai * 128 + m * 16] = f2bf(acc[ai][bj][m][n][j]);
                }
        } else {
            bfu* dst; int ld, kind;
            if (pn < 18) { dst = (bfu*)(ws + WS_SB) + (size_t)((pn - 6) >> 1) * NT * 512 + ((pn - 6) & 1) * 256; ld = 512; kind = 0; }
            else if (pn < 30) { dst = (bfu*)(ws + WS_GL) + (pn - 18) * 256; ld = 3072; kind = 1; }
            else { dst = (bfu*)(ws + WS_LORA) + (pn - 30) * 256; ld = 512; kind = (pn == 31) ? 1 : 2; }
            dst += colw;
#pragma unroll
            for (int ai = 0; ai < 2; ++ai)
#pragma unroll
                for (int m = 0; m < 4; ++m) {
                    bfu* d = dst + (size_t)(row0 + ai * 128 + m * 16) * ld;
#pragma unroll
                    for (int bj = 0; bj < 2; ++bj) {
                        uint2 pk[2];
#pragma unroll
                        for (int n = 0; n < 2; ++n) {
                            f32x4 v = acc[ai][bj][m][n];
                            if (kind == 1) { v[0] = sigmoidf_(v[0]); v[1] = sigmoidf_(v[1]); v[2] = sigmoidf_(v[2]); v[3] = sigmoidf_(v[3]); }
                            else if (kind == 2 && bj == 0) { v[0] = tanhf_(v[0]); v[1] = tanhf_(v[1]); v[2] = tanhf_(v[2]); v[3] = tanhf_(v[3]); }
                            pk[n] = pack4(v);
                        }
                        *(uint4*)(d + bj * 128) = make_uint4(pk[0].x, pk[0].y, pk[1].x, pk[1].y);
                    }
                }
        }
    }
};

__device__ __forceinline__ void phase_gemm_in8(const Args& a, int l, char* smem, int tid, int bid, int nb) {
    SchedDense S;
    S.A = (const char*)(wsp(a) + WS_H); S.B = (const char*)(wsp(a) + WS_WINT) + (size_t)l * 8192 * 1024 * 2;
    S.lda = 1024; S.ldb = 1024; S.nM = 72; S.nN = 32; S.G = nb; S.c = bid; S.skip9 = 0;
    EpiIn E; E.ws = wsp(a); E.l = l;
    g8::gemm8(( LAS unsigned char*)smem, S, E, 1024, tid);
}

__device__ __forceinline__ int scan_tok(int d, int idx) {
    if (d == 0) return (idx < CTX) ? (SEQ + idx) : (idx - CTX);
    return (idx < CTX) ? (TB - 1 - idx) : (SEQ - 1 - (idx - CTX));
}
struct StepRaw { uint2 w, kk, b, ke, r; unsigned v; };

__device__ __forceinline__ void scan_item(const Args& a, int l, int item, int tid) {
    unsigned char* ws = wsp(a);
    const int wave = tid >> 6, lane = tid & 63;
    const int sub = item & 1, d = (item >> 1) & 1, h = (item >> 2) & 7, b = item >> 5;
    const int rg = sub * 8 + wave;
    const int i = rg * 4 + (lane >> 4), jg = lane & 15;
    const bfu* WD = (const bfu*)(ws + WS_WDEC) + (size_t)d * NT * 512 + h * 64 + jg * 4;
    const bfu* KK = (const bfu*)(ws + WS_KKB) + h * 64 + jg * 4;
    const bfu* BV = (const bfu*)(ws + WS_BV) + (size_t)d * NT * 512 + h * 64 + jg * 4;
    const bfu* KE = (const bfu*)(ws + WS_KE) + (size_t)d * NT * 512 + h * 64 + jg * 4;
    const bfu* RR = (const bfu*)(ws + WS_RR) + h * 64 + jg * 4;
    const bfu* RV = (const bfu*)(ws + WS_RV) + h * 64 + i;
    float* Y = (float*)(ws + WS_Y) + (size_t)d * NT * 512 + h * 64 + i;
    const size_t rb = (size_t)b * TB;
    float s0 = 0.f, s1 = 0.f, s2 = 0.f, s3 = 0.f;
    constexpr int U = 4;
    StepRaw nx[U];
#pragma unroll
    for (int u = 0; u < U; ++u) {
        const size_t o = (rb + scan_tok(d, u)) * 512;
        nx[u].w = *(const uint2*)(WD + o); nx[u].kk = *(const uint2*)(KK + o); nx[u].b = *(const uint2*)(BV + o);
        nx[u].ke = *(const uint2*)(KE + o); nx[u].r = *(const uint2*)(RR + o); nx[u].v = RV[o];
    }
    for (int base = 0; base < TB; base += U) {
        StepRaw cu[U];
#pragma unroll
        for (int u = 0; u < U; ++u) cu[u] = nx[u];
        if (base + U < TB) {
#pragma unroll
            for (int u = 0; u < U; ++u) {
                const size_t o = (rb + scan_tok(d, base + U + u)) * 512;
                nx[u].w = *(const uint2*)(WD + o); nx[u].kk = *(const uint2*)(KK + o); nx[u].b = *(const uint2*)(BV + o);
                nx[u].ke = *(const uint2*)(KE + o); nx[u].r = *(const uint2*)(RR + o); nx[u].v = RV[o];
            }
        }
#pragma unroll
        for (int u = 0; u < U; ++u) {
            const float k0 = bflo(cu[u].kk.x), k1 = bfhi(cu[u].kk.x), k2 = bflo(cu[u].kk.y), k3 = bfhi(cu[u].kk.y);
            float sk = s0 * k0 + s1 * k1 + s2 * k2 + s3 * k3;
            sk = red16(sk);
            const float v = bf2f((bfu)cu[u].v);
            s0 = s0 * bflo(cu[u].w.x) + (v * bflo(cu[u].ke.x) - sk * (k0 * bflo(cu[u].b.x)));
            s1 = s1 * bfhi(cu[u].w.x) + (v * bfhi(cu[u].ke.x) - sk * (k1 * bfhi(cu[u].b.x)));
            s2 = s2 * bflo(cu[u].w.y) + (v * bflo(cu[u].ke.y) - sk * (k2 * bflo(cu[u].b.y)));
            s3 = s3 * bfhi(cu[u].w.y) + (v * bfhi(cu[u].ke.y) - sk * (k3 * bfhi(cu[u].b.y)));
            float y = s0 * bflo(cu[u].r.x) + s1 * bfhi(cu[u].r.x) + s2 * bflo(cu[u].r.y) + s3 * bfhi(cu[u].r.y);
            y = red16(y);
            const int tt = scan_tok(d, base + u);
            if (jg == 0 && (l == 0 || tt < SEQ)) Y[(rb + tt) * 512] = y;
        }
    }
}

__device__ __forceinline__ void cvt_expert_tile(const Args& a, unsigned char* ws, int l, int t, int sub, int lane) {
    const int e = t / 768, r = t % 768;
    const float* src; bfu* dst; int lds, tk, tn; bool w1;
    if (r < 512) { w1 = true; src = a.in[29] + (size_t)(l * 32 + e) * 1024 * 2048; lds = 2048; dst = (bfu*)(ws + WS_W1T) + (size_t)(l * 32 + e) * 2048 * 1024; tk = r >> 5; tn = r & 31; }
    else { const int r2 = r - 512; w1 = false; src = a.in[31] + (size_t)(l * 32 + e) * 1024 * 1024; lds = 1024; dst = (bfu*)(ws + WS_W2ET) + (size_t)(l * 32 + e) * 1024 * 1024; tk = r2 >> 4; tn = r2 & 15; }
    const int kq = lane >> 4, n4 = lane & 15;
    const int nd = tn * 64 + n4 * 4;
    const int ns = w1 ? (((nd >> 7) & 1) * 1024 + (nd >> 8) * 128 + (nd & 127)) : nd;
    const float* sp = src + (size_t)(tk * 64 + sub * 32 + kq * 8) * lds + ns;
    float4 v[8];
#pragma unroll
    for (int i = 0; i < 8; ++i) v[i] = *(const float4*)(sp + (size_t)i * lds);
    bfu* dp = dst + (size_t)nd * 1024 + tk * 64 + sub * 32 + kq * 8;
#pragma unroll
    for (int c = 0; c < 4; ++c) {
        uint4 p0;
#define CV_(i) (c == 0 ? v[i].x : c == 1 ? v[i].y : c == 2 ? v[i].z : v[i].w)
        p0.x = pack2(CV_(0), CV_(1)); p0.y = pack2(CV_(2), CV_(3)); p0.z = pack2(CV_(4), CV_(5)); p0.w = pack2(CV_(6), CV_(7));
#undef CV_
        *(uint4*)(dp + (size_t)c * 1024) = p0;
    }
}

__device__ __forceinline__ void cvt_slab_ld(const Args& a, unsigned char* ws, int l, int t, int lane, float4 (&v)[16], bfu*& dp) {
    const int e = t / 768, r = t % 768;
    const float* src; bfu* dst; int lds, tk, tn; bool w1;
    if (r < 512) { w1 = true; src = a.in[29] + (size_t)(l * 32 + e) * 1024 * 2048; lds = 2048; dst = (bfu*)(ws + WS_W1T) + (size_t)(l * 32 + e) * 2048 * 1024; tk = r >> 5; tn = r & 31; }
    else { const int r2 = r - 512; w1 = false; src = a.in[31] + (size_t)(l * 32 + e) * 1024 * 1024; lds = 1024; dst = (bfu*)(ws + WS_W2ET) + (size_t)(l * 32 + e) * 1024 * 1024; tk = r2 >> 4; tn = r2 & 15; }
    const int kq = lane >> 4, n4 = lane & 15;
    const int nd = tn * 64 + n4 * 4;
    const int ns = w1 ? (((nd >> 7) & 1) * 1024 + (nd >> 8) * 128 + (nd & 127)) : nd;
    const float* sp = src + (size_t)(tk * 64 + kq * 8) * lds + ns;
#pragma unroll
    for (int sub = 0; sub < 2; ++sub)
#pragma unroll
        for (int i = 0; i < 8; ++i) v[sub * 8 + i] = *(const float4*)(sp + (size_t)(sub * 32 + i) * lds);
    dp = dst + (size_t)nd * 1024 + tk * 64 + kq * 8;
}
__device__ __forceinline__ void cvt_slab_st(const float4 (&v)[16], bfu* dp) {
#pragma unroll
    for (int sub = 0; sub < 2; ++sub)
#pragma unroll
        for (int c = 0; c < 4; ++c) {
            uint4 p0;
#define CV_(i) (c == 0 ? v[sub * 8 + i].x : c == 1 ? v[sub * 8 + i].y : c == 2 ? v[sub * 8 + i].z : v[sub * 8 + i].w)
            p0.x = pack2(CV_(0), CV_(1)); p0.y = pack2(CV_(2), CV_(3)); p0.z = pack2(CV_(4), CV_(5)); p0.w = pack2(CV_(6), CV_(7));
#undef CV_
            *(uint4*)(dp + (size_t)c * 1024 + sub * 32) = p0;
        }
}

constexpr int SC_CH = 32;
constexpr int SC_STEP = 5 * 64 + 4;
constexpr int SC_BUF = SC_CH * (SC_STEP + 32) * 4;
struct ScanStep { f32x4 w[2], kq[4], b[2], e[2]; float br, kr, v; };
__device__ __forceinline__ void scan_item2(const Args& a, int l, int item, char* smem, int tid) {
    unsigned char* ws = wsp(a);
    const int wave = tid >> 6, lane = tid & 63;
    const int half = item & 1, d = (item >> 1) & 1, h = (item >> 2) & 7, b = item >> 5;
    const int rloc = (wave & 3) * 8 + (lane >> 3), jg = lane & 7;
    const int ss = tid >> 4, sj = tid & 15;
    const bfu* WD = (const bfu*)(ws + WS_WDEC) + (size_t)d * NT * 512 + h * 64 + sj * 4;
    const bfu* AV = (const bfu*)(ws + WS_BV) + (size_t)d * NT * 512 + h * 64 + sj * 4;
    const bfu* RK = (const bfu*)(ws + WS_RK) + h * 64 + sj * 4;
    const bfu* RR = (const bfu*)(ws + WS_RR) + h * 64 + sj * 4;
    const bfu* RV = (const bfu*)(ws + WS_RV) + h * 64 + half * 32 + sj * 2;
    float* Y = (float*)(ws + WS_Y) + (size_t)d * NT * 512 + h * 64 + half * 32 + sj * 2;
    const f32x4 kkw = *(const f32x4*)(a.in[20] + l * 512 + h * 64 + sj * 4);
    const f32x4 kaw = *(const f32x4*)(a.in[21] + l * 512 + h * 64 + sj * 4);
    const size_t rb = (size_t)b * TB;
    float* ybuf0 = (float*)(smem + 2 * SC_BUF);
    uint2 rw, rk, ra, rr; unsigned rv;
#define SC_LOAD(chunk) do { const size_t _o = (rb + scan_tok(d, (chunk) * SC_CH + ss)) * 512; \
        rw = *(const uint2*)(WD + _o); rk = *(const uint2*)(RK + _o); ra = *(const uint2*)(AV + _o); rr = *(const uint2*)(RR + _o); rv = *(const unsigned*)(RV + _o); } while (0)
#define SC_WRITE(bufp) do { float* _b = (float*)(bufp) + ss * SC_STEP + sj * 4; \
        const f32x4 _k = {bflo(rk.x), bfhi(rk.x), bflo(rk.y), bfhi(rk.y)}; const f32x4 _a = {bflo(ra.x), bfhi(ra.x), bflo(ra.y), bfhi(ra.y)}; \
        const f32x4 _w = {bflo(rw.x), bfhi(rw.x), bflo(rw.y), bfhi(rw.y)}; const f32x4 _r = {bflo(rr.x), bfhi(rr.x), bflo(rr.y), bfhi(rr.y)}; \
        f32x4 _q = _k * kkw; float _s = _q[0] * _q[0] + _q[1] * _q[1] + _q[2] * _q[2] + _q[3] * _q[3]; _s = red16(_s); \
        _q *= rsqrtf(fmaxf(_s, 1e-24f)); \
        const f32x4 _bb = _q * _a; const f32x4 _ke = _k * (1.0f + (_a - 1.0f) * kaw); \
        float _br = _bb[0] * _r[0] + _bb[1] * _r[1] + _bb[2] * _r[2] + _bb[3] * _r[3]; _br = red16(_br); \
        float _kr = _ke[0] * _r[0] + _ke[1] * _r[1] + _ke[2] * _r[2] + _ke[3] * _r[3]; _kr = red16(_kr); \
        const f32x4 _wr = _w * _r; float* _kq = (float*)(bufp) + ss * SC_STEP + 64 + sj * 8; \
        *(f32x4*)(_b) = _w; *(f32x4*)(_kq) = (f32x4){_q[0], _wr[0], _q[1], _wr[1]}; *(f32x4*)(_kq + 4) = (f32x4){_q[2], _wr[2], _q[3], _wr[3]}; \
        *(f32x4*)(_b + 192) = _bb; *(f32x4*)(_b + 256) = _ke; \
        if (sj == 0) { float* _sc = (float*)(bufp) + ss * SC_STEP + 320; _sc[0] = _br; _sc[1] = _kr; } \
        float* _v = (float*)(bufp) + SC_CH * SC_STEP + ss * 32 + sj * 2; _v[0] = bflo(rv); _v[1] = bfhi(rv); } while (0)
#define SC_FETCH(dst, st) do { const float* _p = vec + (st) * SC_STEP; \
        dst.w[0] = *(const f32x4*)(_p); dst.w[1] = *(const f32x4*)(_p + 4); \
        dst.kq[0] = *(const f32x4*)(_p + 64 + jg * 8); dst.kq[1] = *(const f32x4*)(_p + 68 + jg * 8); dst.kq[2] = *(const f32x4*)(_p + 72 + jg * 8); dst.kq[3] = *(const f32x4*)(_p + 76 + jg * 8); \
        dst.b[0] = *(const f32x4*)(_p + 192); dst.b[1] = *(const f32x4*)(_p + 196); dst.e[0] = *(const f32x4*)(_p + 256); dst.e[1] = *(const f32x4*)(_p + 260); \
        const float2 _s2 = *(const float2*)(_p + 320 - jg * 8); dst.br = _s2.x; dst.kr = _s2.y; dst.v = vv[(st) * 32]; } while (0)
#define SC_BODY(cu, st) do { \
        f32x2_t d2 = {0.f, 0.f};                           \
        d2 += (f32x2_t){sA[0], sA[0]} * (f32x2_t){cu.kq[0][0], cu.kq[0][1]}; d2 += (f32x2_t){sA[1], sA[1]} * (f32x2_t){cu.kq[0][2], cu.kq[0][3]}; \
        d2 += (f32x2_t){sA[2], sA[2]} * (f32x2_t){cu.kq[1][0], cu.kq[1][1]}; d2 += (f32x2_t){sA[3], sA[3]} * (f32x2_t){cu.kq[1][2], cu.kq[1][3]}; \
        d2 += (f32x2_t){sB[0], sB[0]} * (f32x2_t){cu.kq[2][0], cu.kq[2][1]}; d2 += (f32x2_t){sB[1], sB[1]} * (f32x2_t){cu.kq[2][2], cu.kq[2][3]}; \
        d2 += (f32x2_t){sB[2], sB[2]} * (f32x2_t){cu.kq[3][0], cu.kq[3][1]}; d2 += (f32x2_t){sB[3], sB[3]} * (f32x2_t){cu.kq[3][2], cu.kq[3][3]}; \
        float sk = d2[0], z = d2[1]; \
        sk += dppf<0xB1>(sk); z += dppf<0xB1>(z); \
        sk += dppf<0x4E>(sk); z += dppf<0x4E>(z); \
        sk += dppf<0x141>(sk); z += dppf<0x141>(z); \
        sA = sA * cu.w[0] + (cu.e[0] * cu.v - cu.b[0] * sk); \
        sB = sB * cu.w[1] + (cu.e[1] * cu.v - cu.b[1] * sk); \
        const float _y = z - sk * cu.br + cu.v * cu.kr; \
        yq[(st) >> 3] = (jg == ((st) & 7)) ? _y : yq[(st) >> 3]; } while (0)
    __syncthreads();
    SC_LOAD(0);
    SC_WRITE(smem);
    __syncthreads();
    f32x4 sA = {0.f, 0.f, 0.f, 0.f}, sB = {0.f, 0.f, 0.f, 0.f};
    constexpr int NCH = TB / SC_CH;
    for (int ch = 0; ch < NCH; ++ch) {
        const char* cur = smem + (ch & 1) * SC_BUF;
        float* ybuf = ybuf0 + (ch & 1) * SC_CH * 32;
        if (ch + 1 < NCH) SC_LOAD(ch + 1);
        if (wave >= 4) {
            { const int c2 = (ch + (item % 3)) % NCH, pos = c2 % 3;
              if (pos != 0) cvt_expert_tile(a, ws, l, (item * 4 + (wave - 4)) + 1024 * (c2 / 3), pos - 1, lane); }
        } else {
            const float* vec = (const float*)cur + jg * 8;
            const float* vv = (const float*)cur + SC_CH * SC_STEP + rloc;
            float yq[4] = {0.f, 0.f, 0.f, 0.f};
            ScanStep c0, c1, c2;
            SC_FETCH(c0, 0);
            SC_FETCH(c1, 1);
#pragma unroll
            for (int st = 0; st < SC_CH; st += 3) {
                if (st + 2 < SC_CH) SC_FETCH(c2, st + 2);
                SC_BODY(c0, st);
                if (st + 1 < SC_CH) {
                    if (st + 3 < SC_CH) SC_FETCH(c0, st + 3);
                    SC_BODY(c1, st + 1);
                }
                if (st + 2 < SC_CH) {
                    if (st + 4 < SC_CH) SC_FETCH(c1, st + 4);
                    SC_BODY(c2, st + 2);
                }
            }
#pragma unroll
            for (int o = 0; o < 4; ++o) ybuf[(o * 8 + jg) * 32 + rloc] = yq[o];
        }
        if (ch + 1 < NCH) SC_WRITE(smem + ((ch + 1) & 1) * SC_BUF);
        __syncthreads();
        const int tok = scan_tok(d, ch * SC_CH + ss);
        const float2 yy = *(const float2*)(ybuf + ss * 32 + sj * 2);
        if (l == 0 || tok < SEQ) *(float2*)(Y + (rb + tok) * 512) = yy;
    }
#undef SC_LOAD
#undef SC_WRITE
#undef SC_FETCH
#undef SC_BODY
}

constexpr int KROW = 272;
constexpr int VROW = 144;
__device__ __forceinline__ void attn_item(const Args& a, int l, int item, char* smem, int tid) {
    unsigned char* ws = wsp(a);
    const int wave = tid >> 6, lane = tid & 63, g = lane >> 4, c = lane & 15;
    int b, head, r0, kt0;
    if (item < 512) { b = item >> 6; head = (item >> 4) & 3; r0 = b * TB + (item & 15) * 128; kt0 = 0; }
    else { const int j = item - 512; b = j >> 3; head = (j >> 1) & 3; r0 = b * TB + SEQ + (j & 1) * 128; kt0 = 32; }
    const bfu* Q = (const bfu*)(ws + WS_Q);
    const bfu* Kp = (const bfu*)(ws + WS_K) + (size_t)b * TB * 512 + head * 128;
    const bfu* Vp = (const bfu*)(ws + WS_VT) + (size_t)(b * 4 + head) * 128 * TB;
    char* Ks = smem;
    char* Vs = smem + 64 * KROW;
    const int qrow = r0 + wave * 16 + c;
    bf16x8 q1[2], q2[2];
#pragma unroll
    for (int ks = 0; ks < 2; ++ks) {
        q1[ks] = *(const bf16x8*)(Q + (size_t)qrow * 512 + head * 128 + ks * 32 + g * 8);
        q2[ks] = *(const bf16x8*)(Q + (size_t)qrow * 512 + head * 128 + 64 + ks * 32 + g * 8);
    }
    float m1 = -1e30f, m2 = -1e30f, l1 = 0.f, l2 = 0.f;
    f32x4 o1[8], o2[8];
#pragma unroll
    for (int mt = 0; mt < 8; ++mt) { o1[mt] = (f32x4){0.f, 0.f, 0.f, 0.f}; o2[mt] = (f32x4){0.f, 0.f, 0.f, 0.f}; }
    for (int kt = kt0; kt < 36; ++kt) {
        __syncthreads();
#pragma unroll
        for (int i = 0; i < 2; ++i) {
            const int key = (tid >> 4) + 32 * i, ch = tid & 15;
            *(uint4*)(Ks + key * KROW + ch * 16) = *(const uint4*)(Kp + (size_t)(kt * 64 + key) * 512 + ch * 8);
            const int dim = (tid >> 3) + 64 * i, cv = tid & 7;
            *(uint4*)(Vs + dim * VROW + cv * 16) = *(const uint4*)(Vp + (size_t)dim * TB + kt * 64 + cv * 8);
        }
        __syncthreads();
        f32x4 s1[4], s2[4];
#pragma unroll
        for (int kq = 0; kq < 4; ++kq) {
            s1[kq] = (f32x4){0.f, 0.f, 0.f, 0.f}; s2[kq] = (f32x4){0.f, 0.f, 0.f, 0.f};
#pragma unroll
            for (int ks = 0; ks < 2; ++ks) {
                const bf16x8 a1 = *(const bf16x8*)(Ks + (kq * 16 + c) * KROW + ks * 64 + g * 16);
                const bf16x8 a2 = *(const bf16x8*)(Ks + (kq * 16 + c) * KROW + 128 + ks * 64 + g * 16);
                s1[kq] = __builtin_amdgcn_mfma_f32_16x16x32_bf16(a1, q1[ks], s1[kq], 0, 0, 0);
                s2[kq] = __builtin_amdgcn_mfma_f32_16x16x32_bf16(a2, q2[ks], s2[kq], 0, 0, 0);
            }
        }
        float mx1 = s1[0][0], mx2 = s2[0][0];
#pragma unroll
        for (int kq = 0; kq < 4; ++kq)
#pragma unroll
            for (int r = 0; r < 4; ++r) { mx1 = fmaxf(mx1, s1[kq][r]); mx2 = fmaxf(mx2, s2[kq][r]); }
        mx1 = fmaxf(mx1, shx_(mx1, 16)); mx1 = fmaxf(mx1, shx_(mx1, 32));
        mx2 = fmaxf(mx2, shx_(mx2, 16)); mx2 = fmaxf(mx2, shx_(mx2, 32));
        const float mn1 = fmaxf(m1, mx1), mn2 = fmaxf(m2, mx2);
        const float al1 = exp2f(m1 - mn1), al2 = exp2f(m2 - mn2);
        m1 = mn1; m2 = mn2;
        float ps1 = 0.f, ps2 = 0.f;
        bf16x8 pb1[2], pb2[2];
#pragma unroll
        for (int kk = 0; kk < 2; ++kk) {
            float p[8], q[8];
#pragma unroll
            for (int e = 0; e < 4; ++e) {
                p[e] = exp2f(s1[2 * kk][e] - mn1); p[4 + e] = exp2f(s1[2 * kk + 1][e] - mn1);
                q[e] = exp2f(s2[2 * kk][e] - mn2); q[4 + e] = exp2f(s2[2 * kk + 1][e] - mn2);
            }
#pragma unroll
            for (int e = 0; e < 8; ++e) { ps1 += p[e]; ps2 += q[e]; pb1[kk][e] = (short)f2bf(p[e]); pb2[kk][e] = (short)f2bf(q[e]); }
        }
        l1 = l1 * al1 + ps1; l2 = l2 * al2 + ps2;
#pragma unroll
        for (int mt = 0; mt < 8; ++mt) {
            o1[mt] *= al1; o2[mt] *= al2;
#pragma unroll
            for (int kk = 0; kk < 2; ++kk) {
                const uint2 v0 = *(const uint2*)(Vs + (mt * 16 + c) * VROW + (kk * 32 + g * 4) * 2);
                const uint2 v1 = *(const uint2*)(Vs + (mt * 16 + c) * VROW + (kk * 32 + 16 + g * 4) * 2);
                union { uint4 u; bf16x8 v; } av; av.u = make_uint4(v0.x, v0.y, v1.x, v1.y);
                o1[mt] = __builtin_amdgcn_mfma_f32_16x16x32_bf16(av.v, pb1[kk], o1[mt], 0, 0, 0);
                o2[mt] = __builtin_amdgcn_mfma_f32_16x16x32_bf16(av.v, pb2[kk], o2[mt], 0, 0, 0);
            }
        }
    }
    l1 += shx_(l1, 16); l1 += shx_(l1, 32);
    l2 += shx_(l2, 16); l2 += shx_(l2, 32);
    const float lam = ((const float*)(ws + WS_TAB))[2048 + l];
    const float lam_init = (l == 0) ? 0.2f : (0.8f - 0.6f * 0.7408182206817179f);
    const float i1 = 1.0f / l1, i2 = lam / l2;
    float ss = 0.f;
#pragma unroll
    for (int mt = 0; mt < 8; ++mt)
#pragma unroll
        for (int r = 0; r < 4; ++r) { const float v = o1[mt][r] * i1 - o2[mt][r] * i2; o1[mt][r] = v; ss += v * v; }
    ss += shx_(ss, 16); ss += shx_(ss, 32);
    const float rs = rsqrtf(ss * (1.0f / 128.0f) + 1e-5f) * (1.0f - lam_init);
    bfu* ODA = (bfu*)(ws + WS_ODA);
    const float* sg = a.in[10] + l * 128;
#pragma unroll
    for (int mt = 0; mt < 8; ++mt) {
        const int dim = mt * 16 + g * 4;
        const float4 gg = *(const float4*)(sg + dim);
        uint2 p; p.x = pack2(o1[mt][0] * rs * gg.x, o1[mt][1] * rs * gg.y); p.y = pack2(o1[mt][2] * rs * gg.z, o1[mt][3] * rs * gg.w);
        *(uint2*)(ODA + (size_t)qrow * 512 + head * 128 + dim) = p;
    }
}

struct SlabAddr { const float* src; bfu* dst; int lds; };
__device__ __forceinline__ void slab_addr(const Args& a, unsigned char* ws, int l, int sid, int tid, SlabAddr& A) {
    const int e = sid / 768, r = sid % 768;
    const int n = tid & 63, kq = tid >> 6;
    if (r < 512) {
        const int tk = r >> 5, tn = r & 31, nd = tn * 64 + n;
        const int ns = ((nd >> 7) & 1) * 1024 + (nd >> 8) * 128 + (nd & 127);
        A.lds = 2048; A.src = a.in[29] + (size_t)(l * 32 + e) * 1024 * 2048 + (size_t)(tk * 64 + kq * 8) * 2048 + ns;
        A.dst = (bfu*)(ws + WS_W1T) + (size_t)(l * 32 + e) * 2048 * 1024 + (size_t)nd * 1024 + tk * 64 + kq * 8;
    } else {
        const int r2 = r - 512, tk = r2 >> 4, tn = r2 & 15, nd = tn * 64 + n;
        A.lds = 1024; A.src = a.in[31] + (size_t)(l * 32 + e) * 1024 * 1024 + (size_t)(tk * 64 + kq * 8) * 1024 + nd;
        A.dst = (bfu*)(ws + WS_W2ET) + (size_t)(l * 32 + e) * 1024 * 1024 + (size_t)nd * 1024 + tk * 64 + kq * 8;
    }
}

constexpr int AT_BUF = 64 * KROW + 128 * VROW;
__device__ __forceinline__ void attn_item2(const Args& a, int l, int item, char* smem, int tid) {
    unsigned char* ws = wsp(a);
    const int wave = tid >> 6, lane = tid & 63, g = lane >> 4, c = lane & 15;
    int b, head, r0, kt0;
    if (item < 512) { b = item >> 6; head = (item >> 4) & 3; r0 = b * TB + (item & 15) * 128; kt0 = 0; }
    else { const int j = item - 512; b = j >> 3; head = (j >> 1) & 3; r0 = b * TB + SEQ + (j & 1) * 128; kt0 = 32; }
    const bfu* Q = (const bfu*)(ws + WS_Q);
    const char* Kb = (const char*)(ws + WS_K) + ((size_t)b * TB * 512 + head * 128) * 2;
    const char* Vb = (const char*)(ws + WS_VT) + (size_t)(b * 4 + head) * 128 * TB * 2;
    const unsigned klo = (unsigned)((tid >> 4) * 512 + (tid & 15) * 8) * 2u, vlo = (unsigned)((tid >> 3) * TB + (tid & 7) * 8) * 2u;
    const bool piggy = (item < 512);
    const int pe = item >> 4, pi16 = item & 15;
    const char* ps1 = (const char*)(a.in[29] + ((size_t)(l * 32 + pe) * 1024 + pi16 * 64) * 2048);
    const char* ps2 = (const char*)(a.in[31] + ((size_t)(l * 32 + pe) * 1024 + (pi16 >> 2) * 64) * 1024 + (pi16 & 3) * 256);
    char* pd1 = (char*)((bfu*)(ws + WS_W1T) + (size_t)(l * 32 + pe) * 2048 * 1024 + pi16 * 64);
    char* pd2 = (char*)((bfu*)(ws + WS_W2ET) + (size_t)(l * 32 + pe) * 1024 * 1024 + (size_t)((pi16 & 3) * 256) * 1024 + (pi16 >> 2) * 64);
    const unsigned pls1 = (unsigned)((tid >> 6) * 8 * 2048 + (tid & 63)) * 4u, pls2 = (unsigned)((tid >> 6) * 8 * 1024 + (tid & 63)) * 4u;
    const unsigned pld = (unsigned)((tid & 63) * 1024 + (tid >> 6) * 8) * 2u;
    const int kw = (tid >> 4) * KROW + (tid & 15) * 16;
    const int vw = 64 * KROW + (tid >> 3) * VROW + (tid & 7) * 16;
    const int qrow = r0 + wave * 16 + c;
    bf16x8 q1[2], q2[2];
#pragma unroll
    for (int ks = 0; ks < 2; ++ks) {
        q1[ks] = *(const bf16x8*)(Q + (size_t)qrow * 512 + head * 128 + ks * 32 + g * 8);
        q2[ks] = *(const bf16x8*)(Q + (size_t)qrow * 512 + head * 128 + 64 + ks * 32 + g * 8);
    }
    bf16x8 ones;
#pragma unroll
    for (int e = 0; e < 8; ++e) ones[e] = (short)0x3F80;
    float m1 = 0.f, m2 = 0.f;
    f32x4 o1[8], o2[8], ls1 = {0.f, 0.f, 0.f, 0.f}, ls2 = {0.f, 0.f, 0.f, 0.f};
#pragma unroll
    for (int mt = 0; mt < 8; ++mt) { o1[mt] = (f32x4){0.f, 0.f, 0.f, 0.f}; o2[mt] = (f32x4){0.f, 0.f, 0.f, 0.f}; }
    u32x4_t rk0, rk1, rv0, rv1;
#define AT_LOAD_(kt, K0_, K1_, V0_, V1_) do { GAS const char* kb_ = (GAS const char*)(Kb + (size_t)(kt) * 65536); GAS const char* kb2_ = kb_ + 32768; GAS const char* vb_ = (GAS const char*)(Vb + (kt) * 128); GAS const char* vb2_ = vb_ + 64 * TB * 2; \
        unsigned ko_ = klo, vo_ = vlo; asm volatile("" : "+v"(ko_), "+v"(vo_), "+s"(kb_), "+s"(kb2_), "+s"(vb_), "+s"(vb2_)); \
        K0_ = *(GAS const u32x4_t*)(kb_ + ko_); K1_ = *(GAS const u32x4_t*)(kb2_ + ko_); V0_ = *(GAS const u32x4_t*)(vb_ + vo_); V1_ = *(GAS const u32x4_t*)(vb2_ + vo_); } while (0)
#define AT_LOAD(kt) AT_LOAD_(kt, rk0, rk1, rv0, rv1)
#define AT_WRITE_(bufp, K0_, K1_, V0_, V1_) do { *(u32x4_t*)((bufp) + kw) = K0_; *(u32x4_t*)((bufp) + kw + 32 * KROW) = K1_; *(u32x4_t*)((bufp) + vw) = V0_; *(u32x4_t*)((bufp) + vw + 64 * VROW) = V1_; } while (0)
#define AT_WRITE(bufp) AT_WRITE_(bufp, rk0, rk1, rv0, rv1)
    __syncthreads();
    {
        u32x4_t sk0, sk1, sv0_, sv1_;
        AT_LOAD(kt0);
        AT_LOAD_(kt0 + 1, sk0, sk1, sv0_, sv1_);
        AT_WRITE(smem);
        AT_WRITE_(smem + AT_BUF, sk0, sk1, sv0_, sv1_);
    }
    __syncthreads();
    const bool lag = (wave >= 4);
    if (lag) __builtin_amdgcn_s_barrier();
    int bi = 0;
    for (int kt = kt0; kt < 36; ++kt) {
        const char* Ks = smem + bi * AT_BUF;
        const char* Vs = Ks + 64 * KROW;
        if (kt + 2 < 36) AT_LOAD(kt + 2);
        float sv[8];
        if (piggy) {
            const bool pw1 = (kt < 32);
            const char* su = pw1 ? ps1 + ((((kt >> 1) & 1) * 1024 + (kt >> 2) * 128 + (kt & 1) * 64) * 4) : ps2 + (kt - 32) * 256;
            const int ldsb = pw1 ? 8192 : 4096;
            unsigned so_ = pw1 ? pls1 : pls2; asm volatile("" : "+v"(so_));
#pragma unroll
            for (int i = 0; i < 8; ++i) { GAS const char* bi = (GAS const char*)(su + (size_t)(i * ldsb)); asm volatile("" : "+s"(bi)); sv[i] = *(GAS const float*)(bi + so_); }
        }
        f32x4 s1[4], s2[4];
        {
            const char* kp = Ks + c * KROW + g * 16;
            bf16x8 ka[4], kb[4];
#pragma unroll
            for (int f = 0; f < 4; ++f) ka[f] = *(const bf16x8*)(kp + (f & 1) * 128 + (f >> 1) * 64);
#pragma unroll
            for (int kq = 0; kq < 4; ++kq) {
                if (kq < 3) {
#pragma unroll
                    for (int f = 0; f < 4; ++f) kb[f] = *(const bf16x8*)(kp + (kq + 1) * 16 * KROW + (f & 1) * 128 + (f >> 1) * 64);
                }
                __builtin_amdgcn_sched_barrier(0);
                s1[kq] = (f32x4){-m1, -m1, -m1, -m1}; s2[kq] = (f32x4){-m2, -m2, -m2, -m2};
                __builtin_amdgcn_s_setprio(1);
                s1[kq] = __builtin_amdgcn_mfma_f32_16x16x32_bf16(ka[0], q1[0], s1[kq], 0, 0, 0);
                s2[kq] = __builtin_amdgcn_mfma_f32_16x16x32_bf16(ka[1], q2[0], s2[kq], 0, 0, 0);
                s1[kq] = __builtin_amdgcn_mfma_f32_16x16x32_bf16(ka[2], q1[1], s1[kq], 0, 0, 0);
                s2[kq] = __builtin_amdgcn_mfma_f32_16x16x32_bf16(ka[3], q2[1], s2[kq], 0, 0, 0);
                __builtin_amdgcn_s_setprio(0);
                __builtin_amdgcn_sched_barrier(0);
#pragma unroll
                for (int f = 0; f < 4; ++f) ka[f] = kb[f];
            }
        }
        float mx1 = fmax3_(s1[0][0], s1[0][1], s1[0][2]), mx2 = fmax3_(s2[0][0], s2[0][1], s2[0][2]);
        mx1 = fmax3_(mx1, s1[0][3], s1[1][0]); mx2 = fmax3_(mx2, s2[0][3], s2[1][0]);
        mx1 = fmax3_(mx1, s1[1][1], s1[1][2]); mx2 = fmax3_(mx2, s2[1][1], s2[1][2]);
        mx1 = fmax3_(mx1, s1[1][3], s1[2][0]); mx2 = fmax3_(mx2, s2[1][3], s2[2][0]);
        mx1 = fmax3_(mx1, s1[2][1], s1[2][2]); mx2 = fmax3_(mx2, s2[2][1], s2[2][2]);
        mx1 = fmax3_(mx1, s1[2][3], s1[3][0]); mx2 = fmax3_(mx2, s2[2][3], s2[3][0]);
        mx1 = fmax3_(mx1, s1[3][1], s1[3][2]); mx2 = fmax3_(mx2, s2[3][1], s2[3][2]);
        mx1 = fmax3_(mx1, s1[3][3], mx1); mx2 = fmax3_(mx2, s2[3][3], mx2);
        const bool first = (kt == kt0);
        if (first || __any((mx1 > 8.0f) || (mx2 > 8.0f))) {
            asm volatile("; attn rescale" ::: "memory");
            mx1 = fmaxf(mx1, shx_(mx1, 16)); mx1 = fmaxf(mx1, shx_(mx1, 32));
            mx2 = fmaxf(mx2, shx_(mx2, 16)); mx2 = fmaxf(mx2, shx_(mx2, 32));
            const float d1 = first ? mx1 : fmaxf(mx1, 0.f), d2 = first ? mx2 : fmaxf(mx2, 0.f);
            const float al1 = first ? 1.0f : ex2_(-d1), al2 = first ? 1.0f : ex2_(-d2);
            m1 += d1; m2 += d2;
            ls1 *= al1; ls2 *= al2;
#pragma unroll
            for (int mt = 0; mt < 8; ++mt) { o1[mt] *= al1; o2[mt] *= al2; }
#pragma unroll
            for (int kq = 0; kq < 4; ++kq) { s1[kq] -= d1; s2[kq] -= d2; }
        }
        bf16x8 pb1[2], pb2[2];
#pragma unroll
        for (int kk = 0; kk < 2; ++kk) {
            union { unsigned u[4]; bf16x8 v; } t1, t2;
            t1.u[0] = pack2(ex2_(s1[2 * kk][0]), ex2_(s1[2 * kk][1])); t1.u[1] = pack2(ex2_(s1[2 * kk][2]), ex2_(s1[2 * kk][3]));
            t1.u[2] = pack2(ex2_(s1[2 * kk + 1][0]), ex2_(s1[2 * kk + 1][1])); t1.u[3] = pack2(ex2_(s1[2 * kk + 1][2]), ex2_(s1[2 * kk + 1][3]));
            t2.u[0] = pack2(ex2_(s2[2 * kk][0]), ex2_(s2[2 * kk][1])); t2.u[1] = pack2(ex2_(s2[2 * kk][2]), ex2_(s2[2 * kk][3]));
            t2.u[2] = pack2(ex2_(s2[2 * kk + 1][0]), ex2_(s2[2 * kk + 1][1])); t2.u[3] = pack2(ex2_(s2[2 * kk + 1][2]), ex2_(s2[2 * kk + 1][3]));
            pb1[kk] = t1.v; pb2[kk] = t2.v;
        }
        asm volatile("" ::: "memory"); __builtin_amdgcn_s_barrier(); asm volatile("" ::: "memory");
#pragma unroll
        for (int kk = 0; kk < 2; ++kk) {
            ls1 = __builtin_amdgcn_mfma_f32_16x16x32_bf16(ones, pb1[kk], ls1, 0, 0, 0);
            ls2 = __builtin_amdgcn_mfma_f32_16x16x32_bf16(ones, pb2[kk], ls2, 0, 0, 0);
        }
        {
            const char* vp = Vs + c * VROW + g * 8;
            uint2 va[4], vb[4];
#pragma unroll
            for (int f = 0; f < 4; ++f) va[f] = *(const uint2*)(vp + (f >> 1) * 64 + (f & 1) * 32);
#pragma unroll
            for (int mt = 0; mt < 8; ++mt) {
                if (mt < 7) {
#pragma unroll
                    for (int f = 0; f < 4; ++f) vb[f] = *(const uint2*)(vp + (mt + 1) * 16 * VROW + (f >> 1) * 64 + (f & 1) * 32);
                }
                __builtin_amdgcn_sched_barrier(0);
                union { uint4 u; bf16x8 v; } av0, av1;
                av0.u = make_uint4(va[0].x, va[0].y, va[1].x, va[1].y);
                av1.u = make_uint4(va[2].x, va[2].y, va[3].x, va[3].y);
                __builtin_amdgcn_s_setprio(1);
                o1[mt] = __builtin_amdgcn_mfma_f32_16x16x32_bf16(av0.v, pb1[0], o1[mt], 0, 0, 0);
                o2[mt] = __builtin_amdgcn_mfma_f32_16x16x32_bf16(av0.v, pb2[0], o2[mt], 0, 0, 0);
                o1[mt] = __builtin_amdgcn_mfma_f32_16x16x32_bf16(av1.v, pb1[1], o1[mt], 0, 0, 0);
                o2[mt] = __builtin_amdgcn_mfma_f32_16x16x32_bf16(av1.v, pb2[1], o2[mt], 0, 0, 0);
                __builtin_amdgcn_s_setprio(0);
                __builtin_amdgcn_sched_barrier(0);
#pragma unroll
                for (int f = 0; f < 4; ++f) va[f] = vb[f];
            }
        }
        if (piggy) {
            const u32x4_t p = {pack2(sv[0], sv[1]), pack2(sv[2], sv[3]), pack2(sv[4], sv[5]), pack2(sv[6], sv[7])};
            GAS char* du = (GAS char*)((kt < 32) ? pd1 + (size_t)kt * 131072 : pd2 + (size_t)(kt - 32) * 131072);
            unsigned do_ = pld; asm volatile("" : "+v"(do_), "+s"(du));
            *(GAS u32x4_t*)(du + do_) = p;
        }
        if (kt + 2 < 36) { const int bw = (bi == 0) ? 2 : bi - 1; AT_WRITE(smem + bw * AT_BUF); }
        asm volatile("s_waitcnt lgkmcnt(0)" ::: "memory"); __builtin_amdgcn_s_barrier(); asm volatile("" ::: "memory");
        bi = (bi == 2) ? 0 : bi + 1;
    }
    if (!lag) __builtin_amdgcn_s_barrier();
#undef AT_LOAD
#undef AT_LOAD_
#undef AT_WRITE_
#undef AT_WRITE
    const float lam = ((const float*)(ws + WS_TAB))[2048 + l];
    const float lam_init = (l == 0) ? 0.2f : (0.8f - 0.6f * 0.7408182206817179f);
    const float* sg = a.in[10] + l * 128;
    float4 gga[8];
#pragma unroll
    for (int mt = 0; mt < 8; ++mt) gga[mt] = *(const float4*)(sg + mt * 16 + g * 4);
    const float i1 = 1.0f / ls1[0], i2 = lam / ls2[0];
    float ss = 0.f;
#pragma unroll
    for (int mt = 0; mt < 8; ++mt)
#pragma unroll
        for (int r = 0; r < 4; ++r) { const float v = o1[mt][r] * i1 - o2[mt][r] * i2; o1[mt][r] = v; ss += v * v; }
    ss += shx_(ss, 16); ss += shx_(ss, 32);
    const float rs = rsqrtf(ss * (1.0f / 128.0f) + 1e-5f) * (1.0f - lam_init);
    bfu* ODA = (bfu*)(ws + WS_ODA);
#pragma unroll
    for (int mt = 0; mt < 8; ++mt) {
        const int dim = mt * 16 + g * 4;
        const float4 gg = gga[mt];
        uint2 p; p.x = pack2(o1[mt][0] * rs * gg.x, o1[mt][1] * rs * gg.y); p.y = pack2(o1[mt][2] * rs * gg.z, o1[mt][3] * rs * gg.w);
        *(uint2*)(ODA + (size_t)qrow * 512 + head * 128 + dim) = p;
    }
}

constexpr int CK = 16, NCK = TB / CK, NCHUNK = 128 * NCK;
constexpr size_t WS_CEB  = WS_H2HI;
constexpr size_t WS_CW1  = WS_YB;
constexpr size_t WS_CRH  = WS_CW1 + (size_t)NCHUNK * 1024 * 2;
constexpr size_t WS_CUV  = WS_CRH + (size_t)NCHUNK * 1024 * 2;
constexpr size_t WS_CV   = WS_CUV + (size_t)NCHUNK * 1024 * 2;
constexpr size_t WS_CG   = WS_ACT;
constexpr size_t WS_CPC  = WS_ACT + (size_t)NCHUNK * 512 * 2;
__device__ __forceinline__ int kperm(int jp) { return (jp & 32) + 8 * ((jp >> 2) & 3) + 4 * ((jp >> 4) & 1) + (jp & 3); }
__device__ __forceinline__ bf16x8 neg8(bf16x8 v) { union { bf16x8 v; uint4 u; } t; t.v = v; t.u.x ^= 0x80008000u; t.u.y ^= 0x80008000u; t.u.z ^= 0x80008000u; t.u.w ^= 0x80008000u; return t.v; }
__device__ __forceinline__ bf16x8 zero8() { bf16x8 z; for (int e = 0; e < 8; ++e) z[e] = 0; return z; }
__device__ __forceinline__ bf16x8 ldpad8(const char* p, int g) {
    union { bf16x8 v; uint4 u; } t; t.v = *(const bf16x8*)(p + (g & 1) * 16);
    const unsigned m = (g < 2) ? 0xFFFFFFFFu : 0u; t.u.x &= m; t.u.y &= m; t.u.z &= m; t.u.w &= m; return t.v; }

__device__ __forceinline__ void chunk_pre(const Args& a, unsigned char* ws, int l, int cid, char* L, int lane) {
    const int g = lane >> 4, c = lane & 15;
    const int seq = cid / NCK, ck = cid - seq * NCK;
    const int d = seq & 1, h = (seq >> 1) & 7, b = seq >> 4;
    const bfu* WD = (const bfu*)(ws + WS_WDEC) + (size_t)d * NT * 512;
    const bfu* AV = (const bfu*)(ws + WS_BV) + (size_t)d * NT * 512;
    const bfu* RK = (const bfu*)(ws + WS_RK);
    const bfu* RR = (const bfu*)(ws + WS_RR);
    const bfu* RV = (const bfu*)(ws + WS_RV);
    float KH[4][4], BH[4][4], EH[4][4], RH[4][4], BT[4][4], ET[4][4], VV[4][4], PC[4];
    {
        float kq[4][4], av[4][4], ww[4][4], rr[4][4], ssq[4] = {0.f, 0.f, 0.f, 0.f};
        {
            const size_t ro = ((size_t)b * TB + scan_tok(d, ck * CK + (lane >> 2))) * 512 + h * 64 + (lane & 3) * 16;
            const uint4 w0 = *(const uint4*)(WD + ro), w1_ = *(const uint4*)(WD + ro + 8), k0 = *(const uint4*)(RK + ro), k1 = *(const uint4*)(RK + ro + 8);
            const uint4 a0 = *(const uint4*)(AV + ro), a1 = *(const uint4*)(AV + ro + 8), r0_ = *(const uint4*)(RR + ro), r1_ = *(const uint4*)(RR + ro + 8);
            const uint4 v0 = *(const uint4*)(RV + ro), v1 = *(const uint4*)(RV + ro + 8);
            char* sp = L + (lane >> 2) * 128 + (lane & 3) * 32;
            *(uint4*)(sp) = w0; *(uint4*)(sp + 16) = w1_; *(uint4*)(sp + 2048) = k0; *(uint4*)(sp + 2064) = k1;
            *(uint4*)(sp + 4096) = a0; *(uint4*)(sp + 4112) = a1; *(uint4*)(sp + 6144) = r0_; *(uint4*)(sp + 6160) = r1_;
            *(uint4*)(sp + 8192) = v0; *(uint4*)(sp + 8208) = v1;
            asm volatile("s_waitcnt lgkmcnt(0)" ::: "memory");
#pragma unroll
            for (int r = 0; r < 4; ++r)
#pragma unroll
                for (int nt = 0; nt < 4; ++nt) {
                    const char* ep = L + (4 * g + r) * 128 + (16 * nt + c) * 2;
                    ww[nt][r] = ex2_(-0.87503925f * sigmoidf_(bf2f(*(const bfu*)(ep)))); kq[nt][r] = bf2f(*(const bfu*)(ep + 2048)); av[nt][r] = sigmoidf_(bf2f(*(const bfu*)(ep + 4096)));
                    rr[nt][r] = bf2f(*(const bfu*)(ep + 6144)); VV[nt][r] = bf2f(*(const bfu*)(ep + 8192));
                }
            asm volatile("s_waitcnt lgkmcnt(0)" ::: "memory");
        }
        float dsb[4] = {0.f, 0.f, 0.f, 0.f};
#pragma unroll
        for (int nt = 0; nt < 4; ++nt) {
            const float kkw = a.in[20][l * 512 + h * 64 + 16 * nt + c], kaw = a.in[21][l * 512 + h * 64 + 16 * nt + c];
            const float rkw = a.in[22][l * 512 + h * 64 + 16 * nt + c];
#pragma unroll
            for (int r = 0; r < 4; ++r) {
                const float k = kq[nt][r];
                EH[nt][r] = k * (1.0f + (av[nt][r] - 1.0f) * kaw);
                dsb[r] += rr[nt][r] * EH[nt][r] * rkw;
                kq[nt][r] = k * kkw;
                ssq[r] += kq[nt][r] * kq[nt][r];
            }
        }
        {
            float* DS = (float*)(ws + WS_LOG) + (size_t)d * NT * 8;
#pragma unroll
            for (int r = 0; r < 4; ++r) { const float t_ = red16(dsb[r]); if (c == 0) DS[((size_t)b * TB + scan_tok(d, ck * CK + 4 * g + r)) * 8 + h] = t_; }
        }
#pragma unroll
        for (int r = 0; r < 4; ++r) ssq[r] = rsqrtf(fmaxf(red16(ssq[r]), 1e-24f));
#pragma unroll
        for (int nt = 0; nt < 4; ++nt) {
            float cp[4];
            cp[0] = ww[nt][0]; cp[1] = cp[0] * ww[nt][1]; cp[2] = cp[1] * ww[nt][2]; cp[3] = cp[2] * ww[nt][3];
            const float t0 = shf_(cp[3], c), t1 = shf_(cp[3], c + 16), t2 = shf_(cp[3], c + 32), t3 = shf_(cp[3], c + 48);
            const float pre = ((g > 0) ? t0 : 1.0f) * ((g > 1) ? t1 : 1.0f) * ((g > 2) ? t2 : 1.0f);
            const float pc = (t0 * t1) * (t2 * t3);
            PC[nt] = pc;
#pragma unroll
            for (int r = 0; r < 4; ++r) {
                const float P = pre * cp[r], Pm = (r == 0) ? pre : pre * cp[r - 1];
                const float iP = __builtin_amdgcn_rcpf(P);
                const float kkn = kq[nt][r] * ssq[r], bb = kkn * av[nt][r], ke = EH[nt][r];
                KH[nt][r] = kkn * Pm; BH[nt][r] = bb * iP; EH[nt][r] = ke * iP; RH[nt][r] = rr[nt][r] * P;
                BT[nt][r] = bb * (pc * iP); ET[nt][r] = ke * (pc * iP);
            }
        }
    }
    char* R0 = L; char* R1 = L + 8192;
#pragma unroll
    for (int nt = 0; nt < 4; ++nt) {
#pragma unroll
        for (int r = 0; r < 4; ++r) {
            const int o = (4 * g + r) * 128 + (16 * nt + c) * 2;
            *(bfu*)(R0 + o) = f2bf(KH[nt][r]); *(bfu*)(R0 + 2048 + o) = f2bf(RH[nt][r]);
            *(bfu*)(R0 + 4096 + o) = f2bf(BH[nt][r]); *(bfu*)(R0 + 6144 + o) = f2bf(EH[nt][r]);
        }
        const int ot = (16 * nt + c) * 32 + 8 * g;
        uint2 p;
        p.x = pack2(KH[nt][0], KH[nt][1]); p.y = pack2(KH[nt][2], KH[nt][3]); *(uint2*)(R1 + ot) = p;
        p.x = pack2(VV[nt][0], VV[nt][1]); p.y = pack2(VV[nt][2], VV[nt][3]); *(uint2*)(R1 + 2048 + ot) = p;
        p.x = pack2(BT[nt][0], BT[nt][1]); p.y = pack2(BT[nt][2], BT[nt][3]); *(uint2*)(R1 + 4096 + ot) = p;
        p.x = pack2(ET[nt][0], ET[nt][1]); p.y = pack2(ET[nt][2], ET[nt][3]); *(uint2*)(R1 + 6144 + ot) = p;
    }
    const f32x4 z4 = {0.f, 0.f, 0.f, 0.f};
#define RM_(X, ks) (*(const bf16x8*)(R0 + (X) + c * 128 + (ks) * 64 + g * 16))
#define TR_(base, tile) ldpad8((base) + (16 * (tile) + c) * 32, g)
#define MM_(off) ldpad8(R0 + (off) + c * 32, g)
    f32x4 Am = z4, Bmm = z4, Grb = z4, Grk = z4;
#pragma unroll
    for (int ks = 0; ks < 2; ++ks) {
        const bf16x8 kh = RM_(0, ks), rh = RM_(2048, ks), bh = RM_(4096, ks), eh = RM_(6144, ks);
        Am = __builtin_amdgcn_mfma_f32_16x16x32_bf16(kh, bh, Am, 0, 0, 0);
        Bmm = __builtin_amdgcn_mfma_f32_16x16x32_bf16(kh, eh, Bmm, 0, 0, 0);
        Grb = __builtin_amdgcn_mfma_f32_16x16x32_bf16(rh, bh, Grb, 0, 0, 0);
        Grk = __builtin_amdgcn_mfma_f32_16x16x32_bf16(rh, eh, Grk, 0, 0, 0);
    }
#pragma unroll
    for (int r = 0; r < 4; ++r) {
        const int t = 4 * g + r;
        if (c >= t) { Am[r] = 0.f; Bmm[r] = 0.f; }
        if (c > t) { Grb[r] = 0.f; Grk[r] = 0.f; }
    }
    asm volatile("s_waitcnt lgkmcnt(0)" ::: "memory");
    float* Af = (float*)(R0 + 2048);
#pragma unroll
    for (int r = 0; r < 4; ++r) Af[(4 * g + r) * 16 + c] = Am[r];
    asm volatile("s_waitcnt lgkmcnt(0)" ::: "memory");
    float Tc[16];
#pragma unroll
    for (int t = 0; t < 16; ++t) {
        float acc = (t == c) ? 1.0f : 0.0f, acc2 = 0.0f;
#pragma unroll
        for (int s_ = 0; s_ < t; ++s_) { if (s_ & 1) acc2 -= Af[t * 16 + s_] * Tc[s_]; else acc -= Af[t * 16 + s_] * Tc[s_]; }
        Tc[t] = acc + acc2;
    }
    asm volatile("s_waitcnt lgkmcnt(0)" ::: "memory");
#pragma unroll
    for (int t = 0; t < 16; ++t) *(bfu*)(R0 + t * 32 + c * 2) = f2bf(Tc[t]);
#pragma unroll
    for (int r = 0; r < 4; ++r) {
        const int o = (4 * g + r) * 32 + c * 2;
        *(bfu*)(R0 + 512 + o) = f2bf(Bmm[r]); *(bfu*)(R0 + 1024 + o) = f2bf(Grb[r]); *(bfu*)(R0 + 1536 + o) = f2bf(Grk[r]);
    }
    asm volatile("s_waitcnt lgkmcnt(0)" ::: "memory");
    const bf16x8 mT = MM_(0), mBm = MM_(512), mGrb = MM_(1024), mGrk = MM_(1536);
    const bf16x8 mNGrb = neg8(mGrb);
    char* W1T = R0 + 2048; char* UvT = R0 + 4096; char* BmVT = R0 + 6144;
#pragma unroll
    for (int nt = 0; nt < 4; ++nt) {
        const f32x4 x = __builtin_amdgcn_mfma_f32_16x16x32_bf16(mBm, TR_(R1 + 2048, nt), z4, 0, 0, 0);
        *(uint2*)(BmVT + (16 * nt + c) * 32 + 8 * g) = pack4(x);
        const f32x4 w1 = __builtin_amdgcn_mfma_f32_16x16x32_bf16(mT, TR_(R1, nt), z4, 0, 0, 0);
        {
            const int pos = kperm(16 * nt + c);
            const int fo = ((pos >> 5) * 512 + ((pos >> 3) & 3) * 128 + (pos & 7)) * 2;
#pragma unroll
            for (int r = 0; r < 4; ++r) { *(bfu*)(W1T + fo + (4 * g + r) * 16) = f2bf(w1[r]); *(bfu*)(UvT + fo + (4 * g + r) * 16) = f2bf(RH[nt][r]); }
        }
    }
    asm volatile("s_waitcnt lgkmcnt(0)" ::: "memory");
    {
        bfu* W1P = (bfu*)(ws + WS_CW1) + (size_t)cid * 1024 + lane * 8;
        bfu* RHP = (bfu*)(ws + WS_CRH) + (size_t)cid * 1024 + lane * 8;
        *(uint4*)(W1P) = *(const uint4*)(W1T + lane * 16); *(uint4*)(W1P + 512) = *(const uint4*)(W1T + 1024 + lane * 16);
        *(uint4*)(RHP) = *(const uint4*)(UvT + lane * 16); *(uint4*)(RHP + 512) = *(const uint4*)(UvT + 1024 + lane * 16);
    }
#pragma unroll
    for (int nt = 0; nt < 4; ++nt) {
        const f32x4 uv = __builtin_amdgcn_mfma_f32_16x16x32_bf16(mT, TR_(BmVT, nt), z4, 0, 0, 0);
        *(uint2*)((bfu*)(ws + WS_CUV) + (size_t)cid * 1024 + nt * 256 + lane * 4) = pack4(uv);
        uint2 pv; pv.x = pack2(VV[nt][0], VV[nt][1]); pv.y = pack2(VV[nt][2], VV[nt][3]);
        *(uint2*)((bfu*)(ws + WS_CV) + (size_t)cid * 1024 + nt * 256 + lane * 4) = pv;
        uint4 eb; eb.x = pack2(ET[nt][0], ET[nt][1]); eb.y = pack2(ET[nt][2], ET[nt][3]); eb.z = pack2(BT[nt][0], BT[nt][1]); eb.w = pack2(BT[nt][2], BT[nt][3]);
        *(uint4*)((bfu*)(ws + WS_CEB) + (size_t)cid * 2048 + nt * 512 + lane * 8) = eb;
        if (g == 0) ((bfu*)(ws + WS_CPC))[(size_t)cid * 64 + (c >> 2) * 16 + nt * 4 + (c & 3)] = f2bf(PC[nt]);
    }
    {
        const uint2 gk = *(const uint2*)(R0 + 1536 + c * 32 + 8 * g), gb = *(const uint2*)(R0 + 1024 + c * 32 + 8 * g);
        *(uint4*)((bfu*)(ws + WS_CG) + (size_t)cid * 512 + lane * 8) = make_uint4(gk.x, gk.y, gb.x, gb.y);
    }
    asm volatile("s_waitcnt lgkmcnt(0)" ::: "memory");
#undef RM_
#undef TR_
#undef MM_
}

constexpr int CS_W1 = 0, CS_RH = 2048, CS_EB = 4096, CS_G = 8192, CS_UV = 9216, CS_V = 11264, CS_PC = 13312, CS_SLOT = 13568, CS_D = 8;
__device__ __forceinline__ void chain_dma(unsigned char* ws, LAS unsigned char* slot, size_t cid, int w4, int lane) {
#pragma unroll
    for (int q = 0; q < 4; ++q) {
        const int p = w4 + 4 * q;
        const char* src; int dst; bool on = true;
        if (p < 2) { src = (const char*)(ws + WS_CW1) + cid * 2048 + p * 1024; dst = CS_W1 + p * 1024; }
        else if (p < 4) { src = (const char*)(ws + WS_CRH) + cid * 2048 + (p - 2) * 1024; dst = CS_RH + (p - 2) * 1024; }
        else if (p < 8) { src = (const char*)(ws + WS_CEB) + cid * 4096 + (p - 4) * 1024; dst = CS_EB + (p - 4) * 1024; }
        else if (p < 9) { src = (const char*)(ws + WS_CG) + cid * 1024; dst = CS_G; }
        else if (p < 11) { src = (const char*)(ws + WS_CUV) + cid * 2048 + (p - 9) * 1024; dst = CS_UV + (p - 9) * 1024; }
        else if (p < 13) { src = (const char*)(ws + WS_CV) + cid * 2048 + (p - 11) * 1024; dst = CS_V + (p - 11) * 1024; }
        else if (p < 14) { src = (const char*)(ws + WS_CPC) + cid * 128; dst = CS_PC; on = (lane < 8); }
        else continue;
        if (on) __builtin_amdgcn_global_load_lds((const unsigned*)(src + lane * 16), (LAS unsigned*)(slot + dst), 16, 0, 0);
    }
}
__device__ __forceinline__ void chunk_chain_blk(const Args& a, unsigned char* ws, int l, int seq, char* smem, int tid) {
    const int wave = tid >> 6, lane = tid & 63, g = lane >> 4, c = lane & 15;
    const int d = seq & 1, h = (seq >> 1) & 7, b = seq >> 4;
    const int nt = wave & 3;
    const int wvu = __builtin_amdgcn_readfirstlane(wave);
    const int w4u = wvu & 3;
    LAS unsigned char* ring = (LAS unsigned char*)smem;
    const size_t cbase = (size_t)seq * NCK;
    bfu* Y = (bfu*)(ws + WS_Y) + (size_t)d * NT * 512 + h * 64 + 16 * nt + c;
    f32x4 Z[4];
#pragma unroll
    for (int mt = 0; mt < 4; ++mt) Z[mt] = (f32x4){0.f, 0.f, 0.f, 0.f};
    __syncthreads();
    if (wvu >= 4) {
        for (int k = 0; k < CS_D - 1; ++k) chain_dma(ws, ring + k * CS_SLOT, cbase + k, w4u, lane);
        asm volatile("s_waitcnt vmcnt(18)" ::: "memory");
    }
    __builtin_amdgcn_s_barrier();
    for (int ck = 0; ck < NCK; ++ck) {
        if (wvu >= 4) {
            if (ck + CS_D - 1 < NCK) chain_dma(ws, ring + ((ck + CS_D - 1) % CS_D) * CS_SLOT, cbase + ck + CS_D - 1, w4u, lane);
            if (ck + CS_D - 1 < NCK) asm volatile("s_waitcnt vmcnt(18)" ::: "memory"); else asm volatile("s_waitcnt vmcnt(0)" ::: "memory");
        } else {
            const LAS unsigned char* sl = ring + (ck % CS_D) * CS_SLOT;
            bf16x8 zb[2];
#pragma unroll
            for (int s_ = 0; s_ < 2; ++s_) {
                union { unsigned u[4]; bf16x8 v; } t;
                t.u[0] = pack2(Z[2 * s_][0], Z[2 * s_][1]); t.u[1] = pack2(Z[2 * s_][2], Z[2 * s_][3]);
                t.u[2] = pack2(Z[2 * s_ + 1][0], Z[2 * s_ + 1][1]); t.u[3] = pack2(Z[2 * s_ + 1][2], Z[2 * s_ + 1][3]);
                zb[s_] = t.v;
            }
            const u32x2_t uvq = *(const LAS u32x2_t*)(sl + CS_UV + nt * 512 + lane * 8);
            const u32x2_t vvq = *(const LAS u32x2_t*)(sl + CS_V + nt * 512 + lane * 8);
            f32x4 u = {-bflo(uvq.x), -bfhi(uvq.x), -bflo(uvq.y), -bfhi(uvq.y)};
            u = __builtin_amdgcn_mfma_f32_16x16x32_bf16(neg8(*(const LAS bf16x8*)(sl + CS_W1 + lane * 16)), zb[0], u, 0, 0, 0);
            u = __builtin_amdgcn_mfma_f32_16x16x32_bf16(neg8(*(const LAS bf16x8*)(sl + CS_W1 + 1024 + lane * 16)), zb[1], u, 0, 0, 0);
            f32x4 y = {0.f, 0.f, 0.f, 0.f};
            y = __builtin_amdgcn_mfma_f32_16x16x32_bf16(*(const LAS bf16x8*)(sl + CS_RH + lane * 16), zb[0], y, 0, 0, 0);
            y = __builtin_amdgcn_mfma_f32_16x16x32_bf16(*(const LAS bf16x8*)(sl + CS_RH + 1024 + lane * 16), zb[1], y, 0, 0, 0);
            union { unsigned q[4]; bf16x8 v; } b2; b2.q[0] = vvq.x; b2.q[1] = vvq.y; b2.q[2] = pack2(u[0], u[1]); b2.q[3] = pack2(u[2], u[3]);
            y = __builtin_amdgcn_mfma_f32_16x16x32_bf16(*(const LAS bf16x8*)(sl + CS_G + lane * 16), b2.v, y, 0, 0, 0);
            const u32x4_t pq0 = *(const LAS u32x4_t*)(sl + CS_PC + g * 32), pq1 = *(const LAS u32x4_t*)(sl + CS_PC + g * 32 + 16);
#pragma unroll
            for (int mt = 0; mt < 4; ++mt) {
                const u32x4_t pq = (mt < 2) ? pq0 : pq1;
                const unsigned p01 = (mt & 1) ? pq.z : pq.x, p23 = (mt & 1) ? pq.w : pq.y;
                const f32x4 zi = {Z[mt][0] * bflo(p01), Z[mt][1] * bfhi(p01), Z[mt][2] * bflo(p23), Z[mt][3] * bfhi(p23)};
                Z[mt] = __builtin_amdgcn_mfma_f32_16x16x32_bf16(*(const LAS bf16x8*)(sl + CS_EB + mt * 1024 + lane * 16), b2.v, zi, 0, 0, 0);
            }
            if ((l == 0) || (ck >= CTX / CK)) {
#pragma unroll
                for (int r = 0; r < 4; ++r) Y[((size_t)b * TB + scan_tok(d, ck * CK + 4 * g + r)) * 512] = f2bf(y[r]);
            }
            asm volatile("s_waitcnt lgkmcnt(0)" ::: "memory");
        }
        __builtin_amdgcn_s_barrier();
    }
    asm volatile("s_waitcnt vmcnt(0)" ::: "memory");
    __syncthreads();
}

__device__ __forceinline__ void phase_chunkpre(const Args& a, int l, char* smem, int tid, int bid, int nb) {
    unsigned char* ws = wsp(a);
    const int wave = tid >> 6, lane = tid & 63;
    char* L = smem + wave * 16384;
    for (int w = bid * NW + wave; w < NCHUNK; w += nb * NW) {
        const int d = w & 1, rest = w >> 1, grp = rest % NCK, bh = rest / NCK;
        const int seq = bh * 2 + d, ck = d ? ((grp < CTX / CK) ? (CTX / CK - 1 - grp) : (NCK + CTX / CK - 1 - grp)) : grp;
        chunk_pre(a, ws, l, seq * NCK + ck, L, lane);
    }
}
__device__ __forceinline__ void phase_mix(const Args& a, int l, char* smem, int tid, int bid, int nb) {
    unsigned char* ws = wsp(a);
    const int wave = tid >> 6, lane = tid & 63;
    for (int seq = bid; seq < 128; seq += nb) chunk_chain_blk(a, ws, l, seq, smem, tid);
    if (bid >= 128 || nb <= 128) {
        const int nconv = (nb > 128) ? (nb - 128) * NW : nb * NW;
        const int me = (nb > 128) ? ((bid - 128) * NW + wave) : (bid * NW + wave);
        int j = me;
        float4 v[16]; bfu* dp = nullptr;
        if (j < 6144) cvt_slab_ld(a, ws, l, (j / 192) * 768 + 512 + 64 + (j % 192), lane, v, dp);
        for (; j < 6144; j += nconv) {
            float4 cv[16];
#pragma unroll
            for (int i = 0; i < 16; ++i) cv[i] = v[i];
            bfu* cdp = dp;
            const int jn = j + nconv;
            if (jn < 6144) cvt_slab_ld(a, ws, l, (jn / 192) * 768 + 512 + 64 + (jn % 192), lane, v, dp);
            cvt_slab_st(cv, cdp);
        }
    }
    const int n_attn = (l == 0) ? 576 : 512;
    int* qctr = (int*)(ws + CNT_OFF + 1024) + l * 64;
    int* qsl = (int*)(smem + LDS_MAIN + 448);
    for (;;) {
        __syncthreads();
        if (tid == 0) *qsl = atomicAdd(qctr, 1);
        __syncthreads();
        const int it = __builtin_amdgcn_readfirstlane(*qsl);
        if (it >= n_attn) break;
        attn_item2(a, l, it, smem, tid);
    }
}

__device__ __forceinline__ void phase_post(const Args& a, int l, int tid, int bid, int nb) {
    unsigned char* ws = wsp(a);
    const int wave = tid >> 6, lane = tid & 63;
    const bfu* Y0 = (const bfu*)(ws + WS_Y);
    const bfu* Y1 = Y0 + (size_t)NT * 512;
    const float* DSp = (const float*)(ws + WS_LOG);
    const bfu* RR = (const bfu*)(ws + WS_RR);
    const bfu* RV = (const bfu*)(ws + WS_RV);
    const bfu* RKp = (const bfu*)(ws + WS_RK);
    const bfu* AV0 = (const bfu*)(ws + WS_BV);
    const bfu* AV1 = AV0 + (size_t)NT * 512;
    const float* kap = a.in[21] + l * 512;
    const bfu* GG = (const bfu*)(ws + WS_GG);
    bfu* ORW = (bfu*)(ws + WS_ODA) + (size_t)2 * NT * 512;
    const float* lg = a.in[23] + l * 512;
    const float* lb = a.in[24] + l * 512;
    const float* rk = a.in[22] + l * 512;
    const int stride = nb * NW;
    int row = bid * NW + wave;
    uint4 nA, nB, nV, nG; float nD0 = 0.f, nD1 = 0.f;
#define PO_LOAD(r_) do { const size_t o_ = (size_t)(r_) * 512 + lane * 8; nA = *(const uint4*)(Y0 + o_); nB = *(const uint4*)(Y1 + o_); nV = *(const uint4*)(RV + o_); nG = *(const uint4*)(GG + o_); \
        nD0 = DSp[(size_t)(r_) * 8 + (lane >> 3)]; nD1 = DSp[(size_t)NT * 8 + (size_t)(r_) * 8 + (lane >> 3)]; } while (0)
    if (row < NT) PO_LOAD(row);
    for (; row < NT; row += stride) {
        const int t = row % TB;
        const uint4 a0 = nA, b0 = nB, pv = nV, pg = nG; const float ds = nD0 + nD1;
        if (row + stride < NT) PO_LOAD(row + stride);
        if (l == 1 && t >= SEQ) continue;
        const size_t o = (size_t)row * 512 + lane * 8;
        float y[8];
        {
            y[0] = bflo(a0.x) + bflo(b0.x); y[1] = bfhi(a0.x) + bfhi(b0.x); y[2] = bflo(a0.y) + bflo(b0.y); y[3] = bfhi(a0.y) + bfhi(b0.y);
            y[4] = bflo(a0.z) + bflo(b0.z); y[5] = bfhi(a0.z) + bfhi(b0.z); y[6] = bflo(a0.w) + bflo(b0.w); y[7] = bfhi(a0.w) + bfhi(b0.w);
        }
        float s = 0.f;
#pragma unroll
        for (int e = 0; e < 8; ++e) s += y[e];
        s += shx_(s, 1); s += shx_(s, 2); s += shx_(s, 4);
        const float mu = s * (1.0f / 64.0f);
        float vs = 0.f;
#pragma unroll
        for (int e = 0; e < 8; ++e) { const float dlt = y[e] - mu; vs += dlt * dlt; }
        vs += shx_(vs, 1); vs += shx_(vs, 2); vs += shx_(vs, 4);
        const float rstd = rsqrtf(vs * (1.0f / 64.0f) + 64e-5f);
        const float v8[8] = {bflo(pv.x), bfhi(pv.x), bflo(pv.y), bfhi(pv.y), bflo(pv.z), bfhi(pv.z), bflo(pv.w), bfhi(pv.w)};
        const float g8[8] = {bflo(pg.x), bfhi(pg.x), bflo(pg.y), bfhi(pg.y), bflo(pg.z), bfhi(pg.z), bflo(pg.w), bfhi(pg.w)};
        float ov[8];
#pragma unroll
        for (int e = 0; e < 8; ++e) ov[e] = ((y[e] - mu) * rstd * lg[lane * 8 + e] + lb[lane * 8 + e] + ds * v8[e]) * g8[e];
        uint4 po; po.x = pack2(ov[0], ov[1]); po.y = pack2(ov[2], ov[3]); po.z = pack2(ov[4], ov[5]); po.w = pack2(ov[6], ov[7]);
        *(uint4*)(ORW + o) = po;
    }
#undef PO_LOAD
}

__device__ __forceinline__ void phase_merge(const Args& a, int l, char* smem, int tid, int bid, int nb) {
    unsigned char* ws = wsp(a);
    const int wave = tid >> 6, lane = tid & 63, wm = wave >> 1, wn = wave & 1, g = lane >> 4, c = lane & 15;
    const bfu* GL = (const bfu*)(ws + WS_GL);
    bfu* MB = (bfu*)(ws + WS_MB);
    for (int it = bid; it < 72 * 16; it += nb) {
        const int mt = it >> 4, nt = it & 15;
        if (l == 1 && (mt % 9) == 8) continue;
        const int m0 = mt * 256, n0 = nt * 64;
        int arow[4]; ident_rows(arow, m0, tid);
        const int rowbase = m0 + wm * 64, colbase = n0 + wn * 32;
        f32x4 tot[4][2]; zero_acc<2>(tot);
        for (int n = 0; n < 3; ++n) {
            f32x4 acc[4][2]; zero_acc<2>(acc);
            gemm_loop<2>(acc, (const bfu*)(ws + WS_ODA) + (size_t)n * NT * 512, 512, arow,
                         (const bfu*)(ws + WS_WBT) + (size_t)(l * 3 + n) * 1024 * 512, 512, n0, 512, smem, tid);
#pragma unroll
            for (int mi = 0; mi < 4; ++mi)
#pragma unroll
                for (int ni = 0; ni < 2; ++ni)
#pragma unroll
                    for (int r = 0; r < 4; ++r) {
                        const int row = rowbase + mi * 16 + g * 4 + r;
                        const float gate = bf2f(GL[(size_t)row * 3072 + n * 1024 + colbase + ni * 16 + c]);
                        tot[mi][ni][r] += gate * acc[mi][ni][r];
                    }
        }
#pragma unroll
        for (int mi = 0; mi < 4; ++mi)
#pragma unroll
            for (int ni = 0; ni < 2; ++ni)
#pragma unroll
                for (int r = 0; r < 4; ++r) {
                    const int row = rowbase + mi * 16 + g * 4 + r;
                    MB[(size_t)row * 1024 + colbase + ni * 16 + c] = f2bf(tot[mi][ni][r]);
                }
    }
}

__device__ __forceinline__ void phase_wout(const Args& a, int l, char* smem, int tid, int bid, int nb) {
    unsigned char* ws = wsp(a);
    const int wave = tid >> 6, lane = tid & 63, wm = wave >> 1, wn = wave & 1, g = lane >> 4, c = lane & 15;
    float* xres = (float*)(ws + WS_XRES);
    const float* mod = (const float*)(ws + WS_MOD);
    for (int it = bid; it < 72 * 8; it += nb) {
        const int mt = it >> 3, nt = it & 7;
        if (l == 1 && (mt % 9) == 8) continue;
        const int m0 = mt * 256, n0 = nt * 128;
        int arow[4]; ident_rows(arow, m0, tid);
        f32x4 acc[4][4]; zero_acc<4>(acc);
        gemm_loop<4>(acc, (const bfu*)(ws + WS_MB), 1024, arow, (const bfu*)(ws + WS_WOT) + (size_t)l * 1024 * 1024, 1024, n0, 1024, smem, tid);
        const int rowbase = m0 + wm * 64, colbase = n0 + wn * 64;
        const int b = m0 / TB, m = ((m0 % TB) < SEQ) ? b : 8;
        const float* ga = mod + (size_t)(l * 9 + m) * 6144 + 2 * 1024;
#pragma unroll
        for (int ni = 0; ni < 4; ++ni) {
            const int col = colbase + ni * 16 + c;
            const float gac = ga[col];
#pragma unroll
            for (int mi = 0; mi < 4; ++mi)
#pragma unroll
                for (int r = 0; r < 4; ++r) {
                    const int row = rowbase + mi * 16 + g * 4 + r;
                    xres[(size_t)row * 1024 + col] += gac * acc[mi][ni][r];
                }
        }
    }
}

__device__ __forceinline__ void phase_topk(const Args& a, int l, char* smem, int tid, int bid, int nb) {
    unsigned char* ws = wsp(a);
    const float* LG = (const float*)(ws + WS_LOG);
    int* cnt = (int*)(ws + CNT_OFF) + l * 32;
    int* TOKL = (int*)(ws + WS_TOKL);
    float* GATE = (float*)(ws + WS_GATE);
    int* lcnt = (int*)smem;
    int* lbase = lcnt + 32;
    for (int blk = bid; blk < NT / NTHREADS; blk += nb) {
        const int row = blk * NTHREADS + tid;
        const int t = row % TB;
        const bool active = !(l == 1 && t >= SEQ);
        __syncthreads();
        if (tid < 32) lcnt[tid] = 0;
        __syncthreads();
        int ei[4] = {0, 0, 0, 0}; float ev[4] = {0.f, 0.f, 0.f, 0.f}; int lr[4] = {0, 0, 0, 0};
        if (active) {
            float v[32];
#pragma unroll
            for (int q = 0; q < 8; ++q) {
                const float4 x4 = *(const float4*)(LG + (size_t)row * 32 + q * 4);
                v[q * 4] = x4.x; v[q * 4 + 1] = x4.y; v[q * 4 + 2] = x4.z; v[q * 4 + 3] = x4.w;
            }
#pragma unroll
            for (int k = 0; k < 4; ++k) {
                float best = -3.0e38f; int bi = 0;
#pragma unroll
                for (int e = 0; e < 32; ++e) { const bool tk = v[e] > best; best = tk ? v[e] : best; bi = tk ? e : bi; }
                ei[k] = bi; ev[k] = best;
#pragma unroll
                for (int e = 0; e < 32; ++e) v[e] = (e == bi) ? -3.0e38f : v[e];
            }
            const float e1 = __expf(ev[1] - ev[0]), e2 = __expf(ev[2] - ev[0]), e3 = __expf(ev[3] - ev[0]);
            const float inv = 1.0f / (1.0f + e1 + e2 + e3);
            ev[0] = inv; ev[1] = e1 * inv; ev[2] = e2 * inv; ev[3] = e3 * inv;
#pragma unroll
            for (int k = 0; k < 4; ++k) lr[k] = atomicAdd(&lcnt[ei[k]], 1);
        }
        __syncthreads();
        if (tid < 32) lbase[tid] = (lcnt[tid] > 0) ? atomicAdd(&cnt[tid], lcnt[tid]) : 0;
        __syncthreads();
        if (active) {
#pragma unroll
            for (int k = 0; k < 4; ++k) {
                const int pos = lbase[ei[k]] + lr[k];
                const int id = row * 4 + k;
                TOKL[(size_t)ei[k] * NT + pos] = id;
                ((float*)(ws + WS_GATEL))[(size_t)ei[k] * NT + pos] = ev[k];
            }
        }
    }
}

__device__ __forceinline__ void expert_prefix(const Args& a, int l, int* sm, int tid) {
    const int* cnt = (const int*)(wsp(a) + CNT_OFF) + l * 32;
    __syncthreads();
    if (tid == 0) {
        int tp = 0, rp = 0;
        for (int e = 0; e < 32; ++e) {
            const int cn = cnt[e];
            sm[e] = cn; sm[32 + e] = tp; sm[65 + e] = rp;
            tp += (cn + 255) >> 8; rp += cn;
        }
        sm[64] = tp; sm[97] = rp;
    }
    __syncthreads();
}

__device__ __forceinline__ void phase_gemm1(const Args& a, int l, char* smem, int tid, int bid, int nb) {
    unsigned char* ws = wsp(a);
    int* pre = (int*)(smem + LDS_MAIN);
    expert_prefix(a, l, pre, tid);
    const int wave = tid >> 6, lane = tid & 63, wm = wave >> 1, wn = wave & 1, g = lane >> 4, c = lane & 15;
    const int ntiles = pre[64] * 16;
    const int* TOKL = (const int*)(ws + WS_TOKL);
    const bfu* HI = (const bfu*)(ws + WS_H2HI);
    bfu* ACT = (bfu*)(ws + WS_ACT);
    for (int it = bid; it < ntiles; it += nb) {
        const int tix = it >> 4, nt = it & 15;
        int e = 0;
        while (pre[32 + e + 1] <= tix) ++e;
        const int mt = tix - pre[32 + e];
        const int cn = pre[e], rs = pre[65 + e];
        const int* tl = TOKL + (size_t)e * NT;
        int arow[4];
#pragma unroll
        for (int i = 0; i < 4; ++i) {
            int ri = mt * 256 + (tid >> 3) + 64 * i;
            ri = (ri < cn) ? ri : 0;
            arow[i] = tl[ri] >> 2;
        }
        f32x4 acc[4][4]; zero_acc<4>(acc);
        gemm_loop<4>(acc, HI, 1024, arow, (const bfu*)(ws + WS_W1T) + (size_t)(l * 32 + e) * 2048 * 1024, 1024, nt * 128, 1024, smem, tid);
        const float* b1 = a.in[30] + (size_t)(l * 32 + e) * 2048;
#pragma unroll
        for (int p = 0; p < 2; ++p) {
            const int acol = nt * 64 + wn * 32 + p * 16 + c;
            const float bg = b1[acol], bl = b1[1024 + acol];
#pragma unroll
            for (int mi = 0; mi < 4; ++mi)
#pragma unroll
                for (int r = 0; r < 4; ++r) {
                    const int grow = mt * 256 + wm * 64 + mi * 16 + g * 4 + r;
                    if (grow < cn) {
                        const float glu = fminf(acc[mi][2 * p][r] + bg, 7.0f);
                        const float lin = fminf(fmaxf(acc[mi][2 * p + 1][r] + bl, -7.0f), 7.0f);
                        ACT[(size_t)(rs + grow) * 1024 + acol] = f2bf(glu * sigmoidf_(1.702f * glu) * (lin + 1.0f));
                    }
                }
        }
    }
}

__device__ __forceinline__ void phase_gemm2(const Args& a, int l, char* smem, int tid, int bid, int nb) {
    unsigned char* ws = wsp(a);
    int* pre = (int*)(smem + LDS_MAIN);
    expert_prefix(a, l, pre, tid);
    const int wave = tid >> 6, lane = tid & 63, wm = wave >> 1, wn = wave & 1, g = lane >> 4, c = lane & 15;
    const int ntiles = pre[64] * 8;
    const int* TOKL = (const int*)(ws + WS_TOKL);
    const float* GATE = (const float*)(ws + WS_GATE);
    const bfu* ACT = (const bfu*)(ws + WS_ACT);
    bfu* YB = (bfu*)(ws + WS_YB);
    for (int it = bid; it < ntiles; it += nb) {
        const int tix = it >> 3, nt = it & 7;
        int e = 0;
        while (pre[32 + e + 1] <= tix) ++e;
        const int mt = tix - pre[32 + e];
        const int cn = pre[e], rs = pre[65 + e];
        const int* tl = TOKL + (size_t)e * NT;
        int arow[4];
#pragma unroll
        for (int i = 0; i < 4; ++i) {
            int ri = mt * 256 + (tid >> 3) + 64 * i;
            ri = (ri < cn) ? ri : (cn - 1);
            arow[i] = rs + ri;
        }
        f32x4 acc[4][4]; zero_acc<4>(acc);
        gemm_loop<4>(acc, ACT, 1024, arow, (const bfu*)(ws + WS_W2ET) + (size_t)(l * 32 + e) * 1024 * 1024, 1024, nt * 128, 1024, smem, tid);
        const float* b2 = a.in[32] + (size_t)(l * 32 + e) * 1024;
#pragma unroll
        for (int mi = 0; mi < 4; ++mi)
#pragma unroll
            for (int r = 0; r < 4; ++r) {
                const int grow = mt * 256 + wm * 64 + mi * 16 + g * 4 + r;
                if (grow < cn) {
                    const int id = tl[grow];
                    const float gate = GATE[id];
#pragma unroll
                    for (int ni = 0; ni < 4; ++ni) {
                        const int col = nt * 128 + wn * 64 + ni * 16 + c;
                        YB[(size_t)id * 1024 + col] = f2bf((acc[mi][ni][r] + b2[col]) * gate);
                    }
                }
            }
    }
}

struct EpiWout {
    static constexpr bool PERM = true;
    unsigned char* ws; int l;
    struct Pre {};
    __device__ __forceinline__ void preload(const g8::Unit&, Pre&, int, int, int, int) const {}
    __device__ __forceinline__ void operator()(const f32x4 (&acc)[2][2][4][2], const g8::Unit& u, const Pre& pre, int wr, int wc, int fr, int fq) const {
        bfu* xres = (bfu*)(ws + WS_XRES);
        const int rbase = u.pm * 256;
        const int b = rbase / TB, mm = ((rbase % TB) < SEQ) ? b : 8;
        const float* ga = (const float*)(ws + WS_MOD) + (size_t)(l * 9 + mm) * 6144 + 2 * 1024;
        const int col0 = u.pn * 256 + 32 * wc + 8 * fq;
        f32x4 gv[2][2];
#pragma unroll
        for (int bj = 0; bj < 2; ++bj)
#pragma unroll
            for (int n = 0; n < 2; ++n) gv[bj][n] = *(const f32x4*)(ga + col0 + bj * 128 + n * 4);
        uint4 xpa[2][4][2];
#pragma unroll
        for (int ai = 0; ai < 2; ++ai)
#pragma unroll
            for (int m = 0; m < 4; ++m)
#pragma unroll
                for (int bj = 0; bj < 2; ++bj) xpa[ai][m][bj] = *(const uint4*)(xres + (size_t)(rbase + ai * 128 + wr * 64 + m * 16 + fr) * 1024 + col0 + bj * 128);
#pragma unroll
        for (int ai = 0; ai < 2; ++ai) {
#pragma unroll
            for (int m = 0; m < 4; ++m) {
                bfu* rp = xres + (size_t)(rbase + ai * 128 + wr * 64 + m * 16 + fr) * 1024 + col0;
#pragma unroll
                for (int bj = 0; bj < 2; ++bj) {
                    const uint4 xp = xpa[ai][m][bj];
                    f32x4 x0 = {bflo(xp.x), bfhi(xp.x), bflo(xp.y), bfhi(xp.y)}, x1 = {bflo(xp.z), bfhi(xp.z), bflo(xp.w), bfhi(xp.w)};
                    x0 += gv[bj][0] * acc[ai][bj][m][0]; x1 += gv[bj][1] * acc[ai][bj][m][1];
                    const uint2 lo = pack4(x0), hi = pack4(x1);
                    *(uint4*)(rp + bj * 128) = make_uint4(lo.x, lo.y, hi.x, hi.y);
                }
            }
        }
    }
};
__device__ __forceinline__ void phase_wout8(const Args& a, int l, char* smem, int tid, int bid, int nb) {
    SchedDense S;
    S.A = (const char*)(wsp(a) + WS_GL); S.B = (const char*)(wsp(a) + WS_WOT) + (size_t)l * 1024 * 3072 * 2;
    S.lda = 3072; S.ldb = 3072; S.nM = 64; S.nN = 4; S.G = nb; S.c = bid; S.skip9 = 1;
    EpiWout E; E.ws = wsp(a); E.l = l;
    g8::gemm8((LAS unsigned char*)smem, S, E, 1024, tid);
    if (l == 0) {
        unsigned char* ws = wsp(a);
        const int wave = tid >> 6, lane = tid & 63, wm = wave >> 1, wn = wave & 1, g = lane >> 4, c = lane & 15;
        bfu* xres = (bfu*)(ws + WS_XRES);
        const float* ga = (const float*)(ws + WS_MOD) + (size_t)(l * 9 + 8) * 6144 + 2 * 1024;
        __syncthreads();
        for (int it = bid; it < 128; it += nb) {
            const int mt = (it >> 4) * 9 + 8, nt = it & 15;
            const int m0 = mt * 256, n0 = nt * 64;
            int arow[4]; ident_rows(arow, m0, tid);
            f32x4 acc[4][2]; zero_acc<2>(acc);
            gemm_loop<2>(acc, (const bfu*)(ws + WS_MB), 1024, arow, (const bfu*)(ws + WS_WOT) + (size_t)l * 1024 * 3072, 3072, n0, 1024, smem, tid);
            const int rowbase = m0 + wm * 64, colbase = n0 + wn * 32;
            bfu xo[2][4][4];
#pragma unroll
            for (int ni = 0; ni < 2; ++ni)
#pragma unroll
                for (int mi = 0; mi < 4; ++mi)
#pragma unroll
                    for (int r = 0; r < 4; ++r) xo[ni][mi][r] = xres[(size_t)(rowbase + mi * 16 + g * 4 + r) * 1024 + colbase + ni * 16 + c];
#pragma unroll
            for (int ni = 0; ni < 2; ++ni) {
                const int col = colbase + ni * 16 + c;
                const float gac = ga[col];
#pragma unroll
                for (int mi = 0; mi < 4; ++mi)
#pragma unroll
                    for (int r = 0; r < 4; ++r) {
                        const int row = rowbase + mi * 16 + g * 4 + r;
                        xres[(size_t)row * 1024 + col] = f2bf(bf2f(xo[ni][mi][r]) + gac * acc[mi][ni][r]);
                    }
            }
        }
    }
}

struct SchedMerge {
    static constexpr bool GATHER = false; static constexpr bool UNITK = false;
    unsigned char* ws; int l, lda, ldb, nM, G, c, skip9;
    __device__ __forceinline__ bool next(int i, g8::Unit& u) const {
        const int j = i / 3, n = g8::uni(i - 3 * j);
        int pm, pn; if (!g8::static_tile(j, G, c, nM, 4, pm, pn)) return false;
        if (skip9) pm += pm >> 3;
        pm = g8::uni(pm); pn = g8::uni(pn);
        u.pm = pm; u.pn = pn; u.e = n; u.cn = 0;
        u.A = (const char*)(ws + WS_ODA) + ((size_t)n * NT * 512 + (size_t)pm * 256 * 512) * 2;
        u.B = (const char*)(ws + WS_WBT) + ((size_t)(l * 3 + n) * 1024 * 512 + (size_t)pn * 256 * 512) * 2;
        return true;
    }
    __device__ __forceinline__ void rows(const g8::Unit&, int, int&) const {}
};
struct EpiMerge {
    static constexpr bool PERM = true;
    unsigned char* ws;
    struct Pre {};
    __device__ __forceinline__ void preload(const g8::Unit&, Pre&, int, int, int, int) const {}
    __device__ __forceinline__ void operator()(const f32x4 (&acc)[2][2][4][2], const g8::Unit& u, const Pre& pre, int wr, int wc, int fr, int fq) const {
        bfu* GL = (bfu*)(ws + WS_GL);
        const int col0 = u.pn * 256 + 32 * wc + 8 * fq;
        const int go = u.e * 1024;
        const bool first = (u.e == 0);
#pragma unroll
        for (int ai = 0; ai < 2; ++ai) {
            uint4 gpa[4][2], zpa[4][2];
#pragma unroll
            for (int m = 0; m < 4; ++m) {
                const bfu* rp = GL + (size_t)(u.pm * 256 + ai * 128 + wr * 64 + m * 16 + fr) * 3072 + col0;
#pragma unroll
                for (int bj = 0; bj < 2; ++bj) {
                    gpa[m][bj] = *(const uint4*)(rp + go + bj * 128);
                    zpa[m][bj] = make_uint4(0u, 0u, 0u, 0u);
                    if (!first) zpa[m][bj] = *(const uint4*)(rp + bj * 128);
                }
            }
#pragma unroll
            for (int m = 0; m < 4; ++m) {
                bfu* rp = GL + (size_t)(u.pm * 256 + ai * 128 + wr * 64 + m * 16 + fr) * 3072 + col0;
#pragma unroll
                for (int bj = 0; bj < 2; ++bj) {
                    const uint4 gp = gpa[m][bj], zp = zpa[m][bj];
                    f32x4 v0 = acc[ai][bj][m][0], v1 = acc[ai][bj][m][1];
                    v0[0] = v0[0] * bflo(gp.x) + bflo(zp.x); v0[1] = v0[1] * bfhi(gp.x) + bfhi(zp.x); v0[2] = v0[2] * bflo(gp.y) + bflo(zp.y); v0[3] = v0[3] * bfhi(gp.y) + bfhi(zp.y);
                    v1[0] = v1[0] * bflo(gp.z) + bflo(zp.z); v1[1] = v1[1] * bfhi(gp.z) + bfhi(zp.z); v1[2] = v1[2] * bflo(gp.w) + bflo(zp.w); v1[3] = v1[3] * bfhi(gp.w) + bfhi(zp.w);
                    const uint2 lo = pack4(v0), hi = pack4(v1);
                    *(uint4*)(rp + bj * 128) = make_uint4(lo.x, lo.y, hi.x, hi.y);
                }
            }
        }
    }
};
__device__ __forceinline__ void phase_merge8(const Args& a, int l, char* smem, int tid, int bid, int nb) {
    SchedMerge S; S.ws = wsp(a); S.l = l; S.lda = 512; S.ldb = 512; S.nM = 64; S.G = nb; S.c = bid; S.skip9 = 1;
    EpiMerge E; E.ws = wsp(a);
    g8::gemm8((LAS unsigned char*)smem, S, E, 512, tid);
    if (l == 0) {
        unsigned char* ws = wsp(a);
        const int wave = tid >> 6, lane = tid & 63, wm = wave >> 1, wn = wave & 1, g = lane >> 4, c = lane & 15;
        const bfu* GL = (const bfu*)(ws + WS_GL);
        bfu* MB = (bfu*)(ws + WS_MB);
        __syncthreads();
        for (int it = bid; it < 128; it += nb) {
            const int mt = (it >> 4) * 9 + 8, nt = it & 15;
            const int m0 = mt * 256, n0 = nt * 64;
            int arow[4]; ident_rows(arow, m0, tid);
            const int rowbase = m0 + wm * 64, colbase = n0 + wn * 32;
            f32x4 tot[4][2]; zero_acc<2>(tot);
            for (int n = 0; n < 3; ++n) {
                f32x4 acc[4][2]; zero_acc<2>(acc);
                gemm_loop<2>(acc, (const bfu*)(ws + WS_ODA) + (size_t)n * NT * 512, 512, arow,
                             (const bfu*)(ws + WS_WBT) + (size_t)(l * 3 + n) * 1024 * 512, 512, n0, 512, smem, tid);
#pragma unroll
                for (int mi = 0; mi < 4; ++mi)
#pragma unroll
                    for (int ni = 0; ni < 2; ++ni)
#pragma unroll
                        for (int r = 0; r < 4; ++r) {
                            const int row = rowbase + mi * 16 + g * 4 + r;
                            const float gate = bf2f(GL[(size_t)row * 3072 + n * 1024 + colbase + ni * 16 + c]);
                            tot[mi][ni][r] += gate * acc[mi][ni][r];
                        }
            }
#pragma unroll
            for (int mi = 0; mi < 4; ++mi)
#pragma unroll
                for (int ni = 0; ni < 2; ++ni)
#pragma unroll
                    for (int r = 0; r < 4; ++r) {
                        const int row = rowbase + mi * 16 + g * 4 + r;
                        MB[(size_t)row * 1024 + colbase + ni * 16 + c] = f2bf(tot[mi][ni][r]);
                    }
        }
    }
}

constexpr int N2_RPW = 9;
#ifndef N2_SWAP16
#define N2_SWAP16 1
#endif
__device__ __forceinline__ float rowmax16(float x) {
    x = fmaxf(x, dppf<0xB1>(x)); x = fmaxf(x, dppf<0x4E>(x)); x = fmaxf(x, dppf<0x124>(x)); x = fmaxf(x, dppf<0x128>(x));
    return x;
}
__device__ __forceinline__ void phase_n2rt(const Args& a, int l, char* smem, int tid, int bid, int nb) {
    unsigned char* ws = wsp(a);
    const int wave = tid >> 6, lane = tid & 63;
    float* RT = (float*)smem;
    int* lcnt = (int*)(smem + LDS_MAIN);
    int* lbase = lcnt + 32;
    int* rec_e = (int*)(smem + LDS_MAIN + 512);
    int* rec_r = rec_e + NW * N2_RPW * 4;
    float* rec_g = (float*)(rec_r + NW * N2_RPW * 4);
    const bfu* xres = (const bfu*)(ws + WS_XRES);
    bfu* H = (bfu*)(ws + WS_H);
    const float* mod = (const float*)(ws + WS_MOD);
    int* cnt = (int*)(ws + CNT_OFF) + l * 32;
    int* TOKL = (int*)(ws + WS_TOKL);
    float* GATEL = (float*)(ws + WS_GATEL);
    __syncthreads();
    const int stride = nb * NW;
    uint2 vn[4];
    bool have_first = false;
    if (bid * NW + wave < NT) {
#pragma unroll
        for (int i = 0; i < 4; ++i) vn[i] = *(const uint2*)(xres + (size_t)(bid * NW + wave) * 1024 + i * 256 + lane * 4);
        have_first = true;
    }
    {
        const float* Rs = a.in[27] + (size_t)l * 1024 * 32;
#pragma unroll
        for (int hb = 0; hb < 2; ++hb) {
            float4 rr[8];
#pragma unroll
            for (int q = 0; q < 8; ++q) { const int idx = tid + (hb * 8 + q) * NTHREADS; const int k = idx & 1023, e4 = idx >> 10; rr[q] = *(const float4*)(Rs + (size_t)k * 32 + e4 * 4); }
#pragma unroll
            for (int q = 0; q < 8; ++q) { const int idx = tid + (hb * 8 + q) * NTHREADS; const int k = idx & 1023, e4 = idx >> 10; const float4 r = rr[q];
                RT[(e4 * 4 + 0) * 1024 + k] = r.x; RT[(e4 * 4 + 1) * 1024 + k] = r.y; RT[(e4 * 4 + 2) * 1024 + k] = r.z; RT[(e4 * 4 + 3) * 1024 + k] = r.w; }
        }
    }
    const float bias = a.in[28][l * 32 + (lane >> 1)];
    const bool b5 = (lane & 32) != 0, b4 = (lane & 16) != 0, b3 = (lane & 8) != 0, b2 = (lane & 4) != 0, b1 = (lane & 2) != 0;
    for (int r0 = bid * NW + wave; r0 - wave - bid * NW < NT; r0 += N2_RPW * stride) {
        __syncthreads();
        if (tid < 32) lcnt[tid] = 0;
        __syncthreads();
        if (!have_first && r0 < NT) {
#pragma unroll
            for (int i = 0; i < 4; ++i) vn[i] = *(const uint2*)(xres + (size_t)r0 * 1024 + i * 256 + lane * 4);
        }
        have_first = false;
        for (int kk = 0; kk < N2_RPW; ++kk) {
            const int row = r0 + kk * stride;
            if (row >= NT) { if (lane < 4) rec_e[(wave * N2_RPW + kk) * 4 + lane] = -1; continue; }
            const int b = row / TB, t = row % TB;
            float v[16];
#pragma unroll
            for (int i = 0; i < 4; ++i) { v[i * 4 + 0] = bflo(vn[i].x); v[i * 4 + 1] = bfhi(vn[i].x); v[i * 4 + 2] = bflo(vn[i].y); v[i * 4 + 3] = bfhi(vn[i].y); }
            if (kk + 1 < N2_RPW && row + stride < NT) {
#pragma unroll
                for (int i = 0; i < 4; ++i) vn[i] = *(const uint2*)(xres + (size_t)(row + stride) * 1024 + i * 256 + lane * 4);
            }
            if (l == 1 && t >= SEQ) { if (lane < 4) rec_e[(wave * N2_RPW + kk) * 4 + lane] = -1; continue; }
            const int m = (t < SEQ) ? b : 8;
            const float* md = mod + (size_t)(l * 9 + m) * 6144;
            float y[16];
            norm_mod(v, y, a.in[7] + l * 1024, md + 3 * 1024, md + 4 * 1024, lane);
            store_h_row(H + (size_t)row * 1024, y, lane);
            f32x2_t acc2[32];
#pragma unroll
            for (int e = 0; e < 32; ++e) acc2[e] = (f32x2_t){0.f, 0.f};
            {
                const float* rp = RT + lane * 4;
                f32x4 ra[6], rb[6];
#define N2_LD(dst, bt) do { _Pragma("unroll") for (int q = 0; q < 6; ++q) { const int pe = (bt) * 6 + q; if (pe < 128) dst[q] = *(const f32x4*)(rp + (pe & 31) * 1024 + (pe >> 5) * 256); } } while (0)
#define N2_FM(src, bt) do { _Pragma("unroll") for (int q = 0; q < 6; ++q) { const int pe = (bt) * 6 + q; if (pe < 128) { const int e = pe & 31, i_ = pe >> 5; \
                    const f32x2_t y01 = {y[i_ * 4 + 0], y[i_ * 4 + 1]}, y23 = {y[i_ * 4 + 2], y[i_ * 4 + 3]}; const f32x2_t r01 = {src[q][0], src[q][1]}, r23 = {src[q][2], src[q][3]}; \
                    acc2[e] = y01 * r01 + acc2[e]; acc2[e] = y23 * r23 + acc2[e]; } } } while (0)
                N2_LD(ra, 0);
#pragma unroll
                for (int bt = 0; bt < 22; bt += 2) {
                    N2_LD(rb, bt + 1);
                    __builtin_amdgcn_sched_barrier(0);
                    N2_FM(ra, bt);
                    __builtin_amdgcn_sched_barrier(0);
                    if (bt + 2 < 22) N2_LD(ra, bt + 2);
                    __builtin_amdgcn_sched_barrier(0);
                    N2_FM(rb, bt + 1);
                    __builtin_amdgcn_sched_barrier(0);
                }
#undef N2_LD
#undef N2_FM
            }
            float acc[32];
#pragma unroll
            for (int e = 0; e < 32; ++e) acc[e] = acc2[e][0] + acc2[e][1];
            float S[16], U[8], T4[4], W2[2];
#pragma unroll
            for (int j = 0; j < 16; ++j) {
                const auto r = __builtin_amdgcn_permlane32_swap(__float_as_uint(acc[j]), __float_as_uint(acc[16 + j]), false, false);
                S[j] = __uint_as_float(r[0]) + __uint_as_float(r[1]);
            }
#pragma unroll
            for (int j = 0; j < 8; ++j) {
#if N2_SWAP16
                const auto r = __builtin_amdgcn_permlane16_swap(__float_as_uint(S[j]), __float_as_uint(S[8 + j]), false, false);
                U[j] = __uint_as_float(r[0]) + __uint_as_float(r[1]);
#else
                const float keep = b4 ? S[8 + j] : S[j], send = b4 ? S[j] : S[8 + j];
                U[j] = keep + shx_(send, 16);
#endif
            }
#pragma unroll
            for (int j = 0; j < 4; ++j) { const float keep = b3 ? U[4 + j] : U[j], send = b3 ? U[j] : U[4 + j]; T4[j] = keep + dppf<0x128>(send); }
#pragma unroll
            for (int j = 0; j < 2; ++j) { const float keep = b2 ? T4[2 + j] : T4[j], send = b2 ? T4[j] : T4[2 + j]; W2[j] = keep + shx_(send, 4); }
            float X;
            { const float keep = b1 ? W2[1] : W2[0], send = b1 ? W2[0] : W2[1]; X = keep + dppf<0x4E>(send); }
            X += dppf<0xB1>(X);
            float lg = X + bias;
            int ei[4]; float ev[4];
#pragma unroll
            for (int k = 0; k < 4; ++k) {
                const float rm = rowmax16(lg);
                const float m0 = __int_as_float(__builtin_amdgcn_readlane(__float_as_int(rm), 0)), m1 = __int_as_float(__builtin_amdgcn_readlane(__float_as_int(rm), 16));
                const float m2 = __int_as_float(__builtin_amdgcn_readlane(__float_as_int(rm), 32)), m3 = __int_as_float(__builtin_amdgcn_readlane(__float_as_int(rm), 48));
                const float mx = fmaxf(fmaxf(m0, m1), fmaxf(m2, m3));
                const unsigned long long bm = __ballot(lg == mx);
                const int e = (__ffsll((long long)bm) - 1) >> 1;
                ei[k] = e; ev[k] = mx;
                lg = ((lane >> 1) == e) ? -3.0e38f : lg;
            }
            const float e1 = __expf(ev[1] - ev[0]), e2 = __expf(ev[2] - ev[0]), e3 = __expf(ev[3] - ev[0]);
            const float inv = 1.0f / (1.0f + e1 + e2 + e3);
            if (lane < 4) {
                const int es = (lane == 0) ? ei[0] : (lane == 1) ? ei[1] : (lane == 2) ? ei[2] : ei[3];
                const float gs = ((lane == 0) ? 1.0f : (lane == 1) ? e1 : (lane == 2) ? e2 : e3) * inv;
                const int lr = atomicAdd(&lcnt[es], 1);
                const int ro = (wave * N2_RPW + kk) * 4 + lane;
                rec_e[ro] = es; rec_r[ro] = lr; rec_g[ro] = gs;
            }
        }
        __syncthreads();
        if (tid < 32) lbase[tid] = (lcnt[tid] > 0) ? atomicAdd(&cnt[tid], lcnt[tid]) : 0;
        __syncthreads();
        if (lane < N2_RPW * 4) {
            const int kk = lane >> 2, k = lane & 3;
            const int ro = (wave * N2_RPW + kk) * 4 + k;
            const int e = rec_e[ro];
            if (e >= 0) {
                const int row = r0 + kk * stride;
                const int pos = lbase[e] + rec_r[ro];
                TOKL[(size_t)e * NT + pos] = row * 4 + k;
                GATEL[(size_t)e * NT + pos] = rec_g[ro];
            }
        }
    }
}

struct SchedG1 {
    static constexpr bool GATHER = true; static constexpr bool UNITK = false;
    unsigned char* ws; const int* pre; int l, lda, ldb, G, c; mutable int hint;
    __device__ __forceinline__ bool next(int i, g8::Unit& u) const {
        const int total = pre[64] * 8;
        const long L0 = (long)i * G + c; if (L0 >= total) return false;
        int L = (int)L0; { const int q = total / 8, r = total % 8, xcd = L % 8, off = L / 8; L = (xcd < r ? xcd * (q + 1) : r * (q + 1) + (xcd - r) * q) + off; }
        const int tix = g8::uni(L >> 3), pn = g8::uni(L & 7);
        int e = (pre[32 + hint] <= tix) ? hint : 0; while (pre[32 + e + 1] <= tix) ++e;
        e = g8::uni(e); hint = e;
        u.e = e; u.cn = g8::uni(pre[e]); u.pm = g8::uni(tix - pre[32 + e]); u.pn = pn;
        u.A = (const char*)(ws + WS_H);
        u.B = (const char*)(ws + WS_W1T) + ((size_t)(l * 32 + e) * 2048 + (size_t)pn * 256) * 1024 * 2;
        return true;
    }
    __device__ __forceinline__ void rows(const g8::Unit& u, int r, int& idx) const {
        int ri = u.pm * 256 + r; ri = (ri < u.cn) ? ri : 0;
        idx = ((const int*)(ws + WS_TOKL))[(size_t)u.e * NT + ri] >> 2;
    }
};
struct EpiG1 {
    static constexpr bool PERM = true;
    unsigned char* ws; const int* pre; const float* b1l;
    struct Pre { f32x4 bg[2], bl[2]; };
    __device__ __forceinline__ void preload(const g8::Unit& u, Pre& p, int wr, int wc, int fr, int fq) const {
        const float* b1 = b1l + (size_t)u.e * 2048;
        const int ac0 = u.pn * 128 + 32 * wc + 8 * fq;
#pragma unroll
        for (int n = 0; n < 2; ++n) { p.bg[n] = *(const f32x4*)(b1 + ac0 + 4 * n); p.bl[n] = *(const f32x4*)(b1 + 1024 + ac0 + 4 * n); }
    }
    __device__ __forceinline__ void operator()(const f32x4 (&acc)[2][2][4][2], const g8::Unit& u, const Pre& pl, int wr, int wc, int fr, int fq) const {
        bfu* ACT = (bfu*)(ws + WS_ACT);
        const float* b1 = b1l + (size_t)u.e * 2048;
        const size_t rbase = (size_t)(pre[32 + u.e] + u.pm) * 256 + wr * 64 + fr;
        const int ac0 = u.pn * 128 + 32 * wc + 8 * fq;
        f32x4 bg[2], bl[2];
#pragma unroll
        for (int n = 0; n < 2; ++n) { bg[n] = pl.bg[n]; bl[n] = pl.bl[n] + 1.0f; }
#pragma unroll
        for (int ai = 0; ai < 2; ++ai)
#pragma unroll
            for (int m = 0; m < 4; ++m) {
                uint2 pk[2];
#pragma unroll
                for (int n = 0; n < 2; ++n) {
                    f32x4 o;
#pragma unroll
                    for (int j = 0; j < 4; j += 2) {
                        f32x2_t g2 = (f32x2_t){acc[ai][0][m][n][j], acc[ai][0][m][n][j + 1]} + (f32x2_t){bg[n][j], bg[n][j + 1]};
                        f32x2_t l2 = (f32x2_t){acc[ai][1][m][n][j], acc[ai][1][m][n][j + 1]} + (f32x2_t){bl[n][j], bl[n][j + 1]};
                        g2[0] = fminf(g2[0], 7.0f); g2[1] = fminf(g2[1], 7.0f);
                        l2[0] = __builtin_amdgcn_fmed3f(l2[0], -6.0f, 8.0f); l2[1] = __builtin_amdgcn_fmed3f(l2[1], -6.0f, 8.0f);
                        const f32x2_t t2 = g2 * (-1.702f * 1.4426950408889634f);
                        f32x2_t d2 = (f32x2_t){__builtin_amdgcn_exp2f(t2[0]), __builtin_amdgcn_exp2f(t2[1])} + 1.0f;
                        const f32x2_t s2 = {__builtin_amdgcn_rcpf(d2[0]), __builtin_amdgcn_rcpf(d2[1])};
                        const f32x2_t o2 = (g2 * s2) * l2;
                        o[j] = o2[0]; o[j + 1] = o2[1];
                    }
                    pk[n] = pack4(o);
                }
                *(uint4*)(ACT + (rbase + ai * 128 + m * 16) * 1024 + ac0) = make_uint4(pk[0].x, pk[0].y, pk[1].x, pk[1].y);
            }
    }
};
struct SchedG2 {
    static constexpr bool GATHER = false; static constexpr bool UNITK = false;
    unsigned char* ws; const int* pre; int l, lda, ldb, G, c; mutable int hint;
    __device__ __forceinline__ bool next(int i, g8::Unit& u) const {
        const int total = pre[64] * 4;
        const long L0 = (long)i * G + c; if (L0 >= total) return false;
        int L = (int)L0; { const int q = total / 8, r = total % 8, xcd = L % 8, off = L / 8; L = (xcd < r ? xcd * (q + 1) : r * (q + 1) + (xcd - r) * q) + off; }
        const int tix = g8::uni(L >> 2), pn = g8::uni(L & 3);
        int e = (pre[32 + hint] <= tix) ? hint : 0; while (pre[32 + e + 1] <= tix) ++e;
        e = g8::uni(e); hint = e;
        u.e = e; u.cn = g8::uni(pre[e]); u.pm = g8::uni(tix - pre[32 + e]); u.pn = pn;
        u.A = (const char*)(ws + WS_ACT) + (size_t)tix * 256 * 1024 * 2;
        u.B = (const char*)(ws + WS_W2ET) + ((size_t)(l * 32 + e) * 1024 + (size_t)pn * 256) * 1024 * 2;
        return true;
    }
    __device__ __forceinline__ void rows(const g8::Unit&, int, int&) const {}
};
struct EpiG2 {
    static constexpr bool PERM = true;
    unsigned char* ws; const float* b2l;
    struct Pre { f32x4 bv[2][2]; int ids[2][4]; float gts[2][4]; };
    __device__ __forceinline__ void preload(const g8::Unit& u, Pre& p, int wr, int wc, int fr, int fq) const {
        const int* tl = (const int*)(ws + WS_TOKL) + (size_t)u.e * NT;
        const float* gl = (const float*)(ws + WS_GATEL) + (size_t)u.e * NT;
        const float* b2 = b2l + (size_t)u.e * 1024;
        const int col0 = u.pn * 256 + 32 * wc + 8 * fq;
#pragma unroll
        for (int bj = 0; bj < 2; ++bj)
#pragma unroll
            for (int n = 0; n < 2; ++n) p.bv[bj][n] = *(const f32x4*)(b2 + col0 + bj * 128 + n * 4);
#pragma unroll
        for (int ai = 0; ai < 2; ++ai)
#pragma unroll
            for (int m = 0; m < 4; ++m) {
                int ri = u.pm * 256 + ai * 128 + wr * 64 + m * 16 + fr; ri = (ri < u.cn) ? ri : 0;
                p.ids[ai][m] = tl[ri]; p.gts[ai][m] = gl[ri];
            }
    }
    __device__ __forceinline__ void operator()(const f32x4 (&acc)[2][2][4][2], const g8::Unit& u, const Pre& pre, int wr, int wc, int fr, int fq) const {
        bfu* YB = (bfu*)(ws + WS_YB);
        const int* tl = (const int*)(ws + WS_TOKL) + (size_t)u.e * NT;
        const float* gl = (const float*)(ws + WS_GATEL) + (size_t)u.e * NT;
        const float* b2 = b2l + (size_t)u.e * 1024;
        const int col0 = u.pn * 256 + 32 * wc + 8 * fq;
#pragma unroll
        for (int ai = 0; ai < 2; ++ai)
#pragma unroll
            for (int m = 0; m < 4; ++m) {
                const int ri = u.pm * 256 + ai * 128 + wr * 64 + m * 16 + fr;
                if (ri < u.cn) {
                    const float gate = pre.gts[ai][m];
                    bfu* rp = YB + (size_t)pre.ids[ai][m] * 1024 + col0;
#pragma unroll
                    for (int bj = 0; bj < 2; ++bj) {
                        const uint2 lo = pack4((acc[ai][bj][m][0] + pre.bv[bj][0]) * gate), hi = pack4((acc[ai][bj][m][1] + pre.bv[bj][1]) * gate);
                        *(uint4*)(rp + bj * 128) = make_uint4(lo.x, lo.y, hi.x, hi.y);
                    }
                }
            }
    }
};
__device__ __forceinline__ void expert_prefix8(const Args& a, int l, int* sm, int tid) {
    const int* cnt = (const int*)(wsp(a) + CNT_OFF) + l * 32;
    __syncthreads();
    if (tid == 0) {
        int tp = 0;
        for (int e = 0; e < 32; ++e) { const int cn = cnt[e]; sm[e] = cn; sm[32 + e] = tp; tp += (cn + 255) >> 8; }
        sm[64] = tp;
    }
    __syncthreads();
}
__device__ __forceinline__ void phase_gemm1_8(const Args& a, int l, char* smem, int tid, int bid, int nb) {
    int* pre = (int*)(smem + LDS_MAIN);
    expert_prefix8(a, l, pre, tid);
    SchedG1 S; S.ws = wsp(a); S.pre = pre; S.l = l; S.lda = 1024; S.ldb = 1024; S.G = nb; S.c = bid; S.hint = 0;
    EpiG1 E; E.ws = wsp(a); E.pre = pre; E.b1l = a.in[30] + (size_t)l * 32 * 2048;
    g8::gemm8((LAS unsigned char*)smem, S, E, 1024, tid);
}
__device__ __forceinline__ void phase_gemm2_8(const Args& a, int l, char* smem, int tid, int bid, int nb) {
    int* pre = (int*)(smem + LDS_MAIN);
    expert_prefix8(a, l, pre, tid);
    SchedG2 S; S.ws = wsp(a); S.pre = pre; S.l = l; S.lda = 1024; S.ldb = 1024; S.G = nb; S.c = bid; S.hint = 0;
    EpiG2 E; E.ws = wsp(a); E.b2l = a.in[32] + (size_t)l * 32 * 1024;
    g8::gemm8((LAS unsigned char*)smem, S, E, 1024, tid);
}

struct EpiS2 {
    static constexpr bool PERM = true;
    unsigned char* ws; const float* w0; const float* a0;
    struct Pre { f32x4 bv[2][2]; };
    __device__ __forceinline__ void preload(const g8::Unit& u, Pre& p, int wr, int wc, int fr, int fq) const {
        const int kind = u.pn >> 1;
        const int col0 = (u.pn & 1) * 256 + 32 * wc + 8 * fq;
        const float* bias = (kind < 2) ? w0 + kind * 512 : a0 + ((kind - 2) & 1) * 512;
#pragma unroll
        for (int bj = 0; bj < 2; ++bj)
#pragma unroll
            for (int n = 0; n < 2; ++n) p.bv[bj][n] = *(const f32x4*)(bias + col0 + bj * 128 + n * 4);
    }
    __device__ __forceinline__ void operator()(const f32x4 (&acc)[2][2][4][2], const g8::Unit& u, const Pre& pre, int wr, int wc, int fr, int fq) const {
        const int kind = u.pn >> 1;
        const int col0 = (u.pn & 1) * 256 + 32 * wc + 8 * fq;
        bfu* dst; const float* bias = nullptr;
        if (kind < 2) { dst = (bfu*)(ws + WS_WDEC) + (size_t)kind * NT * 512; bias = w0 + kind * 512; }
        else if (kind < 4) { dst = (bfu*)(ws + WS_BV) + (size_t)(kind - 2) * NT * 512; bias = a0 + (kind - 2) * 512; }
        else dst = (bfu*)(ws + WS_GG);
        f32x4 bv[2][2];
#pragma unroll
        for (int bj = 0; bj < 2; ++bj)
#pragma unroll
            for (int n = 0; n < 2; ++n) bv[bj][n] = bias ? pre.bv[bj][n] : (f32x4){0.f, 0.f, 0.f, 0.f};
#pragma unroll
        for (int ai = 0; ai < 2; ++ai)
#pragma unroll
            for (int m = 0; m < 4; ++m) {
                bfu* d = dst + (size_t)(u.pm * 256 + ai * 128 + wr * 64 + m * 16 + fr) * 512 + col0;
#pragma unroll
                for (int bj = 0; bj < 2; ++bj) {
                    uint2 pk[2];
#pragma unroll
                    for (int n = 0; n < 2; ++n) {
                        f32x4 v = acc[ai][bj][m][n] + bv[bj][n];
                        pk[n] = pack4(v);
                    }
                    *(uint4*)(d + bj * 128) = make_uint4(pk[0].x, pk[0].y, pk[1].x, pk[1].y);
                }
            }
    }
};
struct SchedS2 {
    static constexpr bool GATHER = false; static constexpr bool UNITK = true;
    const char* A; const char* B; int lda, ldb, nM, nN, G, c;
    __device__ __forceinline__ bool next(int i, g8::Unit& u) const {
        int pm, pn; if (!g8::static_tile(i, G, c, nM, nN, pm, pn)) return false;
        pm = g8::uni(pm); pn = g8::uni(pn);
        const int ko = (pn >= 8) ? 512 : (pn >> 2) * 256;
        u.pm = pm; u.pn = pn; u.e = 0; u.cn = (pn >= 8) ? 4 : 2;
        u.A = A + (size_t)pm * 256 * lda * 2 + ko; u.B = B + (size_t)pn * 256 * ldb * 2 + ko; return true;
    }
    __device__ __forceinline__ void rows(const g8::Unit&, int, int&) const {}
};
__device__ __forceinline__ void phase_stage2_8(const Args& a, int l, char* smem, int tid, int bid, int nb) {
    unsigned char* ws = wsp(a);
    {
        SchedS2 S;
        S.A = (const char*)(ws + WS_LORA); S.B = (const char*)(ws + WS_S2T) + (size_t)l * 2560 * 512 * 2;
        S.lda = 512; S.ldb = 512; S.nM = 72; S.nN = 10; S.G = nb; S.c = bid;
        EpiS2 E; E.ws = ws; E.w0 = a.in[12] + l * 1024; E.a0 = a.in[15] + l * 1024;
        int k2 = 256; asm volatile("" : "+s"(k2));
        g8::gemm8((LAS unsigned char*)smem, S, E, k2, tid);
    }
    {
        const bfu* SB = (const bfu*)(ws + WS_SB);
        const bfu* SG = SB + (size_t)NT * 512;
        const bfu* SX = SG + (size_t)NT * 512;
        bfu* OSC = (bfu*)(ws + WS_ODA) + (size_t)NT * 512;
        const float* cw = a.in[11] + l * 3 * 512;
        const int cstride = nb * NTHREADS;
        int i = bid * NTHREADS + tid;
        uint4 ng[3], nx_[3], nb_;
#define CV_LOAD(i_) do { const int row_ = (i_) >> 6, c8_ = ((i_) & 63) * 8; const int t_ = row_ % TB; \
            const bool hp_ = (t_ != 0 && t_ != SEQ), hn_ = (t_ != SEQ - 1 && t_ != TB - 1); \
            _Pragma("unroll") for (int j = 0; j < 3; ++j) { const bool ok_ = (j == 1) || (j == 0 ? hp_ : hn_); \
                const size_t o_ = (size_t)(ok_ ? row_ + j - 1 : row_) * 512 + c8_; ng[j] = *(const uint4*)(SG + o_); nx_[j] = *(const uint4*)(SX + o_); } \
            nb_ = *(const uint4*)(SB + (size_t)row_ * 512 + c8_); } while (0)
        float cwr[3][8];
#pragma unroll
        for (int j = 0; j < 3; ++j) {
            const float4 c0 = *(const float4*)(cw + j * 512 + (tid & 63) * 8), c1 = *(const float4*)(cw + j * 512 + (tid & 63) * 8 + 4);
            cwr[j][0] = c0.x; cwr[j][1] = c0.y; cwr[j][2] = c0.z; cwr[j][3] = c0.w; cwr[j][4] = c1.x; cwr[j][5] = c1.y; cwr[j][6] = c1.z; cwr[j][7] = c1.w;
        }
        if (i < NT * 64) CV_LOAD(i);
        for (; i < NT * 64; i += cstride) {
            const int row = i >> 6, c8 = (i & 63) * 8;
            const int t = row % TB;
            uint4 cg[3], cx_[3];
#pragma unroll
            for (int j = 0; j < 3; ++j) { cg[j] = ng[j]; cx_[j] = nx_[j]; }
            const uint4 pb = nb_;
            if (i + cstride < NT * 64) CV_LOAD(i + cstride);
            if (l == 1 && t >= SEQ) continue;
            const bool hasp = (t != 0 && t != SEQ);
            const bool hasn = (t != SEQ - 1 && t != TB - 1);
            float u[3][8];
#pragma unroll
            for (int j = 0; j < 3; ++j) {
                const bool ok = (j == 1) || (j == 0 ? hasp : hasn);
                if (ok) {
                    const uint4 pg = cg[j], px = cx_[j];
                    u[j][0] = bflo(pg.x) * bflo(px.x); u[j][1] = bfhi(pg.x) * bfhi(px.x);
                    u[j][2] = bflo(pg.y) * bflo(px.y); u[j][3] = bfhi(pg.y) * bfhi(px.y);
                    u[j][4] = bflo(pg.z) * bflo(px.z); u[j][5] = bfhi(pg.z) * bfhi(px.z);
                    u[j][6] = bflo(pg.w) * bflo(px.w); u[j][7] = bfhi(pg.w) * bfhi(px.w);
                } else {
#pragma unroll
                    for (int e = 0; e < 8; ++e) u[j][e] = 0.f;
                }
            }
            float sbv[8] = {bflo(pb.x), bfhi(pb.x), bflo(pb.y), bfhi(pb.y), bflo(pb.z), bfhi(pb.z), bflo(pb.w), bfhi(pb.w)};
            float o[8];
#pragma unroll
            for (int e = 0; e < 8; ++e)
                o[e] = sbv[e] * (cwr[0][e] * u[0][e] + cwr[1][e] * u[1][e] + cwr[2][e] * u[2][e]);
            uint4 po; po.x = pack2(o[0], o[1]); po.y = pack2(o[2], o[3]); po.z = pack2(o[4], o[5]); po.w = pack2(o[6], o[7]);
            *(uint4*)(OSC + (size_t)row * 512 + c8) = po;
        }
#undef CV_LOAD
    }
}

struct EpiRouter {
    static constexpr bool PERM = true;
    unsigned char* ws; const float* bias;
    struct Pre {};
    __device__ __forceinline__ void preload(const g8::Unit&, Pre&, int, int, int, int) const {}
    __device__ __forceinline__ void operator()(const f32x4 (&acc)[2][2][4][2], const g8::Unit& u, const Pre& pre, int wr, int wc, int fr, int fq) const {
        if (wc != 0) return;
        float* LG = (float*)(ws + WS_LOG);
#pragma unroll
        for (int n = 0; n < 2; ++n) {
            const f32x4 bv = *(const f32x4*)(bias + 8 * fq + 4 * n);
#pragma unroll
            for (int ai = 0; ai < 2; ++ai)
#pragma unroll
                for (int m = 0; m < 4; ++m) {
                    const size_t row = (size_t)(u.pm * 256 + ai * 128 + wr * 64 + m * 16 + fr);
                    *(f32x4*)(LG + row * 32 + 8 * fq + 4 * n) = acc[ai][0][m][n] + acc[ai][1][m][n] + bv;
                }
        }
    }
};
__device__ __forceinline__ void phase_router8(const Args& a, int l, char* smem, int tid, int bid, int nb) {
    SchedDense S;
    S.A = (const char*)(wsp(a) + WS_H2HI); S.B = (const char*)(wsp(a) + WS_RT) + (size_t)l * 256 * 2048 * 2;
    S.lda = 2048; S.ldb = 2048; S.nM = (l == 0) ? 72 : 64; S.nN = 1; S.G = nb; S.c = bid; S.skip9 = (l == 1);
    EpiRouter E; E.ws = wsp(a); E.bias = a.in[28] + l * 32;
    g8::gemm8((LAS unsigned char*)smem, S, E, 2048, tid);
}

constexpr int N_PHASES = 2 + 11 * NL;

__global__ void __launch_bounds__(NTHREADS, 2) fwd(Args a0) {
    extern __shared__ __attribute__((aligned(16))) char dyn_smem[];
    char* smem = dyn_smem + 16;
    const int tid = threadIdx.x, bid0 = blockIdx.x, nb0 = gridDim.x;
    const int wave_s = __builtin_amdgcn_readfirstlane(tid >> 6);
    const bool multi = (a0.ph_hi - a0.ph_lo) > 1;
    XcdBarrier bar;
    bar.bar = (unsigned*)(a0.ws + WS_CTL); bar.x = 0; bar.st = (volatile LAS unsigned*)dyn_smem;
    if (multi) {
        if (tid == 0) *(uint4*)dyn_smem = make_uint4(0u, 0u, 0u, 0u);
        __syncthreads();
        bar = xcd_barrier_post((unsigned*)(a0.ws + WS_CTL), (volatile LAS unsigned*)dyn_smem);
    }
#ifndef REP_MASK
#define REP_MASK 0u
#define REP_N 1
#endif
#ifndef PHASE_MASK
#define PHASE_MASK 0xFFFFFFFFu
#endif
#define RUN_PHASE(KIND, ID, CALL) do { if constexpr (((PHASE_MASK) >> (KIND)) & 1u) { const int _id = (ID); if (_id >= a0.ph_lo && _id < a0.ph_hi) { \
    for (int _r = 0; _r < ((((REP_MASK) >> (KIND)) & 1u) ? REP_N : 1); ++_r) { int tid = (wave_s << 6) | lane_id_(), bid = bid0, nb = nb0; const Args& a = a0; asm volatile("" : "+v"(tid), "+s"(bid), "+s"(nb)); CALL; } if (_id + 1 < a0.ph_hi) xcd_barrier(bar, wave_s); } } } while (0)
    RUN_PHASE(0, 0, phase_prep(a, smem, tid, bid, nb));
    RUN_PHASE(1, 1, phase_norm1_l0(a, tid, bid, nb));
    for (int l = 0; l < NL; ++l) {
        const int base = 2 + 11 * l;
        RUN_PHASE(2, base + 0, phase_gemm_in8(a, l, smem, tid, bid, nb));
        RUN_PHASE(3, base + 1, phase_stage2_8(a, l, smem, tid, bid, nb));
        RUN_PHASE(14, base + 2, phase_chunkpre(a, l, smem, tid, bid, nb));
        RUN_PHASE(4, base + 3, phase_mix(a, l, smem, tid, bid, nb));
        RUN_PHASE(5, base + 4, phase_post(a, l, tid, bid, nb));
        RUN_PHASE(6, base + 5, phase_merge8(a, l, smem, tid, bid, nb));
        RUN_PHASE(7, base + 6, phase_wout8(a, l, smem, tid, bid, nb));
        RUN_PHASE(8, base + 7, phase_n2rt(a, l, smem, tid, bid, nb));
        RUN_PHASE(11, base + 8, phase_gemm1_8(a, l, smem, tid, bid, nb));
        RUN_PHASE(12, base + 9, phase_gemm2_8(a, l, smem, tid, bid, nb));
        RUN_PHASE(13, base + 10, phase_combine(a, l, tid, bid, nb));
    }
}

extern "C" void kernel_launch(void* const* d_in, const int* in_sizes, int n_in,
                              void* d_out, int out_size, void* d_ws, size_t ws_size,
                              hipStream_t stream) {
    static int grid = 0;
    if (grid == 0) {
        if (n_in != 34 || ws_size < WS_END) { fprintf(stderr, "kernel_launch: bad inputs (n_in %d, ws %zu < %zu)\n", n_in, ws_size, (size_t)WS_END); grid = -1; return; }
        int dev = 0, cus = 0, per_cu = 0;
        hipGetDevice(&dev);
        hipDeviceGetAttribute(&cus, hipDeviceAttributeMultiprocessorCount, dev);
        if (hipFuncSetAttribute((const void*)fwd, hipFuncAttributeMaxDynamicSharedMemorySize, LDS_BYTES) != hipSuccess) { fprintf(stderr, "hipFuncSetAttribute failed\n"); grid = -1; return; }
        hipOccupancyMaxActiveBlocksPerMultiprocessor(&per_cu, (const void*)fwd, NTHREADS, LDS_BYTES);
        (void)hipGetLastError();
        if (per_cu < 1) per_cu = 1;
        grid = cus;
    }
    if (grid < 0) return;
    hipMemsetAsync((char*)d_ws + WS_CTL, 0, CTL_BYTES, stream);
    Args a{};
    for (int i = 0; i < 34; ++i) a.in[i] = (const float*)d_in[i];
    a.out = (float*)d_out; a.ws = (unsigned char*)d_ws;
#if N_LAUNCH_MODE == 1
    a.ph_lo = 0; a.ph_hi = N_PHASES;
    hipLaunchKernelGGL(fwd, dim3(grid), dim3(NTHREADS), LDS_BYTES, stream, a);
#else
    for (int p = 0; p < N_PHASES; ++p) {
        a.ph_lo = p; a.ph_hi = p + 1;
        hipLaunchKernelGGL(fwd, dim3(grid), dim3(NTHREADS), LDS_BYTES, stream, a);
    }
#endif
}
```
